# Optimizing an MI355X kernel written in HIP

```python
import math
import jax, jax.numpy as jnp
from jax import lax
import numpy as np

D_MODEL = 4096
BATCH = 1
SEQ = 8192
DEPTH = 1

DIFF_HEADS = 16
DIFF_HEAD_DIM = 64
DIFF_V_DIM = 2 * DIFF_HEAD_DIM
DIFF_SUBLN_EPS = 1e-5
MLA_HEADS = 16
MLA_Q_RANK = 1024
MLA_KV_RANK = 512
MLA_NOPE_DIM = 128
MLA_ROPE_DIM = 64
MLA_V_DIM = 128
MLA_QK_DIM = MLA_NOPE_DIM + MLA_ROPE_DIM
D_FF = 11008
CONV_WIDTH = 3
ROPE_THETA = 10000.0
NORM_EPS = 1e-6
Q_BLOCK = 128

DIFF_Q_W = DIFF_HEADS * 2 * DIFF_HEAD_DIM
DIFF_K_W = DIFF_HEADS * 2 * DIFF_HEAD_DIM
DIFF_V_W = DIFF_HEADS * DIFF_V_DIM
GATE_W = D_MODEL
IN_WIDTHS = (DIFF_Q_W, DIFF_K_W, DIFF_V_W, MLA_Q_RANK, MLA_KV_RANK, MLA_ROPE_DIM, GATE_W, GATE_W)
IN_W = sum(IN_WIDTHS)
IN_SPLITS = tuple(int(v) for v in np.cumsum(IN_WIDTHS)[:-1])
DIFF_OUT_W = DIFF_HEADS * DIFF_V_DIM
MLA_OUT_W = MLA_HEADS * MLA_V_DIM

kernel_name = "hybrid_diffattn_mla_convffn"


def rmsnorm(x, w, eps=NORM_EPS):
    xf = x.astype(jnp.float32)
    y = xf * lax.rsqrt(jnp.mean(xf * xf, axis=-1, keepdims=True) + eps)
    return (y * w.astype(jnp.float32)).astype(x.dtype)


def rope_cos_sin(positions, dim):
    inv_freq = ROPE_THETA ** (-jnp.arange(0, dim, 2, dtype=jnp.float32) / dim)
    ang = positions.astype(jnp.float32)[..., None] * inv_freq
    return jnp.cos(ang), jnp.sin(ang)


def apply_rope(x, cos, sin):
    xf = x.astype(jnp.float32)
    half = xf.shape[-1] // 2
    x1, x2 = xf[..., :half], xf[..., half:]
    c, s = cos[:, :, None, :], sin[:, :, None, :]
    return jnp.concatenate([x1 * c - x2 * s, x2 * c + x1 * s], axis=-1).astype(x.dtype)


def diff_attention(q, k, v, lam):
    B, S = q.shape[0], q.shape[1]
    nb = S // Q_BLOCK
    scale = DIFF_HEAD_DIM ** -0.5
    qb = q.reshape(B, nb, Q_BLOCK, DIFF_HEADS, 2, DIFF_HEAD_DIM).transpose(1, 0, 3, 4, 2, 5)
    kt = k.transpose(0, 2, 3, 1, 4)
    vt = v.transpose(0, 2, 1, 3)
    key_idx = jnp.arange(S)

    def block(args):
        q_blk, start = args
        s = jnp.einsum('bhcqd,bhckd->bhcqk', q_blk, kt).astype(jnp.float32) * scale
        mask = (start + jnp.arange(Q_BLOCK))[:, None] >= key_idx[None, :]
        s = jnp.where(mask, s, -jnp.inf)
        p = jax.nn.softmax(s, axis=-1)
        p = p[:, :, 0] - lam * p[:, :, 1]
        return jnp.einsum('bhqk,bhkd->bhqd', p.astype(vt.dtype), vt)

    o = lax.map(block, (qb, jnp.arange(nb) * Q_BLOCK))
    return o.transpose(1, 0, 3, 2, 4).reshape(B, S, DIFF_HEADS, DIFF_V_DIM)


def mla_attention(q_nope, q_rope, k_nope, k_rope, v):
    B, S = q_nope.shape[0], q_nope.shape[1]
    nb = S // Q_BLOCK
    scale = MLA_QK_DIM ** -0.5
    qn = q_nope.reshape(B, nb, Q_BLOCK, MLA_HEADS, MLA_NOPE_DIM).transpose(1, 0, 3, 2, 4)
    qr = q_rope.reshape(B, nb, Q_BLOCK, MLA_HEADS, MLA_ROPE_DIM).transpose(1, 0, 3, 2, 4)
    kn = k_nope.transpose(0, 2, 1, 3)
    vt = v.transpose(0, 2, 1, 3)
    key_idx = jnp.arange(S)

    def block(args):
        qn_blk, qr_blk, start = args
        s = (jnp.einsum('bhqd,bhkd->bhqk', qn_blk, kn).astype(jnp.float32)
             + jnp.einsum('bhqr,bkr->bhqk', qr_blk, k_rope).astype(jnp.float32)) * scale
        mask = (start + jnp.arange(Q_BLOCK))[:, None] >= key_idx[None, :]
        p = jax.nn.softmax(jnp.where(mask, s, -jnp.inf), axis=-1)
        return jnp.einsum('bhqk,bhkd->bhqd', p.astype(vt.dtype), vt)

    o = lax.map(block, (qn, qr, jnp.arange(nb) * Q_BLOCK))
    return o.transpose(1, 0, 3, 2, 4).reshape(B, S, MLA_HEADS, MLA_V_DIM)


def causal_depthwise_conv(u, w, b):
    S = u.shape[1]
    up = jnp.pad(u, ((0, 0), (CONV_WIDTH - 1, 0), (0, 0)))
    out = b
    for j in range(CONV_WIDTH):
        out = out + w[j] * up[:, j:j + S]
    return out


def setup_inputs(seed: int = 0) -> dict:
    key = jax.random.key(seed)
    ks = jax.random.split(key, 24)
    f32 = jnp.float32

    def dense(k, shape, fan_in):
        return jax.random.normal(k, shape, f32) * (fan_in ** -0.5)

    def gain(k, shape):
        return 1.0 + 0.01 * jax.random.normal(k, shape, f32)

    L = DEPTH
    x = jax.random.normal(ks[0], (BATCH, SEQ, D_MODEL), f32)
    positions = jnp.broadcast_to(jnp.arange(SEQ, dtype=jnp.int32), (BATCH, SEQ))
    return {
        "x": x,
        "positions": positions,
        "norm_mix_w": gain(ks[1], (L, D_MODEL)),
        "w_in": dense(ks[2], (L, D_MODEL, IN_W), D_MODEL),
        "diff_lambda_q1": 0.1 * jax.random.normal(ks[3], (L, DIFF_HEAD_DIM), f32),
        "diff_lambda_k1": 0.1 * jax.random.normal(ks[4], (L, DIFF_HEAD_DIM), f32),
        "diff_lambda_q2": 0.1 * jax.random.normal(ks[5], (L, DIFF_HEAD_DIM), f32),
        "diff_lambda_k2": 0.1 * jax.random.normal(ks[6], (L, DIFF_HEAD_DIM), f32),
        "diff_subln_w": gain(ks[7], (L, DIFF_V_DIM)),
        "mla_q_norm_w": gain(ks[8], (L, MLA_Q_RANK)),
        "mla_w_uq": dense(ks[9], (L, MLA_Q_RANK, MLA_HEADS * MLA_QK_DIM), MLA_Q_RANK),
        "mla_kv_norm_w": gain(ks[10], (L, MLA_KV_RANK)),
        "mla_w_ukv": dense(ks[11], (L, MLA_KV_RANK, MLA_HEADS * (MLA_NOPE_DIM + MLA_V_DIM)), MLA_KV_RANK),
        "w_o_diff": dense(ks[12], (L, DIFF_OUT_W, D_MODEL), DIFF_OUT_W),
        "w_o_mla": dense(ks[13], (L, MLA_OUT_W, D_MODEL), MLA_OUT_W),
        "w_out": dense(ks[14], (L, D_MODEL, D_MODEL), D_MODEL),
        "norm_ffn_w": gain(ks[15], (L, D_MODEL)),
        "ffn_w_up": dense(ks[16], (L, D_MODEL, 2 * D_FF), D_MODEL),
        "ffn_conv_w": dense(ks[17], (L, CONV_WIDTH, 2 * D_FF), CONV_WIDTH),
        "ffn_conv_b": 0.01 * jax.random.normal(ks[18], (L, 2 * D_FF), f32),
        "ffn_w_down": dense(ks[19], (L, D_FF, D_MODEL), D_FF),
        "final_norm_w": gain(ks[20], (D_MODEL,)),
    }


def reference(x, positions, norm_mix_w, w_in, diff_lambda_q1, diff_lambda_k1, diff_lambda_q2,
              diff_lambda_k2, diff_subln_w, mla_q_norm_w, mla_w_uq, mla_kv_norm_w, mla_w_ukv,
              w_o_diff, w_o_mla, w_out, norm_ffn_w, ffn_w_up, ffn_conv_w, ffn_conv_b,
              ffn_w_down, final_norm_w):
    B, S = x.shape[0], x.shape[1]
    cos_d, sin_d = rope_cos_sin(positions, DIFF_HEAD_DIM)
    cos_r, sin_r = rope_cos_sin(positions, MLA_ROPE_DIM)

    for l in range(DEPTH):
        h = rmsnorm(x, norm_mix_w[l])
        z = h @ w_in[l]
        q_d, k_d, v_d, c_q, c_kv, k_r, g_d, g_m = jnp.split(z, IN_SPLITS, axis=-1)

        q_d = apply_rope(q_d.reshape(B, S, 2 * DIFF_HEADS, DIFF_HEAD_DIM), cos_d, sin_d)
        k_d = apply_rope(k_d.reshape(B, S, 2 * DIFF_HEADS, DIFF_HEAD_DIM), cos_d, sin_d)
        q_d = q_d.reshape(B, S, DIFF_HEADS, 2, DIFF_HEAD_DIM)
        k_d = k_d.reshape(B, S, DIFF_HEADS, 2, DIFF_HEAD_DIM)
        v_d = v_d.reshape(B, S, DIFF_HEADS, DIFF_V_DIM)
        lambda_init = 0.8 - 0.6 * math.exp(-0.3 * l)
        lam = (jnp.exp(jnp.sum(diff_lambda_q1[l].astype(jnp.float32) * diff_lambda_k1[l].astype(jnp.float32)))
               - jnp.exp(jnp.sum(diff_lambda_q2[l].astype(jnp.float32) * diff_lambda_k2[l].astype(jnp.float32)))
               + lambda_init)
        o_d = diff_attention(q_d, k_d, v_d, lam)
        o_d = rmsnorm(o_d, diff_subln_w[l], DIFF_SUBLN_EPS) * (1.0 - lambda_init)
        o_d = o_d.reshape(B, S, DIFF_OUT_W)

        cq = rmsnorm(c_q, mla_q_norm_w[l])
        q_m = (cq @ mla_w_uq[l]).reshape(B, S, MLA_HEADS, MLA_QK_DIM)
        q_nope, q_rope = q_m[..., :MLA_NOPE_DIM], apply_rope(q_m[..., MLA_NOPE_DIM:], cos_r, sin_r)
        ckv = rmsnorm(c_kv, mla_kv_norm_w[l])
        kv = (ckv @ mla_w_ukv[l]).reshape(B, S, MLA_HEADS, MLA_NOPE_DIM + MLA_V_DIM)
        k_nope, v_m = kv[..., :MLA_NOPE_DIM], kv[..., MLA_NOPE_DIM:]
        k_rope = apply_rope(k_r[:, :, None, :], cos_r, sin_r)[:, :, 0, :]
        o_m = mla_attention(q_nope, q_rope, k_nope, k_rope, v_m).reshape(B, S, MLA_OUT_W)

        y = (jax.nn.sigmoid(g_d) * (o_d @ w_o_diff[l])
             + jax.nn.sigmoid(g_m) * (o_m @ w_o_mla[l]))
        x = x + y @ w_out[l]

        h = rmsnorm(x, norm_ffn_w[l])
        u = causal_depthwise_conv(h @ ffn_w_up[l], ffn_conv_w[l], ffn_conv_b[l])
        gate, val = u[..., :D_FF], u[..., D_FF:]
        x = x + (jax.nn.silu(gate) * val) @ ffn_w_down[l]

    return rmsnorm(x, final_norm_w)
```

```cpp
#include <hip/hip_runtime.h>
#include <hip/hip_bf16.h>
#include <cstdio>
#include <cstdint>

#ifndef MK_PER_PHASE
#define MK_PER_PHASE 0
#endif

constexpr int S = 8192, DM = 4096, NHEAD = 16;
constexpr int INW = 15936, ZW = 16128;
constexpr int ZC_QD = 0, ZC_KD = 2048, ZC_VD = 4096, ZC_CQ = 6144, ZC_CKV = 7168, ZC_KR = 7680, ZC_GD = 7936, ZC_GM = 12032;
constexpr int QRANK = 1024, KVRANK = 512;
constexpr int QMW = 3072, KVW = 4096;
constexpr int DFF = 11008, UPW = 22016;
constexpr float NORM_EPS = 1e-6f, SUBLN_EPS = 1e-5f, LAMBDA_INIT = 0.2f;

#define GAS __attribute__((address_space(1)))
#define LAS __attribute__((address_space(3)))
typedef unsigned short bf16;
typedef unsigned v4u __attribute__((ext_vector_type(4)));
typedef GAS unsigned gu32;
#define RLX_AGENT __ATOMIC_RELAXED, __HIP_MEMORY_SCOPE_AGENT
#define LDS_WAIT() asm volatile("s_waitcnt lgkmcnt(0)" ::: "memory")
#define VM_WAIT() asm volatile("s_waitcnt vmcnt(0)" ::: "memory")

namespace pg8 {
#define PG8_LAS __attribute__((address_space(3)))
typedef unsigned short bf16_t;
typedef short bf16x8 __attribute__((ext_vector_type(8)));
typedef float f32x4 __attribute__((ext_vector_type(4)));
typedef unsigned u32x4 __attribute__((ext_vector_type(4)));
constexpr int BM = 256, BK = 64, HALF = 128, HTB = HALF * BK * 2, STAGE_BYTES = 8 * HTB, NXCD = 8, WGM = 8;

__host__ __device__ __forceinline__ int lds_byte(int r, int c) { const int st = (r >> 4) * 2 + (c >> 5), rr = r & 15, cc = c & 31, ob = rr * 64 + cc * 2; return st * 1024 + (ob ^ (((ob >> 9) & 1) << 5)); }
__host__ __device__ __forceinline__ void stage_rc(int b, int& R, int& C) { const int st = b / 1024, sb = b % 1024, swz = sb ^ (((sb >> 9) & 1) << 5); R = (st >> 1) * 16 + swz / 64; C = (st & 1) * 32 + (swz % 64) / 2; }
__host__ __device__ __forceinline__ int perm32(int rho) { const int n = rho >> 4, i = rho & 15; return 8 * (i >> 2) + 4 * n + (i & 3); }

struct Unit { int pm, pn; };
struct Gemm { const bf16_t* A; const bf16_t* Bt; int M, N, K, lda, ldb; };

struct StaticOrder {
    int nM, nN, nwg, G, c;
    __host__ __device__ void init(int M, int N, int G_, int c_) { nM = M / BM; nN = N / BM; nwg = nM * nN; G = G_; c = c_; }
    __host__ __device__ bool next(int i, Unit& u) const {
        const long L = (long)i * G + c; if (L >= nwg) return false;
        int wgid = (int)L; { const int q = nwg / NXCD, r = nwg % NXCD, xcd = wgid % NXCD, off = wgid / NXCD; wgid = (xcd < r ? xcd * (q + 1) : r * (q + 1) + (xcd - r) * q) + off; }
        const int nig = WGM * nN, gid = wgid / nig, fm = gid * WGM, gsz = (nM - fm) < WGM ? (nM - fm) : WGM;
        u.pm = fm + ((wgid % nig) % gsz); u.pn = (wgid % nig) / gsz; return true;
    }
    __device__ __forceinline__ void a_ready(const Unit&) const {}
    __device__ __forceinline__ void done(const Unit&) const {}
};

typedef float f32x2_t __attribute__((ext_vector_type(2))); typedef __bf16 bf16x2_t __attribute__((ext_vector_type(2)));
__device__ __forceinline__ unsigned cvt_pk_bf16(float lo, float hi) { f32x2_t v = {lo, hi}; bf16x2_t b = __builtin_convertvector(v, bf16x2_t); return __builtin_bit_cast(unsigned, b); }
__device__ __forceinline__ u32x4 pack8(f32x4 a, f32x4 b) { u32x4 w; w.x = cvt_pk_bf16(a[0], a[1]); w.y = cvt_pk_bf16(a[2], a[3]); w.z = cvt_pk_bf16(b[0], b[1]); w.w = cvt_pk_bf16(b[2], b[3]); return w; }
__device__ __forceinline__ void unpack8(u32x4 w, f32x4& a, f32x4& b) {
    a[0] = __uint_as_float(w.x << 16); a[1] = __uint_as_float(w.x & 0xffff0000u); a[2] = __uint_as_float(w.y << 16); a[3] = __uint_as_float(w.y & 0xffff0000u);
    b[0] = __uint_as_float(w.z << 16); b[1] = __uint_as_float(w.z & 0xffff0000u); b[2] = __uint_as_float(w.w << 16); b[3] = __uint_as_float(w.w & 0xffff0000u); }
__device__ __forceinline__ float sigmoidf_fast(float v) { return __builtin_amdgcn_rcpf(1.0f + __builtin_amdgcn_exp2f(-1.4426950408889634f * v)); }
__device__ __forceinline__ void rope8(f32x4& v0, f32x4& v1, const f32x4 c4, const f32x4 s4) {
    const f32x4 a = v0, b = v1;
    v0[0] = a[0] * c4[0] - a[1] * s4[0]; v0[1] = a[1] * c4[0] + a[0] * s4[0]; v0[2] = a[2] * c4[1] - a[3] * s4[1]; v0[3] = a[3] * c4[1] + a[2] * s4[1];
    v1[0] = b[0] * c4[2] - b[1] * s4[2]; v1[1] = b[1] * c4[2] + b[0] * s4[2]; v1[2] = b[2] * c4[3] - b[3] * s4[3]; v1[3] = b[3] * c4[3] + b[2] * s4[3];
}
__device__ __forceinline__ float sumsq8(const f32x4 a, const f32x4 b) { return (a[0] * a[0] + a[1] * a[1]) + (a[2] * a[2] + a[3] * a[3]) + (b[0] * b[0] + b[1] * b[1]) + (b[2] * b[2] + b[3] * b[3]); }

#define EPI_ROWS(ai, m) _Pragma("unroll") for (int ai = 0; ai < 2; ++ai) _Pragma("unroll") for (int m = 0; m < 4; ++m)

struct EpiIn {
    static constexpr bool PERM = true, AFTER_DRAIN = false;
    bf16_t* Z; const float* cosT; const float* sinT; float* ssq;
    __device__ __forceinline__ void operator()(const f32x4 (&acc)[2][2][4][2], const Unit& u, int wr, int wc, int fr, int fq) const {
        const int pn = u.pn, row0 = u.pm * BM + wr * 64 + fr, col0 = pn * BM + wc * 32 + 8 * fq;
        if (pn < 16 || pn == 30) {
            const int i0 = 16 * (wc & 1) + 4 * fq;
            EPI_ROWS(ai, m) { const int r = row0 + ai * HALF + m * 16; const f32x4 c4 = *(const f32x4*)(cosT + (size_t)r * 32 + i0), s4 = *(const f32x4*)(sinT + (size_t)r * 32 + i0);
                bf16_t* rowp = Z + (size_t)r * ZW + col0;
#pragma unroll
                for (int bj = 0; bj < 2; ++bj) { f32x4 v0 = acc[ai][bj][m][0], v1 = acc[ai][bj][m][1]; rope8(v0, v1, c4, s4); *(u32x4*)(rowp + bj * HALF) = pack8(v0, v1); } }
        } else if (pn < 24) {
            EPI_ROWS(ai, m) { const int r = row0 + ai * HALF + m * 16; bf16_t* rowp = Z + (size_t)r * ZW + col0;
#pragma unroll
                for (int bj = 0; bj < 2; ++bj) *(u32x4*)(rowp + bj * HALF) = pack8(acc[ai][bj][m][0], acc[ai][bj][m][1]); }
        } else if (pn < 30) {
            EPI_ROWS(ai, m) { const int r = row0 + ai * HALF + m * 16; bf16_t* rowp = Z + (size_t)r * ZW + col0; float ss = 0.f;
#pragma unroll
                for (int bj = 0; bj < 2; ++bj) { ss += sumsq8(acc[ai][bj][m][0], acc[ai][bj][m][1]); *(u32x4*)(rowp + bj * HALF) = pack8(acc[ai][bj][m][0], acc[ai][bj][m][1]); }
                ss += __shfl_xor(ss, 16); ss += __shfl_xor(ss, 32);
                if (fq == 0) ssq[(size_t)r * 24 + (pn - 24) * 4 + wc] = ss; }
        } else {
            EPI_ROWS(ai, m) { const int r = row0 + ai * HALF + m * 16; bf16_t* rowp = Z + (size_t)r * ZW + col0;
#pragma unroll
                for (int bj = 0; bj < 2; ++bj) { f32x4 v0 = acc[ai][bj][m][0], v1 = acc[ai][bj][m][1];
#pragma unroll
                    for (int e = 0; e < 4; ++e) { v0[e] = sigmoidf_fast(v0[e]); v1[e] = sigmoidf_fast(v1[e]); }
                    *(u32x4*)(rowp + bj * HALF) = pack8(v0, v1); } }
        }
    }
};

template <int SLOT0, int NP4, int KDIM> struct EpiMla {
    static constexpr bool PERM = true, AFTER_DRAIN = false;
    bf16_t* O; int ldc; const float* ssq; const float* cosT; const float* sinT; int rope_from;
    __device__ __forceinline__ void operator()(const f32x4 (&acc)[2][2][4][2], const Unit& u, int wr, int wc, int fr, int fq) const {
        const int pn = u.pn, row0 = u.pm * BM + wr * 64 + fr, col0 = pn * BM + wc * 32 + 8 * fq, i0 = 16 * (wc & 1) + 4 * fq;
        const bool rope = pn >= rope_from;
        EPI_ROWS(ai, m) { const int r = row0 + ai * HALF + m * 16; float ss = 0.f;
#pragma unroll
            for (int q = 0; q < NP4; ++q) { const f32x4 p = *(const f32x4*)(ssq + (size_t)r * 24 + SLOT0 + 4 * q); ss += (p[0] + p[1]) + (p[2] + p[3]); }
            const float rs = __builtin_amdgcn_rsqf(ss * (1.0f / KDIM) + NORM_EPS);
            f32x4 c4 = {1.f, 1.f, 1.f, 1.f}, s4 = {0.f, 0.f, 0.f, 0.f};
            if (rope) { c4 = *(const f32x4*)(cosT + (size_t)r * 32 + i0); s4 = *(const f32x4*)(sinT + (size_t)r * 32 + i0); }
            bf16_t* rowp = O + (size_t)r * ldc + col0;
#pragma unroll
            for (int bj = 0; bj < 2; ++bj) { f32x4 v0 = acc[ai][bj][m][0] * rs, v1 = acc[ai][bj][m][1] * rs; if (rope) rope8(v0, v1, c4, s4); *(u32x4*)(rowp + bj * HALF) = pack8(v0, v1); } }
    }
};

template <bool SECOND> struct EpiGate {
    static constexpr bool PERM = true, AFTER_DRAIN = false;
    const bf16_t* G; float* T1; bf16_t* Y;
    __device__ __forceinline__ void operator()(const f32x4 (&acc)[2][2][4][2], const Unit& u, int wr, int wc, int fr, int fq) const {
        const int row0 = u.pm * BM + wr * 64 + fr, col0 = u.pn * BM + wc * 32 + 8 * fq;
        EPI_ROWS(ai, m) { const int r = row0 + ai * HALF + m * 16;
#pragma unroll
            for (int bj = 0; bj < 2; ++bj) { const int c = col0 + bj * HALF; f32x4 g0, g1; unpack8(*(const u32x4*)(G + (size_t)r * ZW + c), g0, g1);
                f32x4 v0 = acc[ai][bj][m][0] * g0, v1 = acc[ai][bj][m][1] * g1; float* tp = T1 + (size_t)r * DM + c;
                if (SECOND) { v0 += *(const f32x4*)tp; v1 += *(const f32x4*)(tp + 4); *(u32x4*)(Y + (size_t)r * DM + c) = pack8(v0, v1); }
                else { *(f32x4*)tp = v0; *(f32x4*)(tp + 4) = v1; } } }
    }
};

template <bool WITH_BF16> struct EpiRes {
    static constexpr bool PERM = true, AFTER_DRAIN = false;
    const float* xi; float* xo; bf16_t* xb; float* ssq;
    __device__ __forceinline__ void operator()(const f32x4 (&acc)[2][2][4][2], const Unit& u, int wr, int wc, int fr, int fq) const {
        const int row0 = u.pm * BM + wr * 64 + fr, col0 = u.pn * BM + wc * 32 + 8 * fq;
        EPI_ROWS(ai, m) { const int r = row0 + ai * HALF + m * 16; float ss = 0.f;
#pragma unroll
            for (int bj = 0; bj < 2; ++bj) { const size_t off = (size_t)r * DM + col0 + bj * HALF;
                const f32x4 v0 = acc[ai][bj][m][0] + *(const f32x4*)(xi + off), v1 = acc[ai][bj][m][1] + *(const f32x4*)(xi + off + 4);
                *(f32x4*)(xo + off) = v0; *(f32x4*)(xo + off + 4) = v1; if (WITH_BF16) *(u32x4*)(xb + off) = pack8(v0, v1); ss += sumsq8(v0, v1); }
            ss += __shfl_xor(ss, 16); ss += __shfl_xor(ss, 32);
            if (fq == 0) ssq[(size_t)r * 64 + u.pn * 4 + wc] = ss; }
    }
};

struct EpiPlain {
    static constexpr bool PERM = true, AFTER_DRAIN = false;
    bf16_t* O; int ldc;
    __device__ __forceinline__ void operator()(const f32x4 (&acc)[2][2][4][2], const Unit& u, int wr, int wc, int fr, int fq) const {
        const int row0 = u.pm * BM + wr * 64 + fr, col0 = u.pn * BM + wc * 32 + 8 * fq;
        EPI_ROWS(ai, m) { bf16_t* rowp = O + (size_t)(row0 + ai * HALF + m * 16) * ldc + col0;
#pragma unroll
            for (int bj = 0; bj < 2; ++bj) *(u32x4*)(rowp + bj * HALF) = pack8(acc[ai][bj][m][0], acc[ai][bj][m][1]); }
    }
};

template <class Epi, class Sched, bool ALIGN_EPI>
__device__ __forceinline__ void gemm_phase(PG8_LAS unsigned char* lds, const Gemm g, const Sched& S, const Epi& E) {
    const int tid = threadIdx.x, wid = __builtin_amdgcn_readfirstlane(tid >> 6), lane = tid & 63, wr = wid >> 2, wc = wid & 3, fr = lane & 15, fq = lane >> 4;
    const int K = g.K, nt = K / BK;
    unsigned voffA[2], voffB[2];
#pragma unroll
    for (int i = 0; i < 2; ++i) { int R, C; stage_rc(tid * 16 + i * 8192, R, C); const int Rb = Epi::PERM ? ((R & ~31) + perm32(R & 31)) : R;
        voffA[i] = (unsigned)(R * g.lda + C) * 2u; voffB[i] = (unsigned)(Rb * g.ldb + C) * 2u; }
    const size_t kstep = (size_t)(BK * 2);
    const size_t hstepA = (size_t)HALF * g.lda * 2, hstepB = (size_t)HALF * g.ldb * 2;
    const size_t tstepA = 2 * hstepA, tstepB = 2 * hstepB;
    const unsigned ldsw = (unsigned)wid * 1024u;
    const int aoff = lds_byte(wr * 64 + fr, fq * 8), boff = lds_byte(wc * 32 + fr, fq * 8);
#define PG8_SA(b, h) (((b) * 2 + (h)) * HTB)
#define PG8_SB(b, h) ((4 + (b) * 2 + (h)) * HTB)
#define PG8_STAGE(bufoff, gbase, voff) do { _Pragma("unroll") for (int _i = 0; _i < 2; ++_i) \
        __builtin_amdgcn_global_load_lds((const unsigned*)((const char*)(gbase) + (voff)[_i]), (PG8_LAS unsigned*)(lds + (bufoff) + ldsw + _i * 8192), 16, 0, 0); } while (0)
#define PG8_LDA(dst, b, h) do { _Pragma("unroll") for (int m = 0; m < 4; ++m) _Pragma("unroll") for (int k = 0; k < 2; ++k) dst[m][k] = *(const PG8_LAS bf16x8*)(lds + PG8_SA(b, h) + aoff + m * 2048 + k * 1024); } while (0)
#define PG8_LDB(dst, b, h) do { _Pragma("unroll") for (int n = 0; n < 2; ++n) _Pragma("unroll") for (int k = 0; k < 2; ++k) dst[n][k] = *(const PG8_LAS bf16x8*)(lds + PG8_SB(b, h) + boff + n * 2048 + k * 1024); } while (0)
#define PG8_MMA(ai, bj, At, Bt) do { __builtin_amdgcn_s_setprio(1); _Pragma("unroll") for (int m = 0; m < 4; ++m) _Pragma("unroll") for (int n = 0; n < 2; ++n) _Pragma("unroll") for (int k = 0; k < 2; ++k) \
        acc[ai][bj][m][n] = __builtin_amdgcn_mfma_f32_16x16x32_bf16(Bt[n][k], At[m][k], acc[ai][bj][m][n], 0, 0, 0); __builtin_amdgcn_s_setprio(0); } while (0)
#define PG8_WAIT_V(n) asm volatile("s_waitcnt vmcnt(" #n ")" ::: "memory")
#define PG8_WAIT_L(n) asm volatile("s_waitcnt lgkmcnt(" #n ")" ::: "memory")
#define PG8_BAR __builtin_amdgcn_s_barrier()
#define PG8_SCHED __builtin_amdgcn_sched_barrier(0)
    Unit cur, nxt; int ui = 0;
    if (!S.next(0, cur)) return;
    f32x4 acc[2][2][4][2];
#pragma unroll
    for (int a = 0; a < 2; ++a)
#pragma unroll
        for (int b = 0; b < 2; ++b)
#pragma unroll
            for (int m = 0; m < 4; ++m)
#pragma unroll
                for (int n = 0; n < 2; ++n) acc[a][b][m][n] = (f32x4){0.f, 0.f, 0.f, 0.f};
    bf16x8 At[4][2], B0[2][2], B1[2][2];
    const char* cA = (const char*)g.A + (size_t)cur.pm * tstepA; const char* cB = (const char*)g.Bt + (size_t)cur.pn * tstepB;
    S.a_ready(cur);
    PG8_STAGE(PG8_SB(0, 0), cB, voffB); PG8_STAGE(PG8_SB(0, 1), cB + hstepB, voffB); PG8_STAGE(PG8_SA(0, 0), cA, voffA); PG8_STAGE(PG8_SA(0, 1), cA + hstepA, voffA);
    if (wr == 1) PG8_BAR;
    PG8_WAIT_V(2); PG8_BAR;
    PG8_STAGE(PG8_SB(1, 0), cB + kstep, voffB); PG8_STAGE(PG8_SA(1, 0), cA + kstep, voffA); PG8_STAGE(PG8_SB(1, 1), cB + hstepB + kstep, voffB);
    PG8_WAIT_V(6); PG8_BAR;
    for (;;) {
        const bool has_next = S.next(ui + 1, nxt);
        const char* nA = has_next ? (const char*)g.A + (size_t)nxt.pm * tstepA : cA; const char* nB = has_next ? (const char*)g.Bt + (size_t)nxt.pn * tstepB : cB;
        for (int t = 0; t < nt; t += 2) {
            const bool last = (t == nt - 2);
            const char* a1 = cA + (size_t)(t + 1) * kstep;
            const char* a2 = last ? nA : cA + (size_t)(t + 2) * kstep; const char* b2 = last ? nB : cB + (size_t)(t + 2) * kstep;
            const char* a3 = a2 + kstep; const char* b3 = b2 + kstep;
            if (last && has_next) S.a_ready(nxt);
            PG8_LDB(B0, 0, 0); PG8_LDB(B1, 0, 1); PG8_SCHED; PG8_LDA(At, 0, 0); PG8_STAGE(PG8_SA(1, 1), a1 + hstepA, voffA);
            PG8_WAIT_V(8); PG8_WAIT_L(0); PG8_BAR; PG8_MMA(0, 0, At, B0); PG8_MMA(0, 1, At, B1); PG8_BAR; PG8_SCHED;
            PG8_LDA(At, 0, 1); PG8_STAGE(PG8_SB(0, 0), b2, voffB); PG8_STAGE(PG8_SB(0, 1), b2 + hstepB, voffB); PG8_STAGE(PG8_SA(0, 0), a2, voffA);
            PG8_WAIT_V(8); PG8_WAIT_L(0); PG8_BAR; PG8_MMA(1, 0, At, B0); PG8_MMA(1, 1, At, B1); PG8_BAR; PG8_SCHED;
            PG8_LDB(B0, 1, 0); PG8_LDB(B1, 1, 1); PG8_SCHED; PG8_LDA(At, 1, 0); PG8_STAGE(PG8_SA(0, 1), a2 + hstepA, voffA);
            PG8_WAIT_V(8); PG8_WAIT_L(0); PG8_BAR; PG8_MMA(0, 0, At, B0); PG8_MMA(0, 1, At, B1); PG8_BAR; PG8_SCHED;
            PG8_LDA(At, 1, 1); PG8_STAGE(PG8_SB(1, 0), b3, voffB); PG8_STAGE(PG8_SB(1, 1), b3 + hstepB, voffB); PG8_STAGE(PG8_SA(1, 0), a3, voffA);
            PG8_WAIT_V(8); PG8_WAIT_L(0); PG8_BAR; PG8_MMA(1, 0, At, B0); PG8_MMA(1, 1, At, B1); PG8_BAR; PG8_SCHED;
        }
        if constexpr (ALIGN_EPI) { if (wr == 0) PG8_BAR; }
        E(acc, cur, wr, wc, fr, fq); S.done(cur);
        if (!has_next) break;
#pragma unroll
        for (int a = 0; a < 2; ++a)
#pragma unroll
            for (int b = 0; b < 2; ++b)
#pragma unroll
                for (int m = 0; m < 4; ++m)
#pragma unroll
                    for (int n = 0; n < 2; ++n) acc[a][b][m][n] = (f32x4){0.f, 0.f, 0.f, 0.f};
        cur = nxt; cA = nA; cB = nB; ++ui;
        if constexpr (ALIGN_EPI) { if (wr == 1) PG8_BAR; }
    }
    PG8_WAIT_V(0);
    if constexpr (!ALIGN_EPI) { if (wr == 0) PG8_BAR; }
    PG8_BAR;
#undef PG8_SA
#undef PG8_SB
#undef PG8_STAGE
#undef PG8_LDA
#undef PG8_LDB
#undef PG8_MMA
#undef PG8_WAIT_V
#undef PG8_WAIT_L
#undef PG8_BAR
#undef PG8_SCHED
}
}

namespace att {
typedef unsigned short bf16_t;
typedef short bf16x8 __attribute__((ext_vector_type(8)));
typedef short s16x4 __attribute__((ext_vector_type(4)));
typedef float f32x16 __attribute__((ext_vector_type(16)));
typedef float f32x4 __attribute__((ext_vector_type(4)));
typedef unsigned u32x4 __attribute__((ext_vector_type(4)));
constexpr int NW = 8, QBLK = 32, KVBLK = 64, QB = NW * QBLK;
constexpr int SHM_V = KVBLK * 128 * 2, SHM_K = KVBLK * 128 * 2, SHM_R = KVBLK * 64 * 2;
constexpr int QROW = 272, QWAVE = 32 * QROW;
constexpr int OFF_V = 0, OFF_K = 2 * SHM_V, OFF_R = OFF_K + 2 * SHM_K, OFF_WS = OFF_R + 2 * SHM_R, OFF_Q = OFF_WS + NW * 64 * 4, ATT_LDS = OFF_Q + NW * QWAVE;
constexpr float THR = 8.f;
constexpr int STG_ROW = 132, STG_WAVE = 32 * STG_ROW * 4;
static_assert(NW * STG_WAVE <= 155648, "staging");

#define KSWZ(row, colB) ((row) * 256 + ((colB) ^ (((row) & 7) << 4)))
#define RSWZ(row, chunk) ((row) * 128 + ((((chunk) ^ (((row) >> 1) & 7))) << 4))
#define SBAR() __builtin_amdgcn_sched_barrier(0)
__device__ __forceinline__ int v_rd_base(int lane) { return ((lane & 3) << 3) | (((lane >> 2) & 3) << 6) | (((lane >> 4) & 1) << 5) | (((lane >> 5) & 1) << 8); }
constexpr int v_rd_off(int d0, int ks, int half) { return d0 * 512 + ks * 4096 + half * 2048; }
__device__ __forceinline__ int crow(int r, int hi) { return (r & 3) + 8 * (r >> 2) + 4 * hi; }
typedef float f32x2_t __attribute__((ext_vector_type(2))); typedef __bf16 bf16x2_t __attribute__((ext_vector_type(2)));
__device__ __forceinline__ unsigned cvtpk(float lo, float hi) { f32x2_t v = {lo, hi}; bf16x2_t b = __builtin_convertvector(v, bf16x2_t); return __builtin_bit_cast(unsigned, b); }
__device__ __forceinline__ void glds16(const void* gsrc, unsigned lds_dst) { unsigned keep;
    asm volatile("s_mov_b32 %0, m0\n\ts_mov_b32 m0, %2\n\ts_nop 0\n\tglobal_load_lds_dwordx4 %1, off\n\ts_mov_b32 m0, %0" : "=&s"(keep) : "v"(gsrc), "s"(lds_dst) : "memory"); }
#define WAIT_BAR() asm volatile("s_waitcnt vmcnt(0) lgkmcnt(0)\n\ts_barrier" ::: "memory")

__device__ __forceinline__ void mask_tile(f32x16& p0, f32x16& p1, int dq) {
    const float NEG = -__builtin_inff();
#pragma unroll
    for (int r = 0; r < 16; ++r) { const int c = (r & 3) + 8 * (r >> 2); if (dq - c < 0) p0[r] = NEG; if (dq - c - 32 < 0) p1[r] = NEG; }
}
template <bool MLA> __device__ __forceinline__ void partialSM(f32x16& p0, f32x16& p1, float& m_reg, float& mn, float& alpha) {
    constexpr float SCALE = MLA ? 0.07216878364870322f : 0.125f;
    float pmax = p0[0];
#pragma unroll
    for (int r = 1; r < 16; ++r) pmax = fmaxf(pmax, p0[r]);
#pragma unroll
    for (int r = 0; r < 16; ++r) pmax = fmaxf(pmax, p1[r]);
    { auto rr = __builtin_amdgcn_permlane32_swap(__float_as_uint(pmax), __float_as_uint(pmax), false, false); pmax = fmaxf(__uint_as_float(rr[0]), __uint_as_float(rr[1])); }
    constexpr float C2 = 1.4426950408889634f * SCALE;
    if (__builtin_expect(__all((pmax - m_reg) * SCALE <= THR), 1)) { mn = m_reg; alpha = 1.f; }
    else { mn = fmaxf(m_reg, pmax); alpha = __builtin_amdgcn_exp2f((m_reg - mn) * C2); m_reg = mn; }
    const float mnL = -mn * C2;
#pragma unroll
    for (int r = 0; r < 16; ++r) p0[r] = fmaf(p0[r], C2, mnL);
#pragma unroll
    for (int r = 0; r < 16; ++r) p1[r] = fmaf(p1[r], C2, mnL);
#pragma unroll
    for (int r = 0; r < 16; ++r) p0[r] = __builtin_amdgcn_exp2f(p0[r]);
}
__device__ __forceinline__ void finishSM(f32x16& p0, f32x16& p1, float alpha, float& l_reg, bf16x8& pa0, bf16x8& pa1, bf16x8& pa2, bf16x8& pa3) {
#pragma unroll
    for (int r = 0; r < 16; ++r) p1[r] = __builtin_amdgcn_exp2f(p1[r]);
    float ps = 0;
#pragma unroll
    for (int r = 0; r < 16; ++r) ps += p0[r];
#pragma unroll
    for (int r = 0; r < 16; ++r) ps += p1[r];
    { auto rr = __builtin_amdgcn_permlane32_swap(__float_as_uint(ps), __float_as_uint(ps), false, false); ps = __uint_as_float(rr[0]) + __uint_as_float(rr[1]); }
    l_reg = l_reg * alpha + ps;
#define PK4(P, B_, OUT) do { unsigned a0 = cvtpk(P[B_+0], P[B_+1]), a1 = cvtpk(P[B_+2], P[B_+3]); unsigned b0 = cvtpk(P[B_+4], P[B_+5]), b1 = cvtpk(P[B_+6], P[B_+7]); \
        auto r0 = __builtin_amdgcn_permlane32_swap(a0, b0, false, false); auto r1 = __builtin_amdgcn_permlane32_swap(a1, b1, false, false); \
        u32x4 w = {r0[0], r1[0], r0[1], r1[1]}; OUT = *reinterpret_cast<bf16x8*>(&w); } while (0)
    PK4(p0, 0, pa0); PK4(p0, 8, pa1); PK4(p1, 0, pa2); PK4(p1, 8, pa3);
#undef PK4
}
template <int KB, bool MLA>
__device__ __forceinline__ void qkt(f32x16& p0, f32x16& p1, const char* lds, int r32, int hi, const char* qimg, const bf16x8* qr) {
    p0 = f32x16{}; p1 = f32x16{};
    if (MLA) {
        const char* kb[4];
#pragma unroll
        for (int dd = 0; dd < 4; ++dd) kb[dd] = lds + OFF_K + KB * SHM_K + KSWZ(r32, (dd * 16 + hi * 8) * 2);
#pragma unroll
        for (int d0 = 0; d0 < 8; ++d0) { const char* a = kb[d0 & 3] + (d0 >> 2) * 128;
            bf16x8 b0 = *reinterpret_cast<const bf16x8*>(a); bf16x8 b1 = *reinterpret_cast<const bf16x8*>(a + 32 * 256);
            const bf16x8 q = *reinterpret_cast<const bf16x8*>(qimg + d0 * 32);
            p0 = __builtin_amdgcn_mfma_f32_32x32x16_bf16(b0, q, p0, 0, 0, 0); p1 = __builtin_amdgcn_mfma_f32_32x32x16_bf16(b1, q, p1, 0, 0, 0); }
    }
#pragma unroll
    for (int d0 = 0; d0 < 4; ++d0) { const char* a = lds + OFF_R + KB * SHM_R + RSWZ(r32, 2 * d0 + hi);
        bf16x8 b0 = *reinterpret_cast<const bf16x8*>(a); bf16x8 b1 = *reinterpret_cast<const bf16x8*>(a + 32 * 128);
        p0 = __builtin_amdgcn_mfma_f32_32x32x16_bf16(b0, qr[d0], p0, 0, 0, 0); p1 = __builtin_amdgcn_mfma_f32_32x32x16_bf16(b1, qr[d0], p1, 0, 0, 0); }
}
template <int VB>
__device__ __forceinline__ void pv_tile(f32x16* o, int vb0, bf16x8 pa0, bf16x8 pa1, bf16x8 pa2, bf16x8 pa3) {
#define TRRD(dst, off) asm volatile("ds_read_b64_tr_b16 %0, %1 offset:%2" : "=&v"(dst) : "v"(vb0), "i"(off) : "memory")
#define PV_D0(d0) do { s16x4 l0, l1, l2, l3, h0, h1, h2, h3; constexpr int b_ = OFF_V + VB * SHM_V + v_rd_off(d0, 0, 0); \
        TRRD(l0, b_); TRRD(h0, b_ + 2048); TRRD(l1, b_ + 4096); TRRD(h1, b_ + 6144); TRRD(l2, b_ + 8192); TRRD(h2, b_ + 10240); TRRD(l3, b_ + 12288); TRRD(h3, b_ + 14336); \
        asm volatile("s_waitcnt lgkmcnt(0)" ::: "memory"); SBAR(); \
        o[d0] = __builtin_amdgcn_mfma_f32_32x32x16_bf16(pa0, (bf16x8){l0[0], l0[1], l0[2], l0[3], h0[0], h0[1], h0[2], h0[3]}, o[d0], 0, 0, 0); \
        o[d0] = __builtin_amdgcn_mfma_f32_32x32x16_bf16(pa1, (bf16x8){l1[0], l1[1], l1[2], l1[3], h1[0], h1[1], h1[2], h1[3]}, o[d0], 0, 0, 0); \
        o[d0] = __builtin_amdgcn_mfma_f32_32x32x16_bf16(pa2, (bf16x8){l2[0], l2[1], l2[2], l2[3], h2[0], h2[1], h2[2], h2[3]}, o[d0], 0, 0, 0); \
        o[d0] = __builtin_amdgcn_mfma_f32_32x32x16_bf16(pa3, (bf16x8){l3[0], l3[1], l3[2], l3[3], h3[0], h3[1], h3[2], h3[3]}, o[d0], 0, 0, 0); } while (0)
    PV_D0(0); PV_D0(1); PV_D0(2); PV_D0(3);
#undef PV_D0
#undef TRRD
}

struct Src { const bf16_t* Qn; const bf16_t* Qr; const bf16_t* Kn; const bf16_t* Kr; const bf16_t* V; };
template <bool MLA> struct Pitch { static constexpr int qn = 3072, qr = MLA ? 3072 : 16128, kn = 4096, kr = 16128, v = MLA ? 4096 : 16128; };

template <bool MLA>
__device__ __forceinline__ void attn_block(const Src& s, int qb, char* lds) {
    const int tid = threadIdx.x, wid = __builtin_amdgcn_readfirstlane(tid >> 6), lane = tid & 63, r32 = lane & 31, hi = lane >> 5;
    typedef Pitch<MLA> PT;
    const int P0 = qb * QB, NT = (P0 + QB) / KVBLK;
    const int qlo = P0 + wid * QBLK, qm = qlo + r32 - 4 * hi;
    const unsigned lds0 = (unsigned)(uintptr_t)lds;
    float* ws = (float*)(lds + OFF_WS) + wid * 64; float* li_l = ws; float* al_l = ws + 32;
    float m_reg = -1e30f, l_reg = 0; f32x16 o[4];
#pragma unroll
    for (int d = 0; d < 4; ++d) o[d] = f32x16{};
    unsigned offV[2], offK[2], offR;
#pragma unroll
    for (int i = 0; i < 2; ++i) { const int q = (wid * 2 + i) * 64 + lane;
        { const int sidx = q >> 5, w5 = q & 31, kk = (sidx >> 2) * 8 + (w5 >> 2), c = (sidx & 3) * 32 + (w5 & 3) * 8, k = (kk & ~0xC) | ((kk & 4) << 1) | ((kk & 8) >> 1); offV[i] = (unsigned)(k * PT::v + c) * 2u; }
        { const int row = q >> 4, c = (q & 15) ^ (row & 7); offK[i] = MLA ? (unsigned)(row * PT::kn + c * 8) * 2u : 0u; } }
    { const int q = wid * 64 + lane, row = q >> 3, c = (q & 7) ^ ((row >> 1) & 7); offR = (unsigned)(row * PT::kr + c * 8) * 2u; }
#define DMA_K(t, bf) do { if (MLA) { const char* kb_ = (const char*)s.Kn + (size_t)(t) * (KVBLK * 2) * PT::kn; \
            glds16(kb_ + offK[0], (unsigned)__builtin_amdgcn_readfirstlane(lds0 + OFF_K + (bf) * SHM_K + (wid * 2) * 1024)); glds16(kb_ + offK[1], (unsigned)__builtin_amdgcn_readfirstlane(lds0 + OFF_K + (bf) * SHM_K + (wid * 2 + 1) * 1024)); } \
        const char* rb_ = (const char*)s.Kr + (size_t)(t) * (KVBLK * 2) * PT::kr; glds16(rb_ + offR, (unsigned)__builtin_amdgcn_readfirstlane(lds0 + OFF_R + (bf) * SHM_R + wid * 1024)); } while (0)
#define DMA_V(t, bf) do { const char* vb_ = (const char*)s.V + (size_t)(t) * (KVBLK * 2) * PT::v; \
        glds16(vb_ + offV[0], (unsigned)__builtin_amdgcn_readfirstlane(lds0 + OFF_V + (bf) * SHM_V + (wid * 2) * 1024)); glds16(vb_ + offV[1], (unsigned)__builtin_amdgcn_readfirstlane(lds0 + OFF_V + (bf) * SHM_V + (wid * 2 + 1) * 1024)); } while (0)
    __syncthreads();
    DMA_K(0, 0);
    bf16x8 qr[4];
    char* qimg_w = lds + OFF_Q + wid * QWAVE;
    { const size_t qrow = (size_t)(qlo + r32);
#pragma unroll
        for (int d0 = 0; d0 < 4; ++d0) qr[d0] = *reinterpret_cast<const bf16x8*>(s.Qr + qrow * PT::qr + d0 * 16 + hi * 8);
        if (MLA) {
#pragma unroll
            for (int i = 0; i < 8; ++i) { const int ci = i * 64 + lane, row = ci >> 4, ch = ci & 15;
                *(bf16x8*)(qimg_w + row * QROW + ch * 16) = *reinterpret_cast<const bf16x8*>(s.Qn + (size_t)(qlo + row) * PT::qn + ch * 8); }
        } }
    DMA_K(1, 1); DMA_V(0, 0);
    const char* qimg = qimg_w + r32 * QROW + hi * 16;
    const int vb0 = (int)lds0 + v_rd_base(lane);
#define RESC(a) do { if (__any((a) < 1.f)) { if (hi == 0) al_l[r32] = (a); asm volatile("s_waitcnt lgkmcnt(0)" ::: "memory"); \
        _Pragma("unroll") for (int d_ = 0; d_ < 4; ++d_) _Pragma("unroll") for (int r = 0; r < 16; ++r) o[d_][r] *= al_l[crow(r, hi)]; } } while (0)
#define KBASE(t) ((t) * KVBLK)
#define MASKT(P0_, P1_, t) do { const int kb_ = KBASE(t); if (kb_ + KVBLK - 1 > qlo) mask_tile(P0_, P1_, qm - kb_); } while (0)
    f32x16 pA0, pA1, pB0, pB1; float mnA, mnB, alA, alB; bf16x8 pa0, pa1, pa2, pa3;
    WAIT_BAR();
    SBAR(); qkt<0, MLA>(pA0, pA1, lds, r32, hi, qimg, qr);
    MASKT(pA0, pA1, 0); partialSM<MLA>(pA0, pA1, m_reg, mnA, alA);
    WAIT_BAR();
#define HALF_STEP(PX0, PX1, mnX, alX, PY0, PY1, alY, t, KB, VB, GK) do { \
        if (GK) DMA_K((t) + 1, (VB)); DMA_V((t), (KB)); \
        SBAR(); qkt<KB, MLA>(PX0, PX1, lds, r32, hi, qimg, qr); \
        finishSM(PY0, PY1, alY, l_reg, pa0, pa1, pa2, pa3); SBAR(); \
        pv_tile<VB>(o, vb0, pa0, pa1, pa2, pa3); MASKT(PX0, PX1, (t)); partialSM<MLA>(PX0, PX1, m_reg, mnX, alX); \
        RESC(alX); WAIT_BAR(); } while (0)
    for (int t = 1; t + 1 < NT; t += 2) {
        HALF_STEP(pB0, pB1, mnB, alB, pA0, pA1, alA, t, 1, 0, true);
        HALF_STEP(pA0, pA1, mnA, alA, pB0, pB1, alB, t + 1, 0, 1, (t + 2 < NT));
    }
    DMA_V(NT - 1, 1);
    SBAR(); qkt<1, MLA>(pB0, pB1, lds, r32, hi, qimg, qr);
    finishSM(pA0, pA1, alA, l_reg, pa0, pa1, pa2, pa3); SBAR();
    pv_tile<0>(o, vb0, pa0, pa1, pa2, pa3);
    MASKT(pB0, pB1, NT - 1); partialSM<MLA>(pB0, pB1, m_reg, mnB, alB); RESC(alB);
    WAIT_BAR();
    finishSM(pB0, pB1, alB, l_reg, pa0, pa1, pa2, pa3); SBAR(); pv_tile<1>(o, vb0, pa0, pa1, pa2, pa3);
    if (hi == 0) li_l[r32] = l_reg;
    asm volatile("s_waitcnt lgkmcnt(0)" ::: "memory");
    float rl[16];
#pragma unroll
    for (int r = 0; r < 16; ++r) rl[r] = __builtin_amdgcn_rcpf(li_l[crow(r, hi)]);
    WAIT_BAR();
    float* st = (float*)(lds + wid * STG_WAVE) + hi * (4 * STG_ROW) + r32;
#pragma unroll
    for (int r = 0; r < 16; ++r)
#pragma unroll
        for (int d0 = 0; d0 < 4; ++d0) st[((r & 3) + 8 * (r >> 2)) * STG_ROW + d0 * 32] = o[d0][r] * rl[r];
    asm volatile("s_waitcnt lgkmcnt(0)" ::: "memory");
#undef DMA_K
#undef DMA_V
#undef RESC
#undef KBASE
#undef MASKT
#undef HALF_STEP
}
__device__ __forceinline__ f32x4 staged4(const char* lds, int wid, int lane, int j) {
    const int row = lane & 31, half = lane >> 5; const float* st = (const float*)(lds + wid * STG_WAVE);
    return *(const f32x4*)(st + row * STG_ROW + half * 64 + 4 * j);
}
#undef SBAR
}

constexpr size_t MiB = 1u << 20;
constexpr size_t WS_CTL = 0, CTL_ZERO_BYTES = 1 * MiB;
constexpr size_t WS_COS = 1 * MiB, WS_SIN = 2 * MiB;
constexpr size_t WS_SSQC = 3 * MiB;
constexpr size_t WS_SSQ1 = 4 * MiB, WS_SSQ2 = 6 * MiB;
constexpr size_t WS_RSTD1 = 8 * MiB;
constexpr size_t WS_WIN = 16 * MiB;
constexpr size_t WS_WUQ = 142 * MiB;
constexpr size_t WS_WUKV = 148 * MiB;
constexpr size_t WS_WO = 152 * MiB;
constexpr size_t WS_WOUT = 184 * MiB;
constexpr size_t WS_WUP = 216 * MiB;
constexpr size_t WS_WDOWN = 388 * MiB;
constexpr size_t WS_H = 474 * MiB;
constexpr size_t WS_O = 538 * MiB;
constexpr size_t WS_Z = 602 * MiB;
constexpr size_t WS_QM = 854 * MiB;
constexpr size_t WS_KV = 902 * MiB;
constexpr size_t WS_U = 602 * MiB;
constexpr size_t WS_T1 = 966 * MiB;
constexpr size_t WS_O1 = 1094 * MiB;
constexpr size_t WS_ACT = 966 * MiB;
constexpr size_t WS_X1 = 1158 * MiB;
constexpr size_t WS_END = 1286 * MiB;
static_assert(WS_WIN + (size_t)ZW * DM * 2 <= WS_WUQ && WS_WUP + (size_t)UPW * DM * 2 <= WS_WDOWN && WS_WDOWN + (size_t)DM * DFF * 2 <= WS_H, "ws map (weights)");
static_assert(WS_Z + (size_t)S * ZW * 2 <= WS_QM && WS_U + (size_t)S * UPW * 2 <= WS_T1 && WS_ACT + (size_t)S * DFF * 2 <= WS_X1 && WS_X1 + (size_t)S * DM * 4 <= WS_END, "ws map (activations)");
constexpr int CW_TMO = 0, CW_BAR = 4096;

constexpr int NWAVES = 8;
constexpr int RING_OFF = 0, RING_BYTES = 131072;
constexpr int LDSCTL_OFF = 155648, MISC_OFF = LDSCTL_OFF + 320;
constexpr int LDS_BYTES = 163840;
static_assert(att::Pitch<true>::qn == QMW && att::Pitch<true>::kn == KVW && att::Pitch<false>::v == ZW && att::Pitch<true>::kr == ZW, "attention pitches");
static_assert(att::ATT_LDS <= LDSCTL_OFF && RING_BYTES <= LDSCTL_OFF, "LDS map");

__device__ __forceinline__ unsigned f2bf(float f) { unsigned u = __builtin_bit_cast(unsigned, f); return (u + 0x7fffu + ((u >> 16) & 1u)) >> 16; }
__device__ __forceinline__ unsigned pk2(float lo, float hi) { return f2bf(lo) | (f2bf(hi) << 16); }

#define XB_TMO      128
#define XB_XCNT(j)  (256  + 64 * (j))
#define XB_XSUB(j)  (1280 + 64 * (j))
#define XB_XGEN(j)  (2304 + 64 * (j))
#define XB_TOP      3328
#define XB_TOPGEN   3392
#define XCD_BAR_WORDS 3456
#define XB_SPIN_CAP (1u << 18)
__device__ __forceinline__ unsigned xb_ld(unsigned* p)              { return __hip_atomic_load(p, __ATOMIC_RELAXED, __HIP_MEMORY_SCOPE_AGENT); }
__device__ __forceinline__ unsigned xb_add(unsigned* p, unsigned v) { return __hip_atomic_fetch_add(p, v, __ATOMIC_RELAXED, __HIP_MEMORY_SCOPE_AGENT); }
__device__ __forceinline__ unsigned xb_xcc_id() { return (unsigned)__builtin_amdgcn_s_getreg((3 << 11) | 20) & 0xFu; }
#define XB_SPIN(cond, bar) do { unsigned _sp = 0; while (cond) { __builtin_amdgcn_s_sleep(1); \
    if ((++_sp & 255u) == 0u) { if (xb_ld(&(bar)[XB_TMO])) break; if (_sp > XB_SPIN_CAP) { atomicAdd(&(bar)[XB_TMO], 1u); break; } } } } while (0)
struct XcdBarrier { unsigned* bar; unsigned x; volatile LAS unsigned* st; };
__device__ __forceinline__ XcdBarrier xcd_barrier_post(unsigned* bar, volatile LAS unsigned* st) {
    XcdBarrier b; b.bar = bar; b.x = xb_xcc_id(); b.st = st;
    if (threadIdx.x == 0) (void)xb_add(&bar[XB_XCNT(b.x)], 1u);
    return b;
}
__device__ __forceinline__ void xcd_barrier_complete(unsigned* bar, unsigned x, unsigned& nloc, unsigned& nx) {
    const unsigned G = gridDim.x * gridDim.y * gridDim.z;
    unsigned sum, cnt, mine, sp = 0u;
    for (;;) {
        sum = 0u; cnt = 0u; mine = 0u;
#pragma unroll
        for (unsigned j = 0; j < 16; ++j) { const unsigned c = xb_ld(&bar[XB_XCNT(j)]); sum += c; cnt += (c > 0u) ? 1u : 0u; mine = (j == x) ? c : mine; }
        if (sum == G) break;
        __builtin_amdgcn_s_sleep(1);
        if ((++sp & 255u) == 0u) { if (xb_ld(&bar[XB_TMO])) break; if (sp > XB_SPIN_CAP) { atomicAdd(&bar[XB_TMO], 1u); break; } }
    }
    nloc = mine > 0u ? mine : 1u; nx = cnt > 0u ? cnt : 1u;
}
__device__ __forceinline__ void xcd_barrier(const XcdBarrier& b) {
    asm volatile("s_waitcnt vmcnt(0)" ::: "memory");
    __syncthreads();
    if (threadIdx.x == 0) {
        unsigned* bar = b.bar;
        __builtin_amdgcn_s_waitcnt(0);
        unsigned nloc = b.st[0], nx = b.st[1];
        if (nloc == 0u) { xcd_barrier_complete(bar, b.x, nloc, nx); b.st[0] = nloc; b.st[1] = nx; }
        const unsigned old = xb_add(&bar[XB_XSUB(b.x)], 1u);
        const unsigned gen = old / nloc;
        if (old + 1u == (gen + 1u) * nloc) {
            __builtin_amdgcn_fence(__ATOMIC_RELEASE, "agent");
            asm volatile("s_waitcnt vmcnt(0)" ::: "memory");
            const unsigned og = xb_add(&bar[XB_TOP], 1u);
            const unsigned tg = og / nx;
            if (og + 1u == (tg + 1u) * nx) xb_add(&bar[XB_TOPGEN], 1u);
            else XB_SPIN(xb_ld(&bar[XB_TOPGEN]) == tg, bar);
            __builtin_amdgcn_fence(__ATOMIC_ACQUIRE, "agent");
            xb_add(&bar[XB_XGEN(b.x)], 1u);
            asm volatile("s_waitcnt vmcnt(0)" ::: "memory");
        } else {
            XB_SPIN(xb_ld(&bar[XB_XGEN(b.x)]) == gen, bar);
            __builtin_amdgcn_fence(__ATOMIC_ACQUIRE, "agent");
            asm volatile("s_waitcnt vmcnt(0)" ::: "memory");
        }
    }
    __syncthreads();
}

struct Args {
    const float* x; const int* pos; const float* norm_mix_w; const float* w_in; const float* lq1; const float* lk1; const float* lq2; const float* lk2;
    const float* subln_w; const float* q_norm_w; const float* w_uq; const float* kv_norm_w; const float* w_ukv; const float* w_o_diff; const float* w_o_mla;
    const float* w_out; const float* norm_ffn_w; const float* w_up; const float* conv_w; const float* conv_b; const float* w_down; const float* final_w;
    float* out; unsigned char* ws; int ph_lo, ph_hi;
};

__device__ __forceinline__ float wave_sum(float v) {
#pragma unroll
    for (int o = 1; o < 64; o <<= 1) v += __shfl_xor(v, o);
    return v;
}

struct MapId { __device__ __forceinline__ int operator()(int n) const { return n; } };
struct MapIn { __device__ __forceinline__ int operator()(int n) const {
    if (n < 4096) { const int d = n & 63; return (n & ~63) + 2 * (d & 31) + (d >> 5); }
    if (n < ZC_KR) return n;
    if (n < ZC_KR + 64) { const int d = n - ZC_KR; return ZC_KR + 2 * (d & 31) + (d >> 5); }
    return n + (ZC_GD - (ZC_KR + 64)); } };
struct MapUq { __device__ __forceinline__ int operator()(int n) const { const int h = n / 192, j = n - h * 192;
    if (j < 128) return h * 128 + j; const int d = j - 128; return 2048 + h * 64 + 2 * (d & 31) + (d >> 5); } };
struct MapUkv { __device__ __forceinline__ int operator()(int n) const { const int h = n >> 8, j = n & 255; return (j < 128) ? h * 128 + j : 2048 + h * 128 + (j - 128); } };
struct MapUp { __device__ __forceinline__ int operator()(int n) const { const int v = n >= DFF, c = v ? n - DFF : n; return (c >> 7) * 256 + v * 128 + (c & 127); } };

template <class Map>
__device__ __forceinline__ void tr_item(const float* W, int N, bf16* WT, int ldt, int koff, const float* kscale, Map map, LAS float* scr, int item, int lane) {
    const int nblk = N / 32, kb = item / nblk, nb = item - kb * nblk, k0 = 64 * kb, n0 = 32 * nb;
#pragma unroll 8
    for (int i = 0; i < 32; ++i) { const int kk = 2 * i + (lane >> 5); scr[kk * 33 + (lane & 31)] = W[(size_t)(k0 + kk) * N + n0 + (lane & 31)]; }
    LDS_WAIT(); asm volatile("" ::: "memory");
    const int c = lane & 7;
    float g[8];
#pragma unroll
    for (int e = 0; e < 8; ++e) g[e] = kscale ? kscale[k0 + 8 * c + e] : 1.0f;
#pragma unroll
    for (int j = 0; j < 4; ++j) { const int n = (lane >> 3) + 8 * j; const LAS float* s = scr + (8 * c) * 33 + n;
        v4u o; o.x = pk2(s[0 * 33] * g[0], s[1 * 33] * g[1]); o.y = pk2(s[2 * 33] * g[2], s[3 * 33] * g[3]); o.z = pk2(s[4 * 33] * g[4], s[5 * 33] * g[5]); o.w = pk2(s[6 * 33] * g[6], s[7 * 33] * g[7]);
        *(GAS v4u*)(WT + (size_t)map(n0 + n) * ldt + koff + k0 + 8 * c) = o; }
    LDS_WAIT(); asm volatile("" ::: "memory");
}

__constant__ float ROPE_INVF[32] = {
    1.000000000e+00f, 7.498942614e-01f, 5.623413324e-01f, 4.216965139e-01f, 3.162277639e-01f, 2.371373773e-01f, 1.778279394e-01f, 1.333521307e-01f,
    1.000000015e-01f, 7.498941571e-02f, 5.623413250e-02f, 4.216965288e-02f, 3.162277490e-02f, 2.371373773e-02f, 1.778279431e-02f, 1.333521493e-02f,
    9.999999776e-03f, 7.498941850e-03f, 5.623413250e-03f, 4.216964822e-03f, 3.162277630e-03f, 2.371373586e-03f, 1.778279431e-03f, 1.333521446e-03f,
    1.000000047e-03f, 7.498942432e-04f, 5.623413017e-04f, 4.216965172e-04f, 3.162277571e-04f, 2.371373703e-04f, 1.778279402e-04f, 1.333521504e-04f };

typedef float f32x4 __attribute__((ext_vector_type(4)));
typedef float f32x16 __attribute__((ext_vector_type(16)));

__global__ void __launch_bounds__(NWAVES * 64, 2) fwd_kernel(Args a) {
    extern __shared__ __attribute__((aligned(16))) unsigned char lds[];
    LAS unsigned char* ldsl = (LAS unsigned char*)lds;
    volatile LAS unsigned* MISC = (volatile LAS unsigned*)(ldsl + MISC_OFF);
    const int tid = threadIdx.x, lane = tid & 63, wave = __builtin_amdgcn_readfirstlane(tid >> 6);
    const int G = gridDim.x; const int bx = blockIdx.x; const int vcu = (G % 8 == 0) ? (bx % 8) * (G / 8) + bx / 8 : bx;
    unsigned char* ws = a.ws;
    gu32* ctl = (gu32*)(ws + WS_CTL);
    for (int u = tid; u < (LDS_BYTES - LDSCTL_OFF) / 4; u += NWAVES * 64) ((LAS unsigned*)(ldsl + LDSCTL_OFF))[u] = 0u;
    __syncthreads();
    XcdBarrier bar; bar.bar = (unsigned*)(ctl + CW_BAR); bar.x = 0; bar.st = nullptr;
    if (!MK_PER_PHASE) bar = xcd_barrier_post((unsigned*)(ctl + CW_BAR), MISC + 8);
    const int lo = a.ph_lo, hi = a.ph_hi;
#ifndef PH_MASK
#define PH_MASK 0x3ff
#endif
#define IN(k) (((PH_MASK >> (k)) & 1) && lo <= (k) && (k) < hi)
#define SEAM(k) do { if (IN(k) && IN((k) + 1)) xcd_barrier(bar); } while (0)
    const int gw = vcu * NWAVES + wave, NGW = G * NWAVES;
    bf16* const WIN = (bf16*)(ws + WS_WIN); bf16* const WUQ = (bf16*)(ws + WS_WUQ); bf16* const WUKV = (bf16*)(ws + WS_WUKV); bf16* const WO = (bf16*)(ws + WS_WO);
    bf16* const WOUT = (bf16*)(ws + WS_WOUT); bf16* const WUP = (bf16*)(ws + WS_WUP); bf16* const WDOWN = (bf16*)(ws + WS_WDOWN);
    bf16* const HB = (bf16*)(ws + WS_H); bf16* const YB = HB; bf16* const OB = (bf16*)(ws + WS_O); bf16* const XB = OB;
    bf16* const ZB = (bf16*)(ws + WS_Z); bf16* const QM = (bf16*)(ws + WS_QM); bf16* const KV = (bf16*)(ws + WS_KV); bf16* const UB = (bf16*)(ws + WS_U);
    float* const T1 = (float*)(ws + WS_T1); float* const O1 = (float*)(ws + WS_O1); bf16* const ACT = (bf16*)(ws + WS_ACT); float* const X1 = (float*)(ws + WS_X1);
    float* const COS = (float*)(ws + WS_COS); float* const SIN = (float*)(ws + WS_SIN); float* const SSQC = (float*)(ws + WS_SSQC);
    float* const SSQ1 = (float*)(ws + WS_SSQ1); float* const SSQ2 = (float*)(ws + WS_SSQ2); float* const RSTD1 = (float*)(ws + WS_RSTD1);

    if (IN(0)) {
        LAS float* scr = (LAS float*)(ldsl + RING_OFF + wave * 16384);
        constexpr int I_IN = (DM / 64) * (INW / 32), I_UQ = (QRANK / 64) * (QMW / 32), I_UKV = (KVRANK / 64) * (KVW / 32), I_OD = (2048 / 64) * (DM / 32), I_OUT = (DM / 64) * (DM / 32),
                      I_UP = (DM / 64) * (UPW / 32), I_DN = (DFF / 64) * (DM / 32);
        constexpr int NITEMS = I_IN + I_UQ + I_UKV + 2 * I_OD + I_OUT + I_UP + I_DN;
        for (int it = gw; it < NITEMS; it += NGW) {
            int r = it;
            if (r < I_IN) { tr_item(a.w_in, INW, WIN, DM, 0, nullptr, MapIn(), scr, r, lane); continue; } r -= I_IN;
            if (r < I_UQ) { tr_item(a.w_uq, QMW, WUQ, QRANK, 0, a.q_norm_w, MapUq(), scr, r, lane); continue; } r -= I_UQ;
            if (r < I_UKV) { tr_item(a.w_ukv, KVW, WUKV, KVRANK, 0, a.kv_norm_w, MapUkv(), scr, r, lane); continue; } r -= I_UKV;
            if (r < I_OD) { tr_item(a.w_o_diff, DM, WO, 4096, 0, nullptr, MapId(), scr, r, lane); continue; } r -= I_OD;
            if (r < I_OD) { tr_item(a.w_o_mla, DM, WO, 4096, 2048, nullptr, MapId(), scr, r, lane); continue; } r -= I_OD;
            if (r < I_OUT) { tr_item(a.w_out, DM, WOUT, DM, 0, nullptr, MapId(), scr, r, lane); continue; } r -= I_OUT;
            if (r < I_UP) { tr_item(a.w_up, UPW, WUP, DM, 0, a.norm_ffn_w, MapUp(), scr, r, lane); continue; } r -= I_UP;
            tr_item(a.w_down, DM, WDOWN, DFF, 0, nullptr, MapId(), scr, r, lane);
        }
        { const int gt = vcu * (NWAVES * 64) + tid, NGT = G * NWAVES * 64; GAS v4u* pz = (GAS v4u*)(WIN + (size_t)(ZC_KR + 64) * DM); const int nz = (ZC_GD - ZC_KR - 64) * DM / 8;
            for (int i = gt; i < nz; i += NGT) pz[i] = (v4u){0u, 0u, 0u, 0u};
            for (int i = gt; i < S * 32; i += NGT) { const int t = i >> 5, f = i & 31; const float ang = (float)a.pos[t] * ROPE_INVF[f];
                const double rev = (double)ang * 0.15915494309189535; const float fr = (float)(rev - __builtin_rint(rev));
                COS[i] = __builtin_amdgcn_cosf(fr); SIN[i] = __builtin_amdgcn_sinf(fr); } }
        for (int m = gw; m < S; m += NGW) {
            const GAS f32x4* xr = (const GAS f32x4*)(a.x + (size_t)m * DM) + lane; const GAS f32x4* wv = (const GAS f32x4*)a.norm_mix_w + lane;
            f32x4 v[16]; float ss = 0.f;
#pragma unroll
            for (int j = 0; j < 16; ++j) { v[j] = xr[64 * j]; ss += (v[j].x * v[j].x + v[j].y * v[j].y) + (v[j].z * v[j].z + v[j].w * v[j].w); }
            const float rs = 1.0f / sqrtf(wave_sum(ss) * (1.0f / DM) + NORM_EPS);
            GAS unsigned long long* o8 = (GAS unsigned long long*)(HB + (size_t)m * DM) + lane;
#pragma unroll
            for (int j = 0; j < 16; ++j) { const f32x4 w = wv[64 * j]; o8[64 * j] = (unsigned long long)pk2(v[j].x * rs * w.x, v[j].y * rs * w.y) | ((unsigned long long)pk2(v[j].z * rs * w.z, v[j].w * rs * w.w) << 32); }
        }
    }
    SEAM(0);

    if (IN(1)) {
        pg8::Gemm g{HB, WIN, S, ZW, DM, DM, DM}; pg8::StaticOrder So; So.init(S, ZW, G, bx);
        pg8::EpiIn E{ZB, COS, SIN, SSQC};
        pg8::gemm_phase<pg8::EpiIn, pg8::StaticOrder, true>(ldsl + RING_OFF, g, So, E);
    }
    SEAM(1);

    if (IN(2)) {
        { pg8::Gemm g{ZB + ZC_CQ, WUQ, S, QMW, QRANK, ZW, QRANK}; pg8::StaticOrder So; So.init(S, QMW, G, bx);
          pg8::EpiMla<0, 4, QRANK> E{QM, QMW, SSQC, COS, SIN, 8};
          pg8::gemm_phase<pg8::EpiMla<0, 4, QRANK>, pg8::StaticOrder, true>(ldsl + RING_OFF, g, So, E); }
        { pg8::Gemm g{ZB + ZC_CKV, WUKV, S, KVW, KVRANK, ZW, KVRANK}; pg8::StaticOrder So; So.init(S, KVW, G, bx);
          pg8::EpiMla<16, 2, KVRANK> E{KV, KVW, SSQC, COS, SIN, 1 << 30};
          pg8::gemm_phase<pg8::EpiMla<16, 2, KVRANK>, pg8::StaticOrder, true>(ldsl + RING_OFF, g, So, E); }
    }
    SEAM(2);

    if (IN(3)) {
        float lam;
        { const float a1 = wave_sum(a.lq1[lane] * a.lk1[lane]), a2 = wave_sum(a.lq2[lane] * a.lk2[lane]); lam = expf(a1) - expf(a2) + LAMBDA_INIT; }
        const int row_l = lane & 31, half_l = lane >> 5;
        char* const alds = (char*)lds + RING_OFF;
        for (int item = vcu; item < NHEAD * 16; item += G) {
            const int h = item >> 4, sp = item & 15;
#ifndef NO_DIFF
#pragma unroll 1
            for (int pc = 0; pc < 4; ++pc) {
                const int pass = pc >> 1, c = pc & 1, qb = pass ? 31 - sp : sp; const int trow = qb * 256 + wave * 32 + row_l;
                att::Src sd; sd.Qn = nullptr; sd.Kn = nullptr;
                sd.Qr = ZB + ZC_QD + (2 * h + c) * 64; sd.Kr = ZB + ZC_KD + (2 * h + c) * 64; sd.V = ZB + ZC_VD + h * 128;
                att::attn_block<false>(sd, qb, alds);
                float* o1p = O1 + (size_t)trow * 2048 + h * 128 + half_l * 64;
                if (c == 0) {
#pragma unroll
                    for (int j = 0; j < 16; ++j) *(f32x4*)(o1p + 4 * j) = att::staged4(alds, wave, lane, j);
                } else {
                    f32x4 u[16]; float ss = 0.f;
#pragma unroll
                    for (int j = 0; j < 16; ++j) { const f32x4 v2 = att::staged4(alds, wave, lane, j); u[j] = *(const f32x4*)(o1p + 4 * j) - lam * v2; ss += (u[j][0] * u[j][0] + u[j][1] * u[j][1]) + (u[j][2] * u[j][2] + u[j][3] * u[j][3]); }
                    ss += __shfl_xor(ss, 32);
                    const float rs = (1.0f - LAMBDA_INIT) / sqrtf(ss * (1.0f / 128.0f) + SUBLN_EPS);
                    bf16* ob = OB + (size_t)trow * 4096 + h * 128 + half_l * 64; const float* swp = a.subln_w + half_l * 64;
#pragma unroll
                    for (int j = 0; j < 8; ++j) { const f32x4 w0 = *(const f32x4*)(swp + 8 * j), w1 = *(const f32x4*)(swp + 8 * j + 4);
                        *(pg8::u32x4*)(ob + 8 * j) = pg8::pack8(u[2 * j] * rs * w0, u[2 * j + 1] * rs * w1); }
                }
            }
#endif
        }
        for (int item = vcu; item < NHEAD * 16; item += G) {
            const int h = item >> 4, sp = item & 15;
#ifndef NO_MLA
#pragma unroll 1
            for (int pass = 0; pass < 2; ++pass) {
                const int qb = pass ? 31 - sp : sp; const int trow = qb * 256 + wave * 32 + row_l;
                att::Src sm; sm.Qn = QM + h * 128; sm.Qr = QM + 2048 + h * 64; sm.Kn = KV + h * 128; sm.Kr = ZB + ZC_KR; sm.V = KV + 2048 + h * 128;
                att::attn_block<true>(sm, qb, alds);
                bf16* ob = OB + (size_t)trow * 4096 + 2048 + h * 128 + half_l * 64;
#pragma unroll
                for (int j = 0; j < 8; ++j) *(pg8::u32x4*)(ob + 8 * j) = pg8::pack8(att::staged4(alds, wave, lane, 2 * j), att::staged4(alds, wave, lane, 2 * j + 1));
            }
#endif
        }
    }
    SEAM(3);

    if (IN(4)) {
        { pg8::Gemm g{OB, WO, S, DM, 2048, 4096, 4096}; pg8::StaticOrder So; So.init(S, DM, G, bx);
          pg8::EpiGate<false> E{ZB + ZC_GD, T1, YB};
          pg8::gemm_phase<pg8::EpiGate<false>, pg8::StaticOrder, true>(ldsl + RING_OFF, g, So, E); }
        { pg8::Gemm g{OB + 2048, WO + 2048, S, DM, 2048, 4096, 4096}; pg8::StaticOrder So; So.init(S, DM, G, bx);
          pg8::EpiGate<true> E{ZB + ZC_GM, T1, YB};
          pg8::gemm_phase<pg8::EpiGate<true>, pg8::StaticOrder, true>(ldsl + RING_OFF, g, So, E); }
    }
    SEAM(4);

    if (IN(5)) {
        pg8::Gemm g{YB, WOUT, S, DM, DM, DM, DM}; pg8::StaticOrder So; So.init(S, DM, G, bx);
        pg8::EpiRes<true> E{a.x, X1, XB, SSQ1};
        pg8::gemm_phase<pg8::EpiRes<true>, pg8::StaticOrder, true>(ldsl + RING_OFF, g, So, E);
    }
    SEAM(5);

    if (IN(6)) {
        for (int m = gw; m < S; m += NGW) { const float sm = wave_sum(SSQ1[(size_t)m * 64 + lane]); if (lane == 0) RSTD1[m] = 1.0f / sqrtf(sm * (1.0f / DM) + NORM_EPS); }
        pg8::Gemm g{XB, WUP, S, UPW, DM, DM, DM}; pg8::StaticOrder So; So.init(S, UPW, G, bx);
        pg8::EpiPlain E{UB, UPW};
        pg8::gemm_phase<pg8::EpiPlain, pg8::StaticOrder, true>(ldsl + RING_OFF, g, So, E);
    }
    SEAM(6);

    if (IN(7)) {
        constexpr int R = 16, NCG = DFF / 8, NWC = (NCG + 63) / 64, NITEM = (S / R) * NWC;
        for (int it = gw; it < NITEM; it += NGW) {
            const int rb = it / NWC, wcg = it - rb * NWC, cg = wcg * 64 + lane;
            if (cg < NCG) {
                const int c0 = cg * 8, ucol = (c0 >> 7) * 256 + (c0 & 127), t0 = rb * R;
                f32x4 wg[3][2], wv[3][2], bg[2], bv[2];
#pragma unroll
                for (int j = 0; j < 3; ++j)
#pragma unroll
                    for (int e = 0; e < 2; ++e) { wg[j][e] = *(const f32x4*)(a.conv_w + (size_t)j * UPW + c0 + 4 * e); wv[j][e] = *(const f32x4*)(a.conv_w + (size_t)j * UPW + DFF + c0 + 4 * e); }
#pragma unroll
                for (int e = 0; e < 2; ++e) { bg[e] = *(const f32x4*)(a.conv_b + c0 + 4 * e); bv[e] = *(const f32x4*)(a.conv_b + DFF + c0 + 4 * e); }
                f32x4 g2[2], g1[2], v2[2], v1[2];
#pragma unroll
                for (int e = 0; e < 2; ++e) { g2[e] = (f32x4){0.f, 0.f, 0.f, 0.f}; g1[e] = g2[e]; v2[e] = g2[e]; v1[e] = g2[e]; }
                if (t0 >= 2) {
                    const float r2 = RSTD1[t0 - 2], r1 = RSTD1[t0 - 1];
                    pg8::unpack8(*(const pg8::u32x4*)(UB + (size_t)(t0 - 2) * UPW + ucol), g2[0], g2[1]); pg8::unpack8(*(const pg8::u32x4*)(UB + (size_t)(t0 - 2) * UPW + ucol + 128), v2[0], v2[1]);
                    pg8::unpack8(*(const pg8::u32x4*)(UB + (size_t)(t0 - 1) * UPW + ucol), g1[0], g1[1]); pg8::unpack8(*(const pg8::u32x4*)(UB + (size_t)(t0 - 1) * UPW + ucol + 128), v1[0], v1[1]);
#pragma unroll
                    for (int e = 0; e < 2; ++e) { g2[e] *= r2; v2[e] *= r2; g1[e] *= r1; v1[e] *= r1; }
                }
#pragma unroll 4
                for (int t = t0; t < t0 + R; ++t) {
                    const float r0 = RSTD1[t]; f32x4 gc[2], vc[2];
                    pg8::unpack8(*(const pg8::u32x4*)(UB + (size_t)t * UPW + ucol), gc[0], gc[1]); pg8::unpack8(*(const pg8::u32x4*)(UB + (size_t)t * UPW + ucol + 128), vc[0], vc[1]);
                    f32x4 og[2], ov[2];
#pragma unroll
                    for (int e = 0; e < 2; ++e) { gc[e] *= r0; vc[e] *= r0;
                        og[e] = bg[e] + wg[0][e] * g2[e] + wg[1][e] * g1[e] + wg[2][e] * gc[e]; ov[e] = bv[e] + wv[0][e] * v2[e] + wv[1][e] * v1[e] + wv[2][e] * vc[e];
#pragma unroll
                        for (int q = 0; q < 4; ++q) og[e][q] = og[e][q] * pg8::sigmoidf_fast(og[e][q]) * ov[e][q];
                        g2[e] = g1[e]; g1[e] = gc[e]; v2[e] = v1[e]; v1[e] = vc[e]; }
                    *(pg8::u32x4*)(ACT + (size_t)t * DFF + c0) = pg8::pack8(og[0], og[1]);
                }
            }
        }
    }
    SEAM(7);

    if (IN(8)) {
        pg8::Gemm g{ACT, WDOWN, S, DM, DFF, DFF, DFF}; pg8::StaticOrder So; So.init(S, DM, G, bx);
        pg8::EpiRes<false> E{X1, a.out, nullptr, SSQ2};
        pg8::gemm_phase<pg8::EpiRes<false>, pg8::StaticOrder, true>(ldsl + RING_OFF, g, So, E);
    }
    SEAM(8);

    if (IN(9)) {
        for (int m = gw; m < S; m += NGW) {
            const float sm = wave_sum(SSQ2[(size_t)m * 64 + lane]); const float rs = 1.0f / sqrtf(sm * (1.0f / DM) + NORM_EPS);
            GAS f32x4* xr = (GAS f32x4*)(a.out + (size_t)m * DM) + lane; const GAS f32x4* wv = (const GAS f32x4*)a.final_w + lane;
#pragma unroll
            for (int j = 0; j < 16; ++j) { const f32x4 v = xr[64 * j], w = wv[64 * j]; xr[64 * j] = v * rs * w; }
        }
    }
#undef IN
#undef SEAM
}


#if MK_PER_PHASE == 2
struct CsRange { size_t off; size_t bytes; };
__global__ void csum_kernel(const unsigned char* ws, const float* outp, unsigned* cs, CsRange r0, CsRange r1, CsRange r2, int use_out) {
    unsigned s1 = 0u, s2 = 0u;
    const size_t gt = (size_t)blockIdx.x * blockDim.x + threadIdx.x, NT = (size_t)gridDim.x * blockDim.x;
    CsRange rr[3] = {r0, r1, r2};
#pragma unroll
    for (int k = 0; k < 3; ++k) { const unsigned* p = (const unsigned*)(ws + rr[k].off); const size_t n = rr[k].bytes / 4;
        for (size_t i = gt; i < n; i += NT) { const unsigned w = p[i]; s1 += w; s2 += w * ((unsigned)(i & 0xffffu) | 1u); } }
    if (use_out) { const unsigned* p = (const unsigned*)outp; const size_t n = (size_t)S * DM;
        for (size_t i = gt; i < n; i += NT) { const unsigned w = p[i]; s1 += w; s2 += w * ((unsigned)(i & 0xffffu) | 1u); } }
    atomicAdd(cs, s1); atomicAdd(cs + 1, s2);
}
__global__ void encode_kernel(float* outp, const unsigned* cs) {
    int code = 20;
    for (int k = 9; k >= 0; --k) if (cs[2 * k] != cs[32 + 2 * k] || cs[2 * k + 1] != cs[32 + 2 * k + 1]) code = k + 1;
    const float c = sqrtf(10.0f * (float)code);
    const size_t gt = (size_t)blockIdx.x * blockDim.x + threadIdx.x, NT = (size_t)gridDim.x * blockDim.x;
    for (size_t i = gt; i < (size_t)S * DM; i += NT) outp[i] = c;
}
#endif


#if MK_PER_PHASE == 3
__global__ void zsum_kernel(const unsigned char* ws, unsigned* cs) {
    unsigned g[6] = {0u, 0u, 0u, 0u, 0u, 0u};
    const size_t gt = (size_t)blockIdx.x * blockDim.x + threadIdx.x, NT = (size_t)gridDim.x * blockDim.x;
    const unsigned* z = (const unsigned*)(ws + WS_Z); const size_t n = (size_t)S * ZW / 2;
    for (size_t i = gt; i < n; i += NT) { const int col = (int)(i % (ZW / 2)) * 2, pn = col >> 8; const unsigned w = z[i] * ((unsigned)(i & 0xffffu) | 1u);
        const int grp = (pn < 16) ? 0 : (pn < 24) ? 1 : (pn < 30) ? 2 : (pn == 30) ? 4 : 3; g[grp] += w; }
    const unsigned* q = (const unsigned*)(ws + WS_SSQC); for (size_t i = gt; i < (size_t)S * 24; i += NT) g[5] += q[i] * ((unsigned)(i & 0xffffu) | 1u);
#pragma unroll
    for (int k = 0; k < 6; ++k) atomicAdd(cs + k, g[k]);
}
__global__ void encode3_kernel(float* outp, const unsigned* cs) {
    int mask = 0;
    for (int k = 0; k < 6; ++k) if (cs[k] != cs[8 + k]) mask |= (k < 5 ? (1 << k) : 0);
    int rer = 0; for (int k = 0; k < 6; ++k) if (cs[8 + k] != cs[16 + k]) rer = 1;
    const int ssq = cs[5] != cs[13];
    const float c = sqrtf(10.0f * (float)(mask + 1) + 1000.0f * rer + 2000.0f * ssq);
    const size_t gt = (size_t)blockIdx.x * blockDim.x + threadIdx.x, NT = (size_t)gridDim.x * blockDim.x;
    for (size_t i = gt; i < (size_t)S * DM; i += NT) outp[i] = c;
}
#endif

constexpr int N_PHASES = 10;
extern "C" void kernel_launch(void* const* d_in, const int* in_sizes, int n_in, void* d_out, int out_size, void* d_ws, size_t ws_size, hipStream_t stream) {
    static int grid = 0;
    if (grid == 0) {
        if (n_in != 22 || in_sizes[0] != S * DM || out_size != S * DM || ws_size < WS_END) { fprintf(stderr, "kernel_launch: unexpected shapes (n_in %d, in0 %d, out %d, ws %zu)\n", n_in, n_in > 0 ? in_sizes[0] : -1, out_size, ws_size); grid = -1; return; }
        int dev = 0, cus = 0, per_cu = 0;
        if (hipGetDevice(&dev) != hipSuccess || hipDeviceGetAttribute(&cus, hipDeviceAttributeMultiprocessorCount, dev) != hipSuccess) { grid = -1; return; }
        if (hipFuncSetAttribute((const void*)fwd_kernel, hipFuncAttributeMaxDynamicSharedMemorySize, LDS_BYTES) != hipSuccess) { fprintf(stderr, "kernel_launch: hipFuncSetAttribute failed\n"); grid = -1; return; }
        if (hipOccupancyMaxActiveBlocksPerMultiprocessor(&per_cu, (const void*)fwd_kernel, NWAVES * 64, LDS_BYTES) != hipSuccess || per_cu < 1)
            fprintf(stderr, "kernel_launch: note: occupancy query reports %d workgroups per CU\n", per_cu);
        (void)hipGetLastError();
        grid = cus;
    }
    if (grid < 0) return;
    if (hipMemsetAsync((char*)d_ws + WS_CTL, 0, CTL_ZERO_BYTES, stream) != hipSuccess) return;
    Args a{};
    a.x = (const float*)d_in[0]; a.pos = (const int*)d_in[1]; a.norm_mix_w = (const float*)d_in[2]; a.w_in = (const float*)d_in[3];
    a.lq1 = (const float*)d_in[4]; a.lk1 = (const float*)d_in[5]; a.lq2 = (const float*)d_in[6]; a.lk2 = (const float*)d_in[7];
    a.subln_w = (const float*)d_in[8]; a.q_norm_w = (const float*)d_in[9]; a.w_uq = (const float*)d_in[10]; a.kv_norm_w = (const float*)d_in[11];
    a.w_ukv = (const float*)d_in[12]; a.w_o_diff = (const float*)d_in[13]; a.w_o_mla = (const float*)d_in[14]; a.w_out = (const float*)d_in[15];
    a.norm_ffn_w = (const float*)d_in[16]; a.w_up = (const float*)d_in[17]; a.conv_w = (const float*)d_in[18]; a.conv_b = (const float*)d_in[19];
    a.w_down = (const float*)d_in[20]; a.final_w = (const float*)d_in[21];
    a.out = (float*)d_out; a.ws = (unsigned char*)d_ws;
#if MK_PER_PHASE == 3
    unsigned* cs = (unsigned*)((char*)d_ws + 512 * 1024);
    for (int run = 0; run < 2; ++run) {
        hipMemsetAsync((char*)d_ws + MiB, run ? 0x55 : 0xAA, WS_END - MiB, stream);
        for (int p = 0; p < 2; ++p) { a.ph_lo = p; a.ph_hi = p + 1; hipLaunchKernelGGL(fwd_kernel, dim3(grid), dim3(NWAVES * 64), LDS_BYTES, stream, a); }
        hipLaunchKernelGGL(zsum_kernel, dim3(2048), dim3(256), 0, stream, (const unsigned char*)d_ws, cs + 8 * run);
    }
    a.ph_lo = 1; a.ph_hi = 2; hipLaunchKernelGGL(fwd_kernel, dim3(grid), dim3(NWAVES * 64), LDS_BYTES, stream, a);
    hipLaunchKernelGGL(zsum_kernel, dim3(2048), dim3(256), 0, stream, (const unsigned char*)d_ws, cs + 16);
    hipLaunchKernelGGL(encode3_kernel, dim3(2048), dim3(256), 0, stream, (float*)d_out, (const unsigned*)cs);
#elif MK_PER_PHASE == 2
    unsigned* cs = (unsigned*)((char*)d_ws + 512 * 1024);
    for (int run = 0; run < 2; ++run) {
        hipMemsetAsync((char*)d_ws + MiB, run ? 0x55 : 0xAA, WS_END - MiB, stream); hipMemsetAsync(d_out, run ? 0x55 : 0xAA, (size_t)S * DM * 4, stream);
        for (int p = 0; p < N_PHASES; ++p) { a.ph_lo = p; a.ph_hi = p + 1; hipLaunchKernelGGL(fwd_kernel, dim3(grid), dim3(NWAVES * 64), LDS_BYTES, stream, a);
            CsRange r0{0, 0}, r1{0, 0}, r2{0, 0}; int uo = 0;
            switch (p) {
                case 0: r0 = {WS_COS, 2 * MiB}; r1 = {WS_WIN, WS_O - WS_WIN}; break;
                case 1: r0 = {WS_Z, 252 * MiB}; r1 = {WS_SSQC, (size_t)S * 24 * 4}; break;
                case 2: r0 = {WS_QM, 112 * MiB}; break;
                case 3: r0 = {WS_O, 64 * MiB}; r1 = {WS_O1, 64 * MiB}; break;
                case 4: r0 = {WS_H, 64 * MiB}; r1 = {WS_T1, 128 * MiB}; break;
                case 5: r0 = {WS_X1, 128 * MiB}; r1 = {WS_O, 64 * MiB}; r2 = {WS_SSQ1, 2 * MiB}; break;
                case 6: r0 = {WS_U, 344 * MiB}; r1 = {WS_RSTD1, (size_t)S * 4}; break;
                case 7: r0 = {WS_ACT, 172 * MiB}; break;
                case 8: r0 = {WS_SSQ2, 2 * MiB}; uo = 1; break;
                default: uo = 1; break;
            }
            hipLaunchKernelGGL(csum_kernel, dim3(2048), dim3(256), 0, stream, (const unsigned char*)d_ws, (const float*)d_out, cs + 32 * run + 2 * p, r0, r1, r2, uo);
        }
    }
    hipLaunchKernelGGL(encode_kernel, dim3(2048), dim3(256), 0, stream, (float*)d_out, (const unsigned*)cs);
#elif MK_PER_PHASE
    for (int p = 0; p < N_PHASES; ++p) { a.ph_lo = p; a.ph_hi = p + 1; hipLaunchKernelGGL(fwd_kernel, dim3(grid), dim3(NWAVES * 64), LDS_BYTES, stream, a); }
#else
    a.ph_lo = 0; a.ph_hi = N_PHASES;
    hipLaunchKernelGGL(fwd_kernel, dim3(grid), dim3(NWAVES * 64), LDS_BYTES, stream, a);
#endif
    const hipError_t le = hipPeekAtLastError();
    if (le != hipSuccess) fprintf(stderr, "kernel_launch: launch failed: %s\n", hipGetErrorName(le));
}
```

```cpp
#include <hip/hip_runtime.h>
#include <hip/hip_bf16.h>
#include <cstdio>
#include <cstdint>

#ifndef MK_PER_PHASE
#define MK_PER_PHASE 0
#endif

constexpr int S = 8192, DM = 4096, NHEAD = 16;
constexpr int INW = 15936, ZW = 16128;
constexpr int ZC_QD = 0, ZC_KD = 2048, ZC_VD = 4096, ZC_CQ = 6144, ZC_CKV = 7168, ZC_KR = 7680, ZC_GD = 7936, ZC_GM = 12032;
constexpr int QRANK = 1024, KVRANK = 512;
constexpr int QMW = 3072, KVW = 4096;
constexpr int DFF = 11008, UPW = 22016;
constexpr float NORM_EPS = 1e-6f, SUBLN_EPS = 1e-5f, LAMBDA_INIT = 0.2f;

#define GAS __attribute__((address_space(1)))
#define LAS __attribute__((address_space(3)))
typedef unsigned short bf16;
typedef unsigned v4u __attribute__((ext_vector_type(4)));
typedef unsigned v2u __attribute__((ext_vector_type(2)));
typedef GAS unsigned gu32;
#define RLX_AGENT __ATOMIC_RELAXED, __HIP_MEMORY_SCOPE_AGENT
#define LDS_WAIT() asm volatile("s_waitcnt lgkmcnt(0)" ::: "memory")
#define VM_WAIT() asm volatile("s_waitcnt vmcnt(0)" ::: "memory")

namespace pg8 {
#define PG8_LAS __attribute__((address_space(3)))
typedef unsigned short bf16_t;
typedef short bf16x8 __attribute__((ext_vector_type(8)));
typedef float f32x4 __attribute__((ext_vector_type(4)));
typedef unsigned u32x4 __attribute__((ext_vector_type(4)));
constexpr int BM = 256, BK = 64, HALF = 128, HTB = HALF * BK * 2, STAGE_BYTES = 8 * HTB, NXCD = 8, WGM = 8;

__host__ __device__ __forceinline__ int lds_byte(int r, int c) { const int st = (r >> 4) * 2 + (c >> 5), rr = r & 15, cc = c & 31, ob = rr * 64 + cc * 2; return st * 1024 + (ob ^ (((ob >> 9) & 1) << 5)); }
__host__ __device__ __forceinline__ void stage_rc(int b, int& R, int& C) { const int st = b / 1024, sb = b % 1024, swz = sb ^ (((sb >> 9) & 1) << 5); R = (st >> 1) * 16 + swz / 64; C = (st & 1) * 32 + (swz % 64) / 2; }
__host__ __device__ __forceinline__ int perm32(int rho) { const int n = rho >> 4, i = rho & 15; return 8 * (i >> 2) + 4 * n + (i & 3); }

struct Unit { int pm, pn; };
typedef int v8i32g __attribute__((ext_vector_type(8))); typedef int v4i32g __attribute__((ext_vector_type(4)));
struct Gemm { const bf16_t* A; const bf16_t* Bt; int M, N, K, lda, ldb; };

struct StaticOrder {
    int nM, nN, nwg, G, c;
    __host__ __device__ void init(int M, int N, int G_, int c_) { nM = M / BM; nN = N / BM; nwg = nM * nN; G = G_; c = c_; }
    __host__ __device__ __forceinline__ bool next(int i, Unit& u) const {
        const long L = (long)i * G + c; if (L >= nwg) return false;
        int wgid = (int)L; { const int q = nwg / NXCD, r = nwg % NXCD, xcd = wgid % NXCD, off = wgid / NXCD; wgid = (xcd < r ? xcd * (q + 1) : r * (q + 1) + (xcd - r) * q) + off; }
        const int nig = WGM * nN, gid = wgid / nig, fm = gid * WGM, gsz = (nM - fm) < WGM ? (nM - fm) : WGM;
        u.pm = fm + ((wgid % nig) % gsz); u.pn = (wgid % nig) / gsz; return true;
    }
    __device__ __forceinline__ void a_ready(const Unit&) const {}
    __device__ __forceinline__ void done(const Unit&) const {}
};

typedef float f32x2_t __attribute__((ext_vector_type(2))); typedef __bf16 bf16x2_t __attribute__((ext_vector_type(2)));
__device__ __forceinline__ unsigned cvt_pk_bf16(float lo, float hi) { f32x2_t v = {lo, hi}; bf16x2_t b = __builtin_convertvector(v, bf16x2_t); return __builtin_bit_cast(unsigned, b); }
__device__ __forceinline__ u32x4 pack8(f32x4 a, f32x4 b) { u32x4 w; w.x = cvt_pk_bf16(a[0], a[1]); w.y = cvt_pk_bf16(a[2], a[3]); w.z = cvt_pk_bf16(b[0], b[1]); w.w = cvt_pk_bf16(b[2], b[3]); return w; }
__device__ __forceinline__ void unpack8(u32x4 w, f32x4& a, f32x4& b) {
    a[0] = __uint_as_float(w.x << 16); a[1] = __uint_as_float(w.x & 0xffff0000u); a[2] = __uint_as_float(w.y << 16); a[3] = __uint_as_float(w.y & 0xffff0000u);
    b[0] = __uint_as_float(w.z << 16); b[1] = __uint_as_float(w.z & 0xffff0000u); b[2] = __uint_as_float(w.w << 16); b[3] = __uint_as_float(w.w & 0xffff0000u); }
__device__ __forceinline__ unsigned pk4_fp8(const f32x4 v) { int w = __builtin_amdgcn_cvt_pk_fp8_f32(v[0], v[1], 0, false); w = __builtin_amdgcn_cvt_pk_fp8_f32(v[2], v[3], w, true); return (unsigned)w; }
__device__ __forceinline__ unsigned pk4_i8(const f32x4 v) { unsigned w = 0;
#pragma unroll
    for (int e = 0; e < 4; ++e) { const int q = (int)__builtin_rintf(__builtin_fminf(__builtin_fmaxf(v[e], -127.f), 127.f)); w |= ((unsigned)q & 0xffu) << (8 * e); } return w; }
__device__ __forceinline__ float sigmoidf_fast(float v) { return __builtin_amdgcn_rcpf(1.0f + __builtin_amdgcn_exp2f(-1.4426950408889634f * v)); }
__device__ __forceinline__ void rope8(f32x4& v0, f32x4& v1, const f32x4 c4, const f32x4 s4) {
    const f32x4 a = v0, b = v1;
    v0[0] = a[0] * c4[0] - a[1] * s4[0]; v0[1] = a[1] * c4[0] + a[0] * s4[0]; v0[2] = a[2] * c4[1] - a[3] * s4[1]; v0[3] = a[3] * c4[1] + a[2] * s4[1];
    v1[0] = b[0] * c4[2] - b[1] * s4[2]; v1[1] = b[1] * c4[2] + b[0] * s4[2]; v1[2] = b[2] * c4[3] - b[3] * s4[3]; v1[3] = b[3] * c4[3] + b[2] * s4[3];
}
__device__ __forceinline__ float sumsq8(const f32x4 a, const f32x4 b) { return (a[0] * a[0] + a[1] * a[1]) + (a[2] * a[2] + a[3] * a[3]) + (b[0] * b[0] + b[1] * b[1]) + (b[2] * b[2] + b[3] * b[3]); }

#define EPI_ROWS(ai, m) _Pragma("unroll") for (int ai = 0; ai < 2; ++ai) _Pragma("unroll") for (int m = 0; m < 4; ++m)

typedef unsigned u32x2w __attribute__((ext_vector_type(2)));
struct EpiIn {
    static constexpr bool PERM = true, AFTER_DRAIN = false;
    bf16_t* Z; const float* cosT; const float* sinT; float* ssq; unsigned char* KR8;
    __device__ __forceinline__ void operator()(f32x4 (&acc)[2][2][4][2], const Unit& u, int wr, int wc, int fr, int fq) const {
        const int pn = u.pn, row0 = u.pm * BM + wr * 64 + fr, col0 = pn * BM + wc * 32 + 8 * fq;
        if (pn < 16 || pn == 30) {
            const int i0 = 16 * (wc & 1) + 4 * fq; const float qsc = (pn < 8) ? 0.18033688011112042f : 1.0f;
            EPI_ROWS(ai, m) { const int r = row0 + ai * HALF + m * 16; const f32x4 c4 = *(const f32x4*)(cosT + (size_t)r * 32 + i0), s4 = *(const f32x4*)(sinT + (size_t)r * 32 + i0);
                bf16_t* rowp = Z + (size_t)r * ZW + col0;
#pragma unroll
                for (int bj = 0; bj < 2; ++bj) { f32x4 v0 = acc[ai][bj][m][0], v1 = acc[ai][bj][m][1]; rope8(v0, v1, c4, s4); v0 *= qsc; v1 *= qsc; *(u32x4*)(rowp + bj * HALF) = pack8(v0, v1);
                    if (pn == 30 && bj == 0 && wc < 2) { u32x2w w8; w8.x = pk4_fp8(v0); w8.y = pk4_fp8(v1); *(u32x2w*)(KR8 + (size_t)r * 64 + wc * 32 + 8 * fq) = w8; } } }
        } else if (pn < 24) {
            EPI_ROWS(ai, m) { const int r = row0 + ai * HALF + m * 16; bf16_t* rowp = Z + (size_t)r * ZW + col0;
#pragma unroll
                for (int bj = 0; bj < 2; ++bj) *(u32x4*)(rowp + bj * HALF) = pack8(acc[ai][bj][m][0], acc[ai][bj][m][1]); }
        } else if (pn < 30) {
            EPI_ROWS(ai, m) { const int r = row0 + ai * HALF + m * 16; bf16_t* rowp = Z + (size_t)r * ZW + col0; float ss = 0.f;
#pragma unroll
                for (int bj = 0; bj < 2; ++bj) { ss += sumsq8(acc[ai][bj][m][0], acc[ai][bj][m][1]); *(u32x4*)(rowp + bj * HALF) = pack8(acc[ai][bj][m][0], acc[ai][bj][m][1]); }
                ss += __shfl_xor(ss, 16); ss += __shfl_xor(ss, 32);
                if (fq == 0) ssq[(size_t)r * 24 + (pn - 24) * 4 + wc] = ss; }
        } else {
            EPI_ROWS(ai, m) { const int r = row0 + ai * HALF + m * 16; bf16_t* rowp = Z + (size_t)r * ZW + col0;
#pragma unroll
                for (int bj = 0; bj < 2; ++bj) { f32x4 v0 = acc[ai][bj][m][0], v1 = acc[ai][bj][m][1];
#pragma unroll
                    for (int e = 0; e < 4; ++e) { v0[e] = sigmoidf_fast(v0[e]); v1[e] = sigmoidf_fast(v1[e]); }
                    *(u32x4*)(rowp + bj * HALF) = pack8(v0, v1); } }
        }
    }
};

struct EpiInMla {
    static constexpr bool PERM = true, AFTER_DRAIN = false;
    bf16_t* Z; const float* cosT; const float* sinT; float* ssq; unsigned char* KR8;
    __device__ __forceinline__ void operator()(f32x4 (&acc)[2][2][4][2], const Unit& u, int wr, int wc, int fr_, int fq_) const {
        int opq = 0; asm volatile("" : "+v"(opq));
        const int fr = fr_ + opq, fq = fq_ + opq;
        const int pn = u.pn, row0 = u.pm * BM + wr * 64 + fr, col0 = pn * BM + wc * 32 + 8 * fq;
        if (pn == 30) {
            const int i0 = 16 * (wc & 1) + 4 * fq;
            EPI_ROWS(ai, m) { const int r = row0 + ai * HALF + m * 16; const f32x4 c4 = *(const f32x4*)(cosT + (size_t)r * 32 + i0), s4 = *(const f32x4*)(sinT + (size_t)r * 32 + i0);
                bf16_t* rowp = Z + (size_t)r * ZW + col0;
#pragma unroll
                for (int bj = 0; bj < 2; ++bj) { f32x4 v0 = acc[ai][bj][m][0], v1 = acc[ai][bj][m][1]; rope8(v0, v1, c4, s4); *(u32x4*)(rowp + bj * HALF) = pack8(v0, v1);
                    if (bj == 0 && wc < 2) { u32x2w w8; w8.x = pk4_fp8(v0); w8.y = pk4_fp8(v1); *(u32x2w*)(KR8 + (size_t)r * 64 + wc * 32 + 8 * fq) = w8; } } }
        } else {
            EPI_ROWS(ai, m) { const int r = row0 + ai * HALF + m * 16; bf16_t* rowp = Z + (size_t)r * ZW + col0; float ss = 0.f;
#pragma unroll
                for (int bj = 0; bj < 2; ++bj) { ss += sumsq8(acc[ai][bj][m][0], acc[ai][bj][m][1]); *(u32x4*)(rowp + bj * HALF) = pack8(acc[ai][bj][m][0], acc[ai][bj][m][1]); }
                ss += __builtin_bit_cast(float, __builtin_amdgcn_ds_swizzle(__builtin_bit_cast(int, ss), 0x401F));
                { auto rr = __builtin_amdgcn_permlane32_swap(__builtin_bit_cast(unsigned, ss), __builtin_bit_cast(unsigned, ss), false, false); ss = __builtin_bit_cast(float, rr[0]) + __builtin_bit_cast(float, rr[1]); }
                if (fq == 0) ssq[(size_t)r * 24 + (pn - 24) * 4 + wc] = ss; }
        }
    }
};

struct EpiInGate {
    static constexpr bool PERM = true, AFTER_DRAIN = false;
    bf16_t* Z; const float* hsc; const float* wmx;
    __device__ __forceinline__ void operator()(f32x4 (&acc)[2][2][4][2], const Unit& u, int wr, int wc, int fr_, int fq_) const {
        int opq = 0; asm volatile("" : "+v"(opq));
        const int fr = fr_ + opq, fq = fq_ + opq;
        const int row0 = u.pm * BM + wr * 64 + fr, col0 = u.pn * BM + wc * 32 + 8 * fq;
        f32x4 ws0[2], ws1[2];
#pragma unroll
        for (int bj = 0; bj < 2; ++bj) { const float* wp = wmx + (col0 - ZC_GD) + bj * HALF; ws0[bj] = *(const f32x4*)wp * (1.0f / 127.0f); ws1[bj] = *(const f32x4*)(wp + 4) * (1.0f / 127.0f); }
        EPI_ROWS(ai, m) { const int r = row0 + ai * HALF + m * 16; bf16_t* rowp = Z + (size_t)r * ZW + col0; const float dq = hsc[r];
#pragma unroll
            for (int bj = 0; bj < 2; ++bj) { f32x4 v0 = acc[ai][bj][m][0] * (ws0[bj] * dq), v1 = acc[ai][bj][m][1] * (ws1[bj] * dq);
#pragma unroll
                for (int e = 0; e < 4; ++e) { v0[e] = sigmoidf_fast(v0[e]); v1[e] = sigmoidf_fast(v1[e]); }
                *(u32x4*)(rowp + bj * HALF) = pack8(v0, v1); } }
    }
};

template <int SLOT0, int NP4, int KDIM, int F8_BELOW> struct EpiMla {
    static constexpr bool PERM = true, AFTER_DRAIN = false;
    bf16_t* O; int ldc; const float* ssq; const float* cosT; const float* sinT; int rope_from; unsigned char* O8; int ld8;
    __device__ __forceinline__ void operator()(f32x4 (&acc)[2][2][4][2], const Unit& u, int wr, int wc, int fr, int fq) const {
        const int pn = u.pn, row0 = u.pm * BM + wr * 64 + fr, col0 = pn * BM + wc * 32 + 8 * fq, i0 = 16 * (wc & 1) + 4 * fq;
        const bool rope = pn >= rope_from;
        EPI_ROWS(ai, m) { const int r = row0 + ai * HALF + m * 16; float ss = 0.f;
#pragma unroll
            for (int q = 0; q < NP4; ++q) { const f32x4 p = *(const f32x4*)(ssq + (size_t)r * 24 + SLOT0 + 4 * q); ss += (p[0] + p[1]) + (p[2] + p[3]); }
            const float rs = __builtin_amdgcn_rsqf(ss * (1.0f / KDIM) + NORM_EPS);
            f32x4 c4 = {1.f, 1.f, 1.f, 1.f}, s4 = {0.f, 0.f, 0.f, 0.f};
            if (rope) { c4 = *(const f32x4*)(cosT + (size_t)r * 32 + i0); s4 = *(const f32x4*)(sinT + (size_t)r * 32 + i0); }
            bf16_t* rowp = O + (size_t)r * ldc + col0;
#pragma unroll
            for (int bj = 0; bj < 2; ++bj) { f32x4 v0 = acc[ai][bj][m][0] * rs, v1 = acc[ai][bj][m][1] * rs; if (rope) rope8(v0, v1, c4, s4);
                if (pn < F8_BELOW) { u32x2w w8; w8.x = pk4_fp8(v0); w8.y = pk4_fp8(v1); *(u32x2w*)(O8 + (size_t)r * ld8 + col0 + bj * HALF) = w8; }
                else *(u32x4*)(rowp + bj * HALF) = pack8(v0, v1); } }
    }
};

struct GateHook {
    static constexpr bool ENABLED = true;
    const bf16_t* GD; const bf16_t* GM;
    __device__ __forceinline__ void operator()(f32x4 (&acc)[2][2][4][2], const Unit& u, int wr, int wc, int fr, int fq) const {
        int opq = 0; asm volatile("" : "+v"(opq));
        const int row0 = u.pm * BM + wr * 64 + fr + opq, col0 = u.pn * BM + wc * 32 + 8 * fq;
        EPI_ROWS(ai, m) { const size_t ro = (size_t)(row0 + ai * HALF + m * 16) * ZW + col0;
#pragma unroll
            for (int bj = 0; bj < 2; ++bj) { f32x4 d0, d1, m0, m1; unpack8(*(const u32x4*)(GD + ro + bj * HALF), d0, d1); unpack8(*(const u32x4*)(GM + ro + bj * HALF), m0, m1);
#pragma unroll
                for (int e = 0; e < 4; ++e) { acc[ai][bj][m][0][e] *= d0[e] * __builtin_amdgcn_rcpf(fmaxf(m0[e], 1e-20f)); acc[ai][bj][m][1][e] *= d1[e] * __builtin_amdgcn_rcpf(fmaxf(m1[e], 1e-20f)); } }
            asm volatile("" : "+v"(acc[ai][0][m][0]), "+v"(acc[ai][0][m][1]), "+v"(acc[ai][1][m][0]), "+v"(acc[ai][1][m][1]) :: "memory"); }
    }
};
struct EpiGate {
    static constexpr bool PERM = true, AFTER_DRAIN = false;
    const bf16_t* GM; bf16_t* Y;
    __device__ __forceinline__ void operator()(f32x4 (&acc)[2][2][4][2], const Unit& u, int wr, int wc, int fr, int fq) const {
        const int row0 = u.pm * BM + wr * 64 + fr, col0 = u.pn * BM + wc * 32 + 8 * fq;
        EPI_ROWS(ai, m) { const int r = row0 + ai * HALF + m * 16;
#pragma unroll
            for (int bj = 0; bj < 2; ++bj) { const int c = col0 + bj * HALF; f32x4 g0, g1; unpack8(*(const u32x4*)(GM + (size_t)r * ZW + c), g0, g1);
                *(u32x4*)(Y + (size_t)r * DM + c) = pack8(acc[ai][bj][m][0] * g0, acc[ai][bj][m][1] * g1); } }
    }
};

template <bool RES_BF16> struct EpiRes {
    static constexpr bool PERM = true, AFTER_DRAIN = false;
    const float* xi; bf16_t* xb; float* ssq;
    __device__ __forceinline__ void operator()(f32x4 (&acc)[2][2][4][2], const Unit& u, int wr, int wc, int fr, int fq) const {
        const int row0 = u.pm * BM + wr * 64 + fr, col0 = u.pn * BM + wc * 32 + 8 * fq;
        EPI_ROWS(ai, m) { const int r = row0 + ai * HALF + m * 16; float ss = 0.f;
#pragma unroll
            for (int bj = 0; bj < 2; ++bj) { const size_t off = (size_t)r * DM + col0 + bj * HALF; f32x4 r0, r1;
                if (RES_BF16) unpack8(*(const u32x4*)(xb + off), r0, r1); else { r0 = *(const f32x4*)(xi + off); r1 = *(const f32x4*)(xi + off + 4); }
                const f32x4 v0 = acc[ai][bj][m][0] + r0, v1 = acc[ai][bj][m][1] + r1;
                *(u32x4*)(xb + off) = pack8(v0, v1); ss += sumsq8(v0, v1); }
            ss += __shfl_xor(ss, 16); ss += __shfl_xor(ss, 32);
            if (fq == 0) ssq[(size_t)r * 64 + u.pn * 4 + wc] = ss; }
    }
};

struct EpiPlain {
    static constexpr bool PERM = true, AFTER_DRAIN = false;
    bf16_t* O; int ldc;
    __device__ __forceinline__ void operator()(f32x4 (&acc)[2][2][4][2], const Unit& u, int wr, int wc, int fr, int fq) const {
        const int row0 = u.pm * BM + wr * 64 + fr, col0 = u.pn * BM + wc * 32 + 8 * fq;
        EPI_ROWS(ai, m) { bf16_t* rowp = O + (size_t)(row0 + ai * HALF + m * 16) * ldc + col0;
#pragma unroll
            for (int bj = 0; bj < 2; ++bj) *(u32x4*)(rowp + bj * HALF) = pack8(acc[ai][bj][m][0], acc[ai][bj][m][1]); }
    }
};

__device__ __forceinline__ float dpp_shr1(float old, float src) { return __int_as_float(__builtin_amdgcn_update_dpp(__float_as_int(old), __float_as_int(src), 0x111, 0xf, 0xf, false)); }
__device__ __forceinline__ float dpp_shr2(float old, float src) { return __int_as_float(__builtin_amdgcn_update_dpp(__float_as_int(old), __float_as_int(src), 0x112, 0xf, 0xf, false)); }
__device__ __forceinline__ float dpp_ror1(float src) { return __int_as_float(__builtin_amdgcn_update_dpp(0, __float_as_int(src), 0x121, 0xf, 0xf, false)); }
__device__ __forceinline__ float dpp_ror2(float src) { return __int_as_float(__builtin_amdgcn_update_dpp(0, __float_as_int(src), 0x122, 0xf, 0xf, false)); }
typedef unsigned u32x2 __attribute__((ext_vector_type(2)));
struct EpiUpConv {
    static constexpr bool PERM = true, AFTER_DRAIN = false;
    bf16_t* ACT; float* HALO; const float* cw; const float* cb; const float* rstd; PG8_LAS float* xch; const float* wmx;
    static constexpr int UPW_ = 22016, DFF_ = 11008;
    __device__ __forceinline__ void operator()(f32x4 (&acc)[2][2][4][2], const Unit& u, int wr, int wc, int fr_, int fq_) const {
        int opq = 0; asm volatile("" : "+v"(opq));
        const int fr = fr_ + opq, fq = fq_ + opq;
        const int row0 = u.pm * BM + wr * 64 + fr;
        EPI_ROWS(ai, m) { const float rs = rstd[row0 + ai * HALF + m * 16];
#pragma unroll
            for (int bj = 0; bj < 2; ++bj) { acc[ai][bj][m][0] *= rs; acc[ai][bj][m][1] *= rs; } }
        const size_t hcol = (size_t)u.pn * BM + wc * 32 + 8 * fq;
        if (fr >= 14) {
#pragma unroll
            for (int ai = 0; ai < 2; ++ai) { const int ch = ai * 2 + wr; PG8_LAS float* xp = xch + ((((ch * 2 + (fr - 14)) * 4 + wc) * 4 + fq) * 16);
#pragma unroll
                for (int bj = 0; bj < 2; ++bj) { *(PG8_LAS f32x4*)(xp + bj * 8) = acc[ai][bj][3][0]; *(PG8_LAS f32x4*)(xp + bj * 8 + 4) = acc[ai][bj][3][1]; } }
            if (wr == 1) { float* hp = HALO + ((size_t)u.pm * 4 + 2 + (fr - 14)) * UPW_ + hcol;
#pragma unroll
                for (int bj = 0; bj < 2; ++bj) { *(f32x4*)(hp + bj * HALF) = acc[1][bj][3][0]; *(f32x4*)(hp + bj * HALF + 4) = acc[1][bj][3][1]; } }
        }
        if (fr < 2 && wr == 0) { float* hp = HALO + ((size_t)u.pm * 4 + fr) * UPW_ + hcol;
#pragma unroll
            for (int bj = 0; bj < 2; ++bj) { *(f32x4*)(hp + bj * HALF) = acc[0][bj][0][0]; *(f32x4*)(hp + bj * HALF + 4) = acc[0][bj][0][1]; } }
        PG8_LAS float* wl = xch + 2048;
        { const int tq = threadIdx.x + opq, k = tq >> 6, c2 = (tq & 63) * 2, tap = k & 3; const size_t gc = (size_t)u.pn * 128 + c2 + ((k >> 2) ? DFF_ : 0);
          const float* src = (tap < 3) ? cw + (size_t)tap * UPW_ + gc : cb + gc;
          f32x2_t t = *(const f32x2_t*)src; if (tap < 3) { const float* wsp = wmx + (size_t)u.pn * BM + (k >> 2) * HALF + c2; t[0] *= wsp[0] * (1.0f / 127.0f); t[1] *= wsp[1] * (1.0f / 127.0f); }
          *(PG8_LAS f32x2_t*)(wl + k * 128 + c2) = t; }
        asm volatile("s_waitcnt lgkmcnt(0)\n\ts_barrier" ::: "memory");
        const int c0 = u.pn * 128 + wc * 32 + 8 * fq; const PG8_LAS float* wlp = wl + wc * 32 + 8 * fq;
#pragma unroll
        for (int ai = 0; ai < 2; ++ai) {
            const int ch = ai * 2 + wr;
            f32x4 pgn[2], pvn[2];
#pragma unroll
            for (int m = 0; m < 4; ++m) {
                u32x2 keep;
#pragma unroll
                for (int n = 0; n < 2; ++n) {
                    const PG8_LAS float* wp = wlp + 4 * n;
                    const f32x4 wg0 = *(const PG8_LAS f32x4*)(wp), wg1 = *(const PG8_LAS f32x4*)(wp + 128), wg2 = *(const PG8_LAS f32x4*)(wp + 256), bg = *(const PG8_LAS f32x4*)(wp + 384);
                    const f32x4 wv0 = *(const PG8_LAS f32x4*)(wp + 512), wv1 = *(const PG8_LAS f32x4*)(wp + 640), wv2 = *(const PG8_LAS f32x4*)(wp + 768), bv = *(const PG8_LAS f32x4*)(wp + 896);
                    const f32x4 xg = acc[ai][0][m][n], xv = acc[ai][1][m][n]; f32x4 p1g, p2g, p1v, p2v;
                    if (m == 0) {
                        f32x4 h1g = {0.f, 0.f, 0.f, 0.f}, h2g = h1g, h1v = h1g, h2v = h1g;
                        if (ch > 0) { const PG8_LAS float* xp = xch + (((((ch - 1) * 2) * 4 + wc) * 4 + fq) * 16) + 4 * n;
                            h2g = *(const PG8_LAS f32x4*)xp; h2v = *(const PG8_LAS f32x4*)(xp + 8); h1g = *(const PG8_LAS f32x4*)(xp + 256); h1v = *(const PG8_LAS f32x4*)(xp + 256 + 8); }
#pragma unroll
                        for (int e = 0; e < 4; ++e) { p1g[e] = dpp_shr1(h1g[e], xg[e]); p2g[e] = dpp_shr2(fr == 1 ? h1g[e] : h2g[e], xg[e]); p1v[e] = dpp_shr1(h1v[e], xv[e]); p2v[e] = dpp_shr2(fr == 1 ? h1v[e] : h2v[e], xv[e]); }
                    } else {
#pragma unroll
                        for (int e = 0; e < 4; ++e) { p1g[e] = dpp_shr1(dpp_ror1(pgn[n][e]), xg[e]); p2g[e] = dpp_shr2(dpp_ror2(pgn[n][e]), xg[e]); p1v[e] = dpp_shr1(dpp_ror1(pvn[n][e]), xv[e]); p2v[e] = dpp_shr2(dpp_ror2(pvn[n][e]), xv[e]); }
                    }
                    f32x4 og = bg + wg0 * p2g + wg1 * p1g + wg2 * xg; const f32x4 ov = bv + wv0 * p2v + wv1 * p1v + wv2 * xv;
#pragma unroll
                    for (int e = 0; e < 4; ++e) og[e] = og[e] * sigmoidf_fast(og[e]) * ov[e];
                    u32x2 w; w.x = cvt_pk_bf16(og[0], og[1]); w.y = cvt_pk_bf16(og[2], og[3]);
                    if (n == 0) keep = w; else *(u32x4*)(ACT + (size_t)(row0 + ai * HALF + m * 16) * DFF_ + c0) = (u32x4){keep.x, keep.y, w.x, w.y};
                    pgn[n] = xg; pvn[n] = xv;
                }
                __builtin_amdgcn_sched_barrier(0);
            }
        }
    }
};

struct BalOrder {
    StaticOrder so; int c, G;
    __host__ __device__ void init(int M, int N, int G_, int c_) { so.init(M, N, 1, 0); c = c_; G = G_; }
    __host__ __device__ bool next(int i, Unit& u) const {
        int L;
        if (G != 256 || so.nwg != 512) { L = i * G + c; if (L >= so.nwg) return false; }
        else if (c < 128) { if (i >= 1) return false; L = c; }
        else { if (i >= 3) return false; L = 128 + 3 * (c - 128) + i; }
        return so.next(L, u);
    }
    __device__ __forceinline__ void a_ready(const Unit&) const {}
    __device__ __forceinline__ void done(const Unit&) const {}
};
struct VtOrder {
    int c, G;
    __device__ __forceinline__ bool next(int i, Unit& u) const {
        int L;
        if (G != 256) { L = i * G + c; if (L >= 256) return false; }
        else { if (c < 128 || i >= 2) return false; L = 2 * (c - 128) + i; }
        u.pm = L >> 5; u.pn = L & 31; return true;
    }
    __device__ __forceinline__ void a_ready(const Unit&) const {}
    __device__ __forceinline__ void done(const Unit&) const {}
};
struct EpiVT {
    static constexpr bool PERM = true, AFTER_DRAIN = false;
    unsigned char* VT; const float* ssq; int npos;
    __device__ __forceinline__ void operator()(f32x4 (&acc)[2][2][4][2], const Unit& u, int wr, int wc, int fr_, int fq_) const {
        int opq = 0; asm volatile("" : "+v"(opq));
        const int fr = fr_ + opq, fq = fq_ + opq;
        const int row0 = u.pm * BM + wr * 64 + fr, t0 = u.pn * BM + wc * 32 + 8 * fq;
#pragma unroll
        for (int bj = 0; bj < 2; ++bj) {
            const int tb = t0 + bj * HALF, k0 = tb & 63; const size_t pos = (size_t)(tb & ~63) + 16 * ((k0 >> 5) & 1) + 4 * ((k0 >> 3) & 3);
            f32x4 rs0, rs1;
#pragma unroll
            for (int e = 0; e < 8; ++e) { const float* sp = ssq + (size_t)(tb + e) * 24 + 16; const f32x4 p = *(const f32x4*)sp, q = *(const f32x4*)(sp + 4);
                const float r = __builtin_amdgcn_rsqf(((p[0] + p[1]) + (p[2] + p[3]) + (q[0] + q[1]) + (q[2] + q[3])) * (1.0f / KVRANK_) + NORM_EPS_);
                if (e < 4) rs0[e] = r; else rs1[e - 4] = r; }
            EPI_ROWS(ai, m) { unsigned char* rowp = VT + (size_t)(row0 + ai * HALF + m * 16) * npos + pos;
                *(unsigned*)rowp = pk4_fp8(acc[ai][bj][m][0] * rs0); *(unsigned*)(rowp + 32) = pk4_fp8(acc[ai][bj][m][1] * rs1); }
        }
    }
    static constexpr float KVRANK_ = 512.0f, NORM_EPS_ = 1e-6f;
};
struct SkipOrder {
    StaticOrder s; int skip_from, skip_n;
    __device__ __forceinline__ bool next(int i, Unit& u) const { if (!s.next(i, u)) return false; if (u.pn >= skip_from) u.pn += skip_n; return true; }
    __device__ __forceinline__ void a_ready(const Unit&) const {}
    __device__ __forceinline__ void done(const Unit&) const {}
};
struct NoHook { static constexpr bool ENABLED = false; __device__ __forceinline__ void operator()(f32x4 (&)[2][2][4][2], const Unit&, int, int, int, int) const {} };
template <class Epi, class Sched, bool ALIGN_EPI, class Hook = NoHook, bool F8 = false, bool I8 = false>
__device__ __forceinline__ void gemm_phase(PG8_LAS unsigned char* lds, const Gemm g, const Sched& S, const Epi& E, const Hook& HK = Hook()) {
    const int tid = threadIdx.x, wid = __builtin_amdgcn_readfirstlane(tid >> 6), lane = tid & 63, wr = wid >> 2, wc = wid & 3, fr = lane & 15, fq = lane >> 4;
    const int K = g.K, nt = K / BK;
    unsigned voffA[2], voffB[2];
#pragma unroll
    for (int i = 0; i < 2; ++i) { int R, C; stage_rc(tid * 16 + i * 8192, R, C); const int Rb = Epi::PERM ? ((R & ~31) + perm32(R & 31)) : R;
        voffA[i] = (unsigned)(R * g.lda + C) * 2u; voffB[i] = (unsigned)(Rb * g.ldb + C) * 2u; }
    const size_t kstep = (size_t)(BK * 2);
    const size_t hstepA = (size_t)HALF * g.lda * 2, hstepB = (size_t)HALF * g.ldb * 2;
    const size_t tstepA = 2 * hstepA, tstepB = 2 * hstepB;
    const unsigned ldsw = (unsigned)wid * 1024u;
    const int aoff = lds_byte(wr * 64 + fr, F8 ? fq * 16 : fq * 8), boff = lds_byte(wc * 32 + fr, F8 ? fq * 16 : fq * 8);
#define PG8_SA(b, h) (((b) * 2 + (h)) * HTB)
#define PG8_SB(b, h) ((4 + (b) * 2 + (h)) * HTB)
#define PG8_STAGE(bufoff, gbase, voff) do { _Pragma("unroll") for (int _i = 0; _i < 2; ++_i) { \
        if (F8) { unsigned keep_; const unsigned la_ = (unsigned)__builtin_amdgcn_readfirstlane((int)(unsigned)(uintptr_t)(lds + (bufoff) + ldsw + _i * 8192)); \
            asm volatile("s_mov_b32 %0, m0\n\ts_mov_b32 m0, %2\n\ts_nop 0\n\tglobal_load_lds_dwordx4 %1, %3\n\ts_mov_b32 m0, %0" : "=&s"(keep_) : "v"((voff)[_i]), "s"(la_), "s"((const char*)(gbase)) : "memory"); } \
        else __builtin_amdgcn_global_load_lds((const unsigned*)((const char*)(gbase) + (voff)[_i]), (PG8_LAS unsigned*)(lds + (bufoff) + ldsw + _i * 8192), 16, 0, 0); } } while (0)
#define PG8_LDA(dst, b, h) do { if (F8) { _Pragma("unroll") for (int m = 0; m < 2; ++m) dst##8[m] = *(const PG8_LAS v8i32g*)(lds + PG8_SA(b, h) + aoff + m * 2048); } \
        else { _Pragma("unroll") for (int m = 0; m < 4; ++m) _Pragma("unroll") for (int k = 0; k < 2; ++k) dst[m][k] = *(const PG8_LAS bf16x8*)(lds + PG8_SA(b, h) + aoff + m * 2048 + k * 1024); } } while (0)
#define PG8_LDB(dst, b, h) do { if (F8) { _Pragma("unroll") for (int n = 0; n < 2; ++n) dst##8[n] = *(const PG8_LAS v8i32g*)(lds + PG8_SB(b, h) + boff + n * 2048); } \
        else { _Pragma("unroll") for (int n = 0; n < 2; ++n) _Pragma("unroll") for (int k = 0; k < 2; ++k) dst[n][k] = *(const PG8_LAS bf16x8*)(lds + PG8_SB(b, h) + boff + n * 2048 + k * 1024); } } while (0)
#define PG8_MMA(ai, bj, At, Bt) do { __builtin_amdgcn_s_setprio(1); _Pragma("unroll") for (int m = 0; m < 4; ++m) _Pragma("unroll") for (int n = 0; n < 2; ++n) _Pragma("unroll") for (int k = 0; k < 2; ++k) { \
        if (I8) acc[ai][bj][m][n] = __builtin_bit_cast(f32x4, __builtin_amdgcn_mfma_i32_16x16x64_i8(__builtin_bit_cast(v4i32g, Bt[n][k]), __builtin_bit_cast(v4i32g, At[m][k]), __builtin_bit_cast(v4i32g, acc[ai][bj][m][n]), 0, 0, 0)); \
        else acc[ai][bj][m][n] = __builtin_amdgcn_mfma_f32_16x16x32_bf16(Bt[n][k], At[m][k], acc[ai][bj][m][n], 0, 0, 0); } __builtin_amdgcn_s_setprio(0); } while (0)
#define PG8_MMA2(ai, b) do { if (F8) { __builtin_amdgcn_s_setprio(1); \
        _Pragma("unroll") for (int m = 0; m < 2; ++m) _Pragma("unroll") for (int n = 0; n < 2; ++n) { \
            acc[ai][0][m][n] = __builtin_amdgcn_mfma_scale_f32_16x16x128_f8f6f4(B08[n], At8[m], acc[ai][0][m][n], 0, 0, 0, 0, 0, 0); acc[ai][1][m][n] = __builtin_amdgcn_mfma_scale_f32_16x16x128_f8f6f4(B18[n], At8[m], acc[ai][1][m][n], 0, 0, 0, 0, 0, 0); } \
        _Pragma("unroll") for (int m = 0; m < 2; ++m) At8[m] = *(const PG8_LAS v8i32g*)(lds + PG8_SA(b, ai) + aoff + (m + 2) * 2048); \
        _Pragma("unroll") for (int m = 0; m < 2; ++m) _Pragma("unroll") for (int n = 0; n < 2; ++n) { \
            acc[ai][0][m + 2][n] = __builtin_amdgcn_mfma_scale_f32_16x16x128_f8f6f4(B08[n], At8[m], acc[ai][0][m + 2][n], 0, 0, 0, 0, 0, 0); acc[ai][1][m + 2][n] = __builtin_amdgcn_mfma_scale_f32_16x16x128_f8f6f4(B18[n], At8[m], acc[ai][1][m + 2][n], 0, 0, 0, 0, 0, 0); } \
        __builtin_amdgcn_s_setprio(0); } else { PG8_MMA(ai, 0, At, B0); PG8_MMA(ai, 1, At, B1); } } while (0)
#define PG8_WAIT_V(n) asm volatile("s_waitcnt vmcnt(" #n ")" ::: "memory")
#define PG8_WAIT_L(n) asm volatile("s_waitcnt lgkmcnt(" #n ")" ::: "memory")
#define PG8_BAR __builtin_amdgcn_s_barrier()
#define PG8_SCHED __builtin_amdgcn_sched_barrier(0)
    Unit cur, nxt; int ui = 0;
    if (!S.next(0, cur)) return;
    f32x4 acc[2][2][4][2];
#pragma unroll
    for (int a = 0; a < 2; ++a)
#pragma unroll
        for (int b = 0; b < 2; ++b)
#pragma unroll
            for (int m = 0; m < 4; ++m)
#pragma unroll
                for (int n = 0; n < 2; ++n) acc[a][b][m][n] = (f32x4){0.f, 0.f, 0.f, 0.f};
    bf16x8 At[4][2], B0[2][2], B1[2][2];
    v8i32g At8[2], B08[2], B18[2];
    const char* cA = (const char*)g.A + (size_t)cur.pm * tstepA; const char* cB = (const char*)g.Bt + (size_t)cur.pn * tstepB;
    S.a_ready(cur);
    PG8_STAGE(PG8_SB(0, 0), cB, voffB); PG8_STAGE(PG8_SB(0, 1), cB + hstepB, voffB); PG8_STAGE(PG8_SA(0, 0), cA, voffA); PG8_STAGE(PG8_SA(0, 1), cA + hstepA, voffA);
    if (wr == 1) PG8_BAR;
    PG8_WAIT_V(2); PG8_BAR;
    PG8_STAGE(PG8_SB(1, 0), cB + kstep, voffB); PG8_STAGE(PG8_SA(1, 0), cA + kstep, voffA); PG8_STAGE(PG8_SB(1, 1), cB + hstepB + kstep, voffB);
    PG8_WAIT_V(6); PG8_BAR;
    for (;;) {
        const bool has_next = S.next(ui + 1, nxt);
        const char* nA = has_next ? (const char*)g.A + (size_t)nxt.pm * tstepA : cA; const char* nB = has_next ? (const char*)g.Bt + (size_t)nxt.pn * tstepB : cB;
        for (int t = 0; t < nt; t += 2) {
            const bool last = (t == nt - 2);
            const char* a1 = cA + (size_t)(t + 1) * kstep;
            const char* a2 = last ? nA : cA + (size_t)(t + 2) * kstep; const char* b2 = last ? nB : cB + (size_t)(t + 2) * kstep;
            const char* a3 = a2 + kstep; const char* b3 = b2 + kstep;
            if (last && has_next) S.a_ready(nxt);
            if (Hook::ENABLED && t == (nt >> 1)) HK(acc, cur, wr, wc, fr, fq);
            PG8_LDB(B0, 0, 0); PG8_LDB(B1, 0, 1); PG8_SCHED; PG8_LDA(At, 0, 0); PG8_STAGE(PG8_SA(1, 1), a1 + hstepA, voffA);
            PG8_WAIT_V(8); PG8_WAIT_L(0); PG8_BAR; PG8_MMA2(0, 0); PG8_BAR; PG8_SCHED;
            PG8_LDA(At, 0, 1); PG8_STAGE(PG8_SB(0, 0), b2, voffB); PG8_STAGE(PG8_SB(0, 1), b2 + hstepB, voffB); PG8_STAGE(PG8_SA(0, 0), a2, voffA);
            PG8_WAIT_V(8); PG8_WAIT_L(0); PG8_BAR; PG8_MMA2(1, 0); PG8_BAR; PG8_SCHED;
            PG8_LDB(B0, 1, 0); PG8_LDB(B1, 1, 1); PG8_SCHED; PG8_LDA(At, 1, 0); PG8_STAGE(PG8_SA(0, 1), a2 + hstepA, voffA);
            PG8_WAIT_V(8); PG8_WAIT_L(0); PG8_BAR; PG8_MMA2(0, 1); PG8_BAR; PG8_SCHED;
            PG8_LDA(At, 1, 1); PG8_STAGE(PG8_SB(1, 0), b3, voffB); PG8_STAGE(PG8_SB(1, 1), b3 + hstepB, voffB); PG8_STAGE(PG8_SA(1, 0), a3, voffA);
            PG8_WAIT_V(8); PG8_WAIT_L(0); PG8_BAR; PG8_MMA2(1, 1); PG8_BAR; PG8_SCHED;
        }
        if constexpr (ALIGN_EPI) { if (wr == 0) PG8_BAR; }
        if constexpr (I8) {
#pragma unroll
            for (int a = 0; a < 2; ++a)
#pragma unroll
                for (int b = 0; b < 2; ++b)
#pragma unroll
                    for (int m = 0; m < 4; ++m)
#pragma unroll
                        for (int n = 0; n < 2; ++n) acc[a][b][m][n] = __builtin_convertvector(__builtin_bit_cast(v4i32g, acc[a][b][m][n]), f32x4); }
        E(acc, cur, wr, wc, fr, fq); S.done(cur);
        if (!has_next) break;
#pragma unroll
        for (int a = 0; a < 2; ++a)
#pragma unroll
            for (int b = 0; b < 2; ++b)
#pragma unroll
                for (int m = 0; m < 4; ++m)
#pragma unroll
                    for (int n = 0; n < 2; ++n) acc[a][b][m][n] = (f32x4){0.f, 0.f, 0.f, 0.f};
        cur = nxt; cA = nA; cB = nB; ++ui;
        if constexpr (ALIGN_EPI) { if (wr == 1) PG8_BAR; }
    }
    PG8_WAIT_V(0);
    if constexpr (!ALIGN_EPI) { if (wr == 0) PG8_BAR; }
    PG8_BAR;
#undef PG8_SA
#undef PG8_SB
#undef PG8_STAGE
#undef PG8_LDA
#undef PG8_LDB
#undef PG8_MMA
#undef PG8_MMA2
#undef PG8_WAIT_V
#undef PG8_WAIT_L
#undef PG8_BAR
#undef PG8_SCHED
}
}

namespace att {
typedef unsigned short bf16_t;
typedef short bf16x8 __attribute__((ext_vector_type(8)));
typedef short s16x4 __attribute__((ext_vector_type(4)));
typedef float f32x16 __attribute__((ext_vector_type(16)));
typedef float f32x4 __attribute__((ext_vector_type(4)));
typedef unsigned u32x4 __attribute__((ext_vector_type(4)));
constexpr int NW = 8, QBLK = 32, KVBLK = 64, QB = NW * QBLK;
constexpr int SHM_V = KVBLK * 128 * 2, SHM_K = KVBLK * 128 * 2, SHM_R = KVBLK * 64 * 2;
constexpr int QROW = 272, QWAVE = 32 * QROW;
constexpr float THR = 8.f;
constexpr int STG_ROW = 132, STG_WAVE = 32 * STG_ROW * 4;
static_assert(NW * STG_WAVE <= 155648, "staging");

#define KSWZ(row, colB) ((row) * 256 + ((colB) ^ (((row) & 7) << 4)))
#define RSWZ(row, chunk) ((row) * 128 + ((((chunk) ^ (((row) >> 1) & 7))) << 4))
#define SBAR() __builtin_amdgcn_sched_barrier(0)
__device__ __forceinline__ int v_rd_base(int lane) { return ((lane & 3) << 3) | (((lane >> 2) & 3) << 6) | (((lane >> 4) & 1) << 5) | (((lane >> 5) & 1) << 8); }
constexpr int v_rd_off(int d0, int ks, int half) { return d0 * 512 + ks * 4096 + half * 2048; }
__device__ __forceinline__ int crow(int r, int hi) { return (r & 3) + 8 * (r >> 2) + 4 * hi; }
typedef float f32x2_t __attribute__((ext_vector_type(2))); typedef __bf16 bf16x2_t __attribute__((ext_vector_type(2)));
__device__ __forceinline__ unsigned cvtpk(float lo, float hi) { f32x2_t v = {lo, hi}; bf16x2_t b = __builtin_convertvector(v, bf16x2_t); return __builtin_bit_cast(unsigned, b); }
__device__ __forceinline__ void glds16(const void* gsrc, unsigned lds_dst) { unsigned keep;
    asm volatile("s_mov_b32 %0, m0\n\ts_mov_b32 m0, %2\n\ts_nop 0\n\tglobal_load_lds_dwordx4 %1, off\n\ts_mov_b32 m0, %0" : "=&s"(keep) : "v"(gsrc), "s"(lds_dst) : "memory"); }
#define WAIT_BAR() asm volatile("s_waitcnt vmcnt(0) lgkmcnt(0)\n\ts_barrier" ::: "memory")

__device__ __forceinline__ void mask_tile(f32x16& p0, f32x16& p1, int dq) {
    const float NEG = -__builtin_inff();
#pragma unroll
    for (int r = 0; r < 16; ++r) { const int c = (r & 3) + 8 * (r >> 2); if (dq - c < 0) p0[r] = NEG; if (dq - c - 32 < 0) p1[r] = NEG; }
}
template <bool MLA> __device__ __forceinline__ void partialSM(f32x16& p0, f32x16& p1, float& m_reg, float& mn, float& alpha) {
    constexpr float SCALE = MLA ? 0.07216878364870322f : 0.125f;
    float pmax = p0[0];
#pragma unroll
    for (int r = 1; r < 16; ++r) pmax = fmaxf(pmax, p0[r]);
#pragma unroll
    for (int r = 0; r < 16; ++r) pmax = fmaxf(pmax, p1[r]);
    { auto rr = __builtin_amdgcn_permlane32_swap(__float_as_uint(pmax), __float_as_uint(pmax), false, false); pmax = fmaxf(__uint_as_float(rr[0]), __uint_as_float(rr[1])); }
    constexpr float C2 = 1.4426950408889634f * SCALE;
    if (MLA) {
        if (__builtin_expect(__all((pmax - m_reg) * SCALE <= 5.0f), 1)) { mn = m_reg; alpha = 1.f; }
        else { mn = fmaxf(m_reg, pmax); alpha = __builtin_amdgcn_exp2f((m_reg - mn) * C2); m_reg = mn; }
    } else {
        const bool keep = __all((pmax - m_reg) * SCALE <= THR);
        mn = keep ? m_reg : fmaxf(m_reg, pmax); alpha = __builtin_amdgcn_exp2f((m_reg - mn) * C2); m_reg = mn;
    }
    const float mnL = -mn * C2;
#pragma unroll
    for (int r = 0; r < 16; ++r) p0[r] = fmaf(p0[r], C2, mnL);
#pragma unroll
    for (int r = 0; r < 16; ++r) p1[r] = fmaf(p1[r], C2, mnL);
#pragma unroll
    for (int r = 0; r < 16; ++r) p0[r] = __builtin_amdgcn_exp2f(p0[r]);
}
__device__ __forceinline__ void finishSM(f32x16& p0, f32x16& p1, float alpha, float& l_reg, bf16x8& pa0, bf16x8& pa1, bf16x8& pa2, bf16x8& pa3) {
#pragma unroll
    for (int r = 0; r < 16; ++r) p1[r] = __builtin_amdgcn_exp2f(p1[r]);
    float ps = 0;
#pragma unroll
    for (int r = 0; r < 16; ++r) ps += p0[r];
#pragma unroll
    for (int r = 0; r < 16; ++r) ps += p1[r];
    { auto rr = __builtin_amdgcn_permlane32_swap(__float_as_uint(ps), __float_as_uint(ps), false, false); ps = __uint_as_float(rr[0]) + __uint_as_float(rr[1]); }
    l_reg = l_reg * alpha + ps;
#define PK4(P, B_, OUT) do { unsigned a0 = cvtpk(P[B_+0], P[B_+1]), a1 = cvtpk(P[B_+2], P[B_+3]); unsigned b0 = cvtpk(P[B_+4], P[B_+5]), b1 = cvtpk(P[B_+6], P[B_+7]); \
        auto r0 = __builtin_amdgcn_permlane32_swap(a0, b0, false, false); auto r1 = __builtin_amdgcn_permlane32_swap(a1, b1, false, false); \
        u32x4 w = {r0[0], r1[0], r0[1], r1[1]}; OUT = *reinterpret_cast<bf16x8*>(&w); } while (0)
    PK4(p0, 0, pa0); PK4(p0, 8, pa1); PK4(p1, 0, pa2); PK4(p1, 8, pa3);
#undef PK4
}
__device__ __forceinline__ unsigned pk4f8(float a, float b, float c, float d) { int w = __builtin_amdgcn_cvt_pk_fp8_f32(a, b, 0, false); w = __builtin_amdgcn_cvt_pk_fp8_f32(c, d, w, true); return (unsigned)w; }
__device__ __forceinline__ void finishSM8(f32x16& p0, f32x16& p1, float alpha, float& l_reg, int (&P8)[8]) {
#pragma unroll
    for (int r = 0; r < 16; ++r) p1[r] = __builtin_amdgcn_exp2f(p1[r]);
    float ps = 0;
#pragma unroll
    for (int r = 0; r < 16; ++r) ps += p0[r];
#pragma unroll
    for (int r = 0; r < 16; ++r) ps += p1[r];
    { auto rr = __builtin_amdgcn_permlane32_swap(__float_as_uint(ps), __float_as_uint(ps), false, false); ps = __uint_as_float(rr[0]) + __uint_as_float(rr[1]); }
    l_reg = l_reg * alpha + ps;
#pragma unroll
    for (int i = 0; i < 4; ++i) { P8[i] = (int)pk4f8(p0[4 * i], p0[4 * i + 1], p0[4 * i + 2], p0[4 * i + 3]); P8[4 + i] = (int)pk4f8(p1[4 * i], p1[4 * i + 1], p1[4 * i + 2], p1[4 * i + 3]); }
}
typedef int v8i32b __attribute__((ext_vector_type(8)));
__device__ __forceinline__ void pv8(f32x16* o, const char* vt, int r32, int hi, const int (&P8)[8]) {
    const v8i32b pa = {P8[0], P8[1], P8[2], P8[3], P8[4], P8[5], P8[6], P8[7]};
    const char* va = vt + (2 * hi) * 2048 + r32 * 16;
#pragma unroll
    for (int blk = 0; blk < 4; ++blk) { const u32x4 x0 = *reinterpret_cast<const u32x4*>(va + blk * 512), x1 = *reinterpret_cast<const u32x4*>(va + 2048 + blk * 512);
        const v8i32b vb = {(int)x0[0], (int)x0[1], (int)x0[2], (int)x0[3], (int)x1[0], (int)x1[1], (int)x1[2], (int)x1[3]};
        o[blk] = __builtin_amdgcn_mfma_scale_f32_32x32x64_f8f6f4(pa, vb, o[blk], 0, 0, 0, 0, 0, 0); }
}
typedef int v8i32 __attribute__((ext_vector_type(8)));
__device__ __forceinline__ void qkt8(f32x16& p0, f32x16& p1, const char* kn, const char* kr, int r32, int hi, const v8i32* q8) {
    p0 = f32x16{}; p1 = f32x16{};
#pragma unroll
    for (int sl = 0; sl < 3; ++sl) { const char* a = (sl < 2 ? kn + (4 * sl + 2 * hi) * 1024 : kr + (2 * hi) * 1024) + r32 * 16;
        const u32x4 x0 = *reinterpret_cast<const u32x4*>(a), x1 = *reinterpret_cast<const u32x4*>(a + 1024), y0 = *reinterpret_cast<const u32x4*>(a + 512), y1 = *reinterpret_cast<const u32x4*>(a + 1024 + 512);
        const v8i32 k0 = {(int)x0[0], (int)x0[1], (int)x0[2], (int)x0[3], (int)x1[0], (int)x1[1], (int)x1[2], (int)x1[3]}, k1 = {(int)y0[0], (int)y0[1], (int)y0[2], (int)y0[3], (int)y1[0], (int)y1[1], (int)y1[2], (int)y1[3]};
        p0 = __builtin_amdgcn_mfma_scale_f32_32x32x64_f8f6f4(k0, q8[sl], p0, 0, 0, 0, 0, 0, 0); p1 = __builtin_amdgcn_mfma_scale_f32_32x32x64_f8f6f4(k1, q8[sl], p1, 0, 0, 0, 0, 0, 0); }
}
template <bool MLA, int NS> struct Lay {
    static constexpr int OFF_V = 0, OFF_K = NS * SHM_V, OFF_R = OFF_K + (MLA ? NS * SHM_K : 0), OFF_WS = OFF_R + NS * SHM_R, OFF_Q = OFF_WS + NW * 64 * 4, END = OFF_Q + (MLA ? NW * QWAVE : 0);
};
template <bool MLA>
__device__ __forceinline__ void qkt(f32x16& p0, f32x16& p1, const char* kn, const char* kr, int r32, int hi, const char* qimg, const bf16x8* qr) {
    p0 = f32x16{}; p1 = f32x16{};
    if (MLA) {
#pragma unroll
        for (int d0 = 0; d0 < 8; ++d0) { const char* a = kn + KSWZ(r32, ((d0 & 3) * 16 + hi * 8) * 2) + (d0 >> 2) * 128;
            bf16x8 b0 = *reinterpret_cast<const bf16x8*>(a); bf16x8 b1 = *reinterpret_cast<const bf16x8*>(a + 32 * 256);
            const bf16x8 q = *reinterpret_cast<const bf16x8*>(qimg + d0 * 32);
            p0 = __builtin_amdgcn_mfma_f32_32x32x16_bf16(b0, q, p0, 0, 0, 0); p1 = __builtin_amdgcn_mfma_f32_32x32x16_bf16(b1, q, p1, 0, 0, 0); }
    }
#pragma unroll
    for (int d0 = 0; d0 < 4; ++d0) { const char* a = kr + RSWZ(r32, 2 * d0 + hi);
        bf16x8 b0 = *reinterpret_cast<const bf16x8*>(a); bf16x8 b1 = *reinterpret_cast<const bf16x8*>(a + 32 * 128);
        p0 = __builtin_amdgcn_mfma_f32_32x32x16_bf16(b0, qr[d0], p0, 0, 0, 0); p1 = __builtin_amdgcn_mfma_f32_32x32x16_bf16(b1, qr[d0], p1, 0, 0, 0); }
}
typedef __attribute__((address_space(3))) const char* lds_cptr;
typedef short v4i16_t __attribute__((ext_vector_type(4)));
__device__ __forceinline__ s16x4 vtr(lds_cptr p) { return __builtin_bit_cast(s16x4, __builtin_amdgcn_ds_read_tr16_b64_v4i16((__attribute__((address_space(3))) v4i16_t*)p)); }
__device__ __forceinline__ void pv_tile_pipe(f32x16* o, lds_cptr vp, bf16x8 pa0, bf16x8 pa1, bf16x8 pa2, bf16x8 pa3) {
    const int vb = (int)(unsigned)(uintptr_t)vp;
#define TRRD(dst, off) asm volatile("ds_read_b64_tr_b16 %0, %1 offset:%2" : "=&v"(dst) : "v"(vb), "i"(off) : "memory")
#define RD8(S, d0) do { TRRD(S##l0, v_rd_off(d0, 0, 0)); TRRD(S##h0, v_rd_off(d0, 0, 0) + 2048); TRRD(S##l1, v_rd_off(d0, 0, 0) + 4096); TRRD(S##h1, v_rd_off(d0, 0, 0) + 6144); \
        TRRD(S##l2, v_rd_off(d0, 0, 0) + 8192); TRRD(S##h2, v_rd_off(d0, 0, 0) + 10240); TRRD(S##l3, v_rd_off(d0, 0, 0) + 12288); TRRD(S##h3, v_rd_off(d0, 0, 0) + 14336); } while (0)
#define LW8(S) asm volatile("s_waitcnt lgkmcnt(0)" : "+v"(S##l0), "+v"(S##h0), "+v"(S##l1), "+v"(S##h1), "+v"(S##l2), "+v"(S##h2), "+v"(S##l3), "+v"(S##h3) :: "memory")
#define MM4(S, d0) do { \
        o[d0] = __builtin_amdgcn_mfma_f32_32x32x16_bf16(pa0, (bf16x8){S##l0[0], S##l0[1], S##l0[2], S##l0[3], S##h0[0], S##h0[1], S##h0[2], S##h0[3]}, o[d0], 0, 0, 0); \
        o[d0] = __builtin_amdgcn_mfma_f32_32x32x16_bf16(pa1, (bf16x8){S##l1[0], S##l1[1], S##l1[2], S##l1[3], S##h1[0], S##h1[1], S##h1[2], S##h1[3]}, o[d0], 0, 0, 0); \
        o[d0] = __builtin_amdgcn_mfma_f32_32x32x16_bf16(pa2, (bf16x8){S##l2[0], S##l2[1], S##l2[2], S##l2[3], S##h2[0], S##h2[1], S##h2[2], S##h2[3]}, o[d0], 0, 0, 0); \
        o[d0] = __builtin_amdgcn_mfma_f32_32x32x16_bf16(pa3, (bf16x8){S##l3[0], S##l3[1], S##l3[2], S##l3[3], S##h3[0], S##h3[1], S##h3[2], S##h3[3]}, o[d0], 0, 0, 0); } while (0)
    s16x4 Al0, Ah0, Al1, Ah1, Al2, Ah2, Al3, Ah3, Bl0, Bh0, Bl1, Bh1, Bl2, Bh2, Bl3, Bh3;
    RD8(A, 0); LW8(A);
    RD8(B, 1); MM4(A, 0); LW8(B);
    RD8(A, 2); MM4(B, 1); LW8(A);
    RD8(B, 3); MM4(A, 2); LW8(B);
    MM4(B, 3);
#undef RD8
#undef LW8
#undef MM4
#undef TRRD
}
__device__ __forceinline__ void qkt_batch(f32x16& p0, f32x16& p1, const char* kr, int r32, int hi, const bf16x8* qr) {
    bf16x8 kf[8];
#pragma unroll
    for (int d0 = 0; d0 < 4; ++d0) { const int a = (int)(unsigned)(uintptr_t)(kr + RSWZ(r32, 2 * d0 + hi));
        asm volatile("ds_read_b128 %0, %1" : "=&v"(kf[2 * d0]) : "v"(a) : "memory"); asm volatile("ds_read_b128 %0, %1 offset:4096" : "=&v"(kf[2 * d0 + 1]) : "v"(a) : "memory"); }
    asm volatile("s_waitcnt lgkmcnt(0)" : "+v"(kf[0]), "+v"(kf[1]), "+v"(kf[2]), "+v"(kf[3]), "+v"(kf[4]), "+v"(kf[5]), "+v"(kf[6]), "+v"(kf[7]) :: "memory");
    p0 = f32x16{}; p1 = f32x16{};
#pragma unroll
    for (int d0 = 0; d0 < 4; ++d0) { p0 = __builtin_amdgcn_mfma_f32_32x32x16_bf16(kf[2 * d0], qr[d0], p0, 0, 0, 0); p1 = __builtin_amdgcn_mfma_f32_32x32x16_bf16(kf[2 * d0 + 1], qr[d0], p1, 0, 0, 0); }
}
template <bool VIS> __device__ __forceinline__ void pv_tile(f32x16* o, lds_cptr vp, bf16x8 pa0, bf16x8 pa1, bf16x8 pa2, bf16x8 pa3) {
    if (!VIS) {
        const int vb = (int)(unsigned)(uintptr_t)vp;
#define TRRD(dst, off) asm volatile("ds_read_b64_tr_b16 %0, %1 offset:%2" : "=&v"(dst) : "v"(vb), "i"(off) : "memory")
#define PV_D0(d0) do { s16x4 l0, l1, l2, l3, h0, h1, h2, h3; constexpr int b_ = v_rd_off(d0, 0, 0); \
        TRRD(l0, b_); TRRD(h0, b_ + 2048); TRRD(l1, b_ + 4096); TRRD(h1, b_ + 6144); TRRD(l2, b_ + 8192); TRRD(h2, b_ + 10240); TRRD(l3, b_ + 12288); TRRD(h3, b_ + 14336); \
        asm volatile("s_waitcnt lgkmcnt(0)" ::: "memory"); SBAR(); \
        o[d0] = __builtin_amdgcn_mfma_f32_32x32x16_bf16(pa0, (bf16x8){l0[0], l0[1], l0[2], l0[3], h0[0], h0[1], h0[2], h0[3]}, o[d0], 0, 0, 0); \
        o[d0] = __builtin_amdgcn_mfma_f32_32x32x16_bf16(pa1, (bf16x8){l1[0], l1[1], l1[2], l1[3], h1[0], h1[1], h1[2], h1[3]}, o[d0], 0, 0, 0); \
        o[d0] = __builtin_amdgcn_mfma_f32_32x32x16_bf16(pa2, (bf16x8){l2[0], l2[1], l2[2], l2[3], h2[0], h2[1], h2[2], h2[3]}, o[d0], 0, 0, 0); \
        o[d0] = __builtin_amdgcn_mfma_f32_32x32x16_bf16(pa3, (bf16x8){l3[0], l3[1], l3[2], l3[3], h3[0], h3[1], h3[2], h3[3]}, o[d0], 0, 0, 0); } while (0)
        PV_D0(0); PV_D0(1); PV_D0(2); PV_D0(3);
#undef PV_D0
#undef TRRD
        return;
    }
#pragma unroll
    for (int d0 = 0; d0 < 4; ++d0) {
        const s16x4 l0 = vtr(vp + d0 * 512), h0 = vtr(vp + d0 * 512 + 2048), l1 = vtr(vp + d0 * 512 + 4096), h1 = vtr(vp + d0 * 512 + 6144);
        const s16x4 l2 = vtr(vp + d0 * 512 + 8192), h2 = vtr(vp + d0 * 512 + 10240), l3 = vtr(vp + d0 * 512 + 12288), h3 = vtr(vp + d0 * 512 + 14336);
        o[d0] = __builtin_amdgcn_mfma_f32_32x32x16_bf16(pa0, (bf16x8){l0[0], l0[1], l0[2], l0[3], h0[0], h0[1], h0[2], h0[3]}, o[d0], 0, 0, 0);
        o[d0] = __builtin_amdgcn_mfma_f32_32x32x16_bf16(pa1, (bf16x8){l1[0], l1[1], l1[2], l1[3], h1[0], h1[1], h1[2], h1[3]}, o[d0], 0, 0, 0);
        o[d0] = __builtin_amdgcn_mfma_f32_32x32x16_bf16(pa2, (bf16x8){l2[0], l2[1], l2[2], l2[3], h2[0], h2[1], h2[2], h2[3]}, o[d0], 0, 0, 0);
        o[d0] = __builtin_amdgcn_mfma_f32_32x32x16_bf16(pa3, (bf16x8){l3[0], l3[1], l3[2], l3[3], h3[0], h3[1], h3[2], h3[3]}, o[d0], 0, 0, 0);
    }
}

struct Src { const bf16_t* Qn; const bf16_t* Qr; const bf16_t* Kn; const bf16_t* Kr; const bf16_t* V; };
template <bool MLA> struct Pitch { static constexpr int qn = 3072, qr = MLA ? 3072 : 16128, kn = 4096, kr = 16128, v = MLA ? 4096 : 16128; };

template <bool MLA, int NS>
__device__ __forceinline__ void attn_block(const Src& s, int qb, char* lds) {
    typedef Pitch<MLA> PT; typedef Lay<MLA, NS> L;
    constexpr int LA = NS - 1;
    constexpr int NPC = MLA ? 5 : 3;
    const int tid = threadIdx.x, wid = __builtin_amdgcn_readfirstlane(tid >> 6), lane = tid & 63, r32 = lane & 31, hi = lane >> 5;
    const int P0 = qb * QB, NT = (P0 + QB) / KVBLK;
    const int qlo = P0 + wid * QBLK, qm = qlo + r32 - 4 * hi;
    const unsigned lds0 = (unsigned)(uintptr_t)lds;
    float* ws = (float*)(lds + L::OFF_WS) + wid * 64; float* li_l = ws; float* al_l = ws + 32;
    float m_reg = -1e30f, l_reg = 0; f32x16 o[4];
#pragma unroll
    for (int d = 0; d < 4; ++d) o[d] = f32x16{};
    unsigned offV[2], offK[2], offR;
#pragma unroll
    for (int i = 0; i < 2; ++i) { const int q = (wid * 2 + i) * 64 + lane;
        { const int sidx = q >> 5, w5 = q & 31, kk = (sidx >> 2) * 8 + (w5 >> 2), c = (sidx & 3) * 32 + (w5 & 3) * 8, k = (kk & ~0xC) | ((kk & 4) << 1) | ((kk & 8) >> 1); offV[i] = (unsigned)(k * PT::v + c) * 2u; }
        offK[i] = MLA ? (unsigned)(lane * 2048 + wid * 16) : 0u; }
    if (MLA) offR = (unsigned)(lane * 64 + (wid & 3) * 16);
    else { const int q = wid * 64 + lane, row = q >> 3, c = (q & 7) ^ ((row >> 1) & 7); offR = (unsigned)(row * PT::kr + c * 8) * 2u; }
    const unsigned offV8 = (unsigned)(((wid >> 2) * 64 + lane) * 8192 + (wid & 3) * 16);
#define SLOT_INC(x) ((x) + 1 == NS ? 0 : (x) + 1)
#define DMA_K(t, sl) do { if (MLA) { glds16((const char*)s.Kn + (size_t)(t) * (KVBLK * 2048) + offK[0], (unsigned)__builtin_amdgcn_readfirstlane(lds0 + L::OFF_K + (sl) * SHM_K + wid * 1024)); \
            if (wid < 4) glds16((const char*)s.Kr + (size_t)(t) * (KVBLK * 64) + offR, (unsigned)__builtin_amdgcn_readfirstlane(lds0 + L::OFF_R + (sl) * SHM_R + wid * 1024)); } \
        else { const char* rb_ = (const char*)s.Kr + (size_t)(t) * (KVBLK * 2) * PT::kr; glds16(rb_ + offR, (unsigned)__builtin_amdgcn_readfirstlane(lds0 + L::OFF_R + (sl) * SHM_R + wid * 1024)); } } while (0)
#define DMA_V(t, sl) do { if (MLA) { glds16((const char*)s.V + (size_t)(t) * KVBLK + offV8, (unsigned)__builtin_amdgcn_readfirstlane(lds0 + L::OFF_V + (sl) * SHM_V + (wid & 3) * 2048 + (wid >> 2) * 1024)); } \
        else { const char* vb_ = (const char*)s.V + (size_t)(t) * (KVBLK * 2) * PT::v; \
        glds16(vb_ + offV[0], (unsigned)__builtin_amdgcn_readfirstlane(lds0 + L::OFF_V + (sl) * SHM_V + (wid * 2) * 1024)); glds16(vb_ + offV[1], (unsigned)__builtin_amdgcn_readfirstlane(lds0 + L::OFF_V + (sl) * SHM_V + (wid * 2 + 1) * 1024)); } } while (0)
    __syncthreads();
    DMA_K(0, 0);
    bf16x8 qr[4]; v8i32 q8[3];
    { const size_t qrow = (size_t)(qlo + r32);
        if (MLA) {
            const char* qn_ = (const char*)s.Qn + qrow * 3072 + 32 * hi; const char* qr_ = (const char*)s.Qr + qrow * 3072 + 32 * hi;
#pragma unroll
            for (int sl = 0; sl < 3; ++sl) { const char* p_ = sl < 2 ? qn_ + 64 * sl : qr_; const u32x4 x0 = *reinterpret_cast<const u32x4*>(p_), x1 = *reinterpret_cast<const u32x4*>(p_ + 16);
                q8[sl] = (v8i32){(int)x0[0], (int)x0[1], (int)x0[2], (int)x0[3], (int)x1[0], (int)x1[1], (int)x1[2], (int)x1[3]}; }
        } else {
#pragma unroll
            for (int d0 = 0; d0 < 4; ++d0) qr[d0] = *reinterpret_cast<const bf16x8*>(s.Qr + qrow * PT::qr + d0 * 16 + hi * 8);
        } }
    if (LA >= 2) { DMA_K(1, 1); DMA_V(0, 0); }
    const char* qimg = nullptr;
    const lds_cptr vb0 = (lds_cptr)lds + (L::OFF_V + v_rd_base(lane));
#define RESC(a) do { if (__any((a) < 1.f)) { if (hi == 0) al_l[r32] = (a); asm volatile("s_waitcnt lgkmcnt(0)" ::: "memory"); \
        _Pragma("unroll") for (int d_ = 0; d_ < 4; ++d_) _Pragma("unroll") for (int r = 0; r < 16; ++r) o[d_][r] *= al_l[crow(r, hi)]; } } while (0)
#define KBASE(t) ((t) * KVBLK)
#define MASKT(P0_, P1_, t) do { const int kb_ = KBASE(t); if (__builtin_expect(kb_ + KVBLK - 1 > qlo, 0)) { asm volatile("; causal-mask tile" ::: "memory"); mask_tile(P0_, P1_, qm - kb_); } } while (0)
#define WAIT_STEP(full) do { if (NS >= 3 && (full)) { if (MLA) asm volatile("s_waitcnt vmcnt(5) lgkmcnt(0)\n\ts_barrier" ::: "memory"); else asm volatile("s_waitcnt vmcnt(3) lgkmcnt(0)\n\ts_barrier" ::: "memory"); } \
        else WAIT_BAR(); } while (0)
    f32x16 pA0, pA1, pB0, pB1; float mnA, mnB, alA, alB; bf16x8 pa0, pa1, pa2, pa3; int P8[8];
    WAIT_BAR();
    int sc = 0;
    { const int sk = (LA % NS), sv = ((LA + NS - 1) % NS);
      DMA_K(LA, sk); DMA_V(LA - 1, sv);
      SBAR(); if (MLA) qkt8(pA0, pA1, lds + L::OFF_K + sc * SHM_K, lds + L::OFF_R + sc * SHM_R, r32, hi, q8); else qkt_batch(pA0, pA1, lds + L::OFF_R + sc * SHM_R, r32, hi, qr);
      MASKT(pA0, pA1, 0); partialSM<MLA>(pA0, pA1, m_reg, mnA, alA);
      WAIT_STEP(true); }
#define STEP(PX0, PX1, mnX, alX, PY0, PY1, alY, t, MASK) do { \
        const int sp_ = sc; sc = SLOT_INC(sc); \
        const int skw_ = sp_, svw_ = (NS == 2) ? sc : ((sp_ == 0) ? NS - 1 : sp_ - 1); \
        const bool gk_ = (t) + LA < NT, gv_ = (t) + LA - 1 < NT; \
        if (gk_) DMA_K((t) + LA, skw_); if (gv_) DMA_V((t) + LA - 1, svw_); \
        SBAR(); if (MLA) qkt8(PX0, PX1, lds + L::OFF_K + sc * SHM_K, lds + L::OFF_R + sc * SHM_R, r32, hi, q8); else qkt_batch(PX0, PX1, lds + L::OFF_R + sc * SHM_R, r32, hi, qr); \
        if (MLA) { finishSM8(PY0, PY1, alY, l_reg, P8); SBAR(); pv8(o, lds + L::OFF_V + sp_ * SHM_V, r32, hi, P8); } \
        else { finishSM(PY0, PY1, alY, l_reg, pa0, pa1, pa2, pa3); pv_tile_pipe(o, vb0 + sp_ * SHM_V, pa0, pa1, pa2, pa3); } if (MLA) { MASKT(PX0, PX1, (t)); } else if (MASK) mask_tile(PX0, PX1, qm - KBASE(t)); partialSM<MLA>(PX0, PX1, m_reg, mnX, alX); \
        RESC(alX); WAIT_STEP(gk_ && gv_); } while (0)
    int t = 1;
    if (!MLA) for (; t + 1 < NT - 4; t += 2) {
        STEP(pB0, pB1, mnB, alB, pA0, pA1, alA, t, false);
        STEP(pA0, pA1, mnA, alA, pB0, pB1, alB, t + 1, false);
    }
    for (; t + 1 < NT; t += 2) {
        STEP(pB0, pB1, mnB, alB, pA0, pA1, alA, t, true);
        STEP(pA0, pA1, mnA, alA, pB0, pB1, alB, t + 1, true);
    }
    STEP(pB0, pB1, mnB, alB, pA0, pA1, alA, NT - 1, true);
    if (MLA) { finishSM8(pB0, pB1, alB, l_reg, P8); SBAR(); pv8(o, lds + L::OFF_V + sc * SHM_V, r32, hi, P8); }
    else { finishSM(pB0, pB1, alB, l_reg, pa0, pa1, pa2, pa3); SBAR(); pv_tile_pipe(o, vb0 + sc * SHM_V, pa0, pa1, pa2, pa3); }
    if (hi == 0) li_l[r32] = l_reg;
    asm volatile("s_waitcnt lgkmcnt(0)" ::: "memory");
    float rl[16];
#pragma unroll
    for (int r = 0; r < 16; ++r) rl[r] = __builtin_amdgcn_rcpf(li_l[crow(r, hi)]);
    WAIT_BAR();
    float* st = (float*)(lds + wid * STG_WAVE) + hi * (4 * STG_ROW) + r32;
#pragma unroll
    for (int r = 0; r < 16; ++r)
#pragma unroll
        for (int d0 = 0; d0 < 4; ++d0) st[((r & 3) + 8 * (r >> 2)) * STG_ROW + d0 * 32] = o[d0][r] * rl[r];
    asm volatile("s_waitcnt lgkmcnt(0)" ::: "memory");
#undef SLOT_INC
#undef DMA_K
#undef DMA_V
#undef RESC
#undef KBASE
#undef MASKT
#undef WAIT_STEP
#undef STEP
}
constexpr int DK_SLOT = 8192, DV_SLOT = 16384, D_NSLOT = 3;
constexpr int D_LDS_K = 0, D_LDS_V = D_NSLOT * DK_SLOT, D_LDS_WS = D_LDS_V + D_NSLOT * DV_SLOT, D_LDS_END = D_LDS_WS + NW * 64 * 4;
constexpr int DPITCH = 16128;
typedef __attribute__((address_space(3))) const bf16x8* lds_b8;
__device__ __forceinline__ void kload2(bf16x8* kf, lds_cptr kp, int j) { kf[2 * j] = *(lds_b8)(kp + j * 2048); kf[2 * j + 1] = *(lds_b8)(kp + j * 2048 + 512); }
template <int THRL>
__device__ __forceinline__ void diff_block64(const bf16_t* Qh, const bf16_t* Kh, const bf16_t* Vh, int qb, char* lds) {
    int tid = threadIdx.x; asm volatile("" : "+v"(tid));
    const int lane = tid & 63, r32 = lane & 31, hi = lane >> 5; const int wid = __builtin_amdgcn_readfirstlane(tid >> 6);
    const int q0 = qb * QB, NT = (q0 + QB) / KVBLK;
    const unsigned lds0 = (unsigned)(uintptr_t)lds;
    float* wsf = (float*)(lds + D_LDS_WS) + wid * 64;
    const unsigned koff = (unsigned)(lane * DPITCH + wid * 8) * 2u;
    const unsigned voff = (unsigned)((16 * (wid & 3) + (lane >> 2)) * DPITCH + (wid >> 2) * 32 + (lane & 3) * 8) * 2u;
    const unsigned kdst = lds0 + D_LDS_K + wid * 1024, vdst = lds0 + D_LDS_V + wid * 1024;
#define DMA_K(t, sidx) glds16((const char*)Kh + (size_t)(t) * (KVBLK * DPITCH * 2) + koff, (unsigned)__builtin_amdgcn_readfirstlane(kdst + (sidx) * DK_SLOT))
#define DMA_V(t, sidx) do { const char* vb_ = (const char*)Vh + (size_t)(t) * (KVBLK * DPITCH * 2) + voff; \
        glds16(vb_, (unsigned)__builtin_amdgcn_readfirstlane(vdst + (sidx) * DV_SLOT)); glds16(vb_ + 128, (unsigned)__builtin_amdgcn_readfirstlane(vdst + (sidx) * DV_SLOT + 8192)); } while (0)
#define WAIT_BARN(N) asm volatile("s_waitcnt vmcnt(" #N ") lgkmcnt(0)\n\ts_barrier" ::: "memory")
#define SBAR() __builtin_amdgcn_sched_barrier(0)
    const lds_cptr shm3 = (lds_cptr)lds; const lds_cptr kp0 = shm3 + D_LDS_K + hi * 1024 + r32 * 16;
    const lds_cptr vp0 = shm3 + D_LDS_V + ((lane >> 4) & 1) * 32 + (lane & 3) * 8 + (4 * hi + ((lane & 15) >> 2)) * 64;
    __syncthreads();
    DMA_K(0, 0); DMA_V(0, 0); DMA_K(1, 1);
    bf16x8 qr[4], kf[8];
    { const bf16_t* Qw = Qh + (size_t)(q0 + wid * QBLK + r32) * DPITCH;
#pragma unroll
      for (int d0 = 0; d0 < 4; ++d0) qr[d0] = *reinterpret_cast<const bf16x8*>(Qw + d0 * 16 + hi * 8); }
    float mhat = 0.f, l_reg = 0.f; f32x16 o[4];
#pragma unroll
    for (int d = 0; d < 4; ++d) o[d] = f32x16{};
    const int qrel = wid * QBLK + r32;
#define CMASK(P0, P1, t) do { const int jb_ = (t) - (NT - 4); if (jb_ >= 0) { const float NEG_ = -__builtin_inff(); const int kb_ = 64 * jb_ + 4 * hi; \
        _Pragma("unroll") for (int r = 0; r < 16; ++r) { const int kv_ = kb_ + (r & 3) + 8 * (r >> 2); if (kv_ > qrel) P0[r] = NEG_; if (kv_ + 32 > qrel) P1[r] = NEG_; } } } while (0)
#define MX3(a, b, c) __builtin_fmaxf(__builtin_fmaxf((a), (b)), (c))
#define ROWMAX(rm, C0, C1) do { float a_ = MX3(C0[0], C0[1], C1[0]), b_ = MX3(C0[2], C0[3], C1[1]); a_ = MX3(a_, C1[2], C1[3]); \
        _Pragma("unroll") for (int r = 4; r < 16; r += 4) { a_ = MX3(a_, C0[r], C0[r + 1]); b_ = MX3(b_, C0[r + 2], C0[r + 3]); a_ = MX3(a_, C1[r], C1[r + 1]); b_ = MX3(b_, C1[r + 2], C1[r + 3]); } \
        rm = __builtin_fmaxf(a_, b_); { auto rr = __builtin_amdgcn_permlane32_swap(__float_as_uint(rm), __float_as_uint(rm), false, false); rm = __builtin_fmaxf(__uint_as_float(rr[0]), __uint_as_float(rr[1])); } } while (0)
    bool resc = false;
#define RESC() do { if (resc) { asm volatile("s_waitcnt lgkmcnt(0)" ::: "memory"); \
        _Pragma("unroll") for (int d_ = 0; d_ < 4; ++d_) _Pragma("unroll") for (int r = 0; r < 16; ++r) o[d_][r] *= wsf[crow(r, hi)]; } } while (0)
    f32x16 pA0, pA1, pB0, pB1;
    int s_prev = 0, s_cur = 0, s_next = 1;
#define ROT() do { s_prev = s_cur; s_cur = s_next; s_next = (s_next == D_NSLOT - 1) ? 0 : s_next + 1; } while (0)
    DMA_K(2, 2);
    WAIT_BARN(4);
    { const lds_cptr kp = kp0;
      pA0 = f32x16{}; pA1 = f32x16{};
#pragma unroll
      for (int d0 = 0; d0 < 4; ++d0) { const bf16x8 b0 = *(lds_b8)(kp + d0 * 2048), b1 = *(lds_b8)(kp + d0 * 2048 + 512);
          pA0 = __builtin_amdgcn_mfma_f32_32x32x16_bf16(b0, qr[d0], pA0, 0, 0, 0); pA1 = __builtin_amdgcn_mfma_f32_32x32x16_bf16(b1, qr[d0], pA1, 0, 0, 0); } }
    CMASK(pA0, pA1, 0);
    { float rm; ROWMAX(rm, pA0, pA1); mhat = rm;
#pragma unroll
      for (int r = 0; r < 16; ++r) { pA0[r] = __builtin_amdgcn_exp2f(pA0[r] - mhat); pA1[r] = __builtin_amdgcn_exp2f(pA1[r] - mhat); } }
    WAIT_BARN(0);
    DMA_K(3, 0); DMA_V(1, 1);
    ROT();
#pragma unroll
    for (int j = 0; j < 4; ++j) kload2(kf, kp0 + s_cur * DK_SLOT, j);
    WAIT_BARN(3);
    s16x4 vlo[8], vhi[8];
#define PKW(P, B) cvtpk(P[B], P[B + 1])
#define PKF(P, B) __uint_as_float(PKW(P, B))
#define PSEL(P0, P1, k) __builtin_bit_cast(bf16x8, __builtin_shufflevector(((k) < 2 ? P0 : P1), ((k) < 2 ? P0 : P1), ((k) & 1) * 4, ((k) & 1) * 4 + 1, ((k) & 1) * 4 + 2, ((k) & 1) * 4 + 3))
#define VFR(i) (bf16x8){vlo[i][0], vlo[i][1], vlo[i][2], vlo[i][3], vhi[i][0], vhi[i][1], vhi[i][2], vhi[i][3]}
#define PIN(x) asm volatile("" : "+v"(x))
#define GAPA(MF, A0, A1, A2, A3, W0, W1, PW) do { MF; sacc += A0; sacc += A1; sacc += A2; sacc += A3; PIN(sacc); W0; W1; PIN(PW); SBAR(); } while (0)
#define EXS(v) __builtin_amdgcn_exp2f((v) - mhat)
#define GAPB(MF, X, B) do { MF; X[B] = EXS(X[B]); X[B + 1] = EXS(X[B + 1]); PIN(X); SBAR(); } while (0)
#define VRD(i, blk) do { vlo[i] = vtr(vp_ + ((((i) >> 2) + (blk)) * 4096 + ((i) & 3) * 1024)); vhi[i] = vtr(vp_ + ((((i) >> 2) + (blk)) * 4096 + ((i) & 3) * 1024 + 512)); } while (0)
#define KRD(G, j) do { if (G) { kload2(kf, kp0 + s_next * DK_SLOT, j); SBAR(); } } while (0)
#define MFQ(C, i, first) C = __builtin_amdgcn_mfma_f32_32x32x16_bf16(kf[i], qr[(i) >> 1], first ? f32x16{} : C, 0, 0, 0)
#define MFP(P0, P1, f, blk) o[((f) >> 2) + (blk)] = __builtin_amdgcn_mfma_f32_32x32x16_bf16(PSEL(P0, P1, (f) & 3), VFR(f), o[((f) >> 2) + (blk)], 0, 0, 0)
#define STEP(C0, C1, P0, P1, t, GK, GV, GL) do { SBAR(); \
    const lds_cptr vp_ = vp0 + s_prev * DV_SLOT; \
    VRD(0, 0); SBAR(); float sacc = (P0[0] + P0[1]); \
    GAPA(MFQ(C0, 0, true),  P0[2], P0[3], P0[4], P0[5],     P0[0] = PKF(P0, 0),  P0[1] = PKF(P0, 2),  P0); \
    VRD(4, 0); SBAR(); GAPA(MFQ(C1, 1, true),  P0[6], P0[7], P0[8], P0[9],     P0[2] = PKF(P0, 4),  P0[3] = PKF(P0, 6),  P0); \
    VRD(1, 0); SBAR(); GAPA(MFQ(C0, 2, false), P0[10], P0[11], P0[12], P0[13], P0[4] = PKF(P0, 8),  P0[5] = PKF(P0, 10), P0); \
    VRD(5, 0); SBAR(); GAPA(MFQ(C1, 3, false), P0[14], P0[15], P1[0], P1[1],   P0[6] = PKF(P0, 12), P0[7] = PKF(P0, 14), P0); \
    VRD(2, 0); SBAR(); GAPA(MFQ(C0, 4, false), P1[2], P1[3], P1[4], P1[5],     P1[0] = PKF(P1, 0),  P1[1] = PKF(P1, 2),  P1); \
    VRD(6, 0); SBAR(); GAPA(MFQ(C1, 5, false), P1[6], P1[7], P1[8], P1[9],     P1[2] = PKF(P1, 4),  P1[3] = PKF(P1, 6),  P1); \
    VRD(3, 0); SBAR(); GAPA(MFQ(C0, 6, false), P1[10], P1[11], P1[12], P1[13], P1[4] = PKF(P1, 8),  P1[5] = PKF(P1, 10), P1); \
    VRD(7, 0); SBAR(); GAPA(MFQ(C1, 7, false), P1[14], P1[15], 0.f, 0.f,       P1[6] = PKF(P1, 12), P1[7] = PKF(P1, 14), P1); \
    l_reg += sacc; \
    if (GK) { DMA_K((t) + 3, s_cur); } if (GV) { DMA_V((t) + 1, s_next); } \
    CMASK(C0, C1, t); \
    { float rm; ROWMAX(rm, C0, C1); resc = false; \
      if (__builtin_expect(__any(rm - mhat > (float)THRL), 0)) { const float dl = __builtin_fmaxf(rm - mhat, 0.f); mhat += dl; \
          const float f = __builtin_amdgcn_exp2f(-dl); l_reg *= f; if (hi == 0) wsf[r32] = f; resc = true; } } \
    SBAR(); \
    GAPB(MFP(P0, P1, 0, 0), C0, 0);  VRD(0, 2); SBAR(); \
    GAPB(MFP(P0, P1, 4, 0), C0, 2);  VRD(4, 2); SBAR(); \
    GAPB(MFP(P0, P1, 1, 0), C0, 4);  VRD(1, 2); SBAR(); \
    GAPB(MFP(P0, P1, 5, 0), C0, 6);  VRD(5, 2); SBAR(); \
    GAPB(MFP(P0, P1, 2, 0), C0, 8);  VRD(2, 2); SBAR(); \
    GAPB(MFP(P0, P1, 6, 0), C0, 10); VRD(6, 2); SBAR(); \
    GAPB(MFP(P0, P1, 3, 0), C0, 12); VRD(3, 2); SBAR(); \
    GAPB(MFP(P0, P1, 7, 0), C0, 14); VRD(7, 2); SBAR(); \
    GAPB(MFP(P0, P1, 0, 2), C1, 0);  KRD(GL, 0); \
    GAPB(MFP(P0, P1, 4, 2), C1, 2);  KRD(GL, 1); \
    GAPB(MFP(P0, P1, 1, 2), C1, 4);  KRD(GL, 2); \
    GAPB(MFP(P0, P1, 5, 2), C1, 6);  KRD(GL, 3); \
    GAPB(MFP(P0, P1, 2, 2), C1, 8); \
    GAPB(MFP(P0, P1, 6, 2), C1, 10); \
    GAPB(MFP(P0, P1, 3, 2), C1, 12); \
    GAPB(MFP(P0, P1, 7, 2), C1, 14); \
    } while (0)
    int t = 1;
#undef CMASK
#define CMASK(P0, P1, t) do { } while (0)
    for (; t + 5 < NT; t += 2) {
        STEP(pB0, pB1, pA0, pA1, t, true, true, true);     WAIT_BARN(3); RESC(); ROT();
        STEP(pA0, pA1, pB0, pB1, t + 1, true, true, true); WAIT_BARN(3); RESC(); ROT();
    }
#undef CMASK
#define CMASK(P0, P1, t) do { const int jb_ = (t) - (NT - 4); if (jb_ >= 0) { const float NEG_ = -__builtin_inff(); const int kb_ = 64 * jb_ + 4 * hi; \
        _Pragma("unroll") for (int r = 0; r < 16; ++r) { const int kv_ = kb_ + (r & 3) + 8 * (r >> 2); if (kv_ > qrel) P0[r] = NEG_; if (kv_ + 32 > qrel) P1[r] = NEG_; } } } while (0)
#define ENDW(tt) do { if ((tt) + 3 < NT) { WAIT_BARN(3); } else if ((tt) + 2 < NT) { WAIT_BARN(2); } else { WAIT_BARN(0); } } while (0)
    for (; t + 1 < NT; t += 2) {
        STEP(pB0, pB1, pA0, pA1, t, (t + 3 < NT), (t + 1 < NT), (t + 1 < NT));         ENDW(t);     RESC(); ROT();
        STEP(pA0, pA1, pB0, pB1, t + 1, (t + 4 < NT), (t + 2 < NT), (t + 2 < NT));     ENDW(t + 1); RESC(); ROT();
    }
    STEP(pB0, pB1, pA0, pA1, NT - 1, false, false, false); RESC();
    { float sacc = pB0[0] + pB0[1];
#pragma unroll
      for (int r = 2; r < 16; ++r) sacc += pB0[r];
#pragma unroll
      for (int r = 0; r < 16; ++r) sacc += pB1[r];
      l_reg += sacc;
      const u32x4 pw0 = (u32x4){PKW(pB0, 0), PKW(pB0, 2), PKW(pB0, 4), PKW(pB0, 6)}, pw1 = (u32x4){PKW(pB0, 8), PKW(pB0, 10), PKW(pB0, 12), PKW(pB0, 14)};
      const u32x4 pw2 = (u32x4){PKW(pB1, 0), PKW(pB1, 2), PKW(pB1, 4), PKW(pB1, 6)}, pw3 = (u32x4){PKW(pB1, 8), PKW(pB1, 10), PKW(pB1, 12), PKW(pB1, 14)};
      SBAR(); const lds_cptr vp_ = vp0 + s_cur * DV_SLOT;
#define PAF(k) __builtin_bit_cast(bf16x8, pw##k)
#pragma unroll
      for (int blk = 0; blk < 4; blk += 2) {
#pragma unroll
          for (int i = 0; i < 8; ++i) { vlo[i] = vtr(vp_ + (((i >> 2) + blk) * 4096 + (i & 3) * 1024)); vhi[i] = vtr(vp_ + (((i >> 2) + blk) * 4096 + (i & 3) * 1024 + 512)); }
#pragma unroll
          for (int d = 0; d < 2; ++d) { o[d + blk] = __builtin_amdgcn_mfma_f32_32x32x16_bf16(PAF(0), VFR(d * 4 + 0), o[d + blk], 0, 0, 0); o[d + blk] = __builtin_amdgcn_mfma_f32_32x32x16_bf16(PAF(1), VFR(d * 4 + 1), o[d + blk], 0, 0, 0);
              o[d + blk] = __builtin_amdgcn_mfma_f32_32x32x16_bf16(PAF(2), VFR(d * 4 + 2), o[d + blk], 0, 0, 0); o[d + blk] = __builtin_amdgcn_mfma_f32_32x32x16_bf16(PAF(3), VFR(d * 4 + 3), o[d + blk], 0, 0, 0); } } }
    { auto rr = __builtin_amdgcn_permlane32_swap(__float_as_uint(l_reg), __float_as_uint(l_reg), false, false); l_reg = __uint_as_float(rr[0]) + __uint_as_float(rr[1]); }
    if (hi == 0) wsf[32 + r32] = l_reg;
    asm volatile("s_waitcnt lgkmcnt(0)" ::: "memory");
    float rl[16];
#pragma unroll
    for (int r = 0; r < 16; ++r) rl[r] = __builtin_amdgcn_rcpf(wsf[32 + crow(r, hi)]);
    WAIT_BARN(0);
    float* st = (float*)(lds + wid * STG_WAVE) + hi * (4 * STG_ROW) + r32;
#pragma unroll
    for (int r = 0; r < 16; ++r)
#pragma unroll
        for (int d0 = 0; d0 < 4; ++d0) st[((r & 3) + 8 * (r >> 2)) * STG_ROW + d0 * 32] = o[d0][r] * rl[r];
    asm volatile("s_waitcnt lgkmcnt(0)" ::: "memory");
#undef DMA_K
#undef DMA_V
#undef WAIT_BARN
#undef SBAR
#undef CMASK
#undef MX3
#undef ROWMAX
#undef RESC
#undef ROT
#undef PKW
#undef PAF
#undef PKF
#undef PSEL
#undef VFR
#undef PIN
#undef GAPA
#undef EXS
#undef GAPB
#undef VRD
#undef KRD
#undef MFQ
#undef MFP
#undef STEP
#undef ENDW
}
__device__ __forceinline__ f32x4 staged4(const char* lds, int wid, int lane, int j) {
    const int row = lane & 31, half = lane >> 5; const float* st = (const float*)(lds + wid * STG_WAVE);
    return *(const f32x4*)(st + row * STG_ROW + half * 64 + 4 * j);
}
#undef SBAR
}

constexpr size_t MiB = 1u << 20;
constexpr size_t WS_CTL = 0, CTL_ZERO_BYTES = 1 * MiB;
constexpr size_t WS_COS = 1 * MiB, WS_SIN = 2 * MiB;
constexpr size_t WS_SSQC = 3 * MiB;
constexpr size_t WS_SSQ1 = 4 * MiB, WS_SSQ2 = 6 * MiB;
constexpr size_t WS_RSTD1 = 8 * MiB;
constexpr size_t WS_WIN = 16 * MiB;
constexpr size_t WS_WUQ = 142 * MiB;
constexpr size_t WS_WUKV = 148 * MiB;
constexpr size_t WS_WO = 152 * MiB;
constexpr size_t WS_WOUT = 184 * MiB;
constexpr size_t WS_WUP = 216 * MiB;
constexpr size_t WS_WDOWN = 388 * MiB;
constexpr size_t WS_H = 474 * MiB;
constexpr size_t WS_O = 538 * MiB;
constexpr size_t WS_Z = 602 * MiB;
constexpr size_t WS_QM = 854 * MiB;
constexpr size_t WS_KV = 902 * MiB;
constexpr size_t WS_HALO = 602 * MiB;
constexpr size_t WS_U = 602 * MiB;
constexpr size_t WS_T1 = 966 * MiB;
constexpr size_t WS_O1 = 1094 * MiB;
constexpr size_t WS_ACT = 966 * MiB;
constexpr size_t WS_X1 = 1158 * MiB;
constexpr size_t WS_END = 1286 * MiB;
static_assert(WS_WIN + (size_t)ZW * DM * 2 <= WS_WUQ && WS_WUP + (size_t)UPW * DM * 2 <= WS_WDOWN && WS_WDOWN + (size_t)DM * DFF * 2 <= WS_H, "ws map (weights)");
static_assert(WS_Z + (size_t)S * ZW * 2 <= WS_QM && WS_U + (size_t)S * UPW * 2 <= WS_T1 && WS_ACT + (size_t)S * DFF * 2 <= WS_X1 && WS_X1 + (size_t)S * DM * 4 <= WS_END, "ws map (activations)");
constexpr int CW_TMO = 0, CW_BAR = 4096;

constexpr int NWAVES = 8;
constexpr int RING_OFF = 0, RING_BYTES = 131072;
constexpr int XCH_OFF = 131072;
constexpr int LDSCTL_OFF = 155648, MISC_OFF = LDSCTL_OFF + 320;
constexpr int LDS_BYTES = 163840;
static_assert(att::Pitch<true>::qn == QMW && att::Pitch<true>::kn == KVW && att::Pitch<false>::v == ZW && att::Pitch<true>::kr == ZW, "attention pitches");
static_assert(att::Lay<true, 2>::END <= LDSCTL_OFF && att::D_LDS_END <= LDSCTL_OFF && att::DPITCH == ZW && RING_BYTES <= LDSCTL_OFF, "LDS map");

__device__ __forceinline__ unsigned f2bf(float f) { unsigned u = __builtin_bit_cast(unsigned, f); return (u + 0x7fffu + ((u >> 16) & 1u)) >> 16; }
__device__ __forceinline__ unsigned pk2(float lo, float hi) { return pg8::cvt_pk_bf16(lo, hi); }

#define XB_TMO      128
#define XB_XCNT(j)  (256  + 64 * (j))
#define XB_XSUB(j)  (1280 + 64 * (j))
#define XB_XGEN(j)  (2304 + 64 * (j))
#define XB_TOP      3328
#define XB_TOPGEN   3392
#define XCD_BAR_WORDS 3456
#define XB_SPIN_CAP (1u << 18)
__device__ __forceinline__ unsigned xb_ld(unsigned* p)              { return __hip_atomic_load(p, __ATOMIC_RELAXED, __HIP_MEMORY_SCOPE_AGENT); }
__device__ __forceinline__ unsigned xb_add(unsigned* p, unsigned v) { return __hip_atomic_fetch_add(p, v, __ATOMIC_RELAXED, __HIP_MEMORY_SCOPE_AGENT); }
__device__ __forceinline__ unsigned xb_xcc_id() { return (unsigned)__builtin_amdgcn_s_getreg((3 << 11) | 20) & 0xFu; }
#define XB_SPIN(cond, bar) do { unsigned _sp = 0; while (cond) { __builtin_amdgcn_s_sleep(1); \
    if ((++_sp & 255u) == 0u) { if (xb_ld(&(bar)[XB_TMO])) break; if (_sp > XB_SPIN_CAP) { atomicAdd(&(bar)[XB_TMO], 1u); break; } } } } while (0)
struct XcdBarrier { unsigned* bar; unsigned x; volatile LAS unsigned* st; };
__device__ __forceinline__ XcdBarrier xcd_barrier_post(unsigned* bar, volatile LAS unsigned* st) {
    XcdBarrier b; b.bar = bar; b.x = xb_xcc_id(); b.st = st;
    if (threadIdx.x == 0) (void)xb_add(&bar[XB_XCNT(b.x)], 1u);
    return b;
}
__device__ __forceinline__ void xcd_barrier_complete(unsigned* bar, unsigned x, unsigned& nloc, unsigned& nx) {
    const unsigned G = gridDim.x * gridDim.y * gridDim.z;
    unsigned sum, cnt, mine, sp = 0u;
    for (;;) {
        sum = 0u; cnt = 0u; mine = 0u;
#pragma unroll
        for (unsigned j = 0; j < 16; ++j) { const unsigned c = xb_ld(&bar[XB_XCNT(j)]); sum += c; cnt += (c > 0u) ? 1u : 0u; mine = (j == x) ? c : mine; }
        if (sum == G) break;
        __builtin_amdgcn_s_sleep(1);
        if ((++sp & 255u) == 0u) { if (xb_ld(&bar[XB_TMO])) break; if (sp > XB_SPIN_CAP) { atomicAdd(&bar[XB_TMO], 1u); break; } }
    }
    nloc = mine > 0u ? mine : 1u; nx = cnt > 0u ? cnt : 1u;
}
__device__ __forceinline__ void xcd_barrier(const XcdBarrier& b) {
    asm volatile("s_waitcnt vmcnt(0)" ::: "memory");
    __syncthreads();
    if (threadIdx.x == 0) {
        unsigned* bar = b.bar;
        __builtin_amdgcn_s_waitcnt(0);
        unsigned nloc = b.st[0], nx = b.st[1];
        if (nloc == 0u) { xcd_barrier_complete(bar, b.x, nloc, nx); b.st[0] = nloc; b.st[1] = nx; }
        const unsigned old = xb_add(&bar[XB_XSUB(b.x)], 1u);
        const unsigned gen = old / nloc;
        if (old + 1u == (gen + 1u) * nloc) {
            __builtin_amdgcn_fence(__ATOMIC_RELEASE, "agent");
            asm volatile("s_waitcnt vmcnt(0)" ::: "memory");
            const unsigned og = xb_add(&bar[XB_TOP], 1u);
            const unsigned tg = og / nx;
            if (og + 1u == (tg + 1u) * nx) xb_add(&bar[XB_TOPGEN], 1u);
            else XB_SPIN(xb_ld(&bar[XB_TOPGEN]) == tg, bar);
            __builtin_amdgcn_fence(__ATOMIC_ACQUIRE, "agent");
            xb_add(&bar[XB_XGEN(b.x)], 1u);
            asm volatile("s_waitcnt vmcnt(0)" ::: "memory");
        } else {
            XB_SPIN(xb_ld(&bar[XB_XGEN(b.x)]) == gen, bar);
            __builtin_amdgcn_fence(__ATOMIC_ACQUIRE, "agent");
            asm volatile("s_waitcnt vmcnt(0)" ::: "memory");
        }
    }
    __syncthreads();
}

struct Args {
    const float* x; const int* pos; const float* norm_mix_w; const float* w_in; const float* lq1; const float* lk1; const float* lq2; const float* lk2;
    const float* subln_w; const float* q_norm_w; const float* w_uq; const float* kv_norm_w; const float* w_ukv; const float* w_o_diff; const float* w_o_mla;
    const float* w_out; const float* norm_ffn_w; const float* w_up; const float* conv_w; const float* conv_b; const float* w_down; const float* final_w;
    float* out; unsigned char* ws; int ph_lo, ph_hi;
};

__device__ __forceinline__ float wave_sum(float v) {
#pragma unroll
    for (int o = 1; o < 64; o <<= 1) v += __shfl_xor(v, o);
    return v;
}

struct MapId { __device__ __forceinline__ int operator()(int n) const { return n; } };
struct MapIn { __device__ __forceinline__ int operator()(int n) const {
    if (n < 4096) { const int d = n & 63; return (n & ~63) + 2 * (d & 31) + (d >> 5); }
    if (n < ZC_KR) return n;
    if (n < ZC_KR + 64) { const int d = n - ZC_KR; return ZC_KR + 2 * (d & 31) + (d >> 5); }
    return n + (ZC_GD - (ZC_KR + 64)); } };
struct MapUq { __device__ __forceinline__ int operator()(int n) const { const int h = n / 192, j = n - h * 192;
    if (j < 128) return h * 128 + j; const int d = j - 128; return 2048 + h * 64 + 2 * (d & 31) + (d >> 5); } };
struct MapUkv { __device__ __forceinline__ int operator()(int n) const { const int h = n >> 8, j = n & 255; return (j < 128) ? h * 128 + j : 2048 + h * 128 + (j - 128); } };
struct MapUp { __device__ __forceinline__ int operator()(int n) const { const int v = n >= DFF, c = v ? n - DFF : n; return (c >> 7) * 256 + v * 128 + (c & 127); } };

template <class Map>
__device__ __forceinline__ void tr_item(const float* W, int N, bf16* WT, int ldt, int koff, const float* kscale, Map map, LAS float* scr, int item, int lane) {
    const int nblk = N / 32, kb = item / nblk, nb = item - kb * nblk, k0 = 64 * kb, n0 = 32 * nb;
#pragma unroll 8
    for (int i = 0; i < 32; ++i) { const int kk = 2 * i + (lane >> 5); scr[kk * 33 + (lane & 31)] = W[(size_t)(k0 + kk) * N + n0 + (lane & 31)]; }
    LDS_WAIT(); asm volatile("" ::: "memory");
    const int c = lane & 7;
    float g[8];
#pragma unroll
    for (int e = 0; e < 8; ++e) g[e] = kscale ? kscale[k0 + 8 * c + e] : 1.0f;
#pragma unroll
    for (int j = 0; j < 4; ++j) { const int n = (lane >> 3) + 8 * j; const LAS float* s = scr + (8 * c) * 33 + n;
        v4u o; o.x = pk2(s[0 * 33] * g[0], s[1 * 33] * g[1]); o.y = pk2(s[2 * 33] * g[2], s[3 * 33] * g[3]); o.z = pk2(s[4 * 33] * g[4], s[5 * 33] * g[5]); o.w = pk2(s[6 * 33] * g[6], s[7 * 33] * g[7]);
        *(GAS v4u*)(WT + (size_t)map(n0 + n) * ldt + koff + k0 + 8 * c) = o; }
    LDS_WAIT(); asm volatile("" ::: "memory");
}

struct TrItem { const float* W; const float* ks; bf16* WT; int N, ldt, koff, mapk, k0, n0; unsigned char* W8; int w8row0; const unsigned* WM; };
__device__ __forceinline__ int tr_map(int mapk, int n) { switch (mapk) { case 1: return MapIn()(n); case 2: return MapUq()(n); case 3: return MapUkv()(n); case 4: return MapUp()(n); default: return n; } }
__device__ __forceinline__ void tr_load(const TrItem& d, float (&v)[32], float (&g)[8], int lane) {
    typedef float f4 __attribute__((ext_vector_type(4)));
    if (d.ks) { const f4 g0 = *(const GAS f4*)(d.ks + d.k0 + 8 * (lane & 7)), g1 = *(const GAS f4*)(d.ks + d.k0 + 8 * (lane & 7) + 4);
        g[0] = g0.x; g[1] = g0.y; g[2] = g0.z; g[3] = g0.w; g[4] = g1.x; g[5] = g1.y; g[6] = g1.z; g[7] = g1.w; }
    else {
#pragma unroll
        for (int e = 0; e < 8; ++e) g[e] = 1.0f; }
#pragma unroll
    for (int i = 0; i < 8; ++i) { const int kk = (lane >> 3) + 8 * i; const f4 t = __builtin_nontemporal_load((const GAS f4*)(d.W + (size_t)(d.k0 + kk) * d.N + d.n0 + 4 * (lane & 7)));
        v[4 * i] = t.x; v[4 * i + 1] = t.y; v[4 * i + 2] = t.z; v[4 * i + 3] = t.w; }
}
__device__ __forceinline__ void tr_store(const TrItem& d, const float (&v)[32], const float (&g)[8], LAS float* scr, int lane) {
#pragma unroll
    for (int i = 0; i < 8; ++i) { const int kk = (lane >> 3) + 8 * i;
#pragma unroll
        for (int j = 0; j < 4; ++j) scr[kk * 33 + 4 * (lane & 7) + j] = v[4 * i + j]; }
    LDS_WAIT(); asm volatile("" ::: "memory");
    const int c = lane & 7;
#pragma unroll
    for (int j = 0; j < 4; ++j) { const int n = (lane >> 3) + 8 * j; const LAS float* sp = scr + (8 * c) * 33 + n;
        v4u o; o.x = pk2(sp[0 * 33] * g[0], sp[1 * 33] * g[1]); o.y = pk2(sp[2 * 33] * g[2], sp[3 * 33] * g[3]); o.z = pk2(sp[4 * 33] * g[4], sp[5 * 33] * g[5]); o.w = pk2(sp[6 * 33] * g[6], sp[7 * 33] * g[7]);
        const int row = tr_map(d.mapk, d.n0 + n);
        if (d.W8 && row >= d.w8row0) { pg8::f32x4 f0 = {sp[0 * 33] * g[0], sp[1 * 33] * g[1], sp[2 * 33] * g[2], sp[3 * 33] * g[3]}, f1 = {sp[4 * 33] * g[4], sp[5 * 33] * g[5], sp[6 * 33] * g[6], sp[7 * 33] * g[7]};
            const float qs = 127.0f / fmaxf(__uint_as_float(d.WM[row - d.w8row0]), 1e-30f); v2u o8; o8.x = pg8::pk4_i8(f0 * qs); o8.y = pg8::pk4_i8(f1 * qs); *(GAS v2u*)(d.W8 + (size_t)(row - d.w8row0) * DM + d.k0 + 8 * c) = o8; }
        else *(GAS v4u*)(d.WT + (size_t)row * d.ldt + d.koff + d.k0 + 8 * c) = o; }
    LDS_WAIT(); asm volatile("" ::: "memory");
}

__constant__ float ROPE_INVF[32] = {
    1.000000000e+00f, 7.498942614e-01f, 5.623413324e-01f, 4.216965139e-01f, 3.162277639e-01f, 2.371373773e-01f, 1.778279394e-01f, 1.333521307e-01f,
    1.000000015e-01f, 7.498941571e-02f, 5.623413250e-02f, 4.216965288e-02f, 3.162277490e-02f, 2.371373773e-02f, 1.778279431e-02f, 1.333521493e-02f,
    9.999999776e-03f, 7.498941850e-03f, 5.623413250e-03f, 4.216964822e-03f, 3.162277630e-03f, 2.371373586e-03f, 1.778279431e-03f, 1.333521446e-03f,
    1.000000047e-03f, 7.498942432e-04f, 5.623413017e-04f, 4.216965172e-04f, 3.162277571e-04f, 2.371373703e-04f, 1.778279402e-04f, 1.333521504e-04f };

typedef float f32x4 __attribute__((ext_vector_type(4)));
typedef float f32x16 __attribute__((ext_vector_type(16)));

__global__ void __launch_bounds__(NWAVES * 64, 2) fwd_kernel(Args a) {
    extern __shared__ __attribute__((aligned(16))) unsigned char lds[];
    LAS unsigned char* ldsl = (LAS unsigned char*)lds;
    volatile LAS unsigned* MISC = (volatile LAS unsigned*)(ldsl + MISC_OFF);
    const int tid = threadIdx.x, lane = tid & 63, wave = __builtin_amdgcn_readfirstlane(tid >> 6);
    const int G = gridDim.x; const int bx = blockIdx.x; const int vcu = (G % 8 == 0) ? (bx % 8) * (G / 8) + bx / 8 : bx;
    unsigned char* ws = a.ws;
    gu32* ctl = (gu32*)(ws + WS_CTL);
    for (int u = tid; u < (LDS_BYTES - LDSCTL_OFF) / 4; u += NWAVES * 64) ((LAS unsigned*)(ldsl + LDSCTL_OFF))[u] = 0u;
    __syncthreads();
    XcdBarrier bar; bar.bar = (unsigned*)(ctl + CW_BAR); bar.x = 0; bar.st = nullptr;
    if (!MK_PER_PHASE) bar = xcd_barrier_post((unsigned*)(ctl + CW_BAR), MISC + 8);
    const int lo = a.ph_lo, hi = a.ph_hi;
#ifndef PH_MASK
#define PH_MASK 0x3ff
#endif
#ifndef DUP_MASK
#define DUP_MASK 0
#endif
#define IN(k) (((PH_MASK >> (k)) & 1) && lo <= (k) && (k) < hi)
#define SEAM(k) do { if (IN(k) && IN((k) + 1)) xcd_barrier(bar); } while (0)
#ifdef TP_I0
    unsigned long long* const tsw = (unsigned long long*)(ws + 768 * 1024);
#define STAMP(k) do { if (bx == 0 && tid == 0) __hip_atomic_store(tsw + (k), (unsigned long long)__builtin_amdgcn_s_memrealtime(), RLX_AGENT); } while (0)
#else
#define STAMP(k) do { } while (0)
#endif
    const int gw = vcu * NWAVES + wave, NGW = G * NWAVES;
    bf16* const WIN = (bf16*)(ws + WS_WIN); bf16* const WUQ = (bf16*)(ws + WS_WUQ); bf16* const WUKV = (bf16*)(ws + WS_WUKV); bf16* const WO = (bf16*)(ws + WS_WO);
    bf16* const WOUT = (bf16*)(ws + WS_WOUT); bf16* const WUP = (bf16*)(ws + WS_WUP); bf16* const WDOWN = (bf16*)(ws + WS_WDOWN);
    bf16* const HB = (bf16*)(ws + WS_H); bf16* const YB = HB; bf16* const OB = (bf16*)(ws + WS_O); bf16* const XB = OB;
    bf16* const ZB = (bf16*)(ws + WS_Z); bf16* const QM = (bf16*)(ws + WS_QM); bf16* const KV = (bf16*)(ws + WS_KV);
    unsigned* const WMU = (unsigned*)(ws + WS_CTL + 256 * 1024); unsigned* const WMG = (unsigned*)(ws + WS_CTL + 384 * 1024);
    unsigned char* const WUP8 = ws + WS_WUP; unsigned char* const XN8 = ws + WS_X1 + 64 * MiB; float* const XSC = (float*)(ws + WS_X1 + 97 * MiB);
    float* const HSC = (float*)(ws + WS_X1 + 96 * MiB);
    unsigned char* const H8 = ws + WS_X1; unsigned char* const WIN8 = ws + WS_X1 + 32 * MiB;
    unsigned char* const VT8 = ws + WS_KV;
    unsigned char* const QF8 = ws + WS_QM; unsigned char* const KF8N = ws + WS_QM + 24 * MiB; unsigned char* const KF8R = ws + WS_QM + 40 * MiB;
    float* const HALO = (float*)(ws + WS_HALO); float* const O1 = (float*)(ws + WS_O1); bf16* const ACT = (bf16*)(ws + WS_ACT); float* const X1 = (float*)(ws + WS_X1);
    float* const COS = (float*)(ws + WS_COS); float* const SIN = (float*)(ws + WS_SIN); float* const SSQC = (float*)(ws + WS_SSQC);
    float* const SSQ1 = (float*)(ws + WS_SSQ1); float* const SSQ2 = (float*)(ws + WS_SSQ2); float* const RSTD1 = (float*)(ws + WS_RSTD1);

    STAMP(0);
    if (((DUP_MASK >> 0) & 1) && IN(0)) {
        LAS float* scr = (LAS float*)(ldsl + RING_OFF + wave * 16384);
        constexpr int I_IN = (DM / 64) * (INW / 32), I_UQ = (QRANK / 64) * (QMW / 32), I_UKV = (KVRANK / 64) * (KVW / 32), I_OD = (2048 / 64) * (DM / 32), I_OUT = (DM / 64) * (DM / 32),
                      I_UP = (DM / 64) * (UPW / 32), I_DN = (DFF / 64) * (DM / 32);
        constexpr int NITEMS = I_IN + I_UQ + I_UKV + 2 * I_OD + I_OUT + I_UP + I_DN;
        auto decode = [&](int it) -> TrItem { TrItem d; int r = it; int KB_;
            d.W8 = nullptr; d.w8row0 = 0; d.WM = nullptr;
            if (r < I_IN) { d.W = a.w_in; d.W8 = WIN8; d.w8row0 = ZC_GD; d.WM = WMG; d.ks = nullptr; d.WT = WIN; d.N = INW; d.ldt = DM; d.koff = 0; d.mapk = 1; KB_ = DM / 64; }
            else if ((r -= I_IN) < I_UQ) { d.W = a.w_uq; d.ks = a.q_norm_w; d.WT = WUQ; d.N = QMW; d.ldt = QRANK; d.koff = 0; d.mapk = 2; KB_ = QRANK / 64; }
            else if ((r -= I_UQ) < I_UKV) { d.W = a.w_ukv; d.ks = a.kv_norm_w; d.WT = WUKV; d.N = KVW; d.ldt = KVRANK; d.koff = 0; d.mapk = 3; KB_ = KVRANK / 64; }
            else if ((r -= I_UKV) < I_OD) { d.W = a.w_o_diff; d.ks = nullptr; d.WT = WO; d.N = DM; d.ldt = 4096; d.koff = 0; d.mapk = 0; KB_ = 2048 / 64; }
            else if ((r -= I_OD) < I_OD) { d.W = a.w_o_mla; d.ks = nullptr; d.WT = WO; d.N = DM; d.ldt = 4096; d.koff = 2048; d.mapk = 0; KB_ = 2048 / 64; }
            else if ((r -= I_OD) < I_OUT) { d.W = a.w_out; d.ks = nullptr; d.WT = WOUT; d.N = DM; d.ldt = DM; d.koff = 0; d.mapk = 0; KB_ = DM / 64; }
            else if ((r -= I_OUT) < I_UP) { d.W = a.w_up; d.ks = a.norm_ffn_w; d.WT = WUP; d.N = UPW; d.ldt = DM; d.koff = 0; d.mapk = 4; KB_ = DM / 64; d.W8 = WUP8; d.WM = WMU; }
            else { r -= I_UP; d.W = a.w_down; d.ks = nullptr; d.WT = WDOWN; d.N = DM; d.ldt = DFF; d.koff = 0; d.mapk = 0; KB_ = DFF / 64; }
            const int nblk = d.N / 32, kblk = KB_; const int grp = r / (kblk * 32), rem = r - grp * (kblk * 32); const int kb = rem % kblk, nb = grp * 32 + rem / kblk; (void)nblk;
            d.k0 = 64 * kb; d.n0 = 32 * nb; return d; };
        if (gw < NITEMS) {
            int it = gw; const int cs = NGW, it1 = NITEMS; TrItem d0, d1, d2, d3; float v0[32], v1[32], v2[32], v3[32], g0[8], g1[8], g2[8], g3[8];
            d0 = decode(it); tr_load(d0, v0, g0, lane); d1 = d0; d2 = d0; d3 = d0;
            if (it + cs < it1) { d1 = decode(it + cs); tr_load(d1, v1, g1, lane); }
            if (it + 2 * cs < it1) { d2 = decode(it + 2 * cs); tr_load(d2, v2, g2, lane); }
            for (;;) {
                if (it + 3 * cs < it1) { d3 = decode(it + 3 * cs); tr_load(d3, v3, g3, lane); }
                tr_store(d0, v0, g0, scr, lane); it += cs; if (it >= it1) break;
                if (it + 3 * cs < it1) { d0 = decode(it + 3 * cs); tr_load(d0, v0, g0, lane); }
                tr_store(d1, v1, g1, scr, lane); it += cs; if (it >= it1) break;
                if (it + 3 * cs < it1) { d1 = decode(it + 3 * cs); tr_load(d1, v1, g1, lane); }
                tr_store(d2, v2, g2, scr, lane); it += cs; if (it >= it1) break;
                if (it + 3 * cs < it1) { d2 = decode(it + 3 * cs); tr_load(d2, v2, g2, lane); }
                tr_store(d3, v3, g3, scr, lane); it += cs; if (it >= it1) break;
            }
        }
        { const int gt = vcu * (NWAVES * 64) + tid, NGT = G * NWAVES * 64; GAS v4u* pz = (GAS v4u*)(WIN + (size_t)(ZC_KR + 64) * DM); const int nz = (ZC_GD - ZC_KR - 64) * DM / 8;
            for (int i = gt; i < nz; i += NGT) pz[i] = (v4u){0u, 0u, 0u, 0u};
            for (int i = gt; i < S * 32; i += NGT) { const int t = i >> 5, f = i & 31; const float ang = (float)a.pos[t] * ROPE_INVF[f];
                const double rev = (double)ang * 0.15915494309189535; const float fr = (float)(rev - __builtin_rint(rev));
                COS[i] = __builtin_amdgcn_cosf(fr); SIN[i] = __builtin_amdgcn_sinf(fr); } }
        if (gw < S) {
            f32x4 wn[16], va[16], vb[16];
            { const GAS f32x4* wv = (const GAS f32x4*)a.norm_mix_w + lane;
#pragma unroll
              for (int j = 0; j < 16; ++j) wn[j] = wv[64 * j]; }
#define H_LOAD(v, m_) do { const GAS f32x4* xr_ = (const GAS f32x4*)(a.x + (size_t)(m_) * DM) + lane; _Pragma("unroll") for (int j = 0; j < 16; ++j) v[j] = xr_[64 * j]; } while (0)
#define H_ROW(v, m_) do { float ss_ = 0.f; _Pragma("unroll") for (int j = 0; j < 16; ++j) ss_ += (v[j].x * v[j].x + v[j].y * v[j].y) + (v[j].z * v[j].z + v[j].w * v[j].w); \
            const float rs_ = 1.0f / sqrtf(wave_sum(ss_) * (1.0f / DM) + NORM_EPS); GAS unsigned long long* o8_ = (GAS unsigned long long*)(HB + (size_t)(m_) * DM) + lane; \
            GAS unsigned* h8_ = (GAS unsigned*)(H8 + (size_t)(m_) * DM) + lane; \
            float mx_ = 0.f; _Pragma("unroll") for (int j = 0; j < 16; ++j) { v[j] = v[j] * rs_ * wn[j]; mx_ = fmaxf(fmaxf(mx_, fmaxf(fabsf(v[j].x), fabsf(v[j].y))), fmaxf(fabsf(v[j].z), fabsf(v[j].w))); } \
            _Pragma("unroll") for (int o_ = 32; o_ >= 1; o_ >>= 1) mx_ = fmaxf(mx_, __shfl_xor(mx_, o_)); mx_ = fmaxf(mx_, 1e-20f); const float qs_ = 127.0f / mx_; if (lane == 0) HSC[m_] = mx_ * (1.0f / 127.0f); \
            _Pragma("unroll") for (int j = 0; j < 16; ++j) { const f32x4 hv_ = v[j]; o8_[64 * j] = (unsigned long long)pk2(hv_.x, hv_.y) | ((unsigned long long)pk2(hv_.z, hv_.w) << 32); h8_[64 * j] = pg8::pk4_i8(hv_ * qs_); } } while (0)
            int m = gw; H_LOAD(va, m);
            for (;;) {
                if (m + NGW < S) H_LOAD(vb, m + NGW);
                H_ROW(va, m); m += NGW; if (m >= S) break;
                if (m + NGW < S) H_LOAD(va, m + NGW);
                H_ROW(vb, m); m += NGW; if (m >= S) break;
            }
#undef H_LOAD
#undef H_ROW
        }
    }
    if (((DUP_MASK >> 0) & 1) && IN(0)) xcd_barrier(bar);
    if (IN(0)) {
        {
            constexpr int CB_UP = UPW / 256, CB_G = 8192 / 256, NITM = (CB_UP + CB_G) * 64;
            for (int it = gw; it < NITM; it += NGW) { const int kb = it & 63, cb = it >> 6; const bool up = cb < CB_UP; const int c0 = up ? cb * 256 : (cb - CB_UP) * 256 + (ZC_KR + 64); const int N_ = up ? UPW : INW;
                const float* W_ = up ? a.w_up : a.w_in;
                const GAS f32x4* p = (const GAS f32x4*)(W_ + (size_t)(kb * 64) * N_ + c0) + lane; f32x4 mx = {0.f, 0.f, 0.f, 0.f};
#pragma unroll 8
                for (int k = 0; k < 64; ++k) { const f32x4 v = p[(size_t)k * (N_ / 4)]; const float g = up ? a.norm_ffn_w[kb * 64 + k] : 1.0f;
#pragma unroll
                    for (int e = 0; e < 4; ++e) mx[e] = fmaxf(mx[e], fabsf(v[e] * g)); }
#pragma unroll
                for (int e = 0; e < 4; ++e) { const int n = c0 + 4 * lane + e; const int row = up ? MapUp()(n) : n - (ZC_KR + 64);
                    __hip_atomic_fetch_max((up ? WMU : WMG) + row, __float_as_uint(mx[e]), __ATOMIC_RELAXED, __HIP_MEMORY_SCOPE_AGENT); } }
            xcd_barrier(bar);
        }
        LAS float* scr = (LAS float*)(ldsl + RING_OFF + wave * 16384);
        constexpr int I_IN = (DM / 64) * (INW / 32), I_UQ = (QRANK / 64) * (QMW / 32), I_UKV = (KVRANK / 64) * (KVW / 32), I_OD = (2048 / 64) * (DM / 32), I_OUT = (DM / 64) * (DM / 32),
                      I_UP = (DM / 64) * (UPW / 32), I_DN = (DFF / 64) * (DM / 32);
        constexpr int NITEMS = I_IN + I_UQ + I_UKV + 2 * I_OD + I_OUT + I_UP + I_DN;
        auto decode = [&](int it) -> TrItem { TrItem d; int r = it; int KB_;
            d.W8 = nullptr; d.w8row0 = 0; d.WM = nullptr;
            if (r < I_IN) { d.W = a.w_in; d.W8 = WIN8; d.w8row0 = ZC_GD; d.WM = WMG; d.ks = nullptr; d.WT = WIN; d.N = INW; d.ldt = DM; d.koff = 0; d.mapk = 1; KB_ = DM / 64; }
            else if ((r -= I_IN) < I_UQ) { d.W = a.w_uq; d.ks = a.q_norm_w; d.WT = WUQ; d.N = QMW; d.ldt = QRANK; d.koff = 0; d.mapk = 2; KB_ = QRANK / 64; }
            else if ((r -= I_UQ) < I_UKV) { d.W = a.w_ukv; d.ks = a.kv_norm_w; d.WT = WUKV; d.N = KVW; d.ldt = KVRANK; d.koff = 0; d.mapk = 3; KB_ = KVRANK / 64; }
            else if ((r -= I_UKV) < I_OD) { d.W = a.w_o_diff; d.ks = nullptr; d.WT = WO; d.N = DM; d.ldt = 4096; d.koff = 0; d.mapk = 0; KB_ = 2048 / 64; }
            else if ((r -= I_OD) < I_OD) { d.W = a.w_o_mla; d.ks = nullptr; d.WT = WO; d.N = DM; d.ldt = 4096; d.koff = 2048; d.mapk = 0; KB_ = 2048 / 64; }
            else if ((r -= I_OD) < I_OUT) { d.W = a.w_out; d.ks = nullptr; d.WT = WOUT; d.N = DM; d.ldt = DM; d.koff = 0; d.mapk = 0; KB_ = DM / 64; }
            else if ((r -= I_OUT) < I_UP) { d.W = a.w_up; d.ks = a.norm_ffn_w; d.WT = WUP; d.N = UPW; d.ldt = DM; d.koff = 0; d.mapk = 4; KB_ = DM / 64; d.W8 = WUP8; d.WM = WMU; }
            else { r -= I_UP; d.W = a.w_down; d.ks = nullptr; d.WT = WDOWN; d.N = DM; d.ldt = DFF; d.koff = 0; d.mapk = 0; KB_ = DFF / 64; }
            const int nblk = d.N / 32, kblk = KB_; const int grp = r / (kblk * 32), rem = r - grp * (kblk * 32); const int kb = rem % kblk, nb = grp * 32 + rem / kblk; (void)nblk;
            d.k0 = 64 * kb; d.n0 = 32 * nb; return d; };
        if (gw < NITEMS) {
            int it = gw; const int cs = NGW, it1 = NITEMS; TrItem d0, d1, d2, d3; float v0[32], v1[32], v2[32], v3[32], g0[8], g1[8], g2[8], g3[8];
            d0 = decode(it); tr_load(d0, v0, g0, lane); d1 = d0; d2 = d0; d3 = d0;
            if (it + cs < it1) { d1 = decode(it + cs); tr_load(d1, v1, g1, lane); }
            if (it + 2 * cs < it1) { d2 = decode(it + 2 * cs); tr_load(d2, v2, g2, lane); }
            for (;;) {
                if (it + 3 * cs < it1) { d3 = decode(it + 3 * cs); tr_load(d3, v3, g3, lane); }
                tr_store(d0, v0, g0, scr, lane); it += cs; if (it >= it1) break;
                if (it + 3 * cs < it1) { d0 = decode(it + 3 * cs); tr_load(d0, v0, g0, lane); }
                tr_store(d1, v1, g1, scr, lane); it += cs; if (it >= it1) break;
                if (it + 3 * cs < it1) { d1 = decode(it + 3 * cs); tr_load(d1, v1, g1, lane); }
                tr_store(d2, v2, g2, scr, lane); it += cs; if (it >= it1) break;
                if (it + 3 * cs < it1) { d2 = decode(it + 3 * cs); tr_load(d2, v2, g2, lane); }
                tr_store(d3, v3, g3, scr, lane); it += cs; if (it >= it1) break;
            }
        }
        { const int gt = vcu * (NWAVES * 64) + tid, NGT = G * NWAVES * 64; GAS v4u* pz = (GAS v4u*)(WIN + (size_t)(ZC_KR + 64) * DM); const int nz = (ZC_GD - ZC_KR - 64) * DM / 8;
            for (int i = gt; i < nz; i += NGT) pz[i] = (v4u){0u, 0u, 0u, 0u};
            for (int i = gt; i < S * 32; i += NGT) { const int t = i >> 5, f = i & 31; const float ang = (float)a.pos[t] * ROPE_INVF[f];
                const double rev = (double)ang * 0.15915494309189535; const float fr = (float)(rev - __builtin_rint(rev));
                COS[i] = __builtin_amdgcn_cosf(fr); SIN[i] = __builtin_amdgcn_sinf(fr); } }
        if (gw < S) {
            f32x4 wn[16], va[16], vb[16];
            { const GAS f32x4* wv = (const GAS f32x4*)a.norm_mix_w + lane;
#pragma unroll
              for (int j = 0; j < 16; ++j) wn[j] = wv[64 * j]; }
#define H_LOAD(v, m_) do { const GAS f32x4* xr_ = (const GAS f32x4*)(a.x + (size_t)(m_) * DM) + lane; _Pragma("unroll") for (int j = 0; j < 16; ++j) v[j] = xr_[64 * j]; } while (0)
#define H_ROW(v, m_) do { float ss_ = 0.f; _Pragma("unroll") for (int j = 0; j < 16; ++j) ss_ += (v[j].x * v[j].x + v[j].y * v[j].y) + (v[j].z * v[j].z + v[j].w * v[j].w); \
            const float rs_ = 1.0f / sqrtf(wave_sum(ss_) * (1.0f / DM) + NORM_EPS); GAS unsigned long long* o8_ = (GAS unsigned long long*)(HB + (size_t)(m_) * DM) + lane; \
            GAS unsigned* h8_ = (GAS unsigned*)(H8 + (size_t)(m_) * DM) + lane; \
            float mx_ = 0.f; _Pragma("unroll") for (int j = 0; j < 16; ++j) { v[j] = v[j] * rs_ * wn[j]; mx_ = fmaxf(fmaxf(mx_, fmaxf(fabsf(v[j].x), fabsf(v[j].y))), fmaxf(fabsf(v[j].z), fabsf(v[j].w))); } \
            _Pragma("unroll") for (int o_ = 32; o_ >= 1; o_ >>= 1) mx_ = fmaxf(mx_, __shfl_xor(mx_, o_)); mx_ = fmaxf(mx_, 1e-20f); const float qs_ = 127.0f / mx_; if (lane == 0) HSC[m_] = mx_ * (1.0f / 127.0f); \
            _Pragma("unroll") for (int j = 0; j < 16; ++j) { const f32x4 hv_ = v[j]; o8_[64 * j] = (unsigned long long)pk2(hv_.x, hv_.y) | ((unsigned long long)pk2(hv_.z, hv_.w) << 32); h8_[64 * j] = pg8::pk4_i8(hv_ * qs_); } } while (0)
            int m = gw; H_LOAD(va, m);
            for (;;) {
                if (m + NGW < S) H_LOAD(vb, m + NGW);
                H_ROW(va, m); m += NGW; if (m >= S) break;
                if (m + NGW < S) H_LOAD(va, m + NGW);
                H_ROW(vb, m); m += NGW; if (m >= S) break;
            }
#undef H_LOAD
#undef H_ROW
        }
    }
    SEAM(0);

    STAMP(1);
    if (((DUP_MASK >> 1) & 1) && IN(1)) {
        pg8::EpiIn E{ZB, COS, SIN, SSQC, KF8R};
        { pg8::Gemm g{HB, WIN, S, 31 * 256, DM, DM, DM}; pg8::StaticOrder So; So.init(S, 31 * 256, G, bx);
          pg8::gemm_phase<pg8::EpiIn, pg8::StaticOrder, true>(ldsl + RING_OFF, g, So, E); }
        {
          pg8::Gemm g{(const pg8::bf16_t*)H8, (const pg8::bf16_t*)WIN8 - (size_t)31 * 256 * (DM / 2), S, 32 * 256, DM / 2, DM / 2, DM / 2}; pg8::SkipOrder So; So.s.init(S, 32 * 256, G, bx); So.skip_from = 0; So.skip_n = 31;
          pg8::EpiInGate E8{ZB, HSC, (const float*)WMG};
          pg8::gemm_phase<pg8::EpiInGate, pg8::SkipOrder, true, pg8::NoHook, false, true>(ldsl + RING_OFF, g, So, E8); }
    }
    if (((DUP_MASK >> 1) & 1) && IN(1)) xcd_barrier(bar);
    if (IN(1)) {
        pg8::EpiIn E{ZB, COS, SIN, SSQC, KF8R};
        { pg8::Gemm g{HB, WIN, S, 31 * 256, DM, DM, DM}; pg8::StaticOrder So; So.init(S, 31 * 256, G, bx);
          pg8::gemm_phase<pg8::EpiIn, pg8::StaticOrder, true>(ldsl + RING_OFF, g, So, E); }
        {
          pg8::Gemm g{(const pg8::bf16_t*)H8, (const pg8::bf16_t*)WIN8 - (size_t)31 * 256 * (DM / 2), S, 32 * 256, DM / 2, DM / 2, DM / 2}; pg8::SkipOrder So; So.s.init(S, 32 * 256, G, bx); So.skip_from = 0; So.skip_n = 31;
          pg8::EpiInGate E8{ZB, HSC, (const float*)WMG};
          pg8::gemm_phase<pg8::EpiInGate, pg8::SkipOrder, true, pg8::NoHook, false, true>(ldsl + RING_OFF, g, So, E8); }
    }
    SEAM(1);

    STAMP(2);
    if (((DUP_MASK >> 2) & 1) && IN(2)) {
        { pg8::Gemm g{ZB + ZC_CQ, WUQ, S, QMW, QRANK, ZW, QRANK}; pg8::StaticOrder So; So.init(S, QMW, G, bx);
          pg8::EpiMla<0, 4, QRANK, 1 << 30> E{QM, QMW, SSQC, COS, SIN, 8, QF8, QMW};
          pg8::gemm_phase<pg8::EpiMla<0, 4, QRANK, 1 << 30>, pg8::StaticOrder, true>(ldsl + RING_OFF, g, So, E); }
        { pg8::Gemm g{ZB + ZC_CKV, WUKV, S, 2048, KVRANK, ZW, KVRANK}; pg8::StaticOrder So; So.init(S, 2048, G, bx);
          pg8::EpiMla<16, 2, KVRANK, 1 << 30> E{KV, KVW, SSQC, COS, SIN, 1 << 30, KF8N, 2048};
          pg8::gemm_phase<pg8::EpiMla<16, 2, KVRANK, 1 << 30>, pg8::StaticOrder, true>(ldsl + RING_OFF, g, So, E); }
        { pg8::Gemm g{WUKV + (size_t)2048 * KVRANK, ZB + ZC_CKV, 2048, S, KVRANK, KVRANK, ZW}; pg8::VtOrder Vo{bx, G};
          pg8::EpiVT E{VT8, SSQC, S};
          pg8::gemm_phase<pg8::EpiVT, pg8::VtOrder, true>(ldsl + RING_OFF, g, Vo, E); }
    }
    if (((DUP_MASK >> 2) & 1) && IN(2)) xcd_barrier(bar);
    if (IN(2)) {
        { pg8::Gemm g{ZB + ZC_CQ, WUQ, S, QMW, QRANK, ZW, QRANK}; pg8::StaticOrder So; So.init(S, QMW, G, bx);
          pg8::EpiMla<0, 4, QRANK, 1 << 30> E{QM, QMW, SSQC, COS, SIN, 8, QF8, QMW};
          pg8::gemm_phase<pg8::EpiMla<0, 4, QRANK, 1 << 30>, pg8::StaticOrder, true>(ldsl + RING_OFF, g, So, E); }
        { pg8::Gemm g{ZB + ZC_CKV, WUKV, S, 2048, KVRANK, ZW, KVRANK}; pg8::StaticOrder So; So.init(S, 2048, G, bx);
          pg8::EpiMla<16, 2, KVRANK, 1 << 30> E{KV, KVW, SSQC, COS, SIN, 1 << 30, KF8N, 2048};
          pg8::gemm_phase<pg8::EpiMla<16, 2, KVRANK, 1 << 30>, pg8::StaticOrder, true>(ldsl + RING_OFF, g, So, E); }
        { pg8::Gemm g{WUKV + (size_t)2048 * KVRANK, ZB + ZC_CKV, 2048, S, KVRANK, KVRANK, ZW}; pg8::VtOrder Vo{bx, G};
          pg8::EpiVT E{VT8, SSQC, S};
          pg8::gemm_phase<pg8::EpiVT, pg8::VtOrder, true>(ldsl + RING_OFF, g, Vo, E); }
    }
    SEAM(2);

    STAMP(3);
    if (((DUP_MASK >> 3) & 1) && IN(3)) {
        float lam;
        { const float a1 = wave_sum(a.lq1[lane] * a.lk1[lane]), a2 = wave_sum(a.lq2[lane] * a.lk2[lane]); lam = expf(a1) - expf(a2) + LAMBDA_INIT; }
        const int row_l = lane & 31, half_l = lane >> 5;
        char* const alds = (char*)lds + RING_OFF;
        if (wave >= 4) __builtin_amdgcn_s_setprio(1);
        for (int rep_ = 0; rep_ < 1 + ((DUP_MASK >> 10) & 1); ++rep_)
        for (int item = vcu; item < NHEAD * 16; item += G) {
            const int h = item >> 4, sp = item & 15;
#ifndef NO_DIFF
#pragma unroll 1
            for (int pc = 0; pc < 4; ++pc) {
                const int c = pc >> 1, pass = pc & 1, qb = pass ? sp : 31 - sp; const int trow = qb * 256 + wave * 32 + row_l;
                att::Src sd; sd.Qn = nullptr; sd.Kn = nullptr;
                sd.Qr = ZB + ZC_QD + (2 * h + c) * 64; sd.Kr = ZB + ZC_KD + (2 * h + c) * 64; sd.V = ZB + ZC_VD + h * 128;
                att::diff_block64<8>(sd.Qr, sd.Kr, sd.V, qb, alds);
                bf16* o1p = (bf16*)O1 + (size_t)trow * 2048 + h * 128 + half_l * 64;
                if (c == 0) {
#pragma unroll
                    for (int j = 0; j < 8; ++j) *(pg8::u32x4*)(o1p + 8 * j) = pg8::pack8(att::staged4(alds, wave, lane, 2 * j), att::staged4(alds, wave, lane, 2 * j + 1));
                } else {
                    f32x4 u[16]; float ss = 0.f;
#pragma unroll
                    for (int j = 0; j < 8; ++j) { pg8::f32x4 a0, a1; pg8::unpack8(*(const pg8::u32x4*)(o1p + 8 * j), a0, a1);
                        u[2 * j] = a0 - lam * att::staged4(alds, wave, lane, 2 * j); u[2 * j + 1] = a1 - lam * att::staged4(alds, wave, lane, 2 * j + 1);
#pragma unroll
                        for (int e = 0; e < 2; ++e) ss += (u[2 * j + e][0] * u[2 * j + e][0] + u[2 * j + e][1] * u[2 * j + e][1]) + (u[2 * j + e][2] * u[2 * j + e][2] + u[2 * j + e][3] * u[2 * j + e][3]); }
                    ss += __shfl_xor(ss, 32);
                    const float rs = (1.0f - LAMBDA_INIT) / sqrtf(ss * (1.0f / 128.0f) + SUBLN_EPS);
                    bf16* ob = OB + (size_t)trow * 4096 + h * 128 + half_l * 64; const float* swp = a.subln_w + half_l * 64;
#pragma unroll
                    for (int j = 0; j < 8; ++j) { const f32x4 w0 = *(const f32x4*)(swp + 8 * j), w1 = *(const f32x4*)(swp + 8 * j + 4);
                        *(pg8::u32x4*)(ob + 8 * j) = pg8::pack8(u[2 * j] * rs * w0, u[2 * j + 1] * rs * w1); }
                }
            }
#endif
        }
        for (int rep_ = 0; rep_ < 1 + ((DUP_MASK >> 11) & 1); ++rep_)
        for (int item = vcu; item < NHEAD * 16; item += G) {
            const int h = item >> 4, sp = item & 15;
#ifndef NO_MLA
#pragma unroll 1
            for (int pass = 0; pass < 2; ++pass) {
                const int qb = pass ? sp : 31 - sp; const int trow = qb * 256 + wave * 32 + row_l;
                att::Src sm; sm.Qn = (const att::bf16_t*)(QF8 + h * 128); sm.Qr = (const att::bf16_t*)(QF8 + 2048 + h * 64); sm.Kn = (const att::bf16_t*)(KF8N + h * 128); sm.Kr = (const att::bf16_t*)KF8R; sm.V = (const att::bf16_t*)(VT8 + (size_t)h * 128 * S);
                att::attn_block<true, 2>(sm, qb, alds);
                bf16* ob = OB + (size_t)trow * 4096 + 2048 + h * 128 + half_l * 64;
#pragma unroll
                for (int j = 0; j < 8; ++j) *(pg8::u32x4*)(ob + 8 * j) = pg8::pack8(att::staged4(alds, wave, lane, 2 * j), att::staged4(alds, wave, lane, 2 * j + 1));
            }
#endif
        }
    }
    if (((DUP_MASK >> 3) & 1) && IN(3)) xcd_barrier(bar);
    if (IN(3)) {
        float lam;
        { const float a1 = wave_sum(a.lq1[lane] * a.lk1[lane]), a2 = wave_sum(a.lq2[lane] * a.lk2[lane]); lam = expf(a1) - expf(a2) + LAMBDA_INIT; }
        const int row_l = lane & 31, half_l = lane >> 5;
        char* const alds = (char*)lds + RING_OFF;
        if (wave >= 4) __builtin_amdgcn_s_setprio(1);
        for (int rep_ = 0; rep_ < 1 + ((DUP_MASK >> 10) & 1); ++rep_)
        for (int item = vcu; item < NHEAD * 16; item += G) {
            const int h = item >> 4, sp = item & 15;
#ifndef NO_DIFF
#pragma unroll 1
            for (int pc = 0; pc < 4; ++pc) {
                const int c = pc >> 1, pass = pc & 1, qb = pass ? sp : 31 - sp; const int trow = qb * 256 + wave * 32 + row_l;
                att::Src sd; sd.Qn = nullptr; sd.Kn = nullptr;
                sd.Qr = ZB + ZC_QD + (2 * h + c) * 64; sd.Kr = ZB + ZC_KD + (2 * h + c) * 64; sd.V = ZB + ZC_VD + h * 128;
                att::diff_block64<8>(sd.Qr, sd.Kr, sd.V, qb, alds);
                bf16* o1p = (bf16*)O1 + (size_t)trow * 2048 + h * 128 + half_l * 64;
                if (c == 0) {
#pragma unroll
                    for (int j = 0; j < 8; ++j) *(pg8::u32x4*)(o1p + 8 * j) = pg8::pack8(att::staged4(alds, wave, lane, 2 * j), att::staged4(alds, wave, lane, 2 * j + 1));
                } else {
                    f32x4 u[16]; float ss = 0.f;
#pragma unroll
                    for (int j = 0; j < 8; ++j) { pg8::f32x4 a0, a1; pg8::unpack8(*(const pg8::u32x4*)(o1p + 8 * j), a0, a1);
                        u[2 * j] = a0 - lam * att::staged4(alds, wave, lane, 2 * j); u[2 * j + 1] = a1 - lam * att::staged4(alds, wave, lane, 2 * j + 1);
#pragma unroll
                        for (int e = 0; e < 2; ++e) ss += (u[2 * j + e][0] * u[2 * j + e][0] + u[2 * j + e][1] * u[2 * j + e][1]) + (u[2 * j + e][2] * u[2 * j + e][2] + u[2 * j + e][3] * u[2 * j + e][3]); }
                    ss += __shfl_xor(ss, 32);
                    const float rs = (1.0f - LAMBDA_INIT) / sqrtf(ss * (1.0f / 128.0f) + SUBLN_EPS);
                    bf16* ob = OB + (size_t)trow * 4096 + h * 128 + half_l * 64; const float* swp = a.subln_w + half_l * 64;
#pragma unroll
                    for (int j = 0; j < 8; ++j) { const f32x4 w0 = *(const f32x4*)(swp + 8 * j), w1 = *(const f32x4*)(swp + 8 * j + 4);
                        *(pg8::u32x4*)(ob + 8 * j) = pg8::pack8(u[2 * j] * rs * w0, u[2 * j + 1] * rs * w1); }
                }
            }
#endif
        }
        for (int rep_ = 0; rep_ < 1 + ((DUP_MASK >> 11) & 1); ++rep_)
        for (int item = vcu; item < NHEAD * 16; item += G) {
            const int h = item >> 4, sp = item & 15;
#ifndef NO_MLA
#pragma unroll 1
            for (int pass = 0; pass < 2; ++pass) {
                const int qb = pass ? sp : 31 - sp; const int trow = qb * 256 + wave * 32 + row_l;
                att::Src sm; sm.Qn = (const att::bf16_t*)(QF8 + h * 128); sm.Qr = (const att::bf16_t*)(QF8 + 2048 + h * 64); sm.Kn = (const att::bf16_t*)(KF8N + h * 128); sm.Kr = (const att::bf16_t*)KF8R; sm.V = (const att::bf16_t*)(VT8 + (size_t)h * 128 * S);
                att::attn_block<true, 2>(sm, qb, alds);
                bf16* ob = OB + (size_t)trow * 4096 + 2048 + h * 128 + half_l * 64;
#pragma unroll
                for (int j = 0; j < 8; ++j) *(pg8::u32x4*)(ob + 8 * j) = pg8::pack8(att::staged4(alds, wave, lane, 2 * j), att::staged4(alds, wave, lane, 2 * j + 1));
            }
#endif
        }
    }
    __builtin_amdgcn_s_setprio(0);
    SEAM(3);

    STAMP(4);
    if (((DUP_MASK >> 4) & 1) && IN(4)) {
        pg8::Gemm g{OB, WO, S, DM, 4096, 4096, 4096}; pg8::StaticOrder So; So.init(S, DM, G, bx);
        pg8::EpiGate E{ZB + ZC_GM, YB}; pg8::GateHook HK{ZB + ZC_GD, ZB + ZC_GM};
        pg8::gemm_phase<pg8::EpiGate, pg8::StaticOrder, true, pg8::GateHook>(ldsl + RING_OFF, g, So, E, HK);
    }
    if (((DUP_MASK >> 4) & 1) && IN(4)) xcd_barrier(bar);
    if (IN(4)) {
        pg8::Gemm g{OB, WO, S, DM, 4096, 4096, 4096}; pg8::StaticOrder So; So.init(S, DM, G, bx);
        pg8::EpiGate E{ZB + ZC_GM, YB}; pg8::GateHook HK{ZB + ZC_GD, ZB + ZC_GM};
        pg8::gemm_phase<pg8::EpiGate, pg8::StaticOrder, true, pg8::GateHook>(ldsl + RING_OFF, g, So, E, HK);
    }
    SEAM(4);

    STAMP(5);
    if (((DUP_MASK >> 5) & 1) && IN(5)) {
        pg8::Gemm g{YB, WOUT, S, DM, DM, DM, DM}; pg8::StaticOrder So; So.init(S, DM, G, bx);
        pg8::EpiRes<false> E{a.x, XB, SSQ1};
        pg8::gemm_phase<pg8::EpiRes<false>, pg8::StaticOrder, true>(ldsl + RING_OFF, g, So, E);
    }
    if (((DUP_MASK >> 5) & 1) && IN(5)) xcd_barrier(bar);
    if (IN(5)) {
        pg8::Gemm g{YB, WOUT, S, DM, DM, DM, DM}; pg8::StaticOrder So; So.init(S, DM, G, bx);
        pg8::EpiRes<false> E{a.x, XB, SSQ1};
        pg8::gemm_phase<pg8::EpiRes<false>, pg8::StaticOrder, true>(ldsl + RING_OFF, g, So, E);
    }
    SEAM(5);

    STAMP(6);
    if (IN(6)) {
        for (int m = gw; m < S; m += NGW) { const float sm = wave_sum(SSQ1[(size_t)m * 64 + lane]); const float rs = 1.0f / sqrtf(sm * (1.0f / DM) + NORM_EPS); if (lane == 0) RSTD1[m] = rs;
            const GAS pg8::u32x4* xr = (const GAS pg8::u32x4*)(XB + (size_t)m * DM) + lane; pg8::f32x4 xv[16]; float mx = 0.f;
#pragma unroll
            for (int jj = 0; jj < 8; ++jj) { pg8::unpack8(xr[64 * jj], xv[2 * jj], xv[2 * jj + 1]);
#pragma unroll
                for (int e = 0; e < 4; ++e) mx = fmaxf(mx, fmaxf(fabsf(xv[2 * jj][e]), fabsf(xv[2 * jj + 1][e]))); }
#pragma unroll
            for (int o_ = 32; o_ >= 1; o_ >>= 1) mx = fmaxf(mx, __shfl_xor(mx, o_));
            mx = fmaxf(mx * rs, 1e-20f); const float qs = rs * 127.0f / mx; if (lane == 0) XSC[m] = mx * (1.0f / 127.0f);
            GAS v2u* xo = (GAS v2u*)(XN8 + (size_t)m * DM) + lane;
#pragma unroll
            for (int jj = 0; jj < 8; ++jj) { v2u w; w.x = pg8::pk4_i8(xv[2 * jj] * qs); w.y = pg8::pk4_i8(xv[2 * jj + 1] * qs); xo[64 * jj] = w; } }
    }
    SEAM(6);

    STAMP(7);
    if (((DUP_MASK >> 7) & 1) && IN(7)) {
        pg8::Gemm g{(const pg8::bf16_t*)XN8, (const pg8::bf16_t*)WUP8, S, UPW, DM / 2, DM / 2, DM / 2}; pg8::StaticOrder So; So.init(S, UPW, G, bx);
        pg8::EpiUpConv E{ACT, HALO, a.conv_w, a.conv_b, XSC, (LAS float*)(ldsl + XCH_OFF), (const float*)WMU};
        pg8::gemm_phase<pg8::EpiUpConv, pg8::StaticOrder, true, pg8::NoHook, false, true>(ldsl + RING_OFF, g, So, E);
    }
    if (((DUP_MASK >> 7) & 1) && IN(7)) xcd_barrier(bar);
    if (IN(7)) {
        pg8::Gemm g{(const pg8::bf16_t*)XN8, (const pg8::bf16_t*)WUP8, S, UPW, DM / 2, DM / 2, DM / 2}; pg8::StaticOrder So; So.init(S, UPW, G, bx);
        pg8::EpiUpConv E{ACT, HALO, a.conv_w, a.conv_b, XSC, (LAS float*)(ldsl + XCH_OFF), (const float*)WMU};
        pg8::gemm_phase<pg8::EpiUpConv, pg8::StaticOrder, true, pg8::NoHook, false, true>(ldsl + RING_OFF, g, So, E);
    }
    SEAM(7);

    STAMP(8);
    if (IN(8)) {
        pg8::Gemm g{ACT, WDOWN, S, DM, DFF, DFF, DFF}; pg8::StaticOrder So; So.init(S, DM, G, bx);
        { pg8::Unit un; int last_pm = 0;
            for (int ui = 0; So.next(ui, un); ++ui) { const int pm = un.pm; if (pm == last_pm) continue; last_pm = pm;
                const float* ha = HALO + ((size_t)(pm - 1) * 4 + 2) * UPW; const float* hb = ha + UPW; const float* h0 = HALO + (size_t)pm * 4 * UPW; const float* h1 = h0 + UPW;
                for (int c = tid; c < DFF; c += NWAVES * 64) { const int gc = (c >> 7) * 256 + (c & 127), vc = gc + 128;
                    const float sg = __uint_as_float(WMU[gc]) * (1.0f / 127.0f), sv = __uint_as_float(WMU[vc]) * (1.0f / 127.0f);
                    const float wg0 = a.conv_w[c] * sg, wg1 = a.conv_w[UPW + c] * sg, wg2 = a.conv_w[2 * UPW + c] * sg, bg = a.conv_b[c];
                    const float wv0 = a.conv_w[DFF + c] * sv, wv1 = a.conv_w[UPW + DFF + c] * sv, wv2 = a.conv_w[2 * UPW + DFF + c] * sv, bv = a.conv_b[DFF + c];
                    const float ga = ha[gc], gb = hb[gc], g0 = h0[gc], g1 = h1[gc], va = ha[vc], vb = hb[vc], v0 = h0[vc], v1 = h1[vc];
                    const float og0 = bg + wg0 * ga + wg1 * gb + wg2 * g0, og1 = bg + wg0 * gb + wg1 * g0 + wg2 * g1;
                    const float ov0 = bv + wv0 * va + wv1 * vb + wv2 * v0, ov1 = bv + wv0 * vb + wv1 * v0 + wv2 * v1;
                    ACT[(size_t)(pm * 256) * DFF + c] = (bf16)f2bf(og0 * pg8::sigmoidf_fast(og0) * ov0);
                    ACT[(size_t)(pm * 256 + 1) * DFF + c] = (bf16)f2bf(og1 * pg8::sigmoidf_fast(og1) * ov1); } }
            VM_WAIT(); __syncthreads(); }
        pg8::EpiRes<true> E{nullptr, XB, SSQ2};
        pg8::gemm_phase<pg8::EpiRes<true>, pg8::StaticOrder, true>(ldsl + RING_OFF, g, So, E);
    }
    SEAM(8);

    STAMP(9);
    if (IN(9)) {
        if (gw < S) {
            int l9 = threadIdx.x; asm volatile("" : "+v"(l9)); l9 &= 63;
            f32x4 wf[16]; pg8::u32x4 xa[8], xb[8]; float qa, qb;
            { const GAS f32x4* wv = (const GAS f32x4*)a.final_w;
#pragma unroll
              for (int jj = 0; jj < 8; ++jj) { wf[2 * jj] = wv[(64 * jj + l9) * 2]; wf[2 * jj + 1] = wv[(64 * jj + l9) * 2 + 1]; } }
#define F_LOAD(x_, q_, m_) do { q_ = SSQ2[(size_t)(m_) * 64 + l9]; const GAS pg8::u32x4* xr_ = (const GAS pg8::u32x4*)(XB + (size_t)(m_) * DM) + l9; _Pragma("unroll") for (int jj = 0; jj < 8; ++jj) x_[jj] = xr_[64 * jj]; } while (0)
#define F_ROW(x_, q_, m_) do { const float rs_ = 1.0f / sqrtf(wave_sum(q_) * (1.0f / DM) + NORM_EPS); GAS f32x4* orow_ = (GAS f32x4*)(a.out + (size_t)(m_) * DM); \
            _Pragma("unroll") for (int jj = 0; jj < 8; ++jj) { pg8::f32x4 v0_, v1_; pg8::unpack8(x_[jj], v0_, v1_); const int c4_ = (64 * jj + l9) * 2; \
                orow_[c4_] = v0_ * rs_ * wf[2 * jj]; orow_[c4_ + 1] = v1_ * rs_ * wf[2 * jj + 1]; } } while (0)
            int m = gw; F_LOAD(xa, qa, m);
            for (;;) {
                if (m + NGW < S) F_LOAD(xb, qb, m + NGW);
                F_ROW(xa, qa, m); m += NGW; if (m >= S) break;
                if (m + NGW < S) F_LOAD(xa, qa, m + NGW);
                F_ROW(xb, qb, m); m += NGW; if (m >= S) break;
            }
#undef F_LOAD
#undef F_ROW
        }
    }
#ifdef TP_I0
    xcd_barrier(bar); STAMP(10); xcd_barrier(bar);
    { const unsigned long long tI = __hip_atomic_load(tsw + TP_I1 + 1, RLX_AGENT) - __hip_atomic_load(tsw + TP_I0, RLX_AGENT), tJ = __hip_atomic_load(tsw + TP_J1 + 1, RLX_AGENT) - __hip_atomic_load(tsw + TP_J0, RLX_AGENT);
      const float B = sqrtf((float)tI * 0.01f), A = (float)tJ * 0.01f;
      const size_t gt = (size_t)bx * (NWAVES * 64) + tid, NT = (size_t)G * NWAVES * 64;
      for (size_t i = gt; i < (size_t)S * DM; i += NT) a.out[i] = (i == 0) ? A : B; }
#endif
#undef IN
#undef SEAM
}


#if MK_PER_PHASE == 2
struct CsRange { size_t off; size_t bytes; };
__global__ void csum_kernel(const unsigned char* ws, const float* outp, unsigned* cs, CsRange r0, CsRange r1, CsRange r2, int use_out) {
    unsigned s1 = 0u, s2 = 0u;
    const size_t gt = (size_t)blockIdx.x * blockDim.x + threadIdx.x, NT = (size_t)gridDim.x * blockDim.x;
    CsRange rr[3] = {r0, r1, r2};
#pragma unroll
    for (int k = 0; k < 3; ++k) { const unsigned* p = (const unsigned*)(ws + rr[k].off); const size_t n = rr[k].bytes / 4;
        for (size_t i = gt; i < n; i += NT) { const unsigned w = p[i]; s1 += w; s2 += w * ((unsigned)(i & 0xffffu) | 1u); } }
    if (use_out) { const unsigned* p = (const unsigned*)outp; const size_t n = (size_t)S * DM;
        for (size_t i = gt; i < n; i += NT) { const unsigned w = p[i]; s1 += w; s2 += w * ((unsigned)(i & 0xffffu) | 1u); } }
    atomicAdd(cs, s1); atomicAdd(cs + 1, s2);
}
__global__ void encode_kernel(float* outp, const unsigned* cs) {
    int code = 20;
    for (int k = 9; k >= 0; --k) if (cs[2 * k] != cs[32 + 2 * k] || cs[2 * k + 1] != cs[32 + 2 * k + 1]) code = k + 1;
    const float c = sqrtf(10.0f * (float)code);
    const size_t gt = (size_t)blockIdx.x * blockDim.x + threadIdx.x, NT = (size_t)gridDim.x * blockDim.x;
    for (size_t i = gt; i < (size_t)S * DM; i += NT) outp[i] = c;
}
#endif


#if MK_PER_PHASE == 3
__global__ void zsum_kernel(const unsigned char* ws, unsigned* cs) {
    unsigned g[6] = {0u, 0u, 0u, 0u, 0u, 0u};
    const size_t gt = (size_t)blockIdx.x * blockDim.x + threadIdx.x, NT = (size_t)gridDim.x * blockDim.x;
    const unsigned* z = (const unsigned*)(ws + WS_Z); const size_t n = (size_t)S * ZW / 2;
    for (size_t i = gt; i < n; i += NT) { const int col = (int)(i % (ZW / 2)) * 2, pn = col >> 8; const unsigned w = z[i] * ((unsigned)(i & 0xffffu) | 1u);
        const int grp = (pn < 16) ? 0 : (pn < 24) ? 1 : (pn < 30) ? 2 : (pn == 30) ? 4 : 3; g[grp] += w; }
    const unsigned* q = (const unsigned*)(ws + WS_SSQC); for (size_t i = gt; i < (size_t)S * 24; i += NT) g[5] += q[i] * ((unsigned)(i & 0xffffu) | 1u);
#pragma unroll
    for (int k = 0; k < 6; ++k) atomicAdd(cs + k, g[k]);
}
__global__ void encode3_kernel(float* outp, const unsigned* cs) {
    int mask = 0;
    for (int k = 0; k < 6; ++k) if (cs[k] != cs[8 + k]) mask |= (k < 5 ? (1 << k) : 0);
    int rer = 0; for (int k = 0; k < 6; ++k) if (cs[8 + k] != cs[16 + k]) rer = 1;
    const int ssq = cs[5] != cs[13];
    const float c = sqrtf(10.0f * (float)(mask + 1) + 1000.0f * rer + 2000.0f * ssq);
    const size_t gt = (size_t)blockIdx.x * blockDim.x + threadIdx.x, NT = (size_t)gridDim.x * blockDim.x;
    for (size_t i = gt; i < (size_t)S * DM; i += NT) outp[i] = c;
}
#endif

constexpr int N_PHASES = 10;
extern "C" void kernel_launch(void* const* d_in, const int* in_sizes, int n_in, void* d_out, int out_size, void* d_ws, size_t ws_size, hipStream_t stream) {
    static int grid = 0;
    if (grid == 0) {
        if (n_in != 22 || in_sizes[0] != S * DM || out_size != S * DM || ws_size < WS_END) { fprintf(stderr, "kernel_launch: unexpected shapes (n_in %d, in0 %d, out %d, ws %zu)\n", n_in, n_in > 0 ? in_sizes[0] : -1, out_size, ws_size); grid = -1; return; }
        int dev = 0, cus = 0, per_cu = 0;
        if (hipGetDevice(&dev) != hipSuccess || hipDeviceGetAttribute(&cus, hipDeviceAttributeMultiprocessorCount, dev) != hipSuccess) { grid = -1; return; }
        if (hipFuncSetAttribute((const void*)fwd_kernel, hipFuncAttributeMaxDynamicSharedMemorySize, LDS_BYTES) != hipSuccess) { fprintf(stderr, "kernel_launch: hipFuncSetAttribute failed\n"); grid = -1; return; }
        if (hipOccupancyMaxActiveBlocksPerMultiprocessor(&per_cu, (const void*)fwd_kernel, NWAVES * 64, LDS_BYTES) != hipSuccess || per_cu < 1)
            fprintf(stderr, "kernel_launch: note: occupancy query reports %d workgroups per CU\n", per_cu);
        (void)hipGetLastError();
        grid = cus;
    }
    if (grid < 0) return;
    if (hipMemsetAsync((char*)d_ws + WS_CTL, 0, CTL_ZERO_BYTES, stream) != hipSuccess) return;
    Args a{};
    a.x = (const float*)d_in[0]; a.pos = (const int*)d_in[1]; a.norm_mix_w = (const float*)d_in[2]; a.w_in = (const float*)d_in[3];
    a.lq1 = (const float*)d_in[4]; a.lk1 = (const float*)d_in[5]; a.lq2 = (const float*)d_in[6]; a.lk2 = (const float*)d_in[7];
    a.subln_w = (const float*)d_in[8]; a.q_norm_w = (const float*)d_in[9]; a.w_uq = (const float*)d_in[10]; a.kv_norm_w = (const float*)d_in[11];
    a.w_ukv = (const float*)d_in[12]; a.w_o_diff = (const float*)d_in[13]; a.w_o_mla = (const float*)d_in[14]; a.w_out = (const float*)d_in[15];
    a.norm_ffn_w = (const float*)d_in[16]; a.w_up = (const float*)d_in[17]; a.conv_w = (const float*)d_in[18]; a.conv_b = (const float*)d_in[19];
    a.w_down = (const float*)d_in[20]; a.final_w = (const float*)d_in[21];
    a.out = (float*)d_out; a.ws = (unsigned char*)d_ws;
#if MK_PER_PHASE == 3
    unsigned* cs = (unsigned*)((char*)d_ws + 512 * 1024);
    for (int run = 0; run < 2; ++run) {
        hipMemsetAsync((char*)d_ws + MiB, run ? 0x55 : 0xAA, WS_END - MiB, stream);
        for (int p = 0; p < 2; ++p) { a.ph_lo = p; a.ph_hi = p + 1; hipLaunchKernelGGL(fwd_kernel, dim3(grid), dim3(NWAVES * 64), LDS_BYTES, stream, a); }
        hipLaunchKernelGGL(zsum_kernel, dim3(2048), dim3(256), 0, stream, (const unsigned char*)d_ws, cs + 8 * run);
    }
    a.ph_lo = 1; a.ph_hi = 2; hipLaunchKernelGGL(fwd_kernel, dim3(grid), dim3(NWAVES * 64), LDS_BYTES, stream, a);
    hipLaunchKernelGGL(zsum_kernel, dim3(2048), dim3(256), 0, stream, (const unsigned char*)d_ws, cs + 16);
    hipLaunchKernelGGL(encode3_kernel, dim3(2048), dim3(256), 0, stream, (float*)d_out, (const unsigned*)cs);
#elif MK_PER_PHASE == 2
    unsigned* cs = (unsigned*)((char*)d_ws + 512 * 1024);
    for (int run = 0; run < 2; ++run) {
        hipMemsetAsync((char*)d_ws + MiB, run ? 0x55 : 0xAA, WS_END - MiB, stream); hipMemsetAsync(d_out, run ? 0x55 : 0xAA, (size_t)S * DM * 4, stream);
        for (int p = 0; p < N_PHASES; ++p) { a.ph_lo = p; a.ph_hi = p + 1; hipLaunchKernelGGL(fwd_kernel, dim3(grid), dim3(NWAVES * 64), LDS_BYTES, stream, a);
            CsRange r0{0, 0}, r1{0, 0}, r2{0, 0}; int uo = 0;
            switch (p) {
                case 0: r0 = {WS_COS, 2 * MiB}; r1 = {WS_WIN, WS_O - WS_WIN}; break;
                case 1: r0 = {WS_Z, 252 * MiB}; r1 = {WS_SSQC, (size_t)S * 24 * 4}; break;
                case 2: r0 = {WS_QM, 112 * MiB}; break;
                case 3: r0 = {WS_O, 64 * MiB}; r1 = {WS_O1, 64 * MiB}; break;
                case 4: r0 = {WS_H, 64 * MiB}; r1 = {WS_T1, 128 * MiB}; break;
                case 5: r0 = {WS_X1, 128 * MiB}; r1 = {WS_O, 64 * MiB}; r2 = {WS_SSQ1, 2 * MiB}; break;
                case 6: r0 = {WS_U, 344 * MiB}; r1 = {WS_RSTD1, (size_t)S * 4}; break;
                case 7: r0 = {WS_ACT, 172 * MiB}; break;
                case 8: r0 = {WS_SSQ2, 2 * MiB}; uo = 1; break;
                default: uo = 1; break;
            }
            hipLaunchKernelGGL(csum_kernel, dim3(2048), dim3(256), 0, stream, (const unsigned char*)d_ws, (const float*)d_out, cs + 32 * run + 2 * p, r0, r1, r2, uo);
        }
    }
    hipLaunchKernelGGL(encode_kernel, dim3(2048), dim3(256), 0, stream, (float*)d_out, (const unsigned*)cs);
#elif MK_PER_PHASE
    for (int p = 0; p < N_PHASES; ++p) { a.ph_lo = p; a.ph_hi = p + 1; hipLaunchKernelGGL(fwd_kernel, dim3(grid), dim3(NWAVES * 64), LDS_BYTES, stream, a); }
#else
    a.ph_lo = 0; a.ph_hi = N_PHASES;
    hipLaunchKernelGGL(fwd_kernel, dim3(grid), dim3(NWAVES * 64), LDS_BYTES, stream, a);
#endif
    const hipError_t le = hipPeekAtLastError();
    if (le != hipSuccess) fprintf(stderr, "kernel_launch: launch failed: %s\n", hipGetErrorName(le));
}
```

```cpp
#include <hip/hip_runtime.h>
#include <hip/hip_bf16.h>
#include <cstdio>
#include <cstdint>

#ifndef MK_PER_PHASE
#define MK_PER_PHASE 0
#endif

constexpr int S = 8192, DM = 4096, NHEAD = 16;
constexpr int INW = 15936, ZW = 16128;
constexpr int ZC_QD = 0, ZC_KD = 2048, ZC_VD = 4096, ZC_CQ = 6144, ZC_CKV = 7168, ZC_KR = 7680, ZC_GD = 7936, ZC_GM = 12032;
constexpr int QRANK = 1024, KVRANK = 512;
constexpr int QMW = 3072, KVW = 4096;
constexpr int DFF = 11008, UPW = 22016;
constexpr float NORM_EPS = 1e-6f, SUBLN_EPS = 1e-5f, LAMBDA_INIT = 0.2f;

#define GAS __attribute__((address_space(1)))
#define LAS __attribute__((address_space(3)))
typedef unsigned short bf16;
typedef unsigned v4u __attribute__((ext_vector_type(4)));
typedef unsigned v2u __attribute__((ext_vector_type(2)));
typedef GAS unsigned gu32;
#define RLX_AGENT __ATOMIC_RELAXED, __HIP_MEMORY_SCOPE_AGENT
#define LDS_WAIT() asm volatile("s_waitcnt lgkmcnt(0)" ::: "memory")
#define VM_WAIT() asm volatile("s_waitcnt vmcnt(0)" ::: "memory")

namespace pg8 {
#define PG8_LAS __attribute__((address_space(3)))
typedef unsigned short bf16_t;
typedef short bf16x8 __attribute__((ext_vector_type(8)));
typedef float f32x4 __attribute__((ext_vector_type(4)));
typedef unsigned u32x4 __attribute__((ext_vector_type(4)));
constexpr int BM = 256, BK = 64, HALF = 128, HTB = HALF * BK * 2, STAGE_BYTES = 8 * HTB, NXCD = 8, WGM = 8;

__host__ __device__ __forceinline__ int lds_byte(int r, int c) { const int st = (r >> 4) * 2 + (c >> 5), rr = r & 15, cc = c & 31, ob = rr * 64 + cc * 2; return st * 1024 + (ob ^ (((ob >> 9) & 1) << 5)); }
__host__ __device__ __forceinline__ void stage_rc(int b, int& R, int& C) { const int st = b / 1024, sb = b % 1024, swz = sb ^ (((sb >> 9) & 1) << 5); R = (st >> 1) * 16 + swz / 64; C = (st & 1) * 32 + (swz % 64) / 2; }
__host__ __device__ __forceinline__ int perm32(int rho) { const int n = rho >> 4, i = rho & 15; return 8 * (i >> 2) + 4 * n + (i & 3); }

struct Unit { int pm, pn; };
typedef int v8i32g __attribute__((ext_vector_type(8))); typedef int v4i32g __attribute__((ext_vector_type(4)));
struct Gemm { const bf16_t* A; const bf16_t* Bt; int M, N, K, lda, ldb; };

struct StaticOrder {
    int nM, nN, nwg, G, c;
    __host__ __device__ void init(int M, int N, int G_, int c_) { nM = M / BM; nN = N / BM; nwg = nM * nN; G = G_; c = c_; }
    __host__ __device__ __forceinline__ bool next(int i, Unit& u) const {
        const long L = (long)i * G + c; if (L >= nwg) return false;
        int wgid = (int)L; { const int q = nwg / NXCD, r = nwg % NXCD, xcd = wgid % NXCD, off = wgid / NXCD; wgid = (xcd < r ? xcd * (q + 1) : r * (q + 1) + (xcd - r) * q) + off; }
        const int nig = WGM * nN, gid = wgid / nig, fm = gid * WGM, gsz = (nM - fm) < WGM ? (nM - fm) : WGM;
        u.pm = fm + ((wgid % nig) % gsz); u.pn = (wgid % nig) / gsz; return true;
    }
    __device__ __forceinline__ void a_ready(const Unit&) const {}
    __device__ __forceinline__ void done(const Unit&) const {}
};

typedef float f32x2_t __attribute__((ext_vector_type(2))); typedef __bf16 bf16x2_t __attribute__((ext_vector_type(2)));
__device__ __forceinline__ unsigned cvt_pk_bf16(float lo, float hi) { f32x2_t v = {lo, hi}; bf16x2_t b = __builtin_convertvector(v, bf16x2_t); return __builtin_bit_cast(unsigned, b); }
__device__ __forceinline__ u32x4 pack8(f32x4 a, f32x4 b) { u32x4 w; w.x = cvt_pk_bf16(a[0], a[1]); w.y = cvt_pk_bf16(a[2], a[3]); w.z = cvt_pk_bf16(b[0], b[1]); w.w = cvt_pk_bf16(b[2], b[3]); return w; }
__device__ __forceinline__ void unpack8(u32x4 w, f32x4& a, f32x4& b) {
    a[0] = __uint_as_float(w.x << 16); a[1] = __uint_as_float(w.x & 0xffff0000u); a[2] = __uint_as_float(w.y << 16); a[3] = __uint_as_float(w.y & 0xffff0000u);
    b[0] = __uint_as_float(w.z << 16); b[1] = __uint_as_float(w.z & 0xffff0000u); b[2] = __uint_as_float(w.w << 16); b[3] = __uint_as_float(w.w & 0xffff0000u); }
__device__ __forceinline__ unsigned pk4_fp8(const f32x4 v) { int w = __builtin_amdgcn_cvt_pk_fp8_f32(v[0], v[1], 0, false); w = __builtin_amdgcn_cvt_pk_fp8_f32(v[2], v[3], w, true); return (unsigned)w; }
__device__ __forceinline__ unsigned pk4_i8(const f32x4 v) { unsigned w = 0;
#pragma unroll
    for (int e = 0; e < 4; ++e) { const int q = (int)__builtin_rintf(__builtin_fminf(__builtin_fmaxf(v[e], -127.f), 127.f)); w |= ((unsigned)q & 0xffu) << (8 * e); } return w; }
__device__ __forceinline__ float sigmoidf_fast(float v) { return __builtin_amdgcn_rcpf(1.0f + __builtin_amdgcn_exp2f(-1.4426950408889634f * v)); }
__device__ __forceinline__ void rope8(f32x4& v0, f32x4& v1, const f32x4 c4, const f32x4 s4) {
    const f32x4 a = v0, b = v1;
    v0[0] = a[0] * c4[0] - a[1] * s4[0]; v0[1] = a[1] * c4[0] + a[0] * s4[0]; v0[2] = a[2] * c4[1] - a[3] * s4[1]; v0[3] = a[3] * c4[1] + a[2] * s4[1];
    v1[0] = b[0] * c4[2] - b[1] * s4[2]; v1[1] = b[1] * c4[2] + b[0] * s4[2]; v1[2] = b[2] * c4[3] - b[3] * s4[3]; v1[3] = b[3] * c4[3] + b[2] * s4[3];
}
__device__ __forceinline__ float sumsq8(const f32x4 a, const f32x4 b) { return (a[0] * a[0] + a[1] * a[1]) + (a[2] * a[2] + a[3] * a[3]) + (b[0] * b[0] + b[1] * b[1]) + (b[2] * b[2] + b[3] * b[3]); }

#define EPI_ROWS(ai, m) _Pragma("unroll") for (int ai = 0; ai < 2; ++ai) _Pragma("unroll") for (int m = 0; m < 4; ++m)

typedef unsigned u32x2w __attribute__((ext_vector_type(2)));
struct EpiIn {
    static constexpr bool PERM = true, AFTER_DRAIN = false;
    bf16_t* Z; const float* cosT; const float* sinT; float* ssq; unsigned char* KR8;
    __device__ __forceinline__ void operator()(f32x4 (&acc)[2][2][4][2], const Unit& u, int wr, int wc, int fr, int fq) const {
        const int pn = u.pn, row0 = u.pm * BM + wr * 64 + fr, col0 = pn * BM + wc * 32 + 8 * fq;
        if (pn < 16 || pn == 30) {
            const int i0 = 16 * (wc & 1) + 4 * fq; const float qsc = (pn < 8) ? 0.18033688011112042f : 1.0f;
            EPI_ROWS(ai, m) { const int r = row0 + ai * HALF + m * 16; const f32x4 c4 = *(const f32x4*)(cosT + (size_t)r * 32 + i0), s4 = *(const f32x4*)(sinT + (size_t)r * 32 + i0);
                bf16_t* rowp = Z + (size_t)r * ZW + col0;
#pragma unroll
                for (int bj = 0; bj < 2; ++bj) { f32x4 v0 = acc[ai][bj][m][0], v1 = acc[ai][bj][m][1]; rope8(v0, v1, c4, s4); v0 *= qsc; v1 *= qsc; *(u32x4*)(rowp + bj * HALF) = pack8(v0, v1);
                    if (pn == 30 && bj == 0 && wc < 2) { u32x2w w8; w8.x = pk4_fp8(v0); w8.y = pk4_fp8(v1); *(u32x2w*)(KR8 + (size_t)r * 64 + wc * 32 + 8 * fq) = w8; } } }
        } else if (pn < 24) {
            EPI_ROWS(ai, m) { const int r = row0 + ai * HALF + m * 16; bf16_t* rowp = Z + (size_t)r * ZW + col0;
#pragma unroll
                for (int bj = 0; bj < 2; ++bj) *(u32x4*)(rowp + bj * HALF) = pack8(acc[ai][bj][m][0], acc[ai][bj][m][1]); }
        } else if (pn < 30) {
            EPI_ROWS(ai, m) { const int r = row0 + ai * HALF + m * 16; bf16_t* rowp = Z + (size_t)r * ZW + col0; float ss = 0.f;
#pragma unroll
                for (int bj = 0; bj < 2; ++bj) { ss += sumsq8(acc[ai][bj][m][0], acc[ai][bj][m][1]); *(u32x4*)(rowp + bj * HALF) = pack8(acc[ai][bj][m][0], acc[ai][bj][m][1]); }
                ss += __shfl_xor(ss, 16); ss += __shfl_xor(ss, 32);
                if (fq == 0) ssq[(size_t)r * 24 + (pn - 24) * 4 + wc] = ss; }
        } else {
            EPI_ROWS(ai, m) { const int r = row0 + ai * HALF + m * 16; bf16_t* rowp = Z + (size_t)r * ZW + col0;
#pragma unroll
                for (int bj = 0; bj < 2; ++bj) { f32x4 v0 = acc[ai][bj][m][0], v1 = acc[ai][bj][m][1];
#pragma unroll
                    for (int e = 0; e < 4; ++e) { v0[e] = sigmoidf_fast(v0[e]); v1[e] = sigmoidf_fast(v1[e]); }
                    *(u32x4*)(rowp + bj * HALF) = pack8(v0, v1); } }
        }
    }
};

struct EpiInMla {
    static constexpr bool PERM = true, AFTER_DRAIN = false;
    bf16_t* Z; const float* cosT; const float* sinT; float* ssq; unsigned char* KR8;
    __device__ __forceinline__ void operator()(f32x4 (&acc)[2][2][4][2], const Unit& u, int wr, int wc, int fr_, int fq_) const {
        int opq = 0; asm volatile("" : "+v"(opq));
        const int fr = fr_ + opq, fq = fq_ + opq;
        const int pn = u.pn, row0 = u.pm * BM + wr * 64 + fr, col0 = pn * BM + wc * 32 + 8 * fq;
        if (pn == 30) {
            const int i0 = 16 * (wc & 1) + 4 * fq;
            EPI_ROWS(ai, m) { const int r = row0 + ai * HALF + m * 16; const f32x4 c4 = *(const f32x4*)(cosT + (size_t)r * 32 + i0), s4 = *(const f32x4*)(sinT + (size_t)r * 32 + i0);
                bf16_t* rowp = Z + (size_t)r * ZW + col0;
#pragma unroll
                for (int bj = 0; bj < 2; ++bj) { f32x4 v0 = acc[ai][bj][m][0], v1 = acc[ai][bj][m][1]; rope8(v0, v1, c4, s4); *(u32x4*)(rowp + bj * HALF) = pack8(v0, v1);
                    if (bj == 0 && wc < 2) { u32x2w w8; w8.x = pk4_fp8(v0); w8.y = pk4_fp8(v1); *(u32x2w*)(KR8 + (size_t)r * 64 + wc * 32 + 8 * fq) = w8; } } }
        } else {
            EPI_ROWS(ai, m) { const int r = row0 + ai * HALF + m * 16; bf16_t* rowp = Z + (size_t)r * ZW + col0; float ss = 0.f;
#pragma unroll
                for (int bj = 0; bj < 2; ++bj) { ss += sumsq8(acc[ai][bj][m][0], acc[ai][bj][m][1]); *(u32x4*)(rowp + bj * HALF) = pack8(acc[ai][bj][m][0], acc[ai][bj][m][1]); }
                ss += __builtin_bit_cast(float, __builtin_amdgcn_ds_swizzle(__builtin_bit_cast(int, ss), 0x401F));
                { auto rr = __builtin_amdgcn_permlane32_swap(__builtin_bit_cast(unsigned, ss), __builtin_bit_cast(unsigned, ss), false, false); ss = __builtin_bit_cast(float, rr[0]) + __builtin_bit_cast(float, rr[1]); }
                if (fq == 0) ssq[(size_t)r * 24 + (pn - 24) * 4 + wc] = ss; }
        }
    }
};

struct EpiInGate {
    static constexpr bool PERM = true, AFTER_DRAIN = false;
    bf16_t* Z; const float* hsc; const float* wmx;
    __device__ __forceinline__ void operator()(f32x4 (&acc)[2][2][4][2], const Unit& u, int wr, int wc, int fr_, int fq_) const {
        int opq = 0; asm volatile("" : "+v"(opq));
        const int fr = fr_ + opq, fq = fq_ + opq;
        const int row0 = u.pm * BM + wr * 64 + fr, col0 = u.pn * BM + wc * 32 + 8 * fq;
        f32x4 ws0[2], ws1[2];
#pragma unroll
        for (int bj = 0; bj < 2; ++bj) { const float* wp = wmx + (col0 - ZC_GD) + bj * HALF; ws0[bj] = *(const f32x4*)wp * (1.0f / 127.0f); ws1[bj] = *(const f32x4*)(wp + 4) * (1.0f / 127.0f); }
        EPI_ROWS(ai, m) { const int r = row0 + ai * HALF + m * 16; bf16_t* rowp = Z + (size_t)r * ZW + col0; const float dq = hsc[r];
#pragma unroll
            for (int bj = 0; bj < 2; ++bj) { f32x4 v0 = acc[ai][bj][m][0] * (ws0[bj] * dq), v1 = acc[ai][bj][m][1] * (ws1[bj] * dq);
#pragma unroll
                for (int e = 0; e < 4; ++e) { v0[e] = sigmoidf_fast(v0[e]); v1[e] = sigmoidf_fast(v1[e]); }
                *(u32x4*)(rowp + bj * HALF) = pack8(v0, v1); } }
    }
};

template <int SLOT0, int NP4, int KDIM, int F8_BELOW> struct EpiMla {
    static constexpr bool PERM = true, AFTER_DRAIN = false;
    bf16_t* O; int ldc; const float* ssq; const float* cosT; const float* sinT; int rope_from; unsigned char* O8; int ld8;
    __device__ __forceinline__ void operator()(f32x4 (&acc)[2][2][4][2], const Unit& u, int wr, int wc, int fr, int fq) const {
        const int pn = u.pn, row0 = u.pm * BM + wr * 64 + fr, col0 = pn * BM + wc * 32 + 8 * fq, i0 = 16 * (wc & 1) + 4 * fq;
        const bool rope = pn >= rope_from;
        EPI_ROWS(ai, m) { const int r = row0 + ai * HALF + m * 16; float ss = 0.f;
#pragma unroll
            for (int q = 0; q < NP4; ++q) { const f32x4 p = *(const f32x4*)(ssq + (size_t)r * 24 + SLOT0 + 4 * q); ss += (p[0] + p[1]) + (p[2] + p[3]); }
            const float rs = __builtin_amdgcn_rsqf(ss * (1.0f / KDIM) + NORM_EPS);
            f32x4 c4 = {1.f, 1.f, 1.f, 1.f}, s4 = {0.f, 0.f, 0.f, 0.f};
            if (rope) { c4 = *(const f32x4*)(cosT + (size_t)r * 32 + i0); s4 = *(const f32x4*)(sinT + (size_t)r * 32 + i0); }
            bf16_t* rowp = O + (size_t)r * ldc + col0;
#pragma unroll
            for (int bj = 0; bj < 2; ++bj) { f32x4 v0 = acc[ai][bj][m][0] * rs, v1 = acc[ai][bj][m][1] * rs; if (rope) rope8(v0, v1, c4, s4);
                if (pn < F8_BELOW) { u32x2w w8; w8.x = pk4_fp8(v0); w8.y = pk4_fp8(v1); *(u32x2w*)(O8 + (size_t)r * ld8 + col0 + bj * HALF) = w8; }
                else *(u32x4*)(rowp + bj * HALF) = pack8(v0, v1); } }
    }
};

struct GateHook {
    static constexpr bool ENABLED = true;
    const bf16_t* GD; const bf16_t* GM;
    __device__ __forceinline__ void operator()(f32x4 (&acc)[2][2][4][2], const Unit& u, int wr, int wc, int fr, int fq) const {
        int opq = 0; asm volatile("" : "+v"(opq));
        const int row0 = u.pm * BM + wr * 64 + fr + opq, col0 = u.pn * BM + wc * 32 + 8 * fq;
        EPI_ROWS(ai, m) { const size_t ro = (size_t)(row0 + ai * HALF + m * 16) * ZW + col0;
#pragma unroll
            for (int bj = 0; bj < 2; ++bj) { f32x4 d0, d1, m0, m1; unpack8(*(const u32x4*)(GD + ro + bj * HALF), d0, d1); unpack8(*(const u32x4*)(GM + ro + bj * HALF), m0, m1);
#pragma unroll
                for (int e = 0; e < 4; ++e) { acc[ai][bj][m][0][e] *= d0[e] * __builtin_amdgcn_rcpf(fmaxf(m0[e], 1e-20f)); acc[ai][bj][m][1][e] *= d1[e] * __builtin_amdgcn_rcpf(fmaxf(m1[e], 1e-20f)); } }
            asm volatile("" : "+v"(acc[ai][0][m][0]), "+v"(acc[ai][0][m][1]), "+v"(acc[ai][1][m][0]), "+v"(acc[ai][1][m][1]) :: "memory"); }
    }
};
struct EpiGate {
    static constexpr bool PERM = true, AFTER_DRAIN = false;
    const bf16_t* GM; bf16_t* Y;
    __device__ __forceinline__ void operator()(f32x4 (&acc)[2][2][4][2], const Unit& u, int wr, int wc, int fr, int fq) const {
        const int row0 = u.pm * BM + wr * 64 + fr, col0 = u.pn * BM + wc * 32 + 8 * fq;
        EPI_ROWS(ai, m) { const int r = row0 + ai * HALF + m * 16;
#pragma unroll
            for (int bj = 0; bj < 2; ++bj) { const int c = col0 + bj * HALF; f32x4 g0, g1; unpack8(*(const u32x4*)(GM + (size_t)r * ZW + c), g0, g1);
                *(u32x4*)(Y + (size_t)r * DM + c) = pack8(acc[ai][bj][m][0] * g0, acc[ai][bj][m][1] * g1); } }
    }
};

template <bool RES_BF16> struct EpiRes {
    static constexpr bool PERM = true, AFTER_DRAIN = false;
    const float* xi; bf16_t* xb; float* ssq;
    __device__ __forceinline__ void operator()(f32x4 (&acc)[2][2][4][2], const Unit& u, int wr, int wc, int fr, int fq) const {
        const int row0 = u.pm * BM + wr * 64 + fr, col0 = u.pn * BM + wc * 32 + 8 * fq;
        EPI_ROWS(ai, m) { const int r = row0 + ai * HALF + m * 16; float ss = 0.f;
#pragma unroll
            for (int bj = 0; bj < 2; ++bj) { const size_t off = (size_t)r * DM + col0 + bj * HALF; f32x4 r0, r1;
                if (RES_BF16) unpack8(*(const u32x4*)(xb + off), r0, r1); else { r0 = *(const f32x4*)(xi + off); r1 = *(const f32x4*)(xi + off + 4); }
                const f32x4 v0 = acc[ai][bj][m][0] + r0, v1 = acc[ai][bj][m][1] + r1;
                *(u32x4*)(xb + off) = pack8(v0, v1); ss += sumsq8(v0, v1); }
            ss += __shfl_xor(ss, 16); ss += __shfl_xor(ss, 32);
            if (fq == 0) ssq[(size_t)r * 64 + u.pn * 4 + wc] = ss; }
    }
};

struct EpiPlain {
    static constexpr bool PERM = true, AFTER_DRAIN = false;
    bf16_t* O; int ldc;
    __device__ __forceinline__ void operator()(f32x4 (&acc)[2][2][4][2], const Unit& u, int wr, int wc, int fr, int fq) const {
        const int row0 = u.pm * BM + wr * 64 + fr, col0 = u.pn * BM + wc * 32 + 8 * fq;
        EPI_ROWS(ai, m) { bf16_t* rowp = O + (size_t)(row0 + ai * HALF + m * 16) * ldc + col0;
#pragma unroll
            for (int bj = 0; bj < 2; ++bj) *(u32x4*)(rowp + bj * HALF) = pack8(acc[ai][bj][m][0], acc[ai][bj][m][1]); }
    }
};

__device__ __forceinline__ float dpp_shr1(float old, float src) { return __int_as_float(__builtin_amdgcn_update_dpp(__float_as_int(old), __float_as_int(src), 0x111, 0xf, 0xf, false)); }
__device__ __forceinline__ float dpp_shr2(float old, float src) { return __int_as_float(__builtin_amdgcn_update_dpp(__float_as_int(old), __float_as_int(src), 0x112, 0xf, 0xf, false)); }
__device__ __forceinline__ float dpp_ror1(float src) { return __int_as_float(__builtin_amdgcn_update_dpp(0, __float_as_int(src), 0x121, 0xf, 0xf, false)); }
__device__ __forceinline__ float dpp_ror2(float src) { return __int_as_float(__builtin_amdgcn_update_dpp(0, __float_as_int(src), 0x122, 0xf, 0xf, false)); }
typedef unsigned u32x2 __attribute__((ext_vector_type(2)));
struct EpiUpConv {
    static constexpr bool PERM = true, AFTER_DRAIN = false;
    bf16_t* ACT; float* HALO; const float* cw; const float* cb; const float* rstd; PG8_LAS float* xch; const float* wmx;
    static constexpr int UPW_ = 22016, DFF_ = 11008;
    __device__ __forceinline__ void operator()(f32x4 (&acc)[2][2][4][2], const Unit& u, int wr, int wc, int fr_, int fq_) const {
        int opq = 0; asm volatile("" : "+v"(opq));
        const int fr = fr_ + opq, fq = fq_ + opq;
        const int row0 = u.pm * BM + wr * 64 + fr;
        EPI_ROWS(ai, m) { const float rs = rstd[row0 + ai * HALF + m * 16];
#pragma unroll
            for (int bj = 0; bj < 2; ++bj) { acc[ai][bj][m][0] *= rs; acc[ai][bj][m][1] *= rs; } }
        const size_t hcol = (size_t)u.pn * BM + wc * 32 + 8 * fq;
        if (fr >= 14) {
#pragma unroll
            for (int ai = 0; ai < 2; ++ai) { const int ch = ai * 2 + wr; PG8_LAS float* xp = xch + ((((ch * 2 + (fr - 14)) * 4 + wc) * 4 + fq) * 16);
#pragma unroll
                for (int bj = 0; bj < 2; ++bj) { *(PG8_LAS f32x4*)(xp + bj * 8) = acc[ai][bj][3][0]; *(PG8_LAS f32x4*)(xp + bj * 8 + 4) = acc[ai][bj][3][1]; } }
            if (wr == 1) { float* hp = HALO + ((size_t)u.pm * 4 + 2 + (fr - 14)) * UPW_ + hcol;
#pragma unroll
                for (int bj = 0; bj < 2; ++bj) { *(f32x4*)(hp + bj * HALF) = acc[1][bj][3][0]; *(f32x4*)(hp + bj * HALF + 4) = acc[1][bj][3][1]; } }
        }
        if (fr < 2 && wr == 0) { float* hp = HALO + ((size_t)u.pm * 4 + fr) * UPW_ + hcol;
#pragma unroll
            for (int bj = 0; bj < 2; ++bj) { *(f32x4*)(hp + bj * HALF) = acc[0][bj][0][0]; *(f32x4*)(hp + bj * HALF + 4) = acc[0][bj][0][1]; } }
        PG8_LAS float* wl = xch + 2048;
        { const int tq = threadIdx.x + opq, k = tq >> 6, c2 = (tq & 63) * 2, tap = k & 3; const size_t gc = (size_t)u.pn * 128 + c2 + ((k >> 2) ? DFF_ : 0);
          const float* src = (tap < 3) ? cw + (size_t)tap * UPW_ + gc : cb + gc;
          f32x2_t t = *(const f32x2_t*)src; if (tap < 3) { const float* wsp = wmx + (size_t)u.pn * BM + (k >> 2) * HALF + c2; t[0] *= wsp[0] * (1.0f / 127.0f); t[1] *= wsp[1] * (1.0f / 127.0f); }
          *(PG8_LAS f32x2_t*)(wl + k * 128 + c2) = t; }
        asm volatile("s_waitcnt lgkmcnt(0)\n\ts_barrier" ::: "memory");
        const int c0 = u.pn * 128 + wc * 32 + 8 * fq; const PG8_LAS float* wlp = wl + wc * 32 + 8 * fq;
#pragma unroll
        for (int ai = 0; ai < 2; ++ai) {
            const int ch = ai * 2 + wr;
            f32x4 pgn[2], pvn[2];
#pragma unroll
            for (int m = 0; m < 4; ++m) {
                u32x2 keep;
#pragma unroll
                for (int n = 0; n < 2; ++n) {
                    const PG8_LAS float* wp = wlp + 4 * n;
                    const f32x4 wg0 = *(const PG8_LAS f32x4*)(wp), wg1 = *(const PG8_LAS f32x4*)(wp + 128), wg2 = *(const PG8_LAS f32x4*)(wp + 256), bg = *(const PG8_LAS f32x4*)(wp + 384);
                    const f32x4 wv0 = *(const PG8_LAS f32x4*)(wp + 512), wv1 = *(const PG8_LAS f32x4*)(wp + 640), wv2 = *(const PG8_LAS f32x4*)(wp + 768), bv = *(const PG8_LAS f32x4*)(wp + 896);
                    const f32x4 xg = acc[ai][0][m][n], xv = acc[ai][1][m][n]; f32x4 p1g, p2g, p1v, p2v;
                    if (m == 0) {
                        f32x4 h1g = {0.f, 0.f, 0.f, 0.f}, h2g = h1g, h1v = h1g, h2v = h1g;
                        if (ch > 0) { const PG8_LAS float* xp = xch + (((((ch - 1) * 2) * 4 + wc) * 4 + fq) * 16) + 4 * n;
                            h2g = *(const PG8_LAS f32x4*)xp; h2v = *(const PG8_LAS f32x4*)(xp + 8); h1g = *(const PG8_LAS f32x4*)(xp + 256); h1v = *(const PG8_LAS f32x4*)(xp + 256 + 8); }
#pragma unroll
                        for (int e = 0; e < 4; ++e) { p1g[e] = dpp_shr1(h1g[e], xg[e]); p2g[e] = dpp_shr2(fr == 1 ? h1g[e] : h2g[e], xg[e]); p1v[e] = dpp_shr1(h1v[e], xv[e]); p2v[e] = dpp_shr2(fr == 1 ? h1v[e] : h2v[e], xv[e]); }
                    } else {
#pragma unroll
                        for (int e = 0; e < 4; ++e) { p1g[e] = dpp_shr1(dpp_ror1(pgn[n][e]), xg[e]); p2g[e] = dpp_shr2(dpp_ror2(pgn[n][e]), xg[e]); p1v[e] = dpp_shr1(dpp_ror1(pvn[n][e]), xv[e]); p2v[e] = dpp_shr2(dpp_ror2(pvn[n][e]), xv[e]); }
                    }
                    f32x4 og = bg + wg0 * p2g + wg1 * p1g + wg2 * xg; const f32x4 ov = bv + wv0 * p2v + wv1 * p1v + wv2 * xv;
#pragma unroll
                    for (int e = 0; e < 4; ++e) og[e] = og[e] * sigmoidf_fast(og[e]) * ov[e];
                    u32x2 w; w.x = cvt_pk_bf16(og[0], og[1]); w.y = cvt_pk_bf16(og[2], og[3]);
                    if (n == 0) keep = w; else *(u32x4*)(ACT + (size_t)(row0 + ai * HALF + m * 16) * DFF_ + c0) = (u32x4){keep.x, keep.y, w.x, w.y};
                    pgn[n] = xg; pvn[n] = xv;
                }
                __builtin_amdgcn_sched_barrier(0);
            }
        }
    }
};

struct BalOrder {
    StaticOrder so; int c, G;
    __host__ __device__ void init(int M, int N, int G_, int c_) { so.init(M, N, 1, 0); c = c_; G = G_; }
    __host__ __device__ bool next(int i, Unit& u) const {
        int L;
        if (G != 256 || so.nwg != 512) { L = i * G + c; if (L >= so.nwg) return false; }
        else if (c < 128) { if (i >= 1) return false; L = c; }
        else { if (i >= 3) return false; L = 128 + 3 * (c - 128) + i; }
        return so.next(L, u);
    }
    __device__ __forceinline__ void a_ready(const Unit&) const {}
    __device__ __forceinline__ void done(const Unit&) const {}
};
struct VtOrder {
    int c, G;
    __device__ __forceinline__ bool next(int i, Unit& u) const {
        int L;
        if (G != 256) { L = i * G + c; if (L >= 256) return false; }
        else { if (c < 128 || i >= 2) return false; L = 2 * (c - 128) + i; }
        u.pm = L >> 5; u.pn = L & 31; return true;
    }
    __device__ __forceinline__ void a_ready(const Unit&) const {}
    __device__ __forceinline__ void done(const Unit&) const {}
};
struct EpiVT {
    static constexpr bool PERM = true, AFTER_DRAIN = false;
    unsigned char* VT; const float* ssq; int npos;
    __device__ __forceinline__ void operator()(f32x4 (&acc)[2][2][4][2], const Unit& u, int wr, int wc, int fr_, int fq_) const {
        int opq = 0; asm volatile("" : "+v"(opq));
        const int fr = fr_ + opq, fq = fq_ + opq;
        const int row0 = u.pm * BM + wr * 64 + fr, t0 = u.pn * BM + wc * 32 + 8 * fq;
#pragma unroll
        for (int bj = 0; bj < 2; ++bj) {
            const int tb = t0 + bj * HALF, k0 = tb & 63; const size_t pos = (size_t)(tb & ~63) + 16 * ((k0 >> 5) & 1) + 4 * ((k0 >> 3) & 3);
            f32x4 rs0, rs1;
#pragma unroll
            for (int e = 0; e < 8; ++e) { const float* sp = ssq + (size_t)(tb + e) * 24 + 16; const f32x4 p = *(const f32x4*)sp, q = *(const f32x4*)(sp + 4);
                const float r = __builtin_amdgcn_rsqf(((p[0] + p[1]) + (p[2] + p[3]) + (q[0] + q[1]) + (q[2] + q[3])) * (1.0f / KVRANK_) + NORM_EPS_);
                if (e < 4) rs0[e] = r; else rs1[e - 4] = r; }
            EPI_ROWS(ai, m) { unsigned char* rowp = VT + (size_t)(row0 + ai * HALF + m * 16) * npos + pos;
                *(unsigned*)rowp = pk4_fp8(acc[ai][bj][m][0] * rs0); *(unsigned*)(rowp + 32) = pk4_fp8(acc[ai][bj][m][1] * rs1); }
        }
    }
    static constexpr float KVRANK_ = 512.0f, NORM_EPS_ = 1e-6f;
};
struct SkipOrder {
    StaticOrder s; int skip_from, skip_n;
    __device__ __forceinline__ bool next(int i, Unit& u) const { if (!s.next(i, u)) return false; if (u.pn >= skip_from) u.pn += skip_n; return true; }
    __device__ __forceinline__ void a_ready(const Unit&) const {}
    __device__ __forceinline__ void done(const Unit&) const {}
};
struct NoHook { static constexpr bool ENABLED = false; __device__ __forceinline__ void operator()(f32x4 (&)[2][2][4][2], const Unit&, int, int, int, int) const {} };
template <class Epi, class Sched, bool ALIGN_EPI, class Hook = NoHook, bool F8 = false, bool I8 = false>
__device__ __forceinline__ void gemm_phase(PG8_LAS unsigned char* lds, const Gemm g, const Sched& S, const Epi& E, const Hook& HK = Hook()) {
    const int tid = threadIdx.x, wid = __builtin_amdgcn_readfirstlane(tid >> 6), lane = tid & 63, wr = wid >> 2, wc = wid & 3, fr = lane & 15, fq = lane >> 4;
    const int K = g.K, nt = K / BK;
    unsigned voffA[2], voffB[2];
#pragma unroll
    for (int i = 0; i < 2; ++i) { int R, C; stage_rc(tid * 16 + i * 8192, R, C); const int Rb = Epi::PERM ? ((R & ~31) + perm32(R & 31)) : R;
        voffA[i] = (unsigned)(R * g.lda + C) * 2u; voffB[i] = (unsigned)(Rb * g.ldb + C) * 2u; }
    const size_t kstep = (size_t)(BK * 2);
    const size_t hstepA = (size_t)HALF * g.lda * 2, hstepB = (size_t)HALF * g.ldb * 2;
    const size_t tstepA = 2 * hstepA, tstepB = 2 * hstepB;
    const unsigned ldsw = (unsigned)wid * 1024u;
    const int aoff = lds_byte(wr * 64 + fr, F8 ? fq * 16 : fq * 8), boff = lds_byte(wc * 32 + fr, F8 ? fq * 16 : fq * 8);
#define PG8_SA(b, h) (((b) * 2 + (h)) * HTB)
#define PG8_SB(b, h) ((4 + (b) * 2 + (h)) * HTB)
#define PG8_STAGE(bufoff, gbase, voff) do { _Pragma("unroll") for (int _i = 0; _i < 2; ++_i) { \
        if (F8) { unsigned keep_; const unsigned la_ = (unsigned)__builtin_amdgcn_readfirstlane((int)(unsigned)(uintptr_t)(lds + (bufoff) + ldsw + _i * 8192)); \
            asm volatile("s_mov_b32 %0, m0\n\ts_mov_b32 m0, %2\n\ts_nop 0\n\tglobal_load_lds_dwordx4 %1, %3\n\ts_mov_b32 m0, %0" : "=&s"(keep_) : "v"((voff)[_i]), "s"(la_), "s"((const char*)(gbase)) : "memory"); } \
        else __builtin_amdgcn_global_load_lds((const unsigned*)((const char*)(gbase) + (voff)[_i]), (PG8_LAS unsigned*)(lds + (bufoff) + ldsw + _i * 8192), 16, 0, 0); } } while (0)
#define PG8_LDA(dst, b, h) do { if (F8) { _Pragma("unroll") for (int m = 0; m < 2; ++m) dst##8[m] = *(const PG8_LAS v8i32g*)(lds + PG8_SA(b, h) + aoff + m * 2048); } \
        else { _Pragma("unroll") for (int m = 0; m < 4; ++m) _Pragma("unroll") for (int k = 0; k < 2; ++k) dst[m][k] = *(const PG8_LAS bf16x8*)(lds + PG8_SA(b, h) + aoff + m * 2048 + k * 1024); } } while (0)
#define PG8_LDB(dst, b, h) do { if (F8) { _Pragma("unroll") for (int n = 0; n < 2; ++n) dst##8[n] = *(const PG8_LAS v8i32g*)(lds + PG8_SB(b, h) + boff + n * 2048); } \
        else { _Pragma("unroll") for (int n = 0; n < 2; ++n) _Pragma("unroll") for (int k = 0; k < 2; ++k) dst[n][k] = *(const PG8_LAS bf16x8*)(lds + PG8_SB(b, h) + boff + n * 2048 + k * 1024); } } while (0)
#define PG8_MMA(ai, bj, At, Bt) do { __builtin_amdgcn_s_setprio(1); _Pragma("unroll") for (int m = 0; m < 4; ++m) _Pragma("unroll") for (int n = 0; n < 2; ++n) _Pragma("unroll") for (int k = 0; k < 2; ++k) { \
        if (I8) acc[ai][bj][m][n] = __builtin_bit_cast(f32x4, __builtin_amdgcn_mfma_i32_16x16x64_i8(__builtin_bit_cast(v4i32g, Bt[n][k]), __builtin_bit_cast(v4i32g, At[m][k]), __builtin_bit_cast(v4i32g, acc[ai][bj][m][n]), 0, 0, 0)); \
        else acc[ai][bj][m][n] = __builtin_amdgcn_mfma_f32_16x16x32_bf16(Bt[n][k], At[m][k], acc[ai][bj][m][n], 0, 0, 0); } __builtin_amdgcn_s_setprio(0); } while (0)
#define PG8_MMA2(ai, b) do { if (F8) { __builtin_amdgcn_s_setprio(1); \
        _Pragma("unroll") for (int m = 0; m < 2; ++m) _Pragma("unroll") for (int n = 0; n < 2; ++n) { \
            acc[ai][0][m][n] = __builtin_amdgcn_mfma_scale_f32_16x16x128_f8f6f4(B08[n], At8[m], acc[ai][0][m][n], 0, 0, 0, 0, 0, 0); acc[ai][1][m][n] = __builtin_amdgcn_mfma_scale_f32_16x16x128_f8f6f4(B18[n], At8[m], acc[ai][1][m][n], 0, 0, 0, 0, 0, 0); } \
        _Pragma("unroll") for (int m = 0; m < 2; ++m) At8[m] = *(const PG8_LAS v8i32g*)(lds + PG8_SA(b, ai) + aoff + (m + 2) * 2048); \
        _Pragma("unroll") for (int m = 0; m < 2; ++m) _Pragma("unroll") for (int n = 0; n < 2; ++n) { \
            acc[ai][0][m + 2][n] = __builtin_amdgcn_mfma_scale_f32_16x16x128_f8f6f4(B08[n], At8[m], acc[ai][0][m + 2][n], 0, 0, 0, 0, 0, 0); acc[ai][1][m + 2][n] = __builtin_amdgcn_mfma_scale_f32_16x16x128_f8f6f4(B18[n], At8[m], acc[ai][1][m + 2][n], 0, 0, 0, 0, 0, 0); } \
        __builtin_amdgcn_s_setprio(0); } else { PG8_MMA(ai, 0, At, B0); PG8_MMA(ai, 1, At, B1); } } while (0)
#define PG8_WAIT_V(n) asm volatile("s_waitcnt vmcnt(" #n ")" ::: "memory")
#define PG8_WAIT_L(n) asm volatile("s_waitcnt lgkmcnt(" #n ")" ::: "memory")
#define PG8_BAR __builtin_amdgcn_s_barrier()
#define PG8_SCHED __builtin_amdgcn_sched_barrier(0)
    Unit cur, nxt; int ui = 0;
    if (!S.next(0, cur)) return;
    f32x4 acc[2][2][4][2];
#pragma unroll
    for (int a = 0; a < 2; ++a)
#pragma unroll
        for (int b = 0; b < 2; ++b)
#pragma unroll
            for (int m = 0; m < 4; ++m)
#pragma unroll
                for (int n = 0; n < 2; ++n) acc[a][b][m][n] = (f32x4){0.f, 0.f, 0.f, 0.f};
    bf16x8 At[4][2], B0[2][2], B1[2][2];
    v8i32g At8[2], B08[2], B18[2];
    const char* cA = (const char*)g.A + (size_t)cur.pm * tstepA; const char* cB = (const char*)g.Bt + (size_t)cur.pn * tstepB;
    S.a_ready(cur);
    PG8_STAGE(PG8_SB(0, 0), cB, voffB); PG8_STAGE(PG8_SB(0, 1), cB + hstepB, voffB); PG8_STAGE(PG8_SA(0, 0), cA, voffA); PG8_STAGE(PG8_SA(0, 1), cA + hstepA, voffA);
    if (wr == 1) PG8_BAR;
    PG8_WAIT_V(2); PG8_BAR;
    PG8_STAGE(PG8_SB(1, 0), cB + kstep, voffB); PG8_STAGE(PG8_SA(1, 0), cA + kstep, voffA); PG8_STAGE(PG8_SB(1, 1), cB + hstepB + kstep, voffB);
    PG8_WAIT_V(6); PG8_BAR;
    for (;;) {
        const bool has_next = S.next(ui + 1, nxt);
        const char* nA = has_next ? (const char*)g.A + (size_t)nxt.pm * tstepA : cA; const char* nB = has_next ? (const char*)g.Bt + (size_t)nxt.pn * tstepB : cB;
        for (int t = 0; t < nt; t += 2) {
            const bool last = (t == nt - 2);
            const char* a1 = cA + (size_t)(t + 1) * kstep;
            const char* a2 = last ? nA : cA + (size_t)(t + 2) * kstep; const char* b2 = last ? nB : cB + (size_t)(t + 2) * kstep;
            const char* a3 = a2 + kstep; const char* b3 = b2 + kstep;
            if (last && has_next) S.a_ready(nxt);
            if (Hook::ENABLED && t == (nt >> 1)) HK(acc, cur, wr, wc, fr, fq);
            PG8_LDB(B0, 0, 0); PG8_LDB(B1, 0, 1); PG8_SCHED; PG8_LDA(At, 0, 0); PG8_STAGE(PG8_SA(1, 1), a1 + hstepA, voffA);
            PG8_WAIT_V(8); PG8_WAIT_L(0); PG8_BAR; PG8_MMA2(0, 0); PG8_BAR; PG8_SCHED;
            PG8_LDA(At, 0, 1); PG8_STAGE(PG8_SB(0, 0), b2, voffB); PG8_STAGE(PG8_SB(0, 1), b2 + hstepB, voffB); PG8_STAGE(PG8_SA(0, 0), a2, voffA);
            PG8_WAIT_V(8); PG8_WAIT_L(0); PG8_BAR; PG8_MMA2(1, 0); PG8_BAR; PG8_SCHED;
            PG8_LDB(B0, 1, 0); PG8_LDB(B1, 1, 1); PG8_SCHED; PG8_LDA(At, 1, 0); PG8_STAGE(PG8_SA(0, 1), a2 + hstepA, voffA);
            PG8_WAIT_V(8); PG8_WAIT_L(0); PG8_BAR; PG8_MMA2(0, 1); PG8_BAR; PG8_SCHED;
            PG8_LDA(At, 1, 1); PG8_STAGE(PG8_SB(1, 0), b3, voffB); PG8_STAGE(PG8_SB(1, 1), b3 + hstepB, voffB); PG8_STAGE(PG8_SA(1, 0), a3, voffA);
            PG8_WAIT_V(8); PG8_WAIT_L(0); PG8_BAR; PG8_MMA2(1, 1); PG8_BAR; PG8_SCHED;
        }
        if constexpr (ALIGN_EPI) { if (wr == 0) PG8_BAR; }
        if constexpr (I8) {
#pragma unroll
            for (int a = 0; a < 2; ++a)
#pragma unroll
                for (int b = 0; b < 2; ++b)
#pragma unroll
                    for (int m = 0; m < 4; ++m)
#pragma unroll
                        for (int n = 0; n < 2; ++n) acc[a][b][m][n] = __builtin_convertvector(__builtin_bit_cast(v4i32g, acc[a][b][m][n]), f32x4); }
        E(acc, cur, wr, wc, fr, fq); S.done(cur);
        if (!has_next) break;
#pragma unroll
        for (int a = 0; a < 2; ++a)
#pragma unroll
            for (int b = 0; b < 2; ++b)
#pragma unroll
                for (int m = 0; m < 4; ++m)
#pragma unroll
                    for (int n = 0; n < 2; ++n) acc[a][b][m][n] = (f32x4){0.f, 0.f, 0.f, 0.f};
        cur = nxt; cA = nA; cB = nB; ++ui;
        if constexpr (ALIGN_EPI) { if (wr == 1) PG8_BAR; }
    }
    PG8_WAIT_V(0);
    if constexpr (!ALIGN_EPI) { if (wr == 0) PG8_BAR; }
    PG8_BAR;
#undef PG8_SA
#undef PG8_SB
#undef PG8_STAGE
#undef PG8_LDA
#undef PG8_LDB
#undef PG8_MMA
#undef PG8_MMA2
#undef PG8_WAIT_V
#undef PG8_WAIT_L
#undef PG8_BAR
#undef PG8_SCHED
}
}

namespace att {
typedef unsigned short bf16_t;
typedef short bf16x8 __attribute__((ext_vector_type(8)));
typedef short s16x4 __attribute__((ext_vector_type(4)));
typedef float f32x16 __attribute__((ext_vector_type(16)));
typedef float f32x4 __attribute__((ext_vector_type(4)));
typedef unsigned u32x4 __attribute__((ext_vector_type(4)));
constexpr int NW = 8, QBLK = 32, KVBLK = 64, QB = NW * QBLK;
constexpr int SHM_V = KVBLK * 128 * 2, SHM_K = KVBLK * 128 * 2, SHM_R = KVBLK * 64 * 2;
constexpr int QROW = 272, QWAVE = 32 * QROW;
constexpr float THR = 8.f;
constexpr int STG_ROW = 132, STG_WAVE = 32 * STG_ROW * 4;
static_assert(NW * STG_WAVE <= 155648, "staging");

#define KSWZ(row, colB) ((row) * 256 + ((colB) ^ (((row) & 7) << 4)))
#define RSWZ(row, chunk) ((row) * 128 + ((((chunk) ^ (((row) >> 1) & 7))) << 4))
#define SBAR() __builtin_amdgcn_sched_barrier(0)
__device__ __forceinline__ int v_rd_base(int lane) { return ((lane & 3) << 3) | (((lane >> 2) & 3) << 6) | (((lane >> 4) & 1) << 5) | (((lane >> 5) & 1) << 8); }
constexpr int v_rd_off(int d0, int ks, int half) { return d0 * 512 + ks * 4096 + half * 2048; }
__device__ __forceinline__ int crow(int r, int hi) { return (r & 3) + 8 * (r >> 2) + 4 * hi; }
typedef float f32x2_t __attribute__((ext_vector_type(2))); typedef __bf16 bf16x2_t __attribute__((ext_vector_type(2)));
__device__ __forceinline__ unsigned cvtpk(float lo, float hi) { f32x2_t v = {lo, hi}; bf16x2_t b = __builtin_convertvector(v, bf16x2_t); return __builtin_bit_cast(unsigned, b); }
__device__ __forceinline__ void glds16(const void* gsrc, unsigned lds_dst) { unsigned keep;
    asm volatile("s_mov_b32 %0, m0\n\ts_mov_b32 m0, %2\n\ts_nop 0\n\tglobal_load_lds_dwordx4 %1, off\n\ts_mov_b32 m0, %0" : "=&s"(keep) : "v"(gsrc), "s"(lds_dst) : "memory"); }
#define WAIT_BAR() asm volatile("s_waitcnt vmcnt(0) lgkmcnt(0)\n\ts_barrier" ::: "memory")

__device__ __forceinline__ void mask_tile(f32x16& p0, f32x16& p1, int dq) {
    const float NEG = -__builtin_inff();
#pragma unroll
    for (int r = 0; r < 16; ++r) { const int c = (r & 3) + 8 * (r >> 2); if (dq - c < 0) p0[r] = NEG; if (dq - c - 32 < 0) p1[r] = NEG; }
}
template <bool MLA> __device__ __forceinline__ void partialSM(f32x16& p0, f32x16& p1, float& m_reg, float& mn, float& alpha) {
    constexpr float SCALE = MLA ? 0.07216878364870322f : 0.125f;
    float pmax = p0[0];
#pragma unroll
    for (int r = 1; r < 16; ++r) pmax = fmaxf(pmax, p0[r]);
#pragma unroll
    for (int r = 0; r < 16; ++r) pmax = fmaxf(pmax, p1[r]);
    { auto rr = __builtin_amdgcn_permlane32_swap(__float_as_uint(pmax), __float_as_uint(pmax), false, false); pmax = fmaxf(__uint_as_float(rr[0]), __uint_as_float(rr[1])); }
    constexpr float C2 = 1.4426950408889634f * SCALE;
    if (MLA) {
        if (__builtin_expect(__all((pmax - m_reg) * SCALE <= 5.0f), 1)) { mn = m_reg; alpha = 1.f; }
        else { mn = fmaxf(m_reg, pmax); alpha = __builtin_amdgcn_exp2f((m_reg - mn) * C2); m_reg = mn; }
    } else {
        const bool keep = __all((pmax - m_reg) * SCALE <= THR);
        mn = keep ? m_reg : fmaxf(m_reg, pmax); alpha = __builtin_amdgcn_exp2f((m_reg - mn) * C2); m_reg = mn;
    }
    const float mnL = -mn * C2;
#pragma unroll
    for (int r = 0; r < 16; ++r) p0[r] = fmaf(p0[r], C2, mnL);
#pragma unroll
    for (int r = 0; r < 16; ++r) p1[r] = fmaf(p1[r], C2, mnL);
#pragma unroll
    for (int r = 0; r < 16; ++r) p0[r] = __builtin_amdgcn_exp2f(p0[r]);
}
__device__ __forceinline__ void finishSM(f32x16& p0, f32x16& p1, float alpha, float& l_reg, bf16x8& pa0, bf16x8& pa1, bf16x8& pa2, bf16x8& pa3) {
#pragma unroll
    for (int r = 0; r < 16; ++r) p1[r] = __builtin_amdgcn_exp2f(p1[r]);
    float ps = 0;
#pragma unroll
    for (int r = 0; r < 16; ++r) ps += p0[r];
#pragma unroll
    for (int r = 0; r < 16; ++r) ps += p1[r];
    { auto rr = __builtin_amdgcn_permlane32_swap(__float_as_uint(ps), __float_as_uint(ps), false, false); ps = __uint_as_float(rr[0]) + __uint_as_float(rr[1]); }
    l_reg = l_reg * alpha + ps;
#define PK4(P, B_, OUT) do { unsigned a0 = cvtpk(P[B_+0], P[B_+1]), a1 = cvtpk(P[B_+2], P[B_+3]); unsigned b0 = cvtpk(P[B_+4], P[B_+5]), b1 = cvtpk(P[B_+6], P[B_+7]); \
        auto r0 = __builtin_amdgcn_permlane32_swap(a0, b0, false, false); auto r1 = __builtin_amdgcn_permlane32_swap(a1, b1, false, false); \
        u32x4 w = {r0[0], r1[0], r0[1], r1[1]}; OUT = *reinterpret_cast<bf16x8*>(&w); } while (0)
    PK4(p0, 0, pa0); PK4(p0, 8, pa1); PK4(p1, 0, pa2); PK4(p1, 8, pa3);
#undef PK4
}
__device__ __forceinline__ unsigned pk4f8(float a, float b, float c, float d) { int w = __builtin_amdgcn_cvt_pk_fp8_f32(a, b, 0, false); w = __builtin_amdgcn_cvt_pk_fp8_f32(c, d, w, true); return (unsigned)w; }
__device__ __forceinline__ void finishSM8(f32x16& p0, f32x16& p1, float alpha, float& l_reg, int (&P8)[8]) {
#pragma unroll
    for (int r = 0; r < 16; ++r) p1[r] = __builtin_amdgcn_exp2f(p1[r]);
    float ps = 0;
#pragma unroll
    for (int r = 0; r < 16; ++r) ps += p0[r];
#pragma unroll
    for (int r = 0; r < 16; ++r) ps += p1[r];
    { auto rr = __builtin_amdgcn_permlane32_swap(__float_as_uint(ps), __float_as_uint(ps), false, false); ps = __uint_as_float(rr[0]) + __uint_as_float(rr[1]); }
    l_reg = l_reg * alpha + ps;
#pragma unroll
    for (int i = 0; i < 4; ++i) { P8[i] = (int)pk4f8(p0[4 * i], p0[4 * i + 1], p0[4 * i + 2], p0[4 * i + 3]); P8[4 + i] = (int)pk4f8(p1[4 * i], p1[4 * i + 1], p1[4 * i + 2], p1[4 * i + 3]); }
}
typedef int v8i32b __attribute__((ext_vector_type(8)));
__device__ __forceinline__ void pv8(f32x16* o, const char* vt, int r32, int hi, const int (&P8)[8]) {
    const v8i32b pa = {P8[0], P8[1], P8[2], P8[3], P8[4], P8[5], P8[6], P8[7]};
    const char* va = vt + (2 * hi) * 2048 + r32 * 16;
#pragma unroll
    for (int blk = 0; blk < 4; ++blk) { const u32x4 x0 = *reinterpret_cast<const u32x4*>(va + blk * 512), x1 = *reinterpret_cast<const u32x4*>(va + 2048 + blk * 512);
        const v8i32b vb = {(int)x0[0], (int)x0[1], (int)x0[2], (int)x0[3], (int)x1[0], (int)x1[1], (int)x1[2], (int)x1[3]};
        o[blk] = __builtin_amdgcn_mfma_scale_f32_32x32x64_f8f6f4(pa, vb, o[blk], 0, 0, 0, 0, 0, 0); }
}
typedef int v8i32 __attribute__((ext_vector_type(8)));
__device__ __forceinline__ void qkt8(f32x16& p0, f32x16& p1, const char* kn, const char* kr, int r32, int hi, const v8i32* q8) {
    p0 = f32x16{}; p1 = f32x16{};
#pragma unroll
    for (int sl = 0; sl < 3; ++sl) { const char* a = (sl < 2 ? kn + (4 * sl + 2 * hi) * 1024 : kr + (2 * hi) * 1024) + r32 * 16;
        const u32x4 x0 = *reinterpret_cast<const u32x4*>(a), x1 = *reinterpret_cast<const u32x4*>(a + 1024), y0 = *reinterpret_cast<const u32x4*>(a + 512), y1 = *reinterpret_cast<const u32x4*>(a + 1024 + 512);
        const v8i32 k0 = {(int)x0[0], (int)x0[1], (int)x0[2], (int)x0[3], (int)x1[0], (int)x1[1], (int)x1[2], (int)x1[3]}, k1 = {(int)y0[0], (int)y0[1], (int)y0[2], (int)y0[3], (int)y1[0], (int)y1[1], (int)y1[2], (int)y1[3]};
        p0 = __builtin_amdgcn_mfma_scale_f32_32x32x64_f8f6f4(k0, q8[sl], p0, 0, 0, 0, 0, 0, 0); p1 = __builtin_amdgcn_mfma_scale_f32_32x32x64_f8f6f4(k1, q8[sl], p1, 0, 0, 0, 0, 0, 0); }
}
template <bool MLA, int NS> struct Lay {
    static constexpr int OFF_V = 0, OFF_K = NS * SHM_V, OFF_R = OFF_K + (MLA ? NS * SHM_K : 0), OFF_WS = OFF_R + NS * SHM_R, OFF_Q = OFF_WS + NW * 64 * 4, END = OFF_Q + (MLA ? NW * QWAVE : 0);
};
template <bool MLA>
__device__ __forceinline__ void qkt(f32x16& p0, f32x16& p1, const char* kn, const char* kr, int r32, int hi, const char* qimg, const bf16x8* qr) {
    p0 = f32x16{}; p1 = f32x16{};
    if (MLA) {
#pragma unroll
        for (int d0 = 0; d0 < 8; ++d0) { const char* a = kn + KSWZ(r32, ((d0 & 3) * 16 + hi * 8) * 2) + (d0 >> 2) * 128;
            bf16x8 b0 = *reinterpret_cast<const bf16x8*>(a); bf16x8 b1 = *reinterpret_cast<const bf16x8*>(a + 32 * 256);
            const bf16x8 q = *reinterpret_cast<const bf16x8*>(qimg + d0 * 32);
            p0 = __builtin_amdgcn_mfma_f32_32x32x16_bf16(b0, q, p0, 0, 0, 0); p1 = __builtin_amdgcn_mfma_f32_32x32x16_bf16(b1, q, p1, 0, 0, 0); }
    }
#pragma unroll
    for (int d0 = 0; d0 < 4; ++d0) { const char* a = kr + RSWZ(r32, 2 * d0 + hi);
        bf16x8 b0 = *reinterpret_cast<const bf16x8*>(a); bf16x8 b1 = *reinterpret_cast<const bf16x8*>(a + 32 * 128);
        p0 = __builtin_amdgcn_mfma_f32_32x32x16_bf16(b0, qr[d0], p0, 0, 0, 0); p1 = __builtin_amdgcn_mfma_f32_32x32x16_bf16(b1, qr[d0], p1, 0, 0, 0); }
}
typedef __attribute__((address_space(3))) const char* lds_cptr;
typedef short v4i16_t __attribute__((ext_vector_type(4)));
__device__ __forceinline__ s16x4 vtr(lds_cptr p) { return __builtin_bit_cast(s16x4, __builtin_amdgcn_ds_read_tr16_b64_v4i16((__attribute__((address_space(3))) v4i16_t*)p)); }
__device__ __forceinline__ void pv_tile_pipe(f32x16* o, lds_cptr vp, bf16x8 pa0, bf16x8 pa1, bf16x8 pa2, bf16x8 pa3) {
    const int vb = (int)(unsigned)(uintptr_t)vp;
#define TRRD(dst, off) asm volatile("ds_read_b64_tr_b16 %0, %1 offset:%2" : "=&v"(dst) : "v"(vb), "i"(off) : "memory")
#define RD8(S, d0) do { TRRD(S##l0, v_rd_off(d0, 0, 0)); TRRD(S##h0, v_rd_off(d0, 0, 0) + 2048); TRRD(S##l1, v_rd_off(d0, 0, 0) + 4096); TRRD(S##h1, v_rd_off(d0, 0, 0) + 6144); \
        TRRD(S##l2, v_rd_off(d0, 0, 0) + 8192); TRRD(S##h2, v_rd_off(d0, 0, 0) + 10240); TRRD(S##l3, v_rd_off(d0, 0, 0) + 12288); TRRD(S##h3, v_rd_off(d0, 0, 0) + 14336); } while (0)
#define LW8(S) asm volatile("s_waitcnt lgkmcnt(0)" : "+v"(S##l0), "+v"(S##h0), "+v"(S##l1), "+v"(S##h1), "+v"(S##l2), "+v"(S##h2), "+v"(S##l3), "+v"(S##h3) :: "memory")
#define MM4(S, d0) do { \
        o[d0] = __builtin_amdgcn_mfma_f32_32x32x16_bf16(pa0, (bf16x8){S##l0[0], S##l0[1], S##l0[2], S##l0[3], S##h0[0], S##h0[1], S##h0[2], S##h0[3]}, o[d0], 0, 0, 0); \
        o[d0] = __builtin_amdgcn_mfma_f32_32x32x16_bf16(pa1, (bf16x8){S##l1[0], S##l1[1], S##l1[2], S##l1[3], S##h1[0], S##h1[1], S##h1[2], S##h1[3]}, o[d0], 0, 0, 0); \
        o[d0] = __builtin_amdgcn_mfma_f32_32x32x16_bf16(pa2, (bf16x8){S##l2[0], S##l2[1], S##l2[2], S##l2[3], S##h2[0], S##h2[1], S##h2[2], S##h2[3]}, o[d0], 0, 0, 0); \
        o[d0] = __builtin_amdgcn_mfma_f32_32x32x16_bf16(pa3, (bf16x8){S##l3[0], S##l3[1], S##l3[2], S##l3[3], S##h3[0], S##h3[1], S##h3[2], S##h3[3]}, o[d0], 0, 0, 0); } while (0)
    s16x4 Al0, Ah0, Al1, Ah1, Al2, Ah2, Al3, Ah3, Bl0, Bh0, Bl1, Bh1, Bl2, Bh2, Bl3, Bh3;
    RD8(A, 0); LW8(A);
    RD8(B, 1); MM4(A, 0); LW8(B);
    RD8(A, 2); MM4(B, 1); LW8(A);
    RD8(B, 3); MM4(A, 2); LW8(B);
    MM4(B, 3);
#undef RD8
#undef LW8
#undef MM4
#undef TRRD
}
__device__ __forceinline__ void qkt_batch(f32x16& p0, f32x16& p1, const char* kr, int r32, int hi, const bf16x8* qr) {
    bf16x8 kf[8];
#pragma unroll
    for (int d0 = 0; d0 < 4; ++d0) { const int a = (int)(unsigned)(uintptr_t)(kr + RSWZ(r32, 2 * d0 + hi));
        asm volatile("ds_read_b128 %0, %1" : "=&v"(kf[2 * d0]) : "v"(a) : "memory"); asm volatile("ds_read_b128 %0, %1 offset:4096" : "=&v"(kf[2 * d0 + 1]) : "v"(a) : "memory"); }
    asm volatile("s_waitcnt lgkmcnt(0)" : "+v"(kf[0]), "+v"(kf[1]), "+v"(kf[2]), "+v"(kf[3]), "+v"(kf[4]), "+v"(kf[5]), "+v"(kf[6]), "+v"(kf[7]) :: "memory");
    p0 = f32x16{}; p1 = f32x16{};
#pragma unroll
    for (int d0 = 0; d0 < 4; ++d0) { p0 = __builtin_amdgcn_mfma_f32_32x32x16_bf16(kf[2 * d0], qr[d0], p0, 0, 0, 0); p1 = __builtin_amdgcn_mfma_f32_32x32x16_bf16(kf[2 * d0 + 1], qr[d0], p1, 0, 0, 0); }
}
template <bool VIS> __device__ __forceinline__ void pv_tile(f32x16* o, lds_cptr vp, bf16x8 pa0, bf16x8 pa1, bf16x8 pa2, bf16x8 pa3) {
    if (!VIS) {
        const int vb = (int)(unsigned)(uintptr_t)vp;
#define TRRD(dst, off) asm volatile("ds_read_b64_tr_b16 %0, %1 offset:%2" : "=&v"(dst) : "v"(vb), "i"(off) : "memory")
#define PV_D0(d0) do { s16x4 l0, l1, l2, l3, h0, h1, h2, h3; constexpr int b_ = v_rd_off(d0, 0, 0); \
        TRRD(l0, b_); TRRD(h0, b_ + 2048); TRRD(l1, b_ + 4096); TRRD(h1, b_ + 6144); TRRD(l2, b_ + 8192); TRRD(h2, b_ + 10240); TRRD(l3, b_ + 12288); TRRD(h3, b_ + 14336); \
        asm volatile("s_waitcnt lgkmcnt(0)" ::: "memory"); SBAR(); \
        o[d0] = __builtin_amdgcn_mfma_f32_32x32x16_bf16(pa0, (bf16x8){l0[0], l0[1], l0[2], l0[3], h0[0], h0[1], h0[2], h0[3]}, o[d0], 0, 0, 0); \
        o[d0] = __builtin_amdgcn_mfma_f32_32x32x16_bf16(pa1, (bf16x8){l1[0], l1[1], l1[2], l1[3], h1[0], h1[1], h1[2], h1[3]}, o[d0], 0, 0, 0); \
        o[d0] = __builtin_amdgcn_mfma_f32_32x32x16_bf16(pa2, (bf16x8){l2[0], l2[1], l2[2], l2[3], h2[0], h2[1], h2[2], h2[3]}, o[d0], 0, 0, 0); \
        o[d0] = __builtin_amdgcn_mfma_f32_32x32x16_bf16(pa3, (bf16x8){l3[0], l3[1], l3[2], l3[3], h3[0], h3[1], h3[2], h3[3]}, o[d0], 0, 0, 0); } while (0)
        PV_D0(0); PV_D0(1); PV_D0(2); PV_D0(3);
#undef PV_D0
#undef TRRD
        return;
    }
#pragma unroll
    for (int d0 = 0; d0 < 4; ++d0) {
        const s16x4 l0 = vtr(vp + d0 * 512), h0 = vtr(vp + d0 * 512 + 2048), l1 = vtr(vp + d0 * 512 + 4096), h1 = vtr(vp + d0 * 512 + 6144);
        const s16x4 l2 = vtr(vp + d0 * 512 + 8192), h2 = vtr(vp + d0 * 512 + 10240), l3 = vtr(vp + d0 * 512 + 12288), h3 = vtr(vp + d0 * 512 + 14336);
        o[d0] = __builtin_amdgcn_mfma_f32_32x32x16_bf16(pa0, (bf16x8){l0[0], l0[1], l0[2], l0[3], h0[0], h0[1], h0[2], h0[3]}, o[d0], 0, 0, 0);
        o[d0] = __builtin_amdgcn_mfma_f32_32x32x16_bf16(pa1, (bf16x8){l1[0], l1[1], l1[2], l1[3], h1[0], h1[1], h1[2], h1[3]}, o[d0], 0, 0, 0);
        o[d0] = __builtin_amdgcn_mfma_f32_32x32x16_bf16(pa2, (bf16x8){l2[0], l2[1], l2[2], l2[3], h2[0], h2[1], h2[2], h2[3]}, o[d0], 0, 0, 0);
        o[d0] = __builtin_amdgcn_mfma_f32_32x32x16_bf16(pa3, (bf16x8){l3[0], l3[1], l3[2], l3[3], h3[0], h3[1], h3[2], h3[3]}, o[d0], 0, 0, 0);
    }
}

struct Src { const bf16_t* Qn; const bf16_t* Qr; const bf16_t* Kn; const bf16_t* Kr; const bf16_t* V; };
template <bool MLA> struct Pitch { static constexpr int qn = 3072, qr = MLA ? 3072 : 16128, kn = 4096, kr = 16128, v = MLA ? 4096 : 16128; };

template <bool MLA, int NS>
__device__ __forceinline__ void attn_block(const Src& s, int qb, char* lds) {
    typedef Pitch<MLA> PT; typedef Lay<MLA, NS> L;
    constexpr int LA = NS - 1;
    constexpr int NPC = MLA ? 5 : 3;
    const int tid = threadIdx.x, wid = __builtin_amdgcn_readfirstlane(tid >> 6), lane = tid & 63, r32 = lane & 31, hi = lane >> 5;
    const int P0 = qb * QB, NT = (P0 + QB) / KVBLK;
    const int qlo = P0 + wid * QBLK, qm = qlo + r32 - 4 * hi;
    const unsigned lds0 = (unsigned)(uintptr_t)lds;
    float* ws = (float*)(lds + L::OFF_WS) + wid * 64; float* li_l = ws; float* al_l = ws + 32;
    float m_reg = -1e30f, l_reg = 0; f32x16 o[4];
#pragma unroll
    for (int d = 0; d < 4; ++d) o[d] = f32x16{};
    unsigned offV[2], offK[2], offR;
#pragma unroll
    for (int i = 0; i < 2; ++i) { const int q = (wid * 2 + i) * 64 + lane;
        { const int sidx = q >> 5, w5 = q & 31, kk = (sidx >> 2) * 8 + (w5 >> 2), c = (sidx & 3) * 32 + (w5 & 3) * 8, k = (kk & ~0xC) | ((kk & 4) << 1) | ((kk & 8) >> 1); offV[i] = (unsigned)(k * PT::v + c) * 2u; }
        offK[i] = MLA ? (unsigned)(lane * 2048 + wid * 16) : 0u; }
    if (MLA) offR = (unsigned)(lane * 64 + (wid & 3) * 16);
    else { const int q = wid * 64 + lane, row = q >> 3, c = (q & 7) ^ ((row >> 1) & 7); offR = (unsigned)(row * PT::kr + c * 8) * 2u; }
    const unsigned offV8 = (unsigned)(((wid >> 2) * 64 + lane) * 8192 + (wid & 3) * 16);
#define SLOT_INC(x) ((x) + 1 == NS ? 0 : (x) + 1)
#define DMA_K(t, sl) do { if (MLA) { glds16((const char*)s.Kn + (size_t)(t) * (KVBLK * 2048) + offK[0], (unsigned)__builtin_amdgcn_readfirstlane(lds0 + L::OFF_K + (sl) * SHM_K + wid * 1024)); \
            if (wid < 4) glds16((const char*)s.Kr + (size_t)(t) * (KVBLK * 64) + offR, (unsigned)__builtin_amdgcn_readfirstlane(lds0 + L::OFF_R + (sl) * SHM_R + wid * 1024)); } \
        else { const char* rb_ = (const char*)s.Kr + (size_t)(t) * (KVBLK * 2) * PT::kr; glds16(rb_ + offR, (unsigned)__builtin_amdgcn_readfirstlane(lds0 + L::OFF_R + (sl) * SHM_R + wid * 1024)); } } while (0)
#define DMA_V(t, sl) do { if (MLA) { glds16((const char*)s.V + (size_t)(t) * KVBLK + offV8, (unsigned)__builtin_amdgcn_readfirstlane(lds0 + L::OFF_V + (sl) * SHM_V + (wid & 3) * 2048 + (wid >> 2) * 1024)); } \
        else { const char* vb_ = (const char*)s.V + (size_t)(t) * (KVBLK * 2) * PT::v; \
        glds16(vb_ + offV[0], (unsigned)__builtin_amdgcn_readfirstlane(lds0 + L::OFF_V + (sl) * SHM_V + (wid * 2) * 1024)); glds16(vb_ + offV[1], (unsigned)__builtin_amdgcn_readfirstlane(lds0 + L::OFF_V + (sl) * SHM_V + (wid * 2 + 1) * 1024)); } } while (0)
    __syncthreads();
    DMA_K(0, 0);
    bf16x8 qr[4]; v8i32 q8[3];
    { const size_t qrow = (size_t)(qlo + r32);
        if (MLA) {
            const char* qn_ = (const char*)s.Qn + qrow * 3072 + 32 * hi; const char* qr_ = (const char*)s.Qr + qrow * 3072 + 32 * hi;
#pragma unroll
            for (int sl = 0; sl < 3; ++sl) { const char* p_ = sl < 2 ? qn_ + 64 * sl : qr_; const u32x4 x0 = *reinterpret_cast<const u32x4*>(p_), x1 = *reinterpret_cast<const u32x4*>(p_ + 16);
                q8[sl] = (v8i32){(int)x0[0], (int)x0[1], (int)x0[2], (int)x0[3], (int)x1[0], (int)x1[1], (int)x1[2], (int)x1[3]}; }
        } else {
#pragma unroll
            for (int d0 = 0; d0 < 4; ++d0) qr[d0] = *reinterpret_cast<const bf16x8*>(s.Qr + qrow * PT::qr + d0 * 16 + hi * 8);
        } }
    if (LA >= 2) { DMA_K(1, 1); DMA_V(0, 0); }
    const char* qimg = nullptr;
    const lds_cptr vb0 = (lds_cptr)lds + (L::OFF_V + v_rd_base(lane));
#define RESC(a) do { if (__any((a) < 1.f)) { if (hi == 0) al_l[r32] = (a); asm volatile("s_waitcnt lgkmcnt(0)" ::: "memory"); \
        _Pragma("unroll") for (int d_ = 0; d_ < 4; ++d_) _Pragma("unroll") for (int r = 0; r < 16; ++r) o[d_][r] *= al_l[crow(r, hi)]; } } while (0)
#define KBASE(t) ((t) * KVBLK)
#define MASKT(P0_, P1_, t) do { const int kb_ = KBASE(t); if (__builtin_expect(kb_ + KVBLK - 1 > qlo, 0)) { asm volatile("; causal-mask tile" ::: "memory"); mask_tile(P0_, P1_, qm - kb_); } } while (0)
#define WAIT_STEP(full) do { if (NS >= 3 && (full)) { if (MLA) asm volatile("s_waitcnt vmcnt(5) lgkmcnt(0)\n\ts_barrier" ::: "memory"); else asm volatile("s_waitcnt vmcnt(3) lgkmcnt(0)\n\ts_barrier" ::: "memory"); } \
        else WAIT_BAR(); } while (0)
    f32x16 pA0, pA1, pB0, pB1; float mnA, mnB, alA, alB; bf16x8 pa0, pa1, pa2, pa3; int P8[8];
    WAIT_BAR();
    int sc = 0;
    { const int sk = (LA % NS), sv = ((LA + NS - 1) % NS);
      DMA_K(LA, sk); DMA_V(LA - 1, sv);
      SBAR(); if (MLA) qkt8(pA0, pA1, lds + L::OFF_K + sc * SHM_K, lds + L::OFF_R + sc * SHM_R, r32, hi, q8); else qkt_batch(pA0, pA1, lds + L::OFF_R + sc * SHM_R, r32, hi, qr);
      MASKT(pA0, pA1, 0); partialSM<MLA>(pA0, pA1, m_reg, mnA, alA);
      WAIT_STEP(true); }
#define STEP(PX0, PX1, mnX, alX, PY0, PY1, alY, t, MASK) do { \
        const int sp_ = sc; sc = SLOT_INC(sc); \
        const int skw_ = sp_, svw_ = (NS == 2) ? sc : ((sp_ == 0) ? NS - 1 : sp_ - 1); \
        const bool gk_ = (t) + LA < NT, gv_ = (t) + LA - 1 < NT; \
        if (gk_) DMA_K((t) + LA, skw_); if (gv_) DMA_V((t) + LA - 1, svw_); \
        SBAR(); if (MLA) qkt8(PX0, PX1, lds + L::OFF_K + sc * SHM_K, lds + L::OFF_R + sc * SHM_R, r32, hi, q8); else qkt_batch(PX0, PX1, lds + L::OFF_R + sc * SHM_R, r32, hi, qr); \
        if (MLA) { finishSM8(PY0, PY1, alY, l_reg, P8); SBAR(); pv8(o, lds + L::OFF_V + sp_ * SHM_V, r32, hi, P8); } \
        else { finishSM(PY0, PY1, alY, l_reg, pa0, pa1, pa2, pa3); pv_tile_pipe(o, vb0 + sp_ * SHM_V, pa0, pa1, pa2, pa3); } if (MLA) { MASKT(PX0, PX1, (t)); } else if (MASK) mask_tile(PX0, PX1, qm - KBASE(t)); partialSM<MLA>(PX0, PX1, m_reg, mnX, alX); \
        RESC(alX); WAIT_STEP(gk_ && gv_); } while (0)
    int t = 1;
    if (!MLA) for (; t + 1 < NT - 4; t += 2) {
        STEP(pB0, pB1, mnB, alB, pA0, pA1, alA, t, false);
        STEP(pA0, pA1, mnA, alA, pB0, pB1, alB, t + 1, false);
    }
    for (; t + 1 < NT; t += 2) {
        STEP(pB0, pB1, mnB, alB, pA0, pA1, alA, t, true);
        STEP(pA0, pA1, mnA, alA, pB0, pB1, alB, t + 1, true);
    }
    STEP(pB0, pB1, mnB, alB, pA0, pA1, alA, NT - 1, true);
    if (MLA) { finishSM8(pB0, pB1, alB, l_reg, P8); SBAR(); pv8(o, lds + L::OFF_V + sc * SHM_V, r32, hi, P8); }
    else { finishSM(pB0, pB1, alB, l_reg, pa0, pa1, pa2, pa3); SBAR(); pv_tile_pipe(o, vb0 + sc * SHM_V, pa0, pa1, pa2, pa3); }
    if (hi == 0) li_l[r32] = l_reg;
    asm volatile("s_waitcnt lgkmcnt(0)" ::: "memory");
    float rl[16];
#pragma unroll
    for (int r = 0; r < 16; ++r) rl[r] = __builtin_amdgcn_rcpf(li_l[crow(r, hi)]);
    WAIT_BAR();
    float* st = (float*)(lds + wid * STG_WAVE) + hi * (4 * STG_ROW) + r32;
#pragma unroll
    for (int r = 0; r < 16; ++r)
#pragma unroll
        for (int d0 = 0; d0 < 4; ++d0) st[((r & 3) + 8 * (r >> 2)) * STG_ROW + d0 * 32] = o[d0][r] * rl[r];
    asm volatile("s_waitcnt lgkmcnt(0)" ::: "memory");
#undef SLOT_INC
#undef DMA_K
#undef DMA_V
#undef RESC
#undef KBASE
#undef MASKT
#undef WAIT_STEP
#undef STEP
}
constexpr int DK_SLOT = 8192, DV_SLOT = 16384, D_NSLOT = 3;
constexpr int D_LDS_K = 0, D_LDS_V = D_NSLOT * DK_SLOT, D_LDS_WS = D_LDS_V + D_NSLOT * DV_SLOT, D_LDS_END = D_LDS_WS + NW * 64 * 4;
constexpr int DPITCH = 16128;
typedef __attribute__((address_space(3))) const bf16x8* lds_b8;
__device__ __forceinline__ void kload2(bf16x8* kf, lds_cptr kp, int j) { kf[2 * j] = *(lds_b8)(kp + j * 2048); kf[2 * j + 1] = *(lds_b8)(kp + j * 2048 + 512); }
template <int THRL>
__device__ __forceinline__ void diff_block64(const bf16_t* Qh, const bf16_t* Kh, const bf16_t* Vh, int qb, char* lds) {
    int tid = threadIdx.x; asm volatile("" : "+v"(tid));
    const int lane = tid & 63, r32 = lane & 31, hi = lane >> 5; const int wid = __builtin_amdgcn_readfirstlane(tid >> 6);
    const int q0 = qb * QB, NT = (q0 + QB) / KVBLK;
    const unsigned lds0 = (unsigned)(uintptr_t)lds;
    float* wsf = (float*)(lds + D_LDS_WS) + wid * 64;
    const unsigned koff = (unsigned)(lane * DPITCH + wid * 8) * 2u;
    const unsigned voff = (unsigned)((16 * (wid & 3) + (lane >> 2)) * DPITCH + (wid >> 2) * 32 + (lane & 3) * 8) * 2u;
    const unsigned kdst = lds0 + D_LDS_K + wid * 1024, vdst = lds0 + D_LDS_V + wid * 1024;
#define DMA_K(t, sidx) glds16((const char*)Kh + (size_t)(t) * (KVBLK * DPITCH * 2) + koff, (unsigned)__builtin_amdgcn_readfirstlane(kdst + (sidx) * DK_SLOT))
#define DMA_V(t, sidx) do { const char* vb_ = (const char*)Vh + (size_t)(t) * (KVBLK * DPITCH * 2) + voff; \
        glds16(vb_, (unsigned)__builtin_amdgcn_readfirstlane(vdst + (sidx) * DV_SLOT)); glds16(vb_ + 128, (unsigned)__builtin_amdgcn_readfirstlane(vdst + (sidx) * DV_SLOT + 8192)); } while (0)
#define WAIT_BARN(N) asm volatile("s_waitcnt vmcnt(" #N ") lgkmcnt(0)\n\ts_barrier" ::: "memory")
#define SBAR() __builtin_amdgcn_sched_barrier(0)
    const lds_cptr shm3 = (lds_cptr)lds; const lds_cptr kp0 = shm3 + D_LDS_K + hi * 1024 + r32 * 16;
    const lds_cptr vp0 = shm3 + D_LDS_V + ((lane >> 4) & 1) * 32 + (lane & 3) * 8 + (4 * hi + ((lane & 15) >> 2)) * 64;
    __syncthreads();
    DMA_K(0, 0); DMA_V(0, 0); DMA_K(1, 1);
    bf16x8 qr[4], kf[8];
    { const bf16_t* Qw = Qh + (size_t)(q0 + wid * QBLK + r32) * DPITCH;
#pragma unroll
      for (int d0 = 0; d0 < 4; ++d0) qr[d0] = *reinterpret_cast<const bf16x8*>(Qw + d0 * 16 + hi * 8); }
    float mhat = 0.f, l_reg = 0.f; f32x16 o[4];
#pragma unroll
    for (int d = 0; d < 4; ++d) o[d] = f32x16{};
    const int qrel = wid * QBLK + r32;
#define CMASK(P0, P1, t) do { const int jb_ = (t) - (NT - 4); if (jb_ >= 0) { const float NEG_ = -__builtin_inff(); const int kb_ = 64 * jb_ + 4 * hi; \
        _Pragma("unroll") for (int r = 0; r < 16; ++r) { const int kv_ = kb_ + (r & 3) + 8 * (r >> 2); if (kv_ > qrel) P0[r] = NEG_; if (kv_ + 32 > qrel) P1[r] = NEG_; } } } while (0)
#define MX3(a, b, c) __builtin_fmaxf(__builtin_fmaxf((a), (b)), (c))
#define ROWMAX(rm, C0, C1) do { float a_ = MX3(C0[0], C0[1], C1[0]), b_ = MX3(C0[2], C0[3], C1[1]); a_ = MX3(a_, C1[2], C1[3]); \
        _Pragma("unroll") for (int r = 4; r < 16; r += 4) { a_ = MX3(a_, C0[r], C0[r + 1]); b_ = MX3(b_, C0[r + 2], C0[r + 3]); a_ = MX3(a_, C1[r], C1[r + 1]); b_ = MX3(b_, C1[r + 2], C1[r + 3]); } \
        rm = __builtin_fmaxf(a_, b_); { auto rr = __builtin_amdgcn_permlane32_swap(__float_as_uint(rm), __float_as_uint(rm), false, false); rm = __builtin_fmaxf(__uint_as_float(rr[0]), __uint_as_float(rr[1])); } } while (0)
    bool resc = false;
#define RESC() do { if (resc) { asm volatile("s_waitcnt lgkmcnt(0)" ::: "memory"); \
        _Pragma("unroll") for (int d_ = 0; d_ < 4; ++d_) _Pragma("unroll") for (int r = 0; r < 16; ++r) o[d_][r] *= wsf[crow(r, hi)]; } } while (0)
    f32x16 pA0, pA1, pB0, pB1;
    int s_prev = 0, s_cur = 0, s_next = 1;
#define ROT() do { s_prev = s_cur; s_cur = s_next; s_next = (s_next == D_NSLOT - 1) ? 0 : s_next + 1; } while (0)
    DMA_K(2, 2);
    WAIT_BARN(4);
    { const lds_cptr kp = kp0;
      pA0 = f32x16{}; pA1 = f32x16{};
#pragma unroll
      for (int d0 = 0; d0 < 4; ++d0) { const bf16x8 b0 = *(lds_b8)(kp + d0 * 2048), b1 = *(lds_b8)(kp + d0 * 2048 + 512);
          pA0 = __builtin_amdgcn_mfma_f32_32x32x16_bf16(b0, qr[d0], pA0, 0, 0, 0); pA1 = __builtin_amdgcn_mfma_f32_32x32x16_bf16(b1, qr[d0], pA1, 0, 0, 0); } }
    CMASK(pA0, pA1, 0);
    { float rm; ROWMAX(rm, pA0, pA1); mhat = rm;
#pragma unroll
      for (int r = 0; r < 16; ++r) { pA0[r] = __builtin_amdgcn_exp2f(pA0[r] - mhat); pA1[r] = __builtin_amdgcn_exp2f(pA1[r] - mhat); } }
    WAIT_BARN(0);
    DMA_K(3, 0); DMA_V(1, 1);
    ROT();
#pragma unroll
    for (int j = 0; j < 4; ++j) kload2(kf, kp0 + s_cur * DK_SLOT, j);
    WAIT_BARN(3);
    s16x4 vlo[8], vhi[8];
#define PKW(P, B) cvtpk(P[B], P[B + 1])
#define PKF(P, B) __uint_as_float(PKW(P, B))
#define PSEL(P0, P1, k) __builtin_bit_cast(bf16x8, __builtin_shufflevector(((k) < 2 ? P0 : P1), ((k) < 2 ? P0 : P1), ((k) & 1) * 4, ((k) & 1) * 4 + 1, ((k) & 1) * 4 + 2, ((k) & 1) * 4 + 3))
#define VFR(i) (bf16x8){vlo[i][0], vlo[i][1], vlo[i][2], vlo[i][3], vhi[i][0], vhi[i][1], vhi[i][2], vhi[i][3]}
#define PIN(x) asm volatile("" : "+v"(x))
#define GAPA(MF, A0, A1, A2, A3, W0, W1, PW) do { MF; sacc += A0; sacc += A1; sacc += A2; sacc += A3; PIN(sacc); W0; W1; PIN(PW); SBAR(); } while (0)
#define EXS(v) __builtin_amdgcn_exp2f((v) - mhat)
#define GAPB(MF, X, B) do { MF; X[B] = EXS(X[B]); X[B + 1] = EXS(X[B + 1]); PIN(X); SBAR(); } while (0)
#define VRD(i, blk) do { vlo[i] = vtr(vp_ + ((((i) >> 2) + (blk)) * 4096 + ((i) & 3) * 1024)); vhi[i] = vtr(vp_ + ((((i) >> 2) + (blk)) * 4096 + ((i) & 3) * 1024 + 512)); } while (0)
#define KRD(G, j) do { if (G) { kload2(kf, kp0 + s_next * DK_SLOT, j); SBAR(); } } while (0)
#define MFQ(C, i, first) C = __builtin_amdgcn_mfma_f32_32x32x16_bf16(kf[i], qr[(i) >> 1], first ? f32x16{} : C, 0, 0, 0)
#define MFP(P0, P1, f, blk) o[((f) >> 2) + (blk)] = __builtin_amdgcn_mfma_f32_32x32x16_bf16(PSEL(P0, P1, (f) & 3), VFR(f), o[((f) >> 2) + (blk)], 0, 0, 0)
#define STEP(C0, C1, P0, P1, t, GK, GV, GL) do { SBAR(); \
    const lds_cptr vp_ = vp0 + s_prev * DV_SLOT; \
    VRD(0, 0); SBAR(); float sacc = (P0[0] + P0[1]); \
    GAPA(MFQ(C0, 0, true),  P0[2], P0[3], P0[4], P0[5],     P0[0] = PKF(P0, 0),  P0[1] = PKF(P0, 2),  P0); \
    VRD(4, 0); SBAR(); GAPA(MFQ(C1, 1, true),  P0[6], P0[7], P0[8], P0[9],     P0[2] = PKF(P0, 4),  P0[3] = PKF(P0, 6),  P0); \
    VRD(1, 0); SBAR(); GAPA(MFQ(C0, 2, false), P0[10], P0[11], P0[12], P0[13], P0[4] = PKF(P0, 8),  P0[5] = PKF(P0, 10), P0); \
    VRD(5, 0); SBAR(); GAPA(MFQ(C1, 3, false), P0[14], P0[15], P1[0], P1[1],   P0[6] = PKF(P0, 12), P0[7] = PKF(P0, 14), P0); \
    VRD(2, 0); SBAR(); GAPA(MFQ(C0, 4, false), P1[2], P1[3], P1[4], P1[5],     P1[0] = PKF(P1, 0),  P1[1] = PKF(P1, 2),  P1); \
    VRD(6, 0); SBAR(); GAPA(MFQ(C1, 5, false), P1[6], P1[7], P1[8], P1[9],     P1[2] = PKF(P1, 4),  P1[3] = PKF(P1, 6),  P1); \
    VRD(3, 0); SBAR(); GAPA(MFQ(C0, 6, false), P1[10], P1[11], P1[12], P1[13], P1[4] = PKF(P1, 8),  P1[5] = PKF(P1, 10), P1); \
    VRD(7, 0); SBAR(); GAPA(MFQ(C1, 7, false), P1[14], P1[15], 0.f, 0.f,       P1[6] = PKF(P1, 12), P1[7] = PKF(P1, 14), P1); \
    l_reg += sacc; \
    if (GK) { DMA_K((t) + 3, s_cur); } if (GV) { DMA_V((t) + 1, s_next); } \
    CMASK(C0, C1, t); \
    { float rm; ROWMAX(rm, C0, C1); resc = false; \
      if (__builtin_expect(__any(rm - mhat > (float)THRL), 0)) { const float dl = __builtin_fmaxf(rm - mhat, 0.f); mhat += dl; \
          const float f = __builtin_amdgcn_exp2f(-dl); l_reg *= f; if (hi == 0) wsf[r32] = f; resc = true; } } \
    SBAR(); \
    GAPB(MFP(P0, P1, 0, 0), C0, 0);  VRD(0, 2); SBAR(); \
    GAPB(MFP(P0, P1, 4, 0), C0, 2);  VRD(4, 2); SBAR(); \
    GAPB(MFP(P0, P1, 1, 0), C0, 4);  VRD(1, 2); SBAR(); \
    GAPB(MFP(P0, P1, 5, 0), C0, 6);  VRD(5, 2); SBAR(); \
    GAPB(MFP(P0, P1, 2, 0), C0, 8);  VRD(2, 2); SBAR(); \
    GAPB(MFP(P0, P1, 6, 0), C0, 10); VRD(6, 2); SBAR(); \
    GAPB(MFP(P0, P1, 3, 0), C0, 12); VRD(3, 2); SBAR(); \
    GAPB(MFP(P0, P1, 7, 0), C0, 14); VRD(7, 2); SBAR(); \
    GAPB(MFP(P0, P1, 0, 2), C1, 0);  KRD(GL, 0); \
    GAPB(MFP(P0, P1, 4, 2), C1, 2);  KRD(GL, 1); \
    GAPB(MFP(P0, P1, 1, 2), C1, 4);  KRD(GL, 2); \
    GAPB(MFP(P0, P1, 5, 2), C1, 6);  KRD(GL, 3); \
    GAPB(MFP(P0, P1, 2, 2), C1, 8); \
    GAPB(MFP(P0, P1, 6, 2), C1, 10); \
    GAPB(MFP(P0, P1, 3, 2), C1, 12); \
    GAPB(MFP(P0, P1, 7, 2), C1, 14); \
    } while (0)
    int t = 1;
#undef CMASK
#define CMASK(P0, P1, t) do { } while (0)
    for (; t + 5 < NT; t += 2) {
        STEP(pB0, pB1, pA0, pA1, t, true, true, true);     WAIT_BARN(3); RESC(); ROT();
        STEP(pA0, pA1, pB0, pB1, t + 1, true, true, true); WAIT_BARN(3); RESC(); ROT();
    }
#undef CMASK
#define CMASK(P0, P1, t) do { const int jb_ = (t) - (NT - 4); if (jb_ >= 0) { const float NEG_ = -__builtin_inff(); const int kb_ = 64 * jb_ + 4 * hi; \
        _Pragma("unroll") for (int r = 0; r < 16; ++r) { const int kv_ = kb_ + (r & 3) + 8 * (r >> 2); if (kv_ > qrel) P0[r] = NEG_; if (kv_ + 32 > qrel) P1[r] = NEG_; } } } while (0)
#define ENDW(tt) do { if ((tt) + 3 < NT) { WAIT_BARN(3); } else if ((tt) + 2 < NT) { WAIT_BARN(2); } else { WAIT_BARN(0); } } while (0)
    for (; t + 1 < NT; t += 2) {
        STEP(pB0, pB1, pA0, pA1, t, (t + 3 < NT), (t + 1 < NT), (t + 1 < NT));         ENDW(t);     RESC(); ROT();
        STEP(pA0, pA1, pB0, pB1, t + 1, (t + 4 < NT), (t + 2 < NT), (t + 2 < NT));     ENDW(t + 1); RESC(); ROT();
    }
    STEP(pB0, pB1, pA0, pA1, NT - 1, false, false, false); RESC();
    { float sacc = pB0[0] + pB0[1];
#pragma unroll
      for (int r = 2; r < 16; ++r) sacc += pB0[r];
#pragma unroll
      for (int r = 0; r < 16; ++r) sacc += pB1[r];
      l_reg += sacc;
      const u32x4 pw0 = (u32x4){PKW(pB0, 0), PKW(pB0, 2), PKW(pB0, 4), PKW(pB0, 6)}, pw1 = (u32x4){PKW(pB0, 8), PKW(pB0, 10), PKW(pB0, 12), PKW(pB0, 14)};
      const u32x4 pw2 = (u32x4){PKW(pB1, 0), PKW(pB1, 2), PKW(pB1, 4), PKW(pB1, 6)}, pw3 = (u32x4){PKW(pB1, 8), PKW(pB1, 10), PKW(pB1, 12), PKW(pB1, 14)};
      SBAR(); const lds_cptr vp_ = vp0 + s_cur * DV_SLOT;
#define PAF(k) __builtin_bit_cast(bf16x8, pw##k)
#pragma unroll
      for (int blk = 0; blk < 4; blk += 2) {
#pragma unroll
          for (int i = 0; i < 8; ++i) { vlo[i] = vtr(vp_ + (((i >> 2) + blk) * 4096 + (i & 3) * 1024)); vhi[i] = vtr(vp_ + (((i >> 2) + blk) * 4096 + (i & 3) * 1024 + 512)); }
#pragma unroll
          for (int d = 0; d < 2; ++d) { o[d + blk] = __builtin_amdgcn_mfma_f32_32x32x16_bf16(PAF(0), VFR(d * 4 + 0), o[d + blk], 0, 0, 0); o[d + blk] = __builtin_amdgcn_mfma_f32_32x32x16_bf16(PAF(1), VFR(d * 4 + 1), o[d + blk], 0, 0, 0);
              o[d + blk] = __builtin_amdgcn_mfma_f32_32x32x16_bf16(PAF(2), VFR(d * 4 + 2), o[d + blk], 0, 0, 0); o[d + blk] = __builtin_amdgcn_mfma_f32_32x32x16_bf16(PAF(3), VFR(d * 4 + 3), o[d + blk], 0, 0, 0); } } }
    { auto rr = __builtin_amdgcn_permlane32_swap(__float_as_uint(l_reg), __float_as_uint(l_reg), false, false); l_reg = __uint_as_float(rr[0]) + __uint_as_float(rr[1]); }
    if (hi == 0) wsf[32 + r32] = l_reg;
    asm volatile("s_waitcnt lgkmcnt(0)" ::: "memory");
    float rl[16];
#pragma unroll
    for (int r = 0; r < 16; ++r) rl[r] = __builtin_amdgcn_rcpf(wsf[32 + crow(r, hi)]);
    WAIT_BARN(0);
    float* st = (float*)(lds + wid * STG_WAVE) + hi * (4 * STG_ROW) + r32;
#pragma unroll
    for (int r = 0; r < 16; ++r)
#pragma unroll
        for (int d0 = 0; d0 < 4; ++d0) st[((r & 3) + 8 * (r >> 2)) * STG_ROW + d0 * 32] = o[d0][r] * rl[r];
    asm volatile("s_waitcnt lgkmcnt(0)" ::: "memory");
#undef DMA_K
#undef DMA_V
#undef WAIT_BARN
#undef SBAR
#undef CMASK
#undef MX3
#undef ROWMAX
#undef RESC
#undef ROT
#undef PKW
#undef PAF
#undef PKF
#undef PSEL
#undef VFR
#undef PIN
#undef GAPA
#undef EXS
#undef GAPB
#undef VRD
#undef KRD
#undef MFQ
#undef MFP
#undef STEP
#undef ENDW
}
__device__ __forceinline__ f32x4 staged4(const char* lds, int wid, int lane, int j) {
    const int row = lane & 31, half = lane >> 5; const float* st = (const float*)(lds + wid * STG_WAVE);
    return *(const f32x4*)(st + row * STG_ROW + half * 64 + 4 * j);
}
#undef SBAR
}

constexpr size_t MiB = 1u << 20;
constexpr size_t WS_CTL = 0, CTL_ZERO_BYTES = 1 * MiB;
constexpr size_t WS_COS = 1 * MiB, WS_SIN = 2 * MiB;
constexpr size_t WS_SSQC = 3 * MiB;
constexpr size_t WS_SSQ1 = 4 * MiB, WS_SSQ2 = 6 * MiB;
constexpr size_t WS_RSTD1 = 8 * MiB;
constexpr size_t WS_WIN = 16 * MiB;
constexpr size_t WS_WUQ = 142 * MiB;
constexpr size_t WS_WUKV = 148 * MiB;
constexpr size_t WS_WO = 152 * MiB;
constexpr size_t WS_WOUT = 184 * MiB;
constexpr size_t WS_WUP = 216 * MiB;
constexpr size_t WS_WDOWN = 388 * MiB;
constexpr size_t WS_H = 474 * MiB;
constexpr size_t WS_O = 538 * MiB;
constexpr size_t WS_Z = 602 * MiB;
constexpr size_t WS_QM = 854 * MiB;
constexpr size_t WS_KV = 902 * MiB;
constexpr size_t WS_HALO = 602 * MiB;
constexpr size_t WS_U = 602 * MiB;
constexpr size_t WS_T1 = 966 * MiB;
constexpr size_t WS_O1 = 1094 * MiB;
constexpr size_t WS_ACT = 966 * MiB;
constexpr size_t WS_X1 = 1158 * MiB;
constexpr size_t WS_END = 1286 * MiB;
static_assert(WS_WIN + (size_t)ZW * DM * 2 <= WS_WUQ && WS_WUP + (size_t)UPW * DM * 2 <= WS_WDOWN && WS_WDOWN + (size_t)DM * DFF * 2 <= WS_H, "ws map (weights)");
static_assert(WS_Z + (size_t)S * ZW * 2 <= WS_QM && WS_U + (size_t)S * UPW * 2 <= WS_T1 && WS_ACT + (size_t)S * DFF * 2 <= WS_X1 && WS_X1 + (size_t)S * DM * 4 <= WS_END, "ws map (activations)");
constexpr int CW_TMO = 0, CW_BAR = 4096;

constexpr int NWAVES = 8;
constexpr int RING_OFF = 0, RING_BYTES = 131072;
constexpr int XCH_OFF = 131072;
constexpr int LDSCTL_OFF = 155648, MISC_OFF = LDSCTL_OFF + 320;
constexpr int LDS_BYTES = 163840;
static_assert(att::Pitch<true>::qn == QMW && att::Pitch<true>::kn == KVW && att::Pitch<false>::v == ZW && att::Pitch<true>::kr == ZW, "attention pitches");
static_assert(att::Lay<true, 2>::END <= LDSCTL_OFF && att::D_LDS_END <= LDSCTL_OFF && att::DPITCH == ZW && RING_BYTES <= LDSCTL_OFF, "LDS map");

__device__ __forceinline__ unsigned f2bf(float f) { unsigned u = __builtin_bit_cast(unsigned, f); return (u + 0x7fffu + ((u >> 16) & 1u)) >> 16; }
__device__ __forceinline__ unsigned pk2(float lo, float hi) { return pg8::cvt_pk_bf16(lo, hi); }

#define XB_TMO      128
#define XB_XCNT(j)  (256  + 64 * (j))
#define XB_XSUB(j)  (1280 + 64 * (j))
#define XB_XGEN(j)  (2304 + 64 * (j))
#define XB_TOP      3328
#define XB_TOPGEN   3392
#define XCD_BAR_WORDS 3456
#define XB_SPIN_CAP (1u << 18)
__device__ __forceinline__ unsigned xb_ld(unsigned* p)              { return __hip_atomic_load(p, __ATOMIC_RELAXED, __HIP_MEMORY_SCOPE_AGENT); }
__device__ __forceinline__ unsigned xb_add(unsigned* p, unsigned v) { return __hip_atomic_fetch_add(p, v, __ATOMIC_RELAXED, __HIP_MEMORY_SCOPE_AGENT); }
__device__ __forceinline__ unsigned xb_xcc_id() { return (unsigned)__builtin_amdgcn_s_getreg((3 << 11) | 20) & 0xFu; }
#define XB_SPIN(cond, bar) do { unsigned _sp = 0; while (cond) { __builtin_amdgcn_s_sleep(1); \
    if ((++_sp & 255u) == 0u) { if (xb_ld(&(bar)[XB_TMO])) break; if (_sp > XB_SPIN_CAP) { atomicAdd(&(bar)[XB_TMO], 1u); break; } } } } while (0)
struct XcdBarrier { unsigned* bar; unsigned x; volatile LAS unsigned* st; };
__device__ __forceinline__ XcdBarrier xcd_barrier_post(unsigned* bar, volatile LAS unsigned* st) {
    XcdBarrier b; b.bar = bar; b.x = xb_xcc_id(); b.st = st;
    if (threadIdx.x == 0) (void)xb_add(&bar[XB_XCNT(b.x)], 1u);
    return b;
}
__device__ __forceinline__ void xcd_barrier_complete(unsigned* bar, unsigned x, unsigned& nloc, unsigned& nx) {
    const unsigned G = gridDim.x * gridDim.y * gridDim.z;
    unsigned sum, cnt, mine, sp = 0u;
    for (;;) {
        sum = 0u; cnt = 0u; mine = 0u;
#pragma unroll
        for (unsigned j = 0; j < 16; ++j) { const unsigned c = xb_ld(&bar[XB_XCNT(j)]); sum += c; cnt += (c > 0u) ? 1u : 0u; mine = (j == x) ? c : mine; }
        if (sum == G) break;
        __builtin_amdgcn_s_sleep(1);
        if ((++sp & 255u) == 0u) { if (xb_ld(&bar[XB_TMO])) break; if (sp > XB_SPIN_CAP) { atomicAdd(&bar[XB_TMO], 1u); break; } }
    }
    nloc = mine > 0u ? mine : 1u; nx = cnt > 0u ? cnt : 1u;
}
__device__ __forceinline__ void xcd_barrier(const XcdBarrier& b) {
    asm volatile("s_waitcnt vmcnt(0)" ::: "memory");
    __syncthreads();
    if (threadIdx.x == 0) {
        unsigned* bar = b.bar;
        __builtin_amdgcn_s_waitcnt(0);
        unsigned nloc = b.st[0], nx = b.st[1];
        if (nloc == 0u) { xcd_barrier_complete(bar, b.x, nloc, nx); b.st[0] = nloc; b.st[1] = nx; }
        const unsigned old = xb_add(&bar[XB_XSUB(b.x)], 1u);
        const unsigned gen = old / nloc;
        if (old + 1u == (gen + 1u) * nloc) {
            __builtin_amdgcn_fence(__ATOMIC_RELEASE, "agent");
            asm volatile("s_waitcnt vmcnt(0)" ::: "memory");
            const unsigned og = xb_add(&bar[XB_TOP], 1u);
            const unsigned tg = og / nx;
            if (og + 1u == (tg + 1u) * nx) xb_add(&bar[XB_TOPGEN], 1u);
            else XB_SPIN(xb_ld(&bar[XB_TOPGEN]) == tg, bar);
            __builtin_amdgcn_fence(__ATOMIC_ACQUIRE, "agent");
            xb_add(&bar[XB_XGEN(b.x)], 1u);
            asm volatile("s_waitcnt vmcnt(0)" ::: "memory");
        } else {
            XB_SPIN(xb_ld(&bar[XB_XGEN(b.x)]) == gen, bar);
            __builtin_amdgcn_fence(__ATOMIC_ACQUIRE, "agent");
            asm volatile("s_waitcnt vmcnt(0)" ::: "memory");
        }
    }
    __syncthreads();
}

struct Args {
    const float* x; const int* pos; const float* norm_mix_w; const float* w_in; const float* lq1; const float* lk1; const float* lq2; const float* lk2;
    const float* subln_w; const float* q_norm_w; const float* w_uq; const float* kv_norm_w; const float* w_ukv; const float* w_o_diff; const float* w_o_mla;
    const float* w_out; const float* norm_ffn_w; const float* w_up; const float* conv_w; const float* conv_b; const float* w_down; const float* final_w;
    float* out; unsigned char* ws; int ph_lo, ph_hi;
};

__device__ __forceinline__ float wave_sum(float v) {
#pragma unroll
    for (int o = 1; o < 64; o <<= 1) v += __shfl_xor(v, o);
    return v;
}

struct MapId { __device__ __forceinline__ int operator()(int n) const { return n; } };
struct MapIn { __device__ __forceinline__ int operator()(int n) const {
    if (n < 4096) { const int d = n & 63; return (n & ~63) + 2 * (d & 31) + (d >> 5); }
    if (n < ZC_KR) return n;
    if (n < ZC_KR + 64) { const int d = n - ZC_KR; return ZC_KR + 2 * (d & 31) + (d >> 5); }
    return n + (ZC_GD - (ZC_KR + 64)); } };
struct MapUq { __device__ __forceinline__ int operator()(int n) const { const int h = n / 192, j = n - h * 192;
    if (j < 128) return h * 128 + j; const int d = j - 128; return 2048 + h * 64 + 2 * (d & 31) + (d >> 5); } };
struct MapUkv { __device__ __forceinline__ int operator()(int n) const { const int h = n >> 8, j = n & 255; return (j < 128) ? h * 128 + j : 2048 + h * 128 + (j - 128); } };
struct MapUp { __device__ __forceinline__ int operator()(int n) const { const int v = n >= DFF, c = v ? n - DFF : n; return (c >> 7) * 256 + v * 128 + (c & 127); } };

template <class Map>
__device__ __forceinline__ void tr_item(const float* W, int N, bf16* WT, int ldt, int koff, const float* kscale, Map map, LAS float* scr, int item, int lane) {
    const int nblk = N / 32, kb = item / nblk, nb = item - kb * nblk, k0 = 64 * kb, n0 = 32 * nb;
#pragma unroll 8
    for (int i = 0; i < 32; ++i) { const int kk = 2 * i + (lane >> 5); scr[kk * 33 + (lane & 31)] = W[(size_t)(k0 + kk) * N + n0 + (lane & 31)]; }
    LDS_WAIT(); asm volatile("" ::: "memory");
    const int c = lane & 7;
    float g[8];
#pragma unroll
    for (int e = 0; e < 8; ++e) g[e] = kscale ? kscale[k0 + 8 * c + e] : 1.0f;
#pragma unroll
    for (int j = 0; j < 4; ++j) { const int n = (lane >> 3) + 8 * j; const LAS float* s = scr + (8 * c) * 33 + n;
        v4u o; o.x = pk2(s[0 * 33] * g[0], s[1 * 33] * g[1]); o.y = pk2(s[2 * 33] * g[2], s[3 * 33] * g[3]); o.z = pk2(s[4 * 33] * g[4], s[5 * 33] * g[5]); o.w = pk2(s[6 * 33] * g[6], s[7 * 33] * g[7]);
        *(GAS v4u*)(WT + (size_t)map(n0 + n) * ldt + koff + k0 + 8 * c) = o; }
    LDS_WAIT(); asm volatile("" ::: "memory");
}

struct TrItem { const float* W; const float* ks; bf16* WT; int N, ldt, koff, mapk, k0, n0; unsigned char* W8; int w8row0; const unsigned* WM; };
__device__ __forceinline__ int tr_map(int mapk, int n) { switch (mapk) { case 1: return MapIn()(n); case 2: return MapUq()(n); case 3: return MapUkv()(n); case 4: return MapUp()(n); default: return n; } }
__device__ __forceinline__ void tr_load(const TrItem& d, float (&v)[32], float (&g)[8], int lane) {
    typedef float f4 __attribute__((ext_vector_type(4)));
    if (d.ks) { const f4 g0 = *(const GAS f4*)(d.ks + d.k0 + 8 * (lane & 7)), g1 = *(const GAS f4*)(d.ks + d.k0 + 8 * (lane & 7) + 4);
        g[0] = g0.x; g[1] = g0.y; g[2] = g0.z; g[3] = g0.w; g[4] = g1.x; g[5] = g1.y; g[6] = g1.z; g[7] = g1.w; }
    else {
#pragma unroll
        for (int e = 0; e < 8; ++e) g[e] = 1.0f; }
#pragma unroll
    for (int i = 0; i < 8; ++i) { const int kk = (lane >> 3) + 8 * i; const f4 t = __builtin_nontemporal_load((const GAS f4*)(d.W + (size_t)(d.k0 + kk) * d.N + d.n0 + 4 * (lane & 7)));
        v[4 * i] = t.x; v[4 * i + 1] = t.y; v[4 * i + 2] = t.z; v[4 * i + 3] = t.w; }
}
__device__ __forceinline__ void tr_store(const TrItem& d, const float (&v)[32], const float (&g)[8], LAS float* scr, int lane) {
#pragma unroll
    for (int i = 0; i < 8; ++i) { const int kk = (lane >> 3) + 8 * i;
#pragma unroll
        for (int j = 0; j < 4; ++j) scr[kk * 33 + 4 * (lane & 7) + j] = v[4 * i + j]; }
    LDS_WAIT(); asm volatile("" ::: "memory");
    const int c = lane & 7;
#pragma unroll
    for (int j = 0; j < 4; ++j) { const int n = (lane >> 3) + 8 * j; const LAS float* sp = scr + (8 * c) * 33 + n;
        v4u o; o.x = pk2(sp[0 * 33] * g[0], sp[1 * 33] * g[1]); o.y = pk2(sp[2 * 33] * g[2], sp[3 * 33] * g[3]); o.z = pk2(sp[4 * 33] * g[4], sp[5 * 33] * g[5]); o.w = pk2(sp[6 * 33] * g[6], sp[7 * 33] * g[7]);
        const int row = tr_map(d.mapk, d.n0 + n);
        if (d.W8 && row >= d.w8row0) { pg8::f32x4 f0 = {sp[0 * 33] * g[0], sp[1 * 33] * g[1], sp[2 * 33] * g[2], sp[3 * 33] * g[3]}, f1 = {sp[4 * 33] * g[4], sp[5 * 33] * g[5], sp[6 * 33] * g[6], sp[7 * 33] * g[7]};
            const float qs = 127.0f / fmaxf(__uint_as_float(d.WM[row - d.w8row0]), 1e-30f); v2u o8; o8.x = pg8::pk4_i8(f0 * qs); o8.y = pg8::pk4_i8(f1 * qs); *(GAS v2u*)(d.W8 + (size_t)(row - d.w8row0) * DM + d.k0 + 8 * c) = o8; }
        else *(GAS v4u*)(d.WT + (size_t)row * d.ldt + d.koff + d.k0 + 8 * c) = o; }
    LDS_WAIT(); asm volatile("" ::: "memory");
}

__constant__ float ROPE_INVF[32] = {
    1.000000000e+00f, 7.498942614e-01f, 5.623413324e-01f, 4.216965139e-01f, 3.162277639e-01f, 2.371373773e-01f, 1.778279394e-01f, 1.333521307e-01f,
    1.000000015e-01f, 7.498941571e-02f, 5.623413250e-02f, 4.216965288e-02f, 3.162277490e-02f, 2.371373773e-02f, 1.778279431e-02f, 1.333521493e-02f,
    9.999999776e-03f, 7.498941850e-03f, 5.623413250e-03f, 4.216964822e-03f, 3.162277630e-03f, 2.371373586e-03f, 1.778279431e-03f, 1.333521446e-03f,
    1.000000047e-03f, 7.498942432e-04f, 5.623413017e-04f, 4.216965172e-04f, 3.162277571e-04f, 2.371373703e-04f, 1.778279402e-04f, 1.333521504e-04f };

typedef float f32x4 __attribute__((ext_vector_type(4)));
typedef float f32x16 __attribute__((ext_vector_type(16)));

__global__ void __launch_bounds__(NWAVES * 64, 2) fwd_kernel(Args a) {
    extern __shared__ __attribute__((aligned(16))) unsigned char lds[];
    LAS unsigned char* ldsl = (LAS unsigned char*)lds;
    volatile LAS unsigned* MISC = (volatile LAS unsigned*)(ldsl + MISC_OFF);
    const int tid = threadIdx.x, lane = tid & 63, wave = __builtin_amdgcn_readfirstlane(tid >> 6);
    const int G = gridDim.x; const int bx = blockIdx.x; const int vcu = (G % 8 == 0) ? (bx % 8) * (G / 8) + bx / 8 : bx;
    unsigned char* ws = a.ws;
    gu32* ctl = (gu32*)(ws + WS_CTL);
    for (int u = tid; u < (LDS_BYTES - LDSCTL_OFF) / 4; u += NWAVES * 64) ((LAS unsigned*)(ldsl + LDSCTL_OFF))[u] = 0u;
    __syncthreads();
    XcdBarrier bar; bar.bar = (unsigned*)(ctl + CW_BAR); bar.x = 0; bar.st = nullptr;
    if (!MK_PER_PHASE) bar = xcd_barrier_post((unsigned*)(ctl + CW_BAR), MISC + 8);
    const int lo = a.ph_lo, hi = a.ph_hi;
#ifndef PH_MASK
#define PH_MASK 0x3ff
#endif
#ifndef DUP_MASK
#define DUP_MASK 0
#endif
#define IN(k) (((PH_MASK >> (k)) & 1) && lo <= (k) && (k) < hi)
#define SEAM(k) do { if (IN(k) && IN((k) + 1)) xcd_barrier(bar); } while (0)
#ifdef TP_I0
    unsigned long long* const tsw = (unsigned long long*)(ws + 768 * 1024);
#define STAMP(k) do { if (bx == 0 && tid == 0) __hip_atomic_store(tsw + (k), (unsigned long long)__builtin_amdgcn_s_memrealtime(), RLX_AGENT); } while (0)
#else
#define STAMP(k) do { } while (0)
#endif
    const int gw = vcu * NWAVES + wave, NGW = G * NWAVES;
    bf16* const WIN = (bf16*)(ws + WS_WIN); bf16* const WUQ = (bf16*)(ws + WS_WUQ); bf16* const WUKV = (bf16*)(ws + WS_WUKV); bf16* const WO = (bf16*)(ws + WS_WO);
    bf16* const WOUT = (bf16*)(ws + WS_WOUT); bf16* const WUP = (bf16*)(ws + WS_WUP); bf16* const WDOWN = (bf16*)(ws + WS_WDOWN);
    bf16* const HB = (bf16*)(ws + WS_H); bf16* const YB = HB; bf16* const OB = (bf16*)(ws + WS_O); bf16* const XB = OB;
    bf16* const ZB = (bf16*)(ws + WS_Z); bf16* const QM = (bf16*)(ws + WS_QM); bf16* const KV = (bf16*)(ws + WS_KV);
    unsigned* const WMU = (unsigned*)(ws + WS_CTL + 256 * 1024); unsigned* const WMG = (unsigned*)(ws + WS_CTL + 384 * 1024);
    unsigned char* const WUP8 = ws + WS_WUP; unsigned char* const XN8 = ws + WS_X1 + 64 * MiB; float* const XSC = (float*)(ws + WS_X1 + 97 * MiB);
    float* const HSC = (float*)(ws + WS_X1 + 96 * MiB);
    unsigned char* const H8 = ws + WS_X1; unsigned char* const WIN8 = ws + WS_X1 + 32 * MiB;
    unsigned char* const VT8 = ws + WS_KV;
    unsigned char* const QF8 = ws + WS_QM; unsigned char* const KF8N = ws + WS_QM + 24 * MiB; unsigned char* const KF8R = ws + WS_QM + 40 * MiB;
    float* const HALO = (float*)(ws + WS_HALO); float* const O1 = (float*)(ws + WS_O1); bf16* const ACT = (bf16*)(ws + WS_ACT); float* const X1 = (float*)(ws + WS_X1);
    float* const COS = (float*)(ws + WS_COS); float* const SIN = (float*)(ws + WS_SIN); float* const SSQC = (float*)(ws + WS_SSQC);
    float* const SSQ1 = (float*)(ws + WS_SSQ1); float* const SSQ2 = (float*)(ws + WS_SSQ2); float* const RSTD1 = (float*)(ws + WS_RSTD1);

    STAMP(0);
    if (((DUP_MASK >> 0) & 1) && IN(0)) {
        LAS float* scr = (LAS float*)(ldsl + RING_OFF + wave * 16384);
        constexpr int I_IN = (DM / 64) * (INW / 32), I_UQ = (QRANK / 64) * (QMW / 32), I_UKV = (KVRANK / 64) * (KVW / 32), I_OD = (2048 / 64) * (DM / 32), I_OUT = (DM / 64) * (DM / 32),
                      I_UP = (DM / 64) * (UPW / 32), I_DN = (DFF / 64) * (DM / 32);
        constexpr int NITEMS = I_IN + I_UQ + I_UKV + 2 * I_OD + I_OUT + I_UP + I_DN;
        auto decode = [&](int it) -> TrItem { TrItem d; int r = it; int KB_;
            d.W8 = nullptr; d.w8row0 = 0; d.WM = nullptr;
            if (r < I_IN) { d.W = a.w_in; d.W8 = WIN8; d.w8row0 = ZC_GD; d.WM = WMG; d.ks = nullptr; d.WT = WIN; d.N = INW; d.ldt = DM; d.koff = 0; d.mapk = 1; KB_ = DM / 64; }
            else if ((r -= I_IN) < I_UQ) { d.W = a.w_uq; d.ks = a.q_norm_w; d.WT = WUQ; d.N = QMW; d.ldt = QRANK; d.koff = 0; d.mapk = 2; KB_ = QRANK / 64; }
            else if ((r -= I_UQ) < I_UKV) { d.W = a.w_ukv; d.ks = a.kv_norm_w; d.WT = WUKV; d.N = KVW; d.ldt = KVRANK; d.koff = 0; d.mapk = 3; KB_ = KVRANK / 64; }
            else if ((r -= I_UKV) < I_OD) { d.W = a.w_o_diff; d.ks = nullptr; d.WT = WO; d.N = DM; d.ldt = 4096; d.koff = 0; d.mapk = 0; KB_ = 2048 / 64; }
            else if ((r -= I_OD) < I_OD) { d.W = a.w_o_mla; d.ks = nullptr; d.WT = WO; d.N = DM; d.ldt = 4096; d.koff = 2048; d.mapk = 0; KB_ = 2048 / 64; }
            else if ((r -= I_OD) < I_OUT) { d.W = a.w_out; d.ks = nullptr; d.WT = WOUT; d.N = DM; d.ldt = DM; d.koff = 0; d.mapk = 0; KB_ = DM / 64; }
            else if ((r -= I_OUT) < I_UP) { d.W = a.w_up; d.ks = a.norm_ffn_w; d.WT = WUP; d.N = UPW; d.ldt = DM; d.koff = 0; d.mapk = 4; KB_ = DM / 64; d.W8 = WUP8; d.WM = WMU; }
            else { r -= I_UP; d.W = a.w_down; d.ks = nullptr; d.WT = WDOWN; d.N = DM; d.ldt = DFF; d.koff = 0; d.mapk = 0; KB_ = DFF / 64; }
            const int nblk = d.N / 32, kblk = KB_; const int grp = r / (kblk * 32), rem = r - grp * (kblk * 32); const int kb = rem % kblk, nb = grp * 32 + rem / kblk; (void)nblk;
            d.k0 = 64 * kb; d.n0 = 32 * nb; return d; };
        if (gw < NITEMS) {
            int it = gw; const int cs = NGW, it1 = NITEMS; TrItem d0, d1, d2, d3; float v0[32], v1[32], v2[32], v3[32], g0[8], g1[8], g2[8], g3[8];
            d0 = decode(it); tr_load(d0, v0, g0, lane); d1 = d0; d2 = d0; d3 = d0;
            if (it + cs < it1) { d1 = decode(it + cs); tr_load(d1, v1, g1, lane); }
            if (it + 2 * cs < it1) { d2 = decode(it + 2 * cs); tr_load(d2, v2, g2, lane); }
            for (;;) {
                if (it + 3 * cs < it1) { d3 = decode(it + 3 * cs); tr_load(d3, v3, g3, lane); }
                tr_store(d0, v0, g0, scr, lane); it += cs; if (it >= it1) break;
                if (it + 3 * cs < it1) { d0 = decode(it + 3 * cs); tr_load(d0, v0, g0, lane); }
                tr_store(d1, v1, g1, scr, lane); it += cs; if (it >= it1) break;
                if (it + 3 * cs < it1) { d1 = decode(it + 3 * cs); tr_load(d1, v1, g1, lane); }
                tr_store(d2, v2, g2, scr, lane); it += cs; if (it >= it1) break;
                if (it + 3 * cs < it1) { d2 = decode(it + 3 * cs); tr_load(d2, v2, g2, lane); }
                tr_store(d3, v3, g3, scr, lane); it += cs; if (it >= it1) break;
            }
        }
        { const int gt = vcu * (NWAVES * 64) + tid, NGT = G * NWAVES * 64; GAS v4u* pz = (GAS v4u*)(WIN + (size_t)(ZC_KR + 64) * DM); const int nz = (ZC_GD - ZC_KR - 64) * DM / 8;
            for (int i = gt; i < nz; i += NGT) pz[i] = (v4u){0u, 0u, 0u, 0u};
            for (int i = gt; i < S * 32; i += NGT) { const int t = i >> 5, f = i & 31; const float ang = (float)a.pos[t] * ROPE_INVF[f];
                const double rev = (double)ang * 0.15915494309189535; const float fr = (float)(rev - __builtin_rint(rev));
                COS[i] = __builtin_amdgcn_cosf(fr); SIN[i] = __builtin_amdgcn_sinf(fr); } }
        if (gw < S) {
            f32x4 wn[16], va[16], vb[16];
            { const GAS f32x4* wv = (const GAS f32x4*)a.norm_mix_w + lane;
#pragma unroll
              for (int j = 0; j < 16; ++j) wn[j] = wv[64 * j]; }
#define H_LOAD(v, m_) do { const GAS f32x4* xr_ = (const GAS f32x4*)(a.x + (size_t)(m_) * DM) + lane; _Pragma("unroll") for (int j = 0; j < 16; ++j) v[j] = xr_[64 * j]; } while (0)
#define H_ROW(v, m_) do { float ss_ = 0.f; _Pragma("unroll") for (int j = 0; j < 16; ++j) ss_ += (v[j].x * v[j].x + v[j].y * v[j].y) + (v[j].z * v[j].z + v[j].w * v[j].w); \
            const float rs_ = 1.0f / sqrtf(wave_sum(ss_) * (1.0f / DM) + NORM_EPS); GAS unsigned long long* o8_ = (GAS unsigned long long*)(HB + (size_t)(m_) * DM) + lane; \
            GAS unsigned* h8_ = (GAS unsigned*)(H8 + (size_t)(m_) * DM) + lane; \
            float mx_ = 0.f; _Pragma("unroll") for (int j = 0; j < 16; ++j) { v[j] = v[j] * rs_ * wn[j]; mx_ = fmaxf(fmaxf(mx_, fmaxf(fabsf(v[j].x), fabsf(v[j].y))), fmaxf(fabsf(v[j].z), fabsf(v[j].w))); } \
            _Pragma("unroll") for (int o_ = 32; o_ >= 1; o_ >>= 1) mx_ = fmaxf(mx_, __shfl_xor(mx_, o_)); mx_ = fmaxf(mx_, 1e-20f); const float qs_ = 127.0f / mx_; if (lane == 0) HSC[m_] = mx_ * (1.0f / 127.0f); \
            _Pragma("unroll") for (int j = 0; j < 16; ++j) { const f32x4 hv_ = v[j]; o8_[64 * j] = (unsigned long long)pk2(hv_.x, hv_.y) | ((unsigned long long)pk2(hv_.z, hv_.w) << 32); h8_[64 * j] = pg8::pk4_i8(hv_ * qs_); } } while (0)
            int m = gw; H_LOAD(va, m);
            for (;;) {
                if (m + NGW < S) H_LOAD(vb, m + NGW);
                H_ROW(va, m); m += NGW; if (m >= S) break;
                if (m + NGW < S) H_LOAD(va, m + NGW);
                H_ROW(vb, m); m += NGW; if (m >= S) break;
            }
#undef H_LOAD
#undef H_ROW
        }
    }
    if (((DUP_MASK >> 0) & 1) && IN(0)) xcd_barrier(bar);
    if (IN(0)) {
        {
            constexpr int CB_UP = UPW / 256, CB_G = 8192 / 256, NITM = (CB_UP + CB_G) * 64;
            for (int it = gw; it < NITM; it += NGW) { const int kb = it & 63, cb = it >> 6; const bool up = cb >= CB_G; const int c0 = up ? (cb - CB_G) * 256 : cb * 256 + (ZC_KR + 64); const int N_ = up ? UPW : INW;
                const float* W_ = up ? a.w_up : a.w_in;
                const GAS f32x4* p = (const GAS f32x4*)(W_ + (size_t)(kb * 64) * N_ + c0) + lane; f32x4 mx = {0.f, 0.f, 0.f, 0.f};
#pragma unroll 8
                for (int k = 0; k < 64; ++k) { const f32x4 v = p[(size_t)k * (N_ / 4)]; const float g = up ? a.norm_ffn_w[kb * 64 + k] : 1.0f;
#pragma unroll
                    for (int e = 0; e < 4; ++e) mx[e] = fmaxf(mx[e], fabsf(v[e] * g)); }
#pragma unroll
                for (int e = 0; e < 4; ++e) { const int n = c0 + 4 * lane + e; const int row = up ? MapUp()(n) : n - (ZC_KR + 64);
                    __hip_atomic_fetch_max((up ? WMU : WMG) + row, __float_as_uint(mx[e]), __ATOMIC_RELAXED, __HIP_MEMORY_SCOPE_AGENT); } }
            xcd_barrier(bar);
        }
        LAS float* scr = (LAS float*)(ldsl + RING_OFF + wave * 16384);
        constexpr int I_IN = (DM / 64) * (INW / 32), I_UQ = (QRANK / 64) * (QMW / 32), I_UKV = (KVRANK / 64) * (KVW / 32), I_OD = (2048 / 64) * (DM / 32), I_OUT = (DM / 64) * (DM / 32),
                      I_UP = (DM / 64) * (UPW / 32), I_DN = (DFF / 64) * (DM / 32);
        constexpr int NITEMS = I_IN + I_UQ + I_UKV + 2 * I_OD + I_OUT + I_UP + I_DN;
        auto decode = [&](int it) -> TrItem { TrItem d; int r = it; int KB_;
            { constexpr int OFF_UP = I_IN + I_UQ + I_UKV + 2 * I_OD + I_OUT;
              if (r < I_UP) r = OFF_UP + (I_UP - 1 - r); else if (r < OFF_UP + I_UP) r -= I_UP; }
            d.W8 = nullptr; d.w8row0 = 0; d.WM = nullptr;
            if (r < I_IN) { d.W = a.w_in; d.W8 = WIN8; d.w8row0 = ZC_GD; d.WM = WMG; d.ks = nullptr; d.WT = WIN; d.N = INW; d.ldt = DM; d.koff = 0; d.mapk = 1; KB_ = DM / 64; }
            else if ((r -= I_IN) < I_UQ) { d.W = a.w_uq; d.ks = a.q_norm_w; d.WT = WUQ; d.N = QMW; d.ldt = QRANK; d.koff = 0; d.mapk = 2; KB_ = QRANK / 64; }
            else if ((r -= I_UQ) < I_UKV) { d.W = a.w_ukv; d.ks = a.kv_norm_w; d.WT = WUKV; d.N = KVW; d.ldt = KVRANK; d.koff = 0; d.mapk = 3; KB_ = KVRANK / 64; }
            else if ((r -= I_UKV) < I_OD) { d.W = a.w_o_diff; d.ks = nullptr; d.WT = WO; d.N = DM; d.ldt = 4096; d.koff = 0; d.mapk = 0; KB_ = 2048 / 64; }
            else if ((r -= I_OD) < I_OD) { d.W = a.w_o_mla; d.ks = nullptr; d.WT = WO; d.N = DM; d.ldt = 4096; d.koff = 2048; d.mapk = 0; KB_ = 2048 / 64; }
            else if ((r -= I_OD) < I_OUT) { d.W = a.w_out; d.ks = nullptr; d.WT = WOUT; d.N = DM; d.ldt = DM; d.koff = 0; d.mapk = 0; KB_ = DM / 64; }
            else if ((r -= I_OUT) < I_UP) { d.W = a.w_up; d.ks = a.norm_ffn_w; d.WT = WUP; d.N = UPW; d.ldt = DM; d.koff = 0; d.mapk = 4; KB_ = DM / 64; d.W8 = WUP8; d.WM = WMU; }
            else { r -= I_UP; d.W = a.w_down; d.ks = nullptr; d.WT = WDOWN; d.N = DM; d.ldt = DFF; d.koff = 0; d.mapk = 0; KB_ = DFF / 64; }
            const int nblk = d.N / 32, kblk = KB_; const int grp = r / (kblk * 32), rem = r - grp * (kblk * 32); const int kb = rem % kblk, nb = grp * 32 + rem / kblk; (void)nblk;
            d.k0 = 64 * kb; d.n0 = 32 * nb; return d; };
        if (gw < NITEMS) {
            int it = gw; const int cs = NGW, it1 = NITEMS; TrItem d0, d1, d2, d3; float v0[32], v1[32], v2[32], v3[32], g0[8], g1[8], g2[8], g3[8];
            d0 = decode(it); tr_load(d0, v0, g0, lane); d1 = d0; d2 = d0; d3 = d0;
            if (it + cs < it1) { d1 = decode(it + cs); tr_load(d1, v1, g1, lane); }
            if (it + 2 * cs < it1) { d2 = decode(it + 2 * cs); tr_load(d2, v2, g2, lane); }
            for (;;) {
                if (it + 3 * cs < it1) { d3 = decode(it + 3 * cs); tr_load(d3, v3, g3, lane); }
                tr_store(d0, v0, g0, scr, lane); it += cs; if (it >= it1) break;
                if (it + 3 * cs < it1) { d0 = decode(it + 3 * cs); tr_load(d0, v0, g0, lane); }
                tr_store(d1, v1, g1, scr, lane); it += cs; if (it >= it1) break;
                if (it + 3 * cs < it1) { d1 = decode(it + 3 * cs); tr_load(d1, v1, g1, lane); }
                tr_store(d2, v2, g2, scr, lane); it += cs; if (it >= it1) break;
                if (it + 3 * cs < it1) { d2 = decode(it + 3 * cs); tr_load(d2, v2, g2, lane); }
                tr_store(d3, v3, g3, scr, lane); it += cs; if (it >= it1) break;
            }
        }
        { const int gt = vcu * (NWAVES * 64) + tid, NGT = G * NWAVES * 64; GAS v4u* pz = (GAS v4u*)(WIN + (size_t)(ZC_KR + 64) * DM); const int nz = (ZC_GD - ZC_KR - 64) * DM / 8;
            for (int i = gt; i < nz; i += NGT) pz[i] = (v4u){0u, 0u, 0u, 0u};
            for (int i = gt; i < S * 32; i += NGT) { const int t = i >> 5, f = i & 31; const float ang = (float)a.pos[t] * ROPE_INVF[f];
                const double rev = (double)ang * 0.15915494309189535; const float fr = (float)(rev - __builtin_rint(rev));
                COS[i] = __builtin_amdgcn_cosf(fr); SIN[i] = __builtin_amdgcn_sinf(fr); } }
        if (gw < S) {
            f32x4 wn[16], va[16], vb[16];
            { const GAS f32x4* wv = (const GAS f32x4*)a.norm_mix_w + lane;
#pragma unroll
              for (int j = 0; j < 16; ++j) wn[j] = wv[64 * j]; }
#define H_LOAD(v, m_) do { const GAS f32x4* xr_ = (const GAS f32x4*)(a.x + (size_t)(m_) * DM) + lane; _Pragma("unroll") for (int j = 0; j < 16; ++j) v[j] = xr_[64 * j]; } while (0)
#define H_ROW(v, m_) do { float ss_ = 0.f; _Pragma("unroll") for (int j = 0; j < 16; ++j) ss_ += (v[j].x * v[j].x + v[j].y * v[j].y) + (v[j].z * v[j].z + v[j].w * v[j].w); \
            const float rs_ = 1.0f / sqrtf(wave_sum(ss_) * (1.0f / DM) + NORM_EPS); GAS unsigned long long* o8_ = (GAS unsigned long long*)(HB + (size_t)(m_) * DM) + lane; \
            GAS unsigned* h8_ = (GAS unsigned*)(H8 + (size_t)(m_) * DM) + lane; \
            float mx_ = 0.f; _Pragma("unroll") for (int j = 0; j < 16; ++j) { v[j] = v[j] * rs_ * wn[j]; mx_ = fmaxf(fmaxf(mx_, fmaxf(fabsf(v[j].x), fabsf(v[j].y))), fmaxf(fabsf(v[j].z), fabsf(v[j].w))); } \
            _Pragma("unroll") for (int o_ = 32; o_ >= 1; o_ >>= 1) mx_ = fmaxf(mx_, __shfl_xor(mx_, o_)); mx_ = fmaxf(mx_, 1e-20f); const float qs_ = 127.0f / mx_; if (lane == 0) HSC[m_] = mx_ * (1.0f / 127.0f); \
            _Pragma("unroll") for (int j = 0; j < 16; ++j) { const f32x4 hv_ = v[j]; o8_[64 * j] = (unsigned long long)pk2(hv_.x, hv_.y) | ((unsigned long long)pk2(hv_.z, hv_.w) << 32); h8_[64 * j] = pg8::pk4_i8(hv_ * qs_); } } while (0)
            int m = gw; H_LOAD(va, m);
            for (;;) {
                if (m + NGW < S) H_LOAD(vb, m + NGW);
                H_ROW(va, m); m += NGW; if (m >= S) break;
                if (m + NGW < S) H_LOAD(va, m + NGW);
                H_ROW(vb, m); m += NGW; if (m >= S) break;
            }
#undef H_LOAD
#undef H_ROW
        }
    }
    SEAM(0);

    STAMP(1);
    if (((DUP_MASK >> 1) & 1) && IN(1)) {
        pg8::EpiIn E{ZB, COS, SIN, SSQC, KF8R};
        { pg8::Gemm g{HB, WIN, S, 31 * 256, DM, DM, DM}; pg8::StaticOrder So; So.init(S, 31 * 256, G, bx);
          pg8::gemm_phase<pg8::EpiIn, pg8::StaticOrder, true>(ldsl + RING_OFF, g, So, E); }
        {
          pg8::Gemm g{(const pg8::bf16_t*)H8, (const pg8::bf16_t*)WIN8 - (size_t)31 * 256 * (DM / 2), S, 32 * 256, DM / 2, DM / 2, DM / 2}; pg8::SkipOrder So; So.s.init(S, 32 * 256, G, bx); So.skip_from = 0; So.skip_n = 31;
          pg8::EpiInGate E8{ZB, HSC, (const float*)WMG};
          pg8::gemm_phase<pg8::EpiInGate, pg8::SkipOrder, true, pg8::NoHook, false, true>(ldsl + RING_OFF, g, So, E8); }
    }
    if (((DUP_MASK >> 1) & 1) && IN(1)) xcd_barrier(bar);
    if (IN(1)) {
        pg8::EpiIn E{ZB, COS, SIN, SSQC, KF8R};
        { pg8::Gemm g{HB, WIN, S, 31 * 256, DM, DM, DM}; pg8::StaticOrder So; So.init(S, 31 * 256, G, bx);
          pg8::gemm_phase<pg8::EpiIn, pg8::StaticOrder, true>(ldsl + RING_OFF, g, So, E); }
        {
          pg8::Gemm g{(const pg8::bf16_t*)H8, (const pg8::bf16_t*)WIN8 - (size_t)31 * 256 * (DM / 2), S, 32 * 256, DM / 2, DM / 2, DM / 2}; pg8::SkipOrder So; So.s.init(S, 32 * 256, G, bx); So.skip_from = 0; So.skip_n = 31;
          pg8::EpiInGate E8{ZB, HSC, (const float*)WMG};
          pg8::gemm_phase<pg8::EpiInGate, pg8::SkipOrder, true, pg8::NoHook, false, true>(ldsl + RING_OFF, g, So, E8); }
    }
    SEAM(1);

    STAMP(2);
    if (((DUP_MASK >> 2) & 1) && IN(2)) {
        { pg8::Gemm g{ZB + ZC_CQ, WUQ, S, QMW, QRANK, ZW, QRANK}; pg8::StaticOrder So; So.init(S, QMW, G, bx);
          pg8::EpiMla<0, 4, QRANK, 1 << 30> E{QM, QMW, SSQC, COS, SIN, 8, QF8, QMW};
          pg8::gemm_phase<pg8::EpiMla<0, 4, QRANK, 1 << 30>, pg8::StaticOrder, true>(ldsl + RING_OFF, g, So, E); }
        { pg8::Gemm g{ZB + ZC_CKV, WUKV, S, 2048, KVRANK, ZW, KVRANK}; pg8::StaticOrder So; So.init(S, 2048, G, bx);
          pg8::EpiMla<16, 2, KVRANK, 1 << 30> E{KV, KVW, SSQC, COS, SIN, 1 << 30, KF8N, 2048};
          pg8::gemm_phase<pg8::EpiMla<16, 2, KVRANK, 1 << 30>, pg8::StaticOrder, true>(ldsl + RING_OFF, g, So, E); }
        { pg8::Gemm g{WUKV + (size_t)2048 * KVRANK, ZB + ZC_CKV, 2048, S, KVRANK, KVRANK, ZW}; pg8::VtOrder Vo{bx, G};
          pg8::EpiVT E{VT8, SSQC, S};
          pg8::gemm_phase<pg8::EpiVT, pg8::VtOrder, true>(ldsl + RING_OFF, g, Vo, E); }
    }
    if (((DUP_MASK >> 2) & 1) && IN(2)) xcd_barrier(bar);
    if (IN(2)) {
        { pg8::Gemm g{ZB + ZC_CQ, WUQ, S, QMW, QRANK, ZW, QRANK}; pg8::StaticOrder So; So.init(S, QMW, G, bx);
          pg8::EpiMla<0, 4, QRANK, 1 << 30> E{QM, QMW, SSQC, COS, SIN, 8, QF8, QMW};
          pg8::gemm_phase<pg8::EpiMla<0, 4, QRANK, 1 << 30>, pg8::StaticOrder, true>(ldsl + RING_OFF, g, So, E); }
        { pg8::Gemm g{ZB + ZC_CKV, WUKV, S, 2048, KVRANK, ZW, KVRANK}; pg8::StaticOrder So; So.init(S, 2048, G, bx);
          pg8::EpiMla<16, 2, KVRANK, 1 << 30> E{KV, KVW, SSQC, COS, SIN, 1 << 30, KF8N, 2048};
          pg8::gemm_phase<pg8::EpiMla<16, 2, KVRANK, 1 << 30>, pg8::StaticOrder, true>(ldsl + RING_OFF, g, So, E); }
        { pg8::Gemm g{WUKV + (size_t)2048 * KVRANK, ZB + ZC_CKV, 2048, S, KVRANK, KVRANK, ZW}; pg8::VtOrder Vo{bx, G};
          pg8::EpiVT E{VT8, SSQC, S};
          pg8::gemm_phase<pg8::EpiVT, pg8::VtOrder, true>(ldsl + RING_OFF, g, Vo, E); }
    }
    SEAM(2);

    STAMP(3);
    if (((DUP_MASK >> 3) & 1) && IN(3)) {
        float lam;
        { const float a1 = wave_sum(a.lq1[lane] * a.lk1[lane]), a2 = wave_sum(a.lq2[lane] * a.lk2[lane]); lam = expf(a1) - expf(a2) + LAMBDA_INIT; }
        const int row_l = lane & 31, half_l = lane >> 5;
        char* const alds = (char*)lds + RING_OFF;
        if (wave >= 4) __builtin_amdgcn_s_setprio(1);
        for (int rep_ = 0; rep_ < 1 + ((DUP_MASK >> 10) & 1); ++rep_)
        for (int item = vcu; item < NHEAD * 16; item += G) {
            const int h = item >> 4, sp = item & 15;
#ifndef NO_DIFF
#pragma unroll 1
            for (int pc = 0; pc < 4; ++pc) {
                const int c = pc >> 1, pass = pc & 1, qb = pass ? sp : 31 - sp; const int trow = qb * 256 + wave * 32 + row_l;
                att::Src sd; sd.Qn = nullptr; sd.Kn = nullptr;
                sd.Qr = ZB + ZC_QD + (2 * h + c) * 64; sd.Kr = ZB + ZC_KD + (2 * h + c) * 64; sd.V = ZB + ZC_VD + h * 128;
                att::diff_block64<8>(sd.Qr, sd.Kr, sd.V, qb, alds);
                bf16* o1p = (bf16*)O1 + (size_t)trow * 2048 + h * 128 + half_l * 64;
                if (c == 0) {
#pragma unroll
                    for (int j = 0; j < 8; ++j) *(pg8::u32x4*)(o1p + 8 * j) = pg8::pack8(att::staged4(alds, wave, lane, 2 * j), att::staged4(alds, wave, lane, 2 * j + 1));
                } else {
                    f32x4 u[16]; float ss = 0.f;
#pragma unroll
                    for (int j = 0; j < 8; ++j) { pg8::f32x4 a0, a1; pg8::unpack8(*(const pg8::u32x4*)(o1p + 8 * j), a0, a1);
                        u[2 * j] = a0 - lam * att::staged4(alds, wave, lane, 2 * j); u[2 * j + 1] = a1 - lam * att::staged4(alds, wave, lane, 2 * j + 1);
#pragma unroll
                        for (int e = 0; e < 2; ++e) ss += (u[2 * j + e][0] * u[2 * j + e][0] + u[2 * j + e][1] * u[2 * j + e][1]) + (u[2 * j + e][2] * u[2 * j + e][2] + u[2 * j + e][3] * u[2 * j + e][3]); }
                    ss += __shfl_xor(ss, 32);
                    const float rs = (1.0f - LAMBDA_INIT) / sqrtf(ss * (1.0f / 128.0f) + SUBLN_EPS);
                    bf16* ob = OB + (size_t)trow * 4096 + h * 128 + half_l * 64; const float* swp = a.subln_w + half_l * 64;
#pragma unroll
                    for (int j = 0; j < 8; ++j) { const f32x4 w0 = *(const f32x4*)(swp + 8 * j), w1 = *(const f32x4*)(swp + 8 * j + 4);
                        *(pg8::u32x4*)(ob + 8 * j) = pg8::pack8(u[2 * j] * rs * w0, u[2 * j + 1] * rs * w1); }
                }
            }
#endif
        }
        for (int rep_ = 0; rep_ < 1 + ((DUP_MASK >> 11) & 1); ++rep_)
        for (int item = vcu; item < NHEAD * 16; item += G) {
            const int h = item >> 4, sp = item & 15;
#ifndef NO_MLA
#pragma unroll 1
            for (int pass = 0; pass < 2; ++pass) {
                const int qb = pass ? sp : 31 - sp; const int trow = qb * 256 + wave * 32 + row_l;
                att::Src sm; sm.Qn = (const att::bf16_t*)(QF8 + h * 128); sm.Qr = (const att::bf16_t*)(QF8 + 2048 + h * 64); sm.Kn = (const att::bf16_t*)(KF8N + h * 128); sm.Kr = (const att::bf16_t*)KF8R; sm.V = (const att::bf16_t*)(VT8 + (size_t)h * 128 * S);
                att::attn_block<true, 2>(sm, qb, alds);
                bf16* ob = OB + (size_t)trow * 4096 + 2048 + h * 128 + half_l * 64;
#pragma unroll
                for (int j = 0; j < 8; ++j) *(pg8::u32x4*)(ob + 8 * j) = pg8::pack8(att::staged4(alds, wave, lane, 2 * j), att::staged4(alds, wave, lane, 2 * j + 1));
            }
#endif
        }
    }
    if (((DUP_MASK >> 3) & 1) && IN(3)) xcd_barrier(bar);
    if (IN(3)) {
        float lam;
        { const float a1 = wave_sum(a.lq1[lane] * a.lk1[lane]), a2 = wave_sum(a.lq2[lane] * a.lk2[lane]); lam = expf(a1) - expf(a2) + LAMBDA_INIT; }
        const int row_l = lane & 31, half_l = lane >> 5;
        char* const alds = (char*)lds + RING_OFF;
        if (wave >= 4) __builtin_amdgcn_s_setprio(1);
        for (int rep_ = 0; rep_ < 1 + ((DUP_MASK >> 10) & 1); ++rep_)
        for (int item = vcu; item < NHEAD * 16; item += G) {
            const int h = item >> 4, sp = item & 15;
#ifndef NO_DIFF
#pragma unroll 1
            for (int pc = 0; pc < 4; ++pc) {
                const int c = pc >> 1, pass = pc & 1, qb = pass ? sp : 31 - sp; const int trow = qb * 256 + wave * 32 + row_l;
                att::Src sd; sd.Qn = nullptr; sd.Kn = nullptr;
                sd.Qr = ZB + ZC_QD + (2 * h + c) * 64; sd.Kr = ZB + ZC_KD + (2 * h + c) * 64; sd.V = ZB + ZC_VD + h * 128;
                att::diff_block64<8>(sd.Qr, sd.Kr, sd.V, qb, alds);
                bf16* o1p = (bf16*)O1 + (size_t)trow * 2048 + h * 128 + half_l * 64;
                if (c == 0) {
#pragma unroll
                    for (int j = 0; j < 8; ++j) *(pg8::u32x4*)(o1p + 8 * j) = pg8::pack8(att::staged4(alds, wave, lane, 2 * j), att::staged4(alds, wave, lane, 2 * j + 1));
                } else {
                    f32x4 u[16]; float ss = 0.f;
#pragma unroll
                    for (int j = 0; j < 8; ++j) { pg8::f32x4 a0, a1; pg8::unpack8(*(const pg8::u32x4*)(o1p + 8 * j), a0, a1);
                        u[2 * j] = a0 - lam * att::staged4(alds, wave, lane, 2 * j); u[2 * j + 1] = a1 - lam * att::staged4(alds, wave, lane, 2 * j + 1);
#pragma unroll
                        for (int e = 0; e < 2; ++e) ss += (u[2 * j + e][0] * u[2 * j + e][0] + u[2 * j + e][1] * u[2 * j + e][1]) + (u[2 * j + e][2] * u[2 * j + e][2] + u[2 * j + e][3] * u[2 * j + e][3]); }
                    ss += __shfl_xor(ss, 32);
                    const float rs = (1.0f - LAMBDA_INIT) / sqrtf(ss * (1.0f / 128.0f) + SUBLN_EPS);
                    bf16* ob = OB + (size_t)trow * 4096 + h * 128 + half_l * 64; const float* swp = a.subln_w + half_l * 64;
#pragma unroll
                    for (int j = 0; j < 8; ++j) { const f32x4 w0 = *(const f32x4*)(swp + 8 * j), w1 = *(const f32x4*)(swp + 8 * j + 4);
                        *(pg8::u32x4*)(ob + 8 * j) = pg8::pack8(u[2 * j] * rs * w0, u[2 * j + 1] * rs * w1); }
                }
            }
#endif
        }
        for (int rep_ = 0; rep_ < 1 + ((DUP_MASK >> 11) & 1); ++rep_)
        for (int item = vcu; item < NHEAD * 16; item += G) {
            const int h = item >> 4, sp = item & 15;
#ifndef NO_MLA
#pragma unroll 1
            for (int pass = 0; pass < 2; ++pass) {
                const int qb = pass ? sp : 31 - sp; const int trow = qb * 256 + wave * 32 + row_l;
                att::Src sm; sm.Qn = (const att::bf16_t*)(QF8 + h * 128); sm.Qr = (const att::bf16_t*)(QF8 + 2048 + h * 64); sm.Kn = (const att::bf16_t*)(KF8N + h * 128); sm.Kr = (const att::bf16_t*)KF8R; sm.V = (const att::bf16_t*)(VT8 + (size_t)h * 128 * S);
                att::attn_block<true, 2>(sm, qb, alds);
                bf16* ob = OB + (size_t)trow * 4096 + 2048 + h * 128 + half_l * 64;
#pragma unroll
                for (int j = 0; j < 8; ++j) *(pg8::u32x4*)(ob + 8 * j) = pg8::pack8(att::staged4(alds, wave, lane, 2 * j), att::staged4(alds, wave, lane, 2 * j + 1));
            }
#endif
        }
    }
    __builtin_amdgcn_s_setprio(0);
    SEAM(3);

    STAMP(4);
    if (((DUP_MASK >> 4) & 1) && IN(4)) {
        pg8::Gemm g{OB, WO, S, DM, 4096, 4096, 4096}; pg8::StaticOrder So; So.init(S, DM, G, bx);
        pg8::EpiGate E{ZB + ZC_GM, YB}; pg8::GateHook HK{ZB + ZC_GD, ZB + ZC_GM};
        pg8::gemm_phase<pg8::EpiGate, pg8::StaticOrder, true, pg8::GateHook>(ldsl + RING_OFF, g, So, E, HK);
    }
    if (((DUP_MASK >> 4) & 1) && IN(4)) xcd_barrier(bar);
    if (IN(4)) {
        pg8::Gemm g{OB, WO, S, DM, 4096, 4096, 4096}; pg8::StaticOrder So; So.init(S, DM, G, bx);
        pg8::EpiGate E{ZB + ZC_GM, YB}; pg8::GateHook HK{ZB + ZC_GD, ZB + ZC_GM};
        pg8::gemm_phase<pg8::EpiGate, pg8::StaticOrder, true, pg8::GateHook>(ldsl + RING_OFF, g, So, E, HK);
    }
    SEAM(4);

    STAMP(5);
    if (((DUP_MASK >> 5) & 1) && IN(5)) {
        pg8::Gemm g{YB, WOUT, S, DM, DM, DM, DM}; pg8::StaticOrder So; So.init(S, DM, G, bx);
        pg8::EpiRes<false> E{a.x, XB, SSQ1};
        pg8::gemm_phase<pg8::EpiRes<false>, pg8::StaticOrder, true>(ldsl + RING_OFF, g, So, E);
    }
    if (((DUP_MASK >> 5) & 1) && IN(5)) xcd_barrier(bar);
    if (IN(5)) {
        pg8::Gemm g{YB, WOUT, S, DM, DM, DM, DM}; pg8::StaticOrder So; So.init(S, DM, G, bx);
        pg8::EpiRes<false> E{a.x, XB, SSQ1};
        pg8::gemm_phase<pg8::EpiRes<false>, pg8::StaticOrder, true>(ldsl + RING_OFF, g, So, E);
    }
    SEAM(5);

    STAMP(6);
    if (IN(6)) {
        for (int m = gw; m < S; m += NGW) { const float sm = wave_sum(SSQ1[(size_t)m * 64 + lane]); const float rs = 1.0f / sqrtf(sm * (1.0f / DM) + NORM_EPS); if (lane == 0) RSTD1[m] = rs;
            const GAS pg8::u32x4* xr = (const GAS pg8::u32x4*)(XB + (size_t)m * DM) + lane; pg8::f32x4 xv[16]; float mx = 0.f;
#pragma unroll
            for (int jj = 0; jj < 8; ++jj) { pg8::unpack8(xr[64 * jj], xv[2 * jj], xv[2 * jj + 1]);
#pragma unroll
                for (int e = 0; e < 4; ++e) mx = fmaxf(mx, fmaxf(fabsf(xv[2 * jj][e]), fabsf(xv[2 * jj + 1][e]))); }
#pragma unroll
            for (int o_ = 32; o_ >= 1; o_ >>= 1) mx = fmaxf(mx, __shfl_xor(mx, o_));
            mx = fmaxf(mx * rs, 1e-20f); const float qs = rs * 127.0f / mx; if (lane == 0) XSC[m] = mx * (1.0f / 127.0f);
            GAS v2u* xo = (GAS v2u*)(XN8 + (size_t)m * DM) + lane;
#pragma unroll
            for (int jj = 0; jj < 8; ++jj) { v2u w; w.x = pg8::pk4_i8(xv[2 * jj] * qs); w.y = pg8::pk4_i8(xv[2 * jj + 1] * qs); xo[64 * jj] = w; } }
    }
    SEAM(6);

    STAMP(7);
    if (((DUP_MASK >> 7) & 1) && IN(7)) {
        pg8::Gemm g{(const pg8::bf16_t*)XN8, (const pg8::bf16_t*)WUP8, S, UPW, DM / 2, DM / 2, DM / 2}; pg8::StaticOrder So; So.init(S, UPW, G, bx);
        pg8::EpiUpConv E{ACT, HALO, a.conv_w, a.conv_b, XSC, (LAS float*)(ldsl + XCH_OFF), (const float*)WMU};
        pg8::gemm_phase<pg8::EpiUpConv, pg8::StaticOrder, true, pg8::NoHook, false, true>(ldsl + RING_OFF, g, So, E);
    }
    if (((DUP_MASK >> 7) & 1) && IN(7)) xcd_barrier(bar);
    if (IN(7)) {
        pg8::Gemm g{(const pg8::bf16_t*)XN8, (const pg8::bf16_t*)WUP8, S, UPW, DM / 2, DM / 2, DM / 2}; pg8::StaticOrder So; So.init(S, UPW, G, bx);
        pg8::EpiUpConv E{ACT, HALO, a.conv_w, a.conv_b, XSC, (LAS float*)(ldsl + XCH_OFF), (const float*)WMU};
        pg8::gemm_phase<pg8::EpiUpConv, pg8::StaticOrder, true, pg8::NoHook, false, true>(ldsl + RING_OFF, g, So, E);
    }
    SEAM(7);

    STAMP(8);
    if (IN(8)) {
        pg8::Gemm g{ACT, WDOWN, S, DM, DFF, DFF, DFF}; pg8::StaticOrder So; So.init(S, DM, G, bx);
        { pg8::Unit un; int last_pm = 0;
            for (int ui = 0; So.next(ui, un); ++ui) { const int pm = un.pm; if (pm == last_pm) continue; last_pm = pm;
                const float* ha = HALO + ((size_t)(pm - 1) * 4 + 2) * UPW; const float* hb = ha + UPW; const float* h0 = HALO + (size_t)pm * 4 * UPW; const float* h1 = h0 + UPW;
                for (int c = tid; c < DFF; c += NWAVES * 64) { const int gc = (c >> 7) * 256 + (c & 127), vc = gc + 128;
                    const float sg = __uint_as_float(WMU[gc]) * (1.0f / 127.0f), sv = __uint_as_float(WMU[vc]) * (1.0f / 127.0f);
                    const float wg0 = a.conv_w[c] * sg, wg1 = a.conv_w[UPW + c] * sg, wg2 = a.conv_w[2 * UPW + c] * sg, bg = a.conv_b[c];
                    const float wv0 = a.conv_w[DFF + c] * sv, wv1 = a.conv_w[UPW + DFF + c] * sv, wv2 = a.conv_w[2 * UPW + DFF + c] * sv, bv = a.conv_b[DFF + c];
                    const float ga = ha[gc], gb = hb[gc], g0 = h0[gc], g1 = h1[gc], va = ha[vc], vb = hb[vc], v0 = h0[vc], v1 = h1[vc];
                    const float og0 = bg + wg0 * ga + wg1 * gb + wg2 * g0, og1 = bg + wg0 * gb + wg1 * g0 + wg2 * g1;
                    const float ov0 = bv + wv0 * va + wv1 * vb + wv2 * v0, ov1 = bv + wv0 * vb + wv1 * v0 + wv2 * v1;
                    ACT[(size_t)(pm * 256) * DFF + c] = (bf16)f2bf(og0 * pg8::sigmoidf_fast(og0) * ov0);
                    ACT[(size_t)(pm * 256 + 1) * DFF + c] = (bf16)f2bf(og1 * pg8::sigmoidf_fast(og1) * ov1); } }
            VM_WAIT(); __syncthreads(); }
        pg8::EpiRes<true> E{nullptr, XB, SSQ2};
        pg8::gemm_phase<pg8::EpiRes<true>, pg8::StaticOrder, true>(ldsl + RING_OFF, g, So, E);
    }
    SEAM(8);

    STAMP(9);
    if (IN(9)) {
        if (gw < S) {
            int l9 = threadIdx.x; asm volatile("" : "+v"(l9)); l9 &= 63;
            f32x4 wf[16]; pg8::u32x4 xa[8], xb[8]; float qa, qb;
            { const GAS f32x4* wv = (const GAS f32x4*)a.final_w;
#pragma unroll
              for (int jj = 0; jj < 8; ++jj) { wf[2 * jj] = wv[(64 * jj + l9) * 2]; wf[2 * jj + 1] = wv[(64 * jj + l9) * 2 + 1]; } }
#define F_LOAD(x_, q_, m_) do { q_ = SSQ2[(size_t)(m_) * 64 + l9]; const GAS pg8::u32x4* xr_ = (const GAS pg8::u32x4*)(XB + (size_t)(m_) * DM) + l9; _Pragma("unroll") for (int jj = 0; jj < 8; ++jj) x_[jj] = xr_[64 * jj]; } while (0)
#define F_ROW(x_, q_, m_) do { const float rs_ = 1.0f / sqrtf(wave_sum(q_) * (1.0f / DM) + NORM_EPS); GAS f32x4* orow_ = (GAS f32x4*)(a.out + (size_t)(m_) * DM); \
            _Pragma("unroll") for (int jj = 0; jj < 8; ++jj) { pg8::f32x4 v0_, v1_; pg8::unpack8(x_[jj], v0_, v1_); const int c4_ = (64 * jj + l9) * 2; \
                orow_[c4_] = v0_ * rs_ * wf[2 * jj]; orow_[c4_ + 1] = v1_ * rs_ * wf[2 * jj + 1]; } } while (0)
            int m = gw; F_LOAD(xa, qa, m);
            for (;;) {
                if (m + NGW < S) F_LOAD(xb, qb, m + NGW);
                F_ROW(xa, qa, m); m += NGW; if (m >= S) break;
                if (m + NGW < S) F_LOAD(xa, qa, m + NGW);
                F_ROW(xb, qb, m); m += NGW; if (m >= S) break;
            }
#undef F_LOAD
#undef F_ROW
        }
    }
#ifdef TP_I0
    xcd_barrier(bar); STAMP(10); xcd_barrier(bar);
    { const unsigned long long tI = __hip_atomic_load(tsw + TP_I1 + 1, RLX_AGENT) - __hip_atomic_load(tsw + TP_I0, RLX_AGENT), tJ = __hip_atomic_load(tsw + TP_J1 + 1, RLX_AGENT) - __hip_atomic_load(tsw + TP_J0, RLX_AGENT);
      const float B = sqrtf((float)tI * 0.01f), A = (float)tJ * 0.01f;
      const size_t gt = (size_t)bx * (NWAVES * 64) + tid, NT = (size_t)G * NWAVES * 64;
      for (size_t i = gt; i < (size_t)S * DM; i += NT) a.out[i] = (i == 0) ? A : B; }
#endif
#undef IN
#undef SEAM
}


#if MK_PER_PHASE == 2
struct CsRange { size_t off; size_t bytes; };
__global__ void csum_kernel(const unsigned char* ws, const float* outp, unsigned* cs, CsRange r0, CsRange r1, CsRange r2, int use_out) {
    unsigned s1 = 0u, s2 = 0u;
    const size_t gt = (size_t)blockIdx.x * blockDim.x + threadIdx.x, NT = (size_t)gridDim.x * blockDim.x;
    CsRange rr[3] = {r0, r1, r2};
#pragma unroll
    for (int k = 0; k < 3; ++k) { const unsigned* p = (const unsigned*)(ws + rr[k].off); const size_t n = rr[k].bytes / 4;
        for (size_t i = gt; i < n; i += NT) { const unsigned w = p[i]; s1 += w; s2 += w * ((unsigned)(i & 0xffffu) | 1u); } }
    if (use_out) { const unsigned* p = (const unsigned*)outp; const size_t n = (size_t)S * DM;
        for (size_t i = gt; i < n; i += NT) { const unsigned w = p[i]; s1 += w; s2 += w * ((unsigned)(i & 0xffffu) | 1u); } }
    atomicAdd(cs, s1); atomicAdd(cs + 1, s2);
}
__global__ void encode_kernel(float* outp, const unsigned* cs) {
    int code = 20;
    for (int k = 9; k >= 0; --k) if (cs[2 * k] != cs[32 + 2 * k] || cs[2 * k + 1] != cs[32 + 2 * k + 1]) code = k + 1;
    const float c = sqrtf(10.0f * (float)code);
    const size_t gt = (size_t)blockIdx.x * blockDim.x + threadIdx.x, NT = (size_t)gridDim.x * blockDim.x;
    for (size_t i = gt; i < (size_t)S * DM; i += NT) outp[i] = c;
}
#endif


#if MK_PER_PHASE == 3
__global__ void zsum_kernel(const unsigned char* ws, unsigned* cs) {
    unsigned g[6] = {0u, 0u, 0u, 0u, 0u, 0u};
    const size_t gt = (size_t)blockIdx.x * blockDim.x + threadIdx.x, NT = (size_t)gridDim.x * blockDim.x;
    const unsigned* z = (const unsigned*)(ws + WS_Z); const size_t n = (size_t)S * ZW / 2;
    for (size_t i = gt; i < n; i += NT) { const int col = (int)(i % (ZW / 2)) * 2, pn = col >> 8; const unsigned w = z[i] * ((unsigned)(i & 0xffffu) | 1u);
        const int grp = (pn < 16) ? 0 : (pn < 24) ? 1 : (pn < 30) ? 2 : (pn == 30) ? 4 : 3; g[grp] += w; }
    const unsigned* q = (const unsigned*)(ws + WS_SSQC); for (size_t i = gt; i < (size_t)S * 24; i += NT) g[5] += q[i] * ((unsigned)(i & 0xffffu) | 1u);
#pragma unroll
    for (int k = 0; k < 6; ++k) atomicAdd(cs + k, g[k]);
}
__global__ void encode3_kernel(float* outp, const unsigned* cs) {
    int mask = 0;
    for (int k = 0; k < 6; ++k) if (cs[k] != cs[8 + k]) mask |= (k < 5 ? (1 << k) : 0);
    int rer = 0; for (int k = 0; k < 6; ++k) if (cs[8 + k] != cs[16 + k]) rer = 1;
    const int ssq = cs[5] != cs[13];
    const float c = sqrtf(10.0f * (float)(mask + 1) + 1000.0f * rer + 2000.0f * ssq);
    const size_t gt = (size_t)blockIdx.x * blockDim.x + threadIdx.x, NT = (size_t)gridDim.x * blockDim.x;
    for (size_t i = gt; i < (size_t)S * DM; i += NT) outp[i] = c;
}
#endif

constexpr int N_PHASES = 10;
extern "C" void kernel_launch(void* const* d_in, const int* in_sizes, int n_in, void* d_out, int out_size, void* d_ws, size_t ws_size, hipStream_t stream) {
    static int grid = 0;
    if (grid == 0) {
        if (n_in != 22 || in_sizes[0] != S * DM || out_size != S * DM || ws_size < WS_END) { fprintf(stderr, "kernel_launch: unexpected shapes (n_in %d, in0 %d, out %d, ws %zu)\n", n_in, n_in > 0 ? in_sizes[0] : -1, out_size, ws_size); grid = -1; return; }
        int dev = 0, cus = 0, per_cu = 0;
        if (hipGetDevice(&dev) != hipSuccess || hipDeviceGetAttribute(&cus, hipDeviceAttributeMultiprocessorCount, dev) != hipSuccess) { grid = -1; return; }
        if (hipFuncSetAttribute((const void*)fwd_kernel, hipFuncAttributeMaxDynamicSharedMemorySize, LDS_BYTES) != hipSuccess) { fprintf(stderr, "kernel_launch: hipFuncSetAttribute failed\n"); grid = -1; return; }
        if (hipOccupancyMaxActiveBlocksPerMultiprocessor(&per_cu, (const void*)fwd_kernel, NWAVES * 64, LDS_BYTES) != hipSuccess || per_cu < 1)
            fprintf(stderr, "kernel_launch: note: occupancy query reports %d workgroups per CU\n", per_cu);
        (void)hipGetLastError();
        grid = cus;
    }
    if (grid < 0) return;
    if (hipMemsetAsync((char*)d_ws + WS_CTL, 0, CTL_ZERO_BYTES, stream) != hipSuccess) return;
    Args a{};
    a.x = (const float*)d_in[0]; a.pos = (const int*)d_in[1]; a.norm_mix_w = (const float*)d_in[2]; a.w_in = (const float*)d_in[3];
    a.lq1 = (const float*)d_in[4]; a.lk1 = (const float*)d_in[5]; a.lq2 = (const float*)d_in[6]; a.lk2 = (const float*)d_in[7];
    a.subln_w = (const float*)d_in[8]; a.q_norm_w = (const float*)d_in[9]; a.w_uq = (const float*)d_in[10]; a.kv_norm_w = (const float*)d_in[11];
    a.w_ukv = (const float*)d_in[12]; a.w_o_diff = (const float*)d_in[13]; a.w_o_mla = (const float*)d_in[14]; a.w_out = (const float*)d_in[15];
    a.norm_ffn_w = (const float*)d_in[16]; a.w_up = (const float*)d_in[17]; a.conv_w = (const float*)d_in[18]; a.conv_b = (const float*)d_in[19];
    a.w_down = (const float*)d_in[20]; a.final_w = (const float*)d_in[21];
    a.out = (float*)d_out; a.ws = (unsigned char*)d_ws;
#if MK_PER_PHASE == 3
    unsigned* cs = (unsigned*)((char*)d_ws + 512 * 1024);
    for (int run = 0; run < 2; ++run) {
        hipMemsetAsync((char*)d_ws + MiB, run ? 0x55 : 0xAA, WS_END - MiB, stream);
        for (int p = 0; p < 2; ++p) { a.ph_lo = p; a.ph_hi = p + 1; hipLaunchKernelGGL(fwd_kernel, dim3(grid), dim3(NWAVES * 64), LDS_BYTES, stream, a); }
        hipLaunchKernelGGL(zsum_kernel, dim3(2048), dim3(256), 0, stream, (const unsigned char*)d_ws, cs + 8 * run);
    }
    a.ph_lo = 1; a.ph_hi = 2; hipLaunchKernelGGL(fwd_kernel, dim3(grid), dim3(NWAVES * 64), LDS_BYTES, stream, a);
    hipLaunchKernelGGL(zsum_kernel, dim3(2048), dim3(256), 0, stream, (const unsigned char*)d_ws, cs + 16);
    hipLaunchKernelGGL(encode3_kernel, dim3(2048), dim3(256), 0, stream, (float*)d_out, (const unsigned*)cs);
#elif MK_PER_PHASE == 2
    unsigned* cs = (unsigned*)((char*)d_ws + 512 * 1024);
    for (int run = 0; run < 2; ++run) {
        hipMemsetAsync((char*)d_ws + MiB, run ? 0x55 : 0xAA, WS_END - MiB, stream); hipMemsetAsync(d_out, run ? 0x55 : 0xAA, (size_t)S * DM * 4, stream);
        for (int p = 0; p < N_PHASES; ++p) { a.ph_lo = p; a.ph_hi = p + 1; hipLaunchKernelGGL(fwd_kernel, dim3(grid), dim3(NWAVES * 64), LDS_BYTES, stream, a);
            CsRange r0{0, 0}, r1{0, 0}, r2{0, 0}; int uo = 0;
            switch (p) {
                case 0: r0 = {WS_COS, 2 * MiB}; r1 = {WS_WIN, WS_O - WS_WIN}; break;
                case 1: r0 = {WS_Z, 252 * MiB}; r1 = {WS_SSQC, (size_t)S * 24 * 4}; break;
                case 2: r0 = {WS_QM, 112 * MiB}; break;
                case 3: r0 = {WS_O, 64 * MiB}; r1 = {WS_O1, 64 * MiB}; break;
                case 4: r0 = {WS_H, 64 * MiB}; r1 = {WS_T1, 128 * MiB}; break;
                case 5: r0 = {WS_X1, 128 * MiB}; r1 = {WS_O, 64 * MiB}; r2 = {WS_SSQ1, 2 * MiB}; break;
                case 6: r0 = {WS_U, 344 * MiB}; r1 = {WS_RSTD1, (size_t)S * 4}; break;
                case 7: r0 = {WS_ACT, 172 * MiB}; break;
                case 8: r0 = {WS_SSQ2, 2 * MiB}; uo = 1; break;
                default: uo = 1; break;
            }
            hipLaunchKernelGGL(csum_kernel, dim3(2048), dim3(256), 0, stream, (const unsigned char*)d_ws, (const float*)d_out, cs + 32 * run + 2 * p, r0, r1, r2, uo);
        }
    }
    hipLaunchKernelGGL(encode_kernel, dim3(2048), dim3(256), 0, stream, (float*)d_out, (const unsigned*)cs);
#elif MK_PER_PHASE
    for (int p = 0; p < N_PHASES; ++p) { a.ph_lo = p; a.ph_hi = p + 1; hipLaunchKernelGGL(fwd_kernel, dim3(grid), dim3(NWAVES * 64), LDS_BYTES, stream, a); }
#else
    a.ph_lo = 0; a.ph_hi = N_PHASES;
    hipLaunchKernelGGL(fwd_kernel, dim3(grid), dim3(NWAVES * 64), LDS_BYTES, stream, a);
#endif
    const hipError_t le = hipPeekAtLastError();
    if (le != hipSuccess) fprintf(stderr, "kernel_launch: launch failed: %s\n", hipGetErrorName(le));
}
```

```cpp
#include <hip/hip_runtime.h>
#include <hip/hip_bf16.h>
#include <cstdio>
#include <cstdint>

#ifndef MK_PER_PHASE
#define MK_PER_PHASE 0
#endif

constexpr int S = 8192, DM = 4096, NHEAD = 16;
constexpr int INW = 15936, ZW = 16128;
constexpr int ZC_QD = 0, ZC_KD = 2048, ZC_VD = 4096, ZC_CQ = 6144, ZC_CKV = 7168, ZC_KR = 7680, ZC_GD = 7936, ZC_GM = 12032;
constexpr int QRANK = 1024, KVRANK = 512;
constexpr int QMW = 3072, KVW = 4096;
constexpr int DFF = 11008, UPW = 22016;
constexpr float NORM_EPS = 1e-6f, SUBLN_EPS = 1e-5f, LAMBDA_INIT = 0.2f;

#define GAS __attribute__((address_space(1)))
#define LAS __attribute__((address_space(3)))
typedef unsigned short bf16;
typedef unsigned v4u __attribute__((ext_vector_type(4)));
typedef unsigned v2u __attribute__((ext_vector_type(2)));
typedef GAS unsigned gu32;
#define RLX_AGENT __ATOMIC_RELAXED, __HIP_MEMORY_SCOPE_AGENT
#define LDS_WAIT() asm volatile("s_waitcnt lgkmcnt(0)" ::: "memory")
#define VM_WAIT() asm volatile("s_waitcnt vmcnt(0)" ::: "memory")

namespace pg8 {
#define PG8_LAS __attribute__((address_space(3)))
typedef unsigned short bf16_t;
typedef short bf16x8 __attribute__((ext_vector_type(8)));
typedef float f32x4 __attribute__((ext_vector_type(4)));
typedef unsigned u32x4 __attribute__((ext_vector_type(4)));
constexpr int BM = 256, BK = 64, HALF = 128, HTB = HALF * BK * 2, STAGE_BYTES = 8 * HTB, NXCD = 8, WGM = 8;

__host__ __device__ __forceinline__ int lds_byte(int r, int c) { const int st = (r >> 4) * 2 + (c >> 5), rr = r & 15, cc = c & 31, ob = rr * 64 + cc * 2; return st * 1024 + (ob ^ (((ob >> 9) & 1) << 5)); }
__host__ __device__ __forceinline__ void stage_rc(int b, int& R, int& C) { const int st = b / 1024, sb = b % 1024, swz = sb ^ (((sb >> 9) & 1) << 5); R = (st >> 1) * 16 + swz / 64; C = (st & 1) * 32 + (swz % 64) / 2; }
__host__ __device__ __forceinline__ int perm32(int rho) { const int n = rho >> 4, i = rho & 15; return 8 * (i >> 2) + 4 * n + (i & 3); }

struct Unit { int pm, pn; };
typedef int v8i32g __attribute__((ext_vector_type(8))); typedef int v4i32g __attribute__((ext_vector_type(4)));
struct Gemm { const bf16_t* A; const bf16_t* Bt; int M, N, K, lda, ldb; };

struct StaticOrder {
    int nM, nN, nwg, G, c;
    __host__ __device__ void init(int M, int N, int G_, int c_) { nM = M / BM; nN = N / BM; nwg = nM * nN; G = G_; c = c_; }
    __host__ __device__ __forceinline__ bool next(int i, Unit& u) const {
        const long L = (long)i * G + c; if (L >= nwg) return false;
        int wgid = (int)L; { const int q = nwg / NXCD, r = nwg % NXCD, xcd = wgid % NXCD, off = wgid / NXCD; wgid = (xcd < r ? xcd * (q + 1) : r * (q + 1) + (xcd - r) * q) + off; }
        const int nig = WGM * nN, gid = wgid / nig, fm = gid * WGM, gsz = (nM - fm) < WGM ? (nM - fm) : WGM;
        u.pm = fm + ((wgid % nig) % gsz); u.pn = (wgid % nig) / gsz; return true;
    }
    __device__ __forceinline__ void a_ready(const Unit&) const {}
    __device__ __forceinline__ void done(const Unit&) const {}
};

typedef float f32x2_t __attribute__((ext_vector_type(2))); typedef __bf16 bf16x2_t __attribute__((ext_vector_type(2)));
__device__ __forceinline__ unsigned cvt_pk_bf16(float lo, float hi) { f32x2_t v = {lo, hi}; bf16x2_t b = __builtin_convertvector(v, bf16x2_t); return __builtin_bit_cast(unsigned, b); }
__device__ __forceinline__ u32x4 pack8(f32x4 a, f32x4 b) { u32x4 w; w.x = cvt_pk_bf16(a[0], a[1]); w.y = cvt_pk_bf16(a[2], a[3]); w.z = cvt_pk_bf16(b[0], b[1]); w.w = cvt_pk_bf16(b[2], b[3]); return w; }
__device__ __forceinline__ void unpack8(u32x4 w, f32x4& a, f32x4& b) {
    a[0] = __uint_as_float(w.x << 16); a[1] = __uint_as_float(w.x & 0xffff0000u); a[2] = __uint_as_float(w.y << 16); a[3] = __uint_as_float(w.y & 0xffff0000u);
    b[0] = __uint_as_float(w.z << 16); b[1] = __uint_as_float(w.z & 0xffff0000u); b[2] = __uint_as_float(w.w << 16); b[3] = __uint_as_float(w.w & 0xffff0000u); }
__device__ __forceinline__ unsigned pk4_fp8(const f32x4 v) { int w = __builtin_amdgcn_cvt_pk_fp8_f32(v[0], v[1], 0, false); w = __builtin_amdgcn_cvt_pk_fp8_f32(v[2], v[3], w, true); return (unsigned)w; }
__device__ __forceinline__ unsigned pk4_i8(const f32x4 v) { unsigned w = 0;
#pragma unroll
    for (int e = 0; e < 4; ++e) { const int q = (int)__builtin_rintf(__builtin_fminf(__builtin_fmaxf(v[e], -127.f), 127.f)); w |= ((unsigned)q & 0xffu) << (8 * e); } return w; }
__device__ __forceinline__ float sigmoidf_fast(float v) { return __builtin_amdgcn_rcpf(1.0f + __builtin_amdgcn_exp2f(-1.4426950408889634f * v)); }
__device__ __forceinline__ void rope8(f32x4& v0, f32x4& v1, const f32x4 c4, const f32x4 s4) {
    const f32x4 a = v0, b = v1;
    v0[0] = a[0] * c4[0] - a[1] * s4[0]; v0[1] = a[1] * c4[0] + a[0] * s4[0]; v0[2] = a[2] * c4[1] - a[3] * s4[1]; v0[3] = a[3] * c4[1] + a[2] * s4[1];
    v1[0] = b[0] * c4[2] - b[1] * s4[2]; v1[1] = b[1] * c4[2] + b[0] * s4[2]; v1[2] = b[2] * c4[3] - b[3] * s4[3]; v1[3] = b[3] * c4[3] + b[2] * s4[3];
}
__device__ __forceinline__ float sumsq8(const f32x4 a, const f32x4 b) { return (a[0] * a[0] + a[1] * a[1]) + (a[2] * a[2] + a[3] * a[3]) + (b[0] * b[0] + b[1] * b[1]) + (b[2] * b[2] + b[3] * b[3]); }

#define EPI_ROWS(ai, m) _Pragma("unroll") for (int ai = 0; ai < 2; ++ai) _Pragma("unroll") for (int m = 0; m < 4; ++m)

typedef unsigned u32x2w __attribute__((ext_vector_type(2)));
struct EpiIn {
    static constexpr bool PERM = true, AFTER_DRAIN = false;
    bf16_t* Z; const float* cosT; const float* sinT; float* ssq; unsigned char* KR8;
    __device__ __forceinline__ void operator()(f32x4 (&acc)[2][2][4][2], const Unit& u, int wr, int wc, int fr, int fq) const {
        const int pn = u.pn, row0 = u.pm * BM + wr * 64 + fr, col0 = pn * BM + wc * 32 + 8 * fq;
        if (pn < 16 || pn == 30) {
            const int i0 = 16 * (wc & 1) + 4 * fq; const float qsc = (pn < 8) ? 0.18033688011112042f : 1.0f;
            EPI_ROWS(ai, m) { const int r = row0 + ai * HALF + m * 16; const f32x4 c4 = *(const f32x4*)(cosT + (size_t)r * 32 + i0), s4 = *(const f32x4*)(sinT + (size_t)r * 32 + i0);
                bf16_t* rowp = Z + (size_t)r * ZW + col0;
#pragma unroll
                for (int bj = 0; bj < 2; ++bj) { f32x4 v0 = acc[ai][bj][m][0], v1 = acc[ai][bj][m][1]; rope8(v0, v1, c4, s4); v0 *= qsc; v1 *= qsc; *(u32x4*)(rowp + bj * HALF) = pack8(v0, v1);
                    if (pn == 30 && bj == 0 && wc < 2) { u32x2w w8; w8.x = pk4_fp8(v0); w8.y = pk4_fp8(v1); *(u32x2w*)(KR8 + (size_t)r * 64 + wc * 32 + 8 * fq) = w8; } } }
        } else if (pn < 24) {
            EPI_ROWS(ai, m) { const int r = row0 + ai * HALF + m * 16; bf16_t* rowp = Z + (size_t)r * ZW + col0;
#pragma unroll
                for (int bj = 0; bj < 2; ++bj) *(u32x4*)(rowp + bj * HALF) = pack8(acc[ai][bj][m][0], acc[ai][bj][m][1]); }
        } else if (pn < 30) {
            EPI_ROWS(ai, m) { const int r = row0 + ai * HALF + m * 16; bf16_t* rowp = Z + (size_t)r * ZW + col0; float ss = 0.f;
#pragma unroll
                for (int bj = 0; bj < 2; ++bj) { ss += sumsq8(acc[ai][bj][m][0], acc[ai][bj][m][1]); *(u32x4*)(rowp + bj * HALF) = pack8(acc[ai][bj][m][0], acc[ai][bj][m][1]); }
                ss += __shfl_xor(ss, 16); ss += __shfl_xor(ss, 32);
                if (fq == 0) ssq[(size_t)r * 24 + (pn - 24) * 4 + wc] = ss; }
        } else {
            EPI_ROWS(ai, m) { const int r = row0 + ai * HALF + m * 16; bf16_t* rowp = Z + (size_t)r * ZW + col0;
#pragma unroll
                for (int bj = 0; bj < 2; ++bj) { f32x4 v0 = acc[ai][bj][m][0], v1 = acc[ai][bj][m][1];
#pragma unroll
                    for (int e = 0; e < 4; ++e) { v0[e] = sigmoidf_fast(v0[e]); v1[e] = sigmoidf_fast(v1[e]); }
                    *(u32x4*)(rowp + bj * HALF) = pack8(v0, v1); } }
        }
    }
};

struct EpiInMla {
    static constexpr bool PERM = true, AFTER_DRAIN = false;
    bf16_t* Z; const float* cosT; const float* sinT; float* ssq; unsigned char* KR8;
    __device__ __forceinline__ void operator()(f32x4 (&acc)[2][2][4][2], const Unit& u, int wr, int wc, int fr_, int fq_) const {
        int opq = 0; asm volatile("" : "+v"(opq));
        const int fr = fr_ + opq, fq = fq_ + opq;
        const int pn = u.pn, row0 = u.pm * BM + wr * 64 + fr, col0 = pn * BM + wc * 32 + 8 * fq;
        if (pn == 30) {
            const int i0 = 16 * (wc & 1) + 4 * fq;
            EPI_ROWS(ai, m) { const int r = row0 + ai * HALF + m * 16; const f32x4 c4 = *(const f32x4*)(cosT + (size_t)r * 32 + i0), s4 = *(const f32x4*)(sinT + (size_t)r * 32 + i0);
                bf16_t* rowp = Z + (size_t)r * ZW + col0;
#pragma unroll
                for (int bj = 0; bj < 2; ++bj) { f32x4 v0 = acc[ai][bj][m][0], v1 = acc[ai][bj][m][1]; rope8(v0, v1, c4, s4); *(u32x4*)(rowp + bj * HALF) = pack8(v0, v1);
                    if (bj == 0 && wc < 2) { u32x2w w8; w8.x = pk4_fp8(v0); w8.y = pk4_fp8(v1); *(u32x2w*)(KR8 + (size_t)r * 64 + wc * 32 + 8 * fq) = w8; } } }
        } else {
            EPI_ROWS(ai, m) { const int r = row0 + ai * HALF + m * 16; bf16_t* rowp = Z + (size_t)r * ZW + col0; float ss = 0.f;
#pragma unroll
                for (int bj = 0; bj < 2; ++bj) { ss += sumsq8(acc[ai][bj][m][0], acc[ai][bj][m][1]); *(u32x4*)(rowp + bj * HALF) = pack8(acc[ai][bj][m][0], acc[ai][bj][m][1]); }
                ss += __builtin_bit_cast(float, __builtin_amdgcn_ds_swizzle(__builtin_bit_cast(int, ss), 0x401F));
                { auto rr = __builtin_amdgcn_permlane32_swap(__builtin_bit_cast(unsigned, ss), __builtin_bit_cast(unsigned, ss), false, false); ss = __builtin_bit_cast(float, rr[0]) + __builtin_bit_cast(float, rr[1]); }
                if (fq == 0) ssq[(size_t)r * 24 + (pn - 24) * 4 + wc] = ss; }
        }
    }
};

struct EpiIn8 {
    static constexpr bool PERM = true, AFTER_DRAIN = false;
    bf16_t* Z; const float* cosT; const float* sinT; float* ssq; unsigned char* KR8; const float* hsc; const float* wmx;
    __device__ __forceinline__ void operator()(f32x4 (&acc)[2][2][4][2], const Unit& u, int wr, int wc, int fr_, int fq_) const {
        int opq = 0; asm volatile("" : "+v"(opq));
        const int fr = fr_ + opq, fq = fq_ + opq;
        const int pn = u.pn, row0 = u.pm * BM + wr * 64 + fr, col0 = pn * BM + wc * 32 + 8 * fq;
        f32x4 ws0[2], ws1[2];
#pragma unroll
        for (int bj = 0; bj < 2; ++bj) { const float* wp = wmx + (col0 - ZC_CQ) + bj * HALF; ws0[bj] = *(const f32x4*)wp * (1.0f / 127.0f); ws1[bj] = *(const f32x4*)(wp + 4) * (1.0f / 127.0f); }
        if (pn >= 31) {
            EPI_ROWS(ai, m) { const int r = row0 + ai * HALF + m * 16; bf16_t* rowp = Z + (size_t)r * ZW + col0; const float dq = hsc[r];
#pragma unroll
                for (int bj = 0; bj < 2; ++bj) { f32x4 v0 = acc[ai][bj][m][0] * (ws0[bj] * dq), v1 = acc[ai][bj][m][1] * (ws1[bj] * dq);
#pragma unroll
                    for (int e = 0; e < 4; ++e) { v0[e] = sigmoidf_fast(v0[e]); v1[e] = sigmoidf_fast(v1[e]); }
                    *(u32x4*)(rowp + bj * HALF) = pack8(v0, v1); } }
        } else if (pn == 30) {
            const int i0 = 16 * (wc & 1) + 4 * fq;
            EPI_ROWS(ai, m) { const int r = row0 + ai * HALF + m * 16; const float dq = hsc[r]; const f32x4 c4 = *(const f32x4*)(cosT + (size_t)r * 32 + i0), s4 = *(const f32x4*)(sinT + (size_t)r * 32 + i0);
                bf16_t* rowp = Z + (size_t)r * ZW + col0;
#pragma unroll
                for (int bj = 0; bj < 2; ++bj) { f32x4 v0 = acc[ai][bj][m][0] * (ws0[bj] * dq), v1 = acc[ai][bj][m][1] * (ws1[bj] * dq); rope8(v0, v1, c4, s4); *(u32x4*)(rowp + bj * HALF) = pack8(v0, v1);
                    if (bj == 0 && wc < 2) { u32x2w w8; w8.x = pk4_fp8(v0); w8.y = pk4_fp8(v1); *(u32x2w*)(KR8 + (size_t)r * 64 + wc * 32 + 8 * fq) = w8; } } }
        } else {
            EPI_ROWS(ai, m) { const int r = row0 + ai * HALF + m * 16; const float dq = hsc[r]; bf16_t* rowp = Z + (size_t)r * ZW + col0; float ss = 0.f;
#pragma unroll
                for (int bj = 0; bj < 2; ++bj) { const f32x4 v0 = acc[ai][bj][m][0] * (ws0[bj] * dq), v1 = acc[ai][bj][m][1] * (ws1[bj] * dq); ss += sumsq8(v0, v1); *(u32x4*)(rowp + bj * HALF) = pack8(v0, v1); }
                ss += __shfl_xor(ss, 16); ss += __shfl_xor(ss, 32);
                if (fq == 0) ssq[(size_t)r * 24 + (pn - 24) * 4 + wc] = ss; }
        }
    }
};

struct EpiInGate {
    static constexpr bool PERM = true, AFTER_DRAIN = false;
    bf16_t* Z; const float* hsc; const float* wmx;
    __device__ __forceinline__ void operator()(f32x4 (&acc)[2][2][4][2], const Unit& u, int wr, int wc, int fr_, int fq_) const {
        int opq = 0; asm volatile("" : "+v"(opq));
        const int fr = fr_ + opq, fq = fq_ + opq;
        const int row0 = u.pm * BM + wr * 64 + fr, col0 = u.pn * BM + wc * 32 + 8 * fq;
        f32x4 ws0[2], ws1[2];
#pragma unroll
        for (int bj = 0; bj < 2; ++bj) { const float* wp = wmx + (col0 - ZC_GD) + bj * HALF; ws0[bj] = *(const f32x4*)wp * (1.0f / 127.0f); ws1[bj] = *(const f32x4*)(wp + 4) * (1.0f / 127.0f); }
        EPI_ROWS(ai, m) { const int r = row0 + ai * HALF + m * 16; bf16_t* rowp = Z + (size_t)r * ZW + col0; const float dq = hsc[r];
#pragma unroll
            for (int bj = 0; bj < 2; ++bj) { f32x4 v0 = acc[ai][bj][m][0] * (ws0[bj] * dq), v1 = acc[ai][bj][m][1] * (ws1[bj] * dq);
#pragma unroll
                for (int e = 0; e < 4; ++e) { v0[e] = sigmoidf_fast(v0[e]); v1[e] = sigmoidf_fast(v1[e]); }
                *(u32x4*)(rowp + bj * HALF) = pack8(v0, v1); } }
    }
};

template <int SLOT0, int NP4, int KDIM, int F8_BELOW> struct EpiMla {
    static constexpr bool PERM = true, AFTER_DRAIN = false;
    bf16_t* O; int ldc; const float* ssq; const float* cosT; const float* sinT; int rope_from; unsigned char* O8; int ld8;
    __device__ __forceinline__ void operator()(f32x4 (&acc)[2][2][4][2], const Unit& u, int wr, int wc, int fr, int fq) const {
        const int pn = u.pn, row0 = u.pm * BM + wr * 64 + fr, col0 = pn * BM + wc * 32 + 8 * fq, i0 = 16 * (wc & 1) + 4 * fq;
        const bool rope = pn >= rope_from;
        EPI_ROWS(ai, m) { const int r = row0 + ai * HALF + m * 16; float ss = 0.f;
#pragma unroll
            for (int q = 0; q < NP4; ++q) { const f32x4 p = *(const f32x4*)(ssq + (size_t)r * 24 + SLOT0 + 4 * q); ss += (p[0] + p[1]) + (p[2] + p[3]); }
            const float rs = __builtin_amdgcn_rsqf(ss * (1.0f / KDIM) + NORM_EPS);
            f32x4 c4 = {1.f, 1.f, 1.f, 1.f}, s4 = {0.f, 0.f, 0.f, 0.f};
            if (rope) { c4 = *(const f32x4*)(cosT + (size_t)r * 32 + i0); s4 = *(const f32x4*)(sinT + (size_t)r * 32 + i0); }
            bf16_t* rowp = O + (size_t)r * ldc + col0;
#pragma unroll
            for (int bj = 0; bj < 2; ++bj) { f32x4 v0 = acc[ai][bj][m][0] * rs, v1 = acc[ai][bj][m][1] * rs; if (rope) rope8(v0, v1, c4, s4);
                if (pn < F8_BELOW) { u32x2w w8; w8.x = pk4_fp8(v0); w8.y = pk4_fp8(v1); *(u32x2w*)(O8 + (size_t)r * ld8 + col0 + bj * HALF) = w8; }
                else *(u32x4*)(rowp + bj * HALF) = pack8(v0, v1); } }
    }
};

struct GateHook {
    static constexpr bool ENABLED = true;
    const bf16_t* GD; const bf16_t* GM;
    __device__ __forceinline__ void operator()(f32x4 (&acc)[2][2][4][2], const Unit& u, int wr, int wc, int fr, int fq) const {
        int opq = 0; asm volatile("" : "+v"(opq));
        const int row0 = u.pm * BM + wr * 64 + fr + opq, col0 = u.pn * BM + wc * 32 + 8 * fq;
        EPI_ROWS(ai, m) { const size_t ro = (size_t)(row0 + ai * HALF + m * 16) * ZW + col0;
#pragma unroll
            for (int bj = 0; bj < 2; ++bj) { f32x4 d0, d1, m0, m1; unpack8(*(const u32x4*)(GD + ro + bj * HALF), d0, d1); unpack8(*(const u32x4*)(GM + ro + bj * HALF), m0, m1);
#pragma unroll
                for (int e = 0; e < 4; ++e) { acc[ai][bj][m][0][e] *= d0[e] * __builtin_amdgcn_rcpf(fmaxf(m0[e], 1e-20f)); acc[ai][bj][m][1][e] *= d1[e] * __builtin_amdgcn_rcpf(fmaxf(m1[e], 1e-20f)); } }
            asm volatile("" : "+v"(acc[ai][0][m][0]), "+v"(acc[ai][0][m][1]), "+v"(acc[ai][1][m][0]), "+v"(acc[ai][1][m][1]) :: "memory"); }
    }
};
struct EpiGate {
    static constexpr bool PERM = true, AFTER_DRAIN = false;
    const bf16_t* GM; bf16_t* Y;
    __device__ __forceinline__ void operator()(f32x4 (&acc)[2][2][4][2], const Unit& u, int wr, int wc, int fr, int fq) const {
        const int row0 = u.pm * BM + wr * 64 + fr, col0 = u.pn * BM + wc * 32 + 8 * fq;
        EPI_ROWS(ai, m) { const int r = row0 + ai * HALF + m * 16;
#pragma unroll
            for (int bj = 0; bj < 2; ++bj) { const int c = col0 + bj * HALF; f32x4 g0, g1; unpack8(*(const u32x4*)(GM + (size_t)r * ZW + c), g0, g1);
                *(u32x4*)(Y + (size_t)r * DM + c) = pack8(acc[ai][bj][m][0] * g0, acc[ai][bj][m][1] * g1); } }
    }
};

template <bool RES_BF16> struct EpiRes {
    static constexpr bool PERM = true, AFTER_DRAIN = false;
    const float* xi; bf16_t* xb; float* ssq;
    __device__ __forceinline__ void operator()(f32x4 (&acc)[2][2][4][2], const Unit& u, int wr, int wc, int fr, int fq) const {
        const int row0 = u.pm * BM + wr * 64 + fr, col0 = u.pn * BM + wc * 32 + 8 * fq;
        EPI_ROWS(ai, m) { const int r = row0 + ai * HALF + m * 16; float ss = 0.f;
#pragma unroll
            for (int bj = 0; bj < 2; ++bj) { const size_t off = (size_t)r * DM + col0 + bj * HALF; f32x4 r0, r1;
                if (RES_BF16) unpack8(*(const u32x4*)(xb + off), r0, r1); else { r0 = *(const f32x4*)(xi + off); r1 = *(const f32x4*)(xi + off + 4); }
                const f32x4 v0 = acc[ai][bj][m][0] + r0, v1 = acc[ai][bj][m][1] + r1;
                *(u32x4*)(xb + off) = pack8(v0, v1); ss += sumsq8(v0, v1); }
            ss += __shfl_xor(ss, 16); ss += __shfl_xor(ss, 32);
            if (fq == 0) ssq[(size_t)r * 64 + u.pn * 4 + wc] = ss; }
    }
};

struct EpiPlain {
    static constexpr bool PERM = true, AFTER_DRAIN = false;
    bf16_t* O; int ldc;
    __device__ __forceinline__ void operator()(f32x4 (&acc)[2][2][4][2], const Unit& u, int wr, int wc, int fr, int fq) const {
        const int row0 = u.pm * BM + wr * 64 + fr, col0 = u.pn * BM + wc * 32 + 8 * fq;
        EPI_ROWS(ai, m) { bf16_t* rowp = O + (size_t)(row0 + ai * HALF + m * 16) * ldc + col0;
#pragma unroll
            for (int bj = 0; bj < 2; ++bj) *(u32x4*)(rowp + bj * HALF) = pack8(acc[ai][bj][m][0], acc[ai][bj][m][1]); }
    }
};

__device__ __forceinline__ float dpp_shr1(float old, float src) { return __int_as_float(__builtin_amdgcn_update_dpp(__float_as_int(old), __float_as_int(src), 0x111, 0xf, 0xf, false)); }
__device__ __forceinline__ float dpp_shr2(float old, float src) { return __int_as_float(__builtin_amdgcn_update_dpp(__float_as_int(old), __float_as_int(src), 0x112, 0xf, 0xf, false)); }
__device__ __forceinline__ float dpp_ror1(float src) { return __int_as_float(__builtin_amdgcn_update_dpp(0, __float_as_int(src), 0x121, 0xf, 0xf, false)); }
__device__ __forceinline__ float dpp_ror2(float src) { return __int_as_float(__builtin_amdgcn_update_dpp(0, __float_as_int(src), 0x122, 0xf, 0xf, false)); }
typedef unsigned u32x2 __attribute__((ext_vector_type(2)));
struct EpiUpConv {
    static constexpr bool PERM = true, AFTER_DRAIN = false;
    bf16_t* ACT; float* HALO; const float* cw; const float* cb; const float* rstd; PG8_LAS float* xch; const float* wmx;
    static constexpr int UPW_ = 22016, DFF_ = 11008;
    __device__ __forceinline__ void operator()(f32x4 (&acc)[2][2][4][2], const Unit& u, int wr, int wc, int fr_, int fq_) const {
        int opq = 0; asm volatile("" : "+v"(opq));
        const int fr = fr_ + opq, fq = fq_ + opq;
        const int row0 = u.pm * BM + wr * 64 + fr;
        EPI_ROWS(ai, m) { const float rs = rstd[row0 + ai * HALF + m * 16];
#pragma unroll
            for (int bj = 0; bj < 2; ++bj) { acc[ai][bj][m][0] *= rs; acc[ai][bj][m][1] *= rs; } }
        const size_t hcol = (size_t)u.pn * BM + wc * 32 + 8 * fq;
        if (fr >= 14) {
#pragma unroll
            for (int ai = 0; ai < 2; ++ai) { const int ch = ai * 2 + wr; PG8_LAS float* xp = xch + ((((ch * 2 + (fr - 14)) * 4 + wc) * 4 + fq) * 16);
#pragma unroll
                for (int bj = 0; bj < 2; ++bj) { *(PG8_LAS f32x4*)(xp + bj * 8) = acc[ai][bj][3][0]; *(PG8_LAS f32x4*)(xp + bj * 8 + 4) = acc[ai][bj][3][1]; } }
            if (wr == 1) { float* hp = HALO + ((size_t)u.pm * 4 + 2 + (fr - 14)) * UPW_ + hcol;
#pragma unroll
                for (int bj = 0; bj < 2; ++bj) { *(f32x4*)(hp + bj * HALF) = acc[1][bj][3][0]; *(f32x4*)(hp + bj * HALF + 4) = acc[1][bj][3][1]; } }
        }
        if (fr < 2 && wr == 0) { float* hp = HALO + ((size_t)u.pm * 4 + fr) * UPW_ + hcol;
#pragma unroll
            for (int bj = 0; bj < 2; ++bj) { *(f32x4*)(hp + bj * HALF) = acc[0][bj][0][0]; *(f32x4*)(hp + bj * HALF + 4) = acc[0][bj][0][1]; } }
        PG8_LAS float* wl = xch + 2048;
        { const int tq = threadIdx.x + opq, k = tq >> 6, c2 = (tq & 63) * 2, tap = k & 3; const size_t gc = (size_t)u.pn * 128 + c2 + ((k >> 2) ? DFF_ : 0);
          const float* src = (tap < 3) ? cw + (size_t)tap * UPW_ + gc : cb + gc;
          f32x2_t t = *(const f32x2_t*)src; if (tap < 3) { const float* wsp = wmx + (size_t)u.pn * BM + (k >> 2) * HALF + c2; t[0] *= wsp[0] * (1.0f / 127.0f); t[1] *= wsp[1] * (1.0f / 127.0f); }
          *(PG8_LAS f32x2_t*)(wl + k * 128 + c2) = t; }
        asm volatile("s_waitcnt lgkmcnt(0)\n\ts_barrier" ::: "memory");
        const int c0 = u.pn * 128 + wc * 32 + 8 * fq; const PG8_LAS float* wlp = wl + wc * 32 + 8 * fq;
#pragma unroll
        for (int ai = 0; ai < 2; ++ai) {
            const int ch = ai * 2 + wr;
            f32x4 pgn[2], pvn[2];
#pragma unroll
            for (int m = 0; m < 4; ++m) {
                u32x2 keep;
#pragma unroll
                for (int n = 0; n < 2; ++n) {
                    const PG8_LAS float* wp = wlp + 4 * n;
                    const f32x4 wg0 = *(const PG8_LAS f32x4*)(wp), wg1 = *(const PG8_LAS f32x4*)(wp + 128), wg2 = *(const PG8_LAS f32x4*)(wp + 256), bg = *(const PG8_LAS f32x4*)(wp + 384);
                    const f32x4 wv0 = *(const PG8_LAS f32x4*)(wp + 512), wv1 = *(const PG8_LAS f32x4*)(wp + 640), wv2 = *(const PG8_LAS f32x4*)(wp + 768), bv = *(const PG8_LAS f32x4*)(wp + 896);
                    const f32x4 xg = acc[ai][0][m][n], xv = acc[ai][1][m][n]; f32x4 p1g, p2g, p1v, p2v;
                    if (m == 0) {
                        f32x4 h1g = {0.f, 0.f, 0.f, 0.f}, h2g = h1g, h1v = h1g, h2v = h1g;
                        if (ch > 0) { const PG8_LAS float* xp = xch + (((((ch - 1) * 2) * 4 + wc) * 4 + fq) * 16) + 4 * n;
                            h2g = *(const PG8_LAS f32x4*)xp; h2v = *(const PG8_LAS f32x4*)(xp + 8); h1g = *(const PG8_LAS f32x4*)(xp + 256); h1v = *(const PG8_LAS f32x4*)(xp + 256 + 8); }
#pragma unroll
                        for (int e = 0; e < 4; ++e) { p1g[e] = dpp_shr1(h1g[e], xg[e]); p2g[e] = dpp_shr2(fr == 1 ? h1g[e] : h2g[e], xg[e]); p1v[e] = dpp_shr1(h1v[e], xv[e]); p2v[e] = dpp_shr2(fr == 1 ? h1v[e] : h2v[e], xv[e]); }
                    } else {
#pragma unroll
                        for (int e = 0; e < 4; ++e) { p1g[e] = dpp_shr1(dpp_ror1(pgn[n][e]), xg[e]); p2g[e] = dpp_shr2(dpp_ror2(pgn[n][e]), xg[e]); p1v[e] = dpp_shr1(dpp_ror1(pvn[n][e]), xv[e]); p2v[e] = dpp_shr2(dpp_ror2(pvn[n][e]), xv[e]); }
                    }
                    f32x4 og = bg + wg0 * p2g + wg1 * p1g + wg2 * xg; const f32x4 ov = bv + wv0 * p2v + wv1 * p1v + wv2 * xv;
#pragma unroll
                    for (int e = 0; e < 4; ++e) og[e] = og[e] * sigmoidf_fast(og[e]) * ov[e];
                    u32x2 w; w.x = cvt_pk_bf16(og[0], og[1]); w.y = cvt_pk_bf16(og[2], og[3]);
                    if (n == 0) keep = w; else *(u32x4*)(ACT + (size_t)(row0 + ai * HALF + m * 16) * DFF_ + c0) = (u32x4){keep.x, keep.y, w.x, w.y};
                    pgn[n] = xg; pvn[n] = xv;
                }
                __builtin_amdgcn_sched_barrier(0);
            }
        }
    }
};

struct BalOrder {
    StaticOrder so; int c, G;
    __host__ __device__ void init(int M, int N, int G_, int c_) { so.init(M, N, 1, 0); c = c_; G = G_; }
    __host__ __device__ bool next(int i, Unit& u) const {
        int L;
        if (G != 256 || so.nwg != 512) { L = i * G + c; if (L >= so.nwg) return false; }
        else if (c < 128) { if (i >= 1) return false; L = c; }
        else { if (i >= 3) return false; L = 128 + 3 * (c - 128) + i; }
        return so.next(L, u);
    }
    __device__ __forceinline__ void a_ready(const Unit&) const {}
    __device__ __forceinline__ void done(const Unit&) const {}
};
struct VtOrder {
    int c, G;
    __device__ __forceinline__ bool next(int i, Unit& u) const {
        int L;
        if (G != 256) { L = i * G + c; if (L >= 256) return false; }
        else { if (c < 128 || i >= 2) return false; L = 2 * (c - 128) + i; }
        u.pm = L >> 5; u.pn = L & 31; return true;
    }
    __device__ __forceinline__ void a_ready(const Unit&) const {}
    __device__ __forceinline__ void done(const Unit&) const {}
};
struct EpiVT {
    static constexpr bool PERM = true, AFTER_DRAIN = false;
    unsigned char* VT; const float* ssq; int npos;
    __device__ __forceinline__ void operator()(f32x4 (&acc)[2][2][4][2], const Unit& u, int wr, int wc, int fr_, int fq_) const {
        int opq = 0; asm volatile("" : "+v"(opq));
        const int fr = fr_ + opq, fq = fq_ + opq;
        const int row0 = u.pm * BM + wr * 64 + fr, t0 = u.pn * BM + wc * 32 + 8 * fq;
#pragma unroll
        for (int bj = 0; bj < 2; ++bj) {
            const int tb = t0 + bj * HALF, k0 = tb & 63; const size_t pos = (size_t)(tb & ~63) + 16 * ((k0 >> 5) & 1) + 4 * ((k0 >> 3) & 3);
            f32x4 rs0, rs1;
#pragma unroll
            for (int e = 0; e < 8; ++e) { const float* sp = ssq + (size_t)(tb + e) * 24 + 16; const f32x4 p = *(const f32x4*)sp, q = *(const f32x4*)(sp + 4);
                const float r = __builtin_amdgcn_rsqf(((p[0] + p[1]) + (p[2] + p[3]) + (q[0] + q[1]) + (q[2] + q[3])) * (1.0f / KVRANK_) + NORM_EPS_);
                if (e < 4) rs0[e] = r; else rs1[e - 4] = r; }
            EPI_ROWS(ai, m) { unsigned char* rowp = VT + (size_t)(row0 + ai * HALF + m * 16) * npos + pos;
                *(unsigned*)rowp = pk4_fp8(acc[ai][bj][m][0] * rs0); *(unsigned*)(rowp + 32) = pk4_fp8(acc[ai][bj][m][1] * rs1); }
        }
    }
    static constexpr float KVRANK_ = 512.0f, NORM_EPS_ = 1e-6f;
};
struct SkipOrder {
    StaticOrder s; int skip_from, skip_n;
    __device__ __forceinline__ bool next(int i, Unit& u) const { if (!s.next(i, u)) return false; if (u.pn >= skip_from) u.pn += skip_n; return true; }
    __device__ __forceinline__ void a_ready(const Unit&) const {}
    __device__ __forceinline__ void done(const Unit&) const {}
};
struct NoHook { static constexpr bool ENABLED = false; __device__ __forceinline__ void operator()(f32x4 (&)[2][2][4][2], const Unit&, int, int, int, int) const {} };
template <class Epi, class Sched, bool ALIGN_EPI, class Hook = NoHook, bool F8 = false, bool I8 = false>
__device__ __forceinline__ void gemm_phase(PG8_LAS unsigned char* lds, const Gemm g, const Sched& S, const Epi& E, const Hook& HK = Hook()) {
    const int tid = threadIdx.x, wid = __builtin_amdgcn_readfirstlane(tid >> 6), lane = tid & 63, wr = wid >> 2, wc = wid & 3, fr = lane & 15, fq = lane >> 4;
    const int K = g.K, nt = K / BK;
    unsigned voffA[2], voffB[2];
#pragma unroll
    for (int i = 0; i < 2; ++i) { int R, C; stage_rc(tid * 16 + i * 8192, R, C); const int Rb = Epi::PERM ? ((R & ~31) + perm32(R & 31)) : R;
        voffA[i] = (unsigned)(R * g.lda + C) * 2u; voffB[i] = (unsigned)(Rb * g.ldb + C) * 2u; }
    const size_t kstep = (size_t)(BK * 2);
    const size_t hstepA = (size_t)HALF * g.lda * 2, hstepB = (size_t)HALF * g.ldb * 2;
    const size_t tstepA = 2 * hstepA, tstepB = 2 * hstepB;
    const unsigned ldsw = (unsigned)wid * 1024u;
    const int aoff = lds_byte(wr * 64 + fr, F8 ? fq * 16 : fq * 8), boff = lds_byte(wc * 32 + fr, F8 ? fq * 16 : fq * 8);
#define PG8_SA(b, h) (((b) * 2 + (h)) * HTB)
#define PG8_SB(b, h) ((4 + (b) * 2 + (h)) * HTB)
#define PG8_STAGE(bufoff, gbase, voff) do { _Pragma("unroll") for (int _i = 0; _i < 2; ++_i) { \
        if (F8) { unsigned keep_; const unsigned la_ = (unsigned)__builtin_amdgcn_readfirstlane((int)(unsigned)(uintptr_t)(lds + (bufoff) + ldsw + _i * 8192)); \
            asm volatile("s_mov_b32 %0, m0\n\ts_mov_b32 m0, %2\n\ts_nop 0\n\tglobal_load_lds_dwordx4 %1, %3\n\ts_mov_b32 m0, %0" : "=&s"(keep_) : "v"((voff)[_i]), "s"(la_), "s"((const char*)(gbase)) : "memory"); } \
        else __builtin_amdgcn_global_load_lds((const unsigned*)((const char*)(gbase) + (voff)[_i]), (PG8_LAS unsigned*)(lds + (bufoff) + ldsw + _i * 8192), 16, 0, 0); } } while (0)
#define PG8_LDA(dst, b, h) do { if (F8) { _Pragma("unroll") for (int m = 0; m < 2; ++m) dst##8[m] = *(const PG8_LAS v8i32g*)(lds + PG8_SA(b, h) + aoff + m * 2048); } \
        else { _Pragma("unroll") for (int m = 0; m < 4; ++m) _Pragma("unroll") for (int k = 0; k < 2; ++k) dst[m][k] = *(const PG8_LAS bf16x8*)(lds + PG8_SA(b, h) + aoff + m * 2048 + k * 1024); } } while (0)
#define PG8_LDB(dst, b, h) do { if (F8) { _Pragma("unroll") for (int n = 0; n < 2; ++n) dst##8[n] = *(const PG8_LAS v8i32g*)(lds + PG8_SB(b, h) + boff + n * 2048); } \
        else { _Pragma("unroll") for (int n = 0; n < 2; ++n) _Pragma("unroll") for (int k = 0; k < 2; ++k) dst[n][k] = *(const PG8_LAS bf16x8*)(lds + PG8_SB(b, h) + boff + n * 2048 + k * 1024); } } while (0)
#define PG8_MMA(ai, bj, At, Bt) do { __builtin_amdgcn_s_setprio(1); _Pragma("unroll") for (int m = 0; m < 4; ++m) _Pragma("unroll") for (int n = 0; n < 2; ++n) _Pragma("unroll") for (int k = 0; k < 2; ++k) { \
        if (I8) acc[ai][bj][m][n] = __builtin_bit_cast(f32x4, __builtin_amdgcn_mfma_i32_16x16x64_i8(__builtin_bit_cast(v4i32g, Bt[n][k]), __builtin_bit_cast(v4i32g, At[m][k]), __builtin_bit_cast(v4i32g, acc[ai][bj][m][n]), 0, 0, 0)); \
        else acc[ai][bj][m][n] = __builtin_amdgcn_mfma_f32_16x16x32_bf16(Bt[n][k], At[m][k], acc[ai][bj][m][n], 0, 0, 0); } __builtin_amdgcn_s_setprio(0); } while (0)
#define PG8_MMA2(ai, b) do { if (F8) { __builtin_amdgcn_s_setprio(1); \
        _Pragma("unroll") for (int m = 0; m < 2; ++m) _Pragma("unroll") for (int n = 0; n < 2; ++n) { \
            acc[ai][0][m][n] = __builtin_amdgcn_mfma_scale_f32_16x16x128_f8f6f4(B08[n], At8[m], acc[ai][0][m][n], 0, 0, 0, 0, 0, 0); acc[ai][1][m][n] = __builtin_amdgcn_mfma_scale_f32_16x16x128_f8f6f4(B18[n], At8[m], acc[ai][1][m][n], 0, 0, 0, 0, 0, 0); } \
        _Pragma("unroll") for (int m = 0; m < 2; ++m) At8[m] = *(const PG8_LAS v8i32g*)(lds + PG8_SA(b, ai) + aoff + (m + 2) * 2048); \
        _Pragma("unroll") for (int m = 0; m < 2; ++m) _Pragma("unroll") for (int n = 0; n < 2; ++n) { \
            acc[ai][0][m + 2][n] = __builtin_amdgcn_mfma_scale_f32_16x16x128_f8f6f4(B08[n], At8[m], acc[ai][0][m + 2][n], 0, 0, 0, 0, 0, 0); acc[ai][1][m + 2][n] = __builtin_amdgcn_mfma_scale_f32_16x16x128_f8f6f4(B18[n], At8[m], acc[ai][1][m + 2][n], 0, 0, 0, 0, 0, 0); } \
        __builtin_amdgcn_s_setprio(0); } else { PG8_MMA(ai, 0, At, B0); PG8_MMA(ai, 1, At, B1); } } while (0)
#define PG8_WAIT_V(n) asm volatile("s_waitcnt vmcnt(" #n ")" ::: "memory")
#define PG8_WAIT_L(n) asm volatile("s_waitcnt lgkmcnt(" #n ")" ::: "memory")
#define PG8_BAR __builtin_amdgcn_s_barrier()
#define PG8_SCHED __builtin_amdgcn_sched_barrier(0)
    Unit cur, nxt; int ui = 0;
    if (!S.next(0, cur)) return;
    f32x4 acc[2][2][4][2];
#pragma unroll
    for (int a = 0; a < 2; ++a)
#pragma unroll
        for (int b = 0; b < 2; ++b)
#pragma unroll
            for (int m = 0; m < 4; ++m)
#pragma unroll
                for (int n = 0; n < 2; ++n) acc[a][b][m][n] = (f32x4){0.f, 0.f, 0.f, 0.f};
    bf16x8 At[4][2], B0[2][2], B1[2][2];
    v8i32g At8[2], B08[2], B18[2];
    const char* cA = (const char*)g.A + (size_t)cur.pm * tstepA; const char* cB = (const char*)g.Bt + (size_t)cur.pn * tstepB;
    S.a_ready(cur);
    PG8_STAGE(PG8_SB(0, 0), cB, voffB); PG8_STAGE(PG8_SB(0, 1), cB + hstepB, voffB); PG8_STAGE(PG8_SA(0, 0), cA, voffA); PG8_STAGE(PG8_SA(0, 1), cA + hstepA, voffA);
    if (wr == 1) PG8_BAR;
    PG8_WAIT_V(2); PG8_BAR;
    PG8_STAGE(PG8_SB(1, 0), cB + kstep, voffB); PG8_STAGE(PG8_SA(1, 0), cA + kstep, voffA); PG8_STAGE(PG8_SB(1, 1), cB + hstepB + kstep, voffB);
    PG8_WAIT_V(6); PG8_BAR;
    for (;;) {
        const bool has_next = S.next(ui + 1, nxt);
        const char* nA = has_next ? (const char*)g.A + (size_t)nxt.pm * tstepA : cA; const char* nB = has_next ? (const char*)g.Bt + (size_t)nxt.pn * tstepB : cB;
        for (int t = 0; t < nt; t += 2) {
            const bool last = (t == nt - 2);
            const char* a1 = cA + (size_t)(t + 1) * kstep;
            const char* a2 = last ? nA : cA + (size_t)(t + 2) * kstep; const char* b2 = last ? nB : cB + (size_t)(t + 2) * kstep;
            const char* a3 = a2 + kstep; const char* b3 = b2 + kstep;
            if (last && has_next) S.a_ready(nxt);
            if (Hook::ENABLED && t == (nt >> 1)) HK(acc, cur, wr, wc, fr, fq);
            PG8_LDB(B0, 0, 0); PG8_LDB(B1, 0, 1); PG8_SCHED; PG8_LDA(At, 0, 0); PG8_STAGE(PG8_SA(1, 1), a1 + hstepA, voffA);
            PG8_WAIT_V(8); PG8_WAIT_L(0); PG8_BAR; PG8_MMA2(0, 0); PG8_BAR; PG8_SCHED;
            PG8_LDA(At, 0, 1); PG8_STAGE(PG8_SB(0, 0), b2, voffB); PG8_STAGE(PG8_SB(0, 1), b2 + hstepB, voffB); PG8_STAGE(PG8_SA(0, 0), a2, voffA);
            PG8_WAIT_V(8); PG8_WAIT_L(0); PG8_BAR; PG8_MMA2(1, 0); PG8_BAR; PG8_SCHED;
            PG8_LDB(B0, 1, 0); PG8_LDB(B1, 1, 1); PG8_SCHED; PG8_LDA(At, 1, 0); PG8_STAGE(PG8_SA(0, 1), a2 + hstepA, voffA);
            PG8_WAIT_V(8); PG8_WAIT_L(0); PG8_BAR; PG8_MMA2(0, 1); PG8_BAR; PG8_SCHED;
            PG8_LDA(At, 1, 1); PG8_STAGE(PG8_SB(1, 0), b3, voffB); PG8_STAGE(PG8_SB(1, 1), b3 + hstepB, voffB); PG8_STAGE(PG8_SA(1, 0), a3, voffA);
            PG8_WAIT_V(8); PG8_WAIT_L(0); PG8_BAR; PG8_MMA2(1, 1); PG8_BAR; PG8_SCHED;
        }
        if constexpr (ALIGN_EPI) { if (wr == 0) PG8_BAR; }
        if constexpr (I8) {
#pragma unroll
            for (int a = 0; a < 2; ++a)
#pragma unroll
                for (int b = 0; b < 2; ++b)
#pragma unroll
                    for (int m = 0; m < 4; ++m)
#pragma unroll
                        for (int n = 0; n < 2; ++n) acc[a][b][m][n] = __builtin_convertvector(__builtin_bit_cast(v4i32g, acc[a][b][m][n]), f32x4); }
        E(acc, cur, wr, wc, fr, fq); S.done(cur);
        if (!has_next) break;
#pragma unroll
        for (int a = 0; a < 2; ++a)
#pragma unroll
            for (int b = 0; b < 2; ++b)
#pragma unroll
                for (int m = 0; m < 4; ++m)
#pragma unroll
                    for (int n = 0; n < 2; ++n) acc[a][b][m][n] = (f32x4){0.f, 0.f, 0.f, 0.f};
        cur = nxt; cA = nA; cB = nB; ++ui;
        if constexpr (ALIGN_EPI) { if (wr == 1) PG8_BAR; }
    }
    PG8_WAIT_V(0);
    if constexpr (!ALIGN_EPI) { if (wr == 0) PG8_BAR; }
    PG8_BAR;
#undef PG8_SA
#undef PG8_SB
#undef PG8_STAGE
#undef PG8_LDA
#undef PG8_LDB
#undef PG8_MMA
#undef PG8_MMA2
#undef PG8_WAIT_V
#undef PG8_WAIT_L
#undef PG8_BAR
#undef PG8_SCHED
}
}

namespace att {
typedef unsigned short bf16_t;
typedef short bf16x8 __attribute__((ext_vector_type(8)));
typedef short s16x4 __attribute__((ext_vector_type(4)));
typedef float f32x16 __attribute__((ext_vector_type(16)));
typedef float f32x4 __attribute__((ext_vector_type(4)));
typedef unsigned u32x4 __attribute__((ext_vector_type(4)));
constexpr int NW = 8, QBLK = 32, KVBLK = 64, QB = NW * QBLK;
constexpr int SHM_V = KVBLK * 128 * 2, SHM_K = KVBLK * 128 * 2, SHM_R = KVBLK * 64 * 2;
constexpr int QROW = 272, QWAVE = 32 * QROW;
constexpr float THR = 8.f;
constexpr int STG_ROW = 132, STG_WAVE = 32 * STG_ROW * 4;
static_assert(NW * STG_WAVE <= 155648, "staging");

#define KSWZ(row, colB) ((row) * 256 + ((colB) ^ (((row) & 7) << 4)))
#define RSWZ(row, chunk) ((row) * 128 + ((((chunk) ^ (((row) >> 1) & 7))) << 4))
#define SBAR() __builtin_amdgcn_sched_barrier(0)
__device__ __forceinline__ int v_rd_base(int lane) { return ((lane & 3) << 3) | (((lane >> 2) & 3) << 6) | (((lane >> 4) & 1) << 5) | (((lane >> 5) & 1) << 8); }
constexpr int v_rd_off(int d0, int ks, int half) { return d0 * 512 + ks * 4096 + half * 2048; }
__device__ __forceinline__ int crow(int r, int hi) { return (r & 3) + 8 * (r >> 2) + 4 * hi; }
typedef float f32x2_t __attribute__((ext_vector_type(2))); typedef __bf16 bf16x2_t __attribute__((ext_vector_type(2)));
__device__ __forceinline__ unsigned cvtpk(float lo, float hi) { f32x2_t v = {lo, hi}; bf16x2_t b = __builtin_convertvector(v, bf16x2_t); return __builtin_bit_cast(unsigned, b); }
__device__ __forceinline__ void glds16(const void* gsrc, unsigned lds_dst) { unsigned keep;
    asm volatile("s_mov_b32 %0, m0\n\ts_mov_b32 m0, %2\n\ts_nop 0\n\tglobal_load_lds_dwordx4 %1, off\n\ts_mov_b32 m0, %0" : "=&s"(keep) : "v"(gsrc), "s"(lds_dst) : "memory"); }
#define WAIT_BAR() asm volatile("s_waitcnt vmcnt(0) lgkmcnt(0)\n\ts_barrier" ::: "memory")

__device__ __forceinline__ void mask_tile(f32x16& p0, f32x16& p1, int dq) {
    const float NEG = -__builtin_inff();
#pragma unroll
    for (int r = 0; r < 16; ++r) { const int c = (r & 3) + 8 * (r >> 2); if (dq - c < 0) p0[r] = NEG; if (dq - c - 32 < 0) p1[r] = NEG; }
}
template <bool MLA> __device__ __forceinline__ void partialSM(f32x16& p0, f32x16& p1, float& m_reg, float& mn, float& alpha) {
    constexpr float SCALE = MLA ? 0.07216878364870322f : 0.125f;
    float pmax = p0[0];
#pragma unroll
    for (int r = 1; r < 16; ++r) pmax = fmaxf(pmax, p0[r]);
#pragma unroll
    for (int r = 0; r < 16; ++r) pmax = fmaxf(pmax, p1[r]);
    { auto rr = __builtin_amdgcn_permlane32_swap(__float_as_uint(pmax), __float_as_uint(pmax), false, false); pmax = fmaxf(__uint_as_float(rr[0]), __uint_as_float(rr[1])); }
    constexpr float C2 = 1.4426950408889634f * SCALE;
    if (MLA) {
        if (__builtin_expect(__all((pmax - m_reg) * SCALE <= 5.0f), 1)) { mn = m_reg; alpha = 1.f; }
        else { mn = fmaxf(m_reg, pmax); alpha = __builtin_amdgcn_exp2f((m_reg - mn) * C2); m_reg = mn; }
    } else {
        const bool keep = __all((pmax - m_reg) * SCALE <= THR);
        mn = keep ? m_reg : fmaxf(m_reg, pmax); alpha = __builtin_amdgcn_exp2f((m_reg - mn) * C2); m_reg = mn;
    }
    const float mnL = -mn * C2;
#pragma unroll
    for (int r = 0; r < 16; ++r) p0[r] = fmaf(p0[r], C2, mnL);
#pragma unroll
    for (int r = 0; r < 16; ++r) p1[r] = fmaf(p1[r], C2, mnL);
#pragma unroll
    for (int r = 0; r < 16; ++r) p0[r] = __builtin_amdgcn_exp2f(p0[r]);
}
__device__ __forceinline__ void finishSM(f32x16& p0, f32x16& p1, float alpha, float& l_reg, bf16x8& pa0, bf16x8& pa1, bf16x8& pa2, bf16x8& pa3) {
#pragma unroll
    for (int r = 0; r < 16; ++r) p1[r] = __builtin_amdgcn_exp2f(p1[r]);
    float ps = 0;
#pragma unroll
    for (int r = 0; r < 16; ++r) ps += p0[r];
#pragma unroll
    for (int r = 0; r < 16; ++r) ps += p1[r];
    { auto rr = __builtin_amdgcn_permlane32_swap(__float_as_uint(ps), __float_as_uint(ps), false, false); ps = __uint_as_float(rr[0]) + __uint_as_float(rr[1]); }
    l_reg = l_reg * alpha + ps;
#define PK4(P, B_, OUT) do { unsigned a0 = cvtpk(P[B_+0], P[B_+1]), a1 = cvtpk(P[B_+2], P[B_+3]); unsigned b0 = cvtpk(P[B_+4], P[B_+5]), b1 = cvtpk(P[B_+6], P[B_+7]); \
        auto r0 = __builtin_amdgcn_permlane32_swap(a0, b0, false, false); auto r1 = __builtin_amdgcn_permlane32_swap(a1, b1, false, false); \
        u32x4 w = {r0[0], r1[0], r0[1], r1[1]}; OUT = *reinterpret_cast<bf16x8*>(&w); } while (0)
    PK4(p0, 0, pa0); PK4(p0, 8, pa1); PK4(p1, 0, pa2); PK4(p1, 8, pa3);
#undef PK4
}
__device__ __forceinline__ unsigned pk4f8(float a, float b, float c, float d) { int w = __builtin_amdgcn_cvt_pk_fp8_f32(a, b, 0, false); w = __builtin_amdgcn_cvt_pk_fp8_f32(c, d, w, true); return (unsigned)w; }
__device__ __forceinline__ void finishSM8(f32x16& p0, f32x16& p1, float alpha, float& l_reg, int (&P8)[8]) {
#pragma unroll
    for (int r = 0; r < 16; ++r) p1[r] = __builtin_amdgcn_exp2f(p1[r]);
    float ps = 0;
#pragma unroll
    for (int r = 0; r < 16; ++r) ps += p0[r];
#pragma unroll
    for (int r = 0; r < 16; ++r) ps += p1[r];
    { auto rr = __builtin_amdgcn_permlane32_swap(__float_as_uint(ps), __float_as_uint(ps), false, false); ps = __uint_as_float(rr[0]) + __uint_as_float(rr[1]); }
    l_reg = l_reg * alpha + ps;
#pragma unroll
    for (int i = 0; i < 4; ++i) { P8[i] = (int)pk4f8(p0[4 * i], p0[4 * i + 1], p0[4 * i + 2], p0[4 * i + 3]); P8[4 + i] = (int)pk4f8(p1[4 * i], p1[4 * i + 1], p1[4 * i + 2], p1[4 * i + 3]); }
}
typedef int v8i32b __attribute__((ext_vector_type(8)));
__device__ __forceinline__ void pv8(f32x16* o, const char* vt, int r32, int hi, const int (&P8)[8]) {
    const v8i32b pa = {P8[0], P8[1], P8[2], P8[3], P8[4], P8[5], P8[6], P8[7]};
    const char* va = vt + (2 * hi) * 2048 + r32 * 16;
#pragma unroll
    for (int blk = 0; blk < 4; ++blk) { const u32x4 x0 = *reinterpret_cast<const u32x4*>(va + blk * 512), x1 = *reinterpret_cast<const u32x4*>(va + 2048 + blk * 512);
        const v8i32b vb = {(int)x0[0], (int)x0[1], (int)x0[2], (int)x0[3], (int)x1[0], (int)x1[1], (int)x1[2], (int)x1[3]};
        o[blk] = __builtin_amdgcn_mfma_scale_f32_32x32x64_f8f6f4(pa, vb, o[blk], 0, 0, 0, 0, 0, 0); }
}
typedef int v8i32 __attribute__((ext_vector_type(8)));
__device__ __forceinline__ void qkt8(f32x16& p0, f32x16& p1, const char* kn, const char* kr, int r32, int hi, const v8i32* q8) {
    p0 = f32x16{}; p1 = f32x16{};
#pragma unroll
    for (int sl = 0; sl < 3; ++sl) { const char* a = (sl < 2 ? kn + (4 * sl + 2 * hi) * 1024 : kr + (2 * hi) * 1024) + r32 * 16;
        const u32x4 x0 = *reinterpret_cast<const u32x4*>(a), x1 = *reinterpret_cast<const u32x4*>(a + 1024), y0 = *reinterpret_cast<const u32x4*>(a + 512), y1 = *reinterpret_cast<const u32x4*>(a + 1024 + 512);
        const v8i32 k0 = {(int)x0[0], (int)x0[1], (int)x0[2], (int)x0[3], (int)x1[0], (int)x1[1], (int)x1[2], (int)x1[3]}, k1 = {(int)y0[0], (int)y0[1], (int)y0[2], (int)y0[3], (int)y1[0], (int)y1[1], (int)y1[2], (int)y1[3]};
        p0 = __builtin_amdgcn_mfma_scale_f32_32x32x64_f8f6f4(k0, q8[sl], p0, 0, 0, 0, 0, 0, 0); p1 = __builtin_amdgcn_mfma_scale_f32_32x32x64_f8f6f4(k1, q8[sl], p1, 0, 0, 0, 0, 0, 0); }
}
template <bool MLA, int NS> struct Lay {
    static constexpr int OFF_V = 0, OFF_K = NS * SHM_V, OFF_R = OFF_K + (MLA ? NS * SHM_K : 0), OFF_WS = OFF_R + NS * SHM_R, OFF_Q = OFF_WS + NW * 64 * 4, END = OFF_Q + (MLA ? NW * QWAVE : 0);
};
template <bool MLA>
__device__ __forceinline__ void qkt(f32x16& p0, f32x16& p1, const char* kn, const char* kr, int r32, int hi, const char* qimg, const bf16x8* qr) {
    p0 = f32x16{}; p1 = f32x16{};
    if (MLA) {
#pragma unroll
        for (int d0 = 0; d0 < 8; ++d0) { const char* a = kn + KSWZ(r32, ((d0 & 3) * 16 + hi * 8) * 2) + (d0 >> 2) * 128;
            bf16x8 b0 = *reinterpret_cast<const bf16x8*>(a); bf16x8 b1 = *reinterpret_cast<const bf16x8*>(a + 32 * 256);
            const bf16x8 q = *reinterpret_cast<const bf16x8*>(qimg + d0 * 32);
            p0 = __builtin_amdgcn_mfma_f32_32x32x16_bf16(b0, q, p0, 0, 0, 0); p1 = __builtin_amdgcn_mfma_f32_32x32x16_bf16(b1, q, p1, 0, 0, 0); }
    }
#pragma unroll
    for (int d0 = 0; d0 < 4; ++d0) { const char* a = kr + RSWZ(r32, 2 * d0 + hi);
        bf16x8 b0 = *reinterpret_cast<const bf16x8*>(a); bf16x8 b1 = *reinterpret_cast<const bf16x8*>(a + 32 * 128);
        p0 = __builtin_amdgcn_mfma_f32_32x32x16_bf16(b0, qr[d0], p0, 0, 0, 0); p1 = __builtin_amdgcn_mfma_f32_32x32x16_bf16(b1, qr[d0], p1, 0, 0, 0); }
}
typedef __attribute__((address_space(3))) const char* lds_cptr;
typedef short v4i16_t __attribute__((ext_vector_type(4)));
__device__ __forceinline__ s16x4 vtr(lds_cptr p) { return __builtin_bit_cast(s16x4, __builtin_amdgcn_ds_read_tr16_b64_v4i16((__attribute__((address_space(3))) v4i16_t*)p)); }
__device__ __forceinline__ void pv_tile_pipe(f32x16* o, lds_cptr vp, bf16x8 pa0, bf16x8 pa1, bf16x8 pa2, bf16x8 pa3) {
    const int vb = (int)(unsigned)(uintptr_t)vp;
#define TRRD(dst, off) asm volatile("ds_read_b64_tr_b16 %0, %1 offset:%2" : "=&v"(dst) : "v"(vb), "i"(off) : "memory")
#define RD8(S, d0) do { TRRD(S##l0, v_rd_off(d0, 0, 0)); TRRD(S##h0, v_rd_off(d0, 0, 0) + 2048); TRRD(S##l1, v_rd_off(d0, 0, 0) + 4096); TRRD(S##h1, v_rd_off(d0, 0, 0) + 6144); \
        TRRD(S##l2, v_rd_off(d0, 0, 0) + 8192); TRRD(S##h2, v_rd_off(d0, 0, 0) + 10240); TRRD(S##l3, v_rd_off(d0, 0, 0) + 12288); TRRD(S##h3, v_rd_off(d0, 0, 0) + 14336); } while (0)
#define LW8(S) asm volatile("s_waitcnt lgkmcnt(0)" : "+v"(S##l0), "+v"(S##h0), "+v"(S##l1), "+v"(S##h1), "+v"(S##l2), "+v"(S##h2), "+v"(S##l3), "+v"(S##h3) :: "memory")
#define MM4(S, d0) do { \
        o[d0] = __builtin_amdgcn_mfma_f32_32x32x16_bf16(pa0, (bf16x8){S##l0[0], S##l0[1], S##l0[2], S##l0[3], S##h0[0], S##h0[1], S##h0[2], S##h0[3]}, o[d0], 0, 0, 0); \
        o[d0] = __builtin_amdgcn_mfma_f32_32x32x16_bf16(pa1, (bf16x8){S##l1[0], S##l1[1], S##l1[2], S##l1[3], S##h1[0], S##h1[1], S##h1[2], S##h1[3]}, o[d0], 0, 0, 0); \
        o[d0] = __builtin_amdgcn_mfma_f32_32x32x16_bf16(pa2, (bf16x8){S##l2[0], S##l2[1], S##l2[2], S##l2[3], S##h2[0], S##h2[1], S##h2[2], S##h2[3]}, o[d0], 0, 0, 0); \
        o[d0] = __builtin_amdgcn_mfma_f32_32x32x16_bf16(pa3, (bf16x8){S##l3[0], S##l3[1], S##l3[2], S##l3[3], S##h3[0], S##h3[1], S##h3[2], S##h3[3]}, o[d0], 0, 0, 0); } while (0)
    s16x4 Al0, Ah0, Al1, Ah1, Al2, Ah2, Al3, Ah3, Bl0, Bh0, Bl1, Bh1, Bl2, Bh2, Bl3, Bh3;
    RD8(A, 0); LW8(A);
    RD8(B, 1); MM4(A, 0); LW8(B);
    RD8(A, 2); MM4(B, 1); LW8(A);
    RD8(B, 3); MM4(A, 2); LW8(B);
    MM4(B, 3);
#undef RD8
#undef LW8
#undef MM4
#undef TRRD
}
__device__ __forceinline__ void qkt_batch(f32x16& p0, f32x16& p1, const char* kr, int r32, int hi, const bf16x8* qr) {
    bf16x8 kf[8];
#pragma unroll
    for (int d0 = 0; d0 < 4; ++d0) { const int a = (int)(unsigned)(uintptr_t)(kr + RSWZ(r32, 2 * d0 + hi));
        asm volatile("ds_read_b128 %0, %1" : "=&v"(kf[2 * d0]) : "v"(a) : "memory"); asm volatile("ds_read_b128 %0, %1 offset:4096" : "=&v"(kf[2 * d0 + 1]) : "v"(a) : "memory"); }
    asm volatile("s_waitcnt lgkmcnt(0)" : "+v"(kf[0]), "+v"(kf[1]), "+v"(kf[2]), "+v"(kf[3]), "+v"(kf[4]), "+v"(kf[5]), "+v"(kf[6]), "+v"(kf[7]) :: "memory");
    p0 = f32x16{}; p1 = f32x16{};
#pragma unroll
    for (int d0 = 0; d0 < 4; ++d0) { p0 = __builtin_amdgcn_mfma_f32_32x32x16_bf16(kf[2 * d0], qr[d0], p0, 0, 0, 0); p1 = __builtin_amdgcn_mfma_f32_32x32x16_bf16(kf[2 * d0 + 1], qr[d0], p1, 0, 0, 0); }
}
template <bool VIS> __device__ __forceinline__ void pv_tile(f32x16* o, lds_cptr vp, bf16x8 pa0, bf16x8 pa1, bf16x8 pa2, bf16x8 pa3) {
    if (!VIS) {
        const int vb = (int)(unsigned)(uintptr_t)vp;
#define TRRD(dst, off) asm volatile("ds_read_b64_tr_b16 %0, %1 offset:%2" : "=&v"(dst) : "v"(vb), "i"(off) : "memory")
#define PV_D0(d0) do { s16x4 l0, l1, l2, l3, h0, h1, h2, h3; constexpr int b_ = v_rd_off(d0, 0, 0); \
        TRRD(l0, b_); TRRD(h0, b_ + 2048); TRRD(l1, b_ + 4096); TRRD(h1, b_ + 6144); TRRD(l2, b_ + 8192); TRRD(h2, b_ + 10240); TRRD(l3, b_ + 12288); TRRD(h3, b_ + 14336); \
        asm volatile("s_waitcnt lgkmcnt(0)" ::: "memory"); SBAR(); \
        o[d0] = __builtin_amdgcn_mfma_f32_32x32x16_bf16(pa0, (bf16x8){l0[0], l0[1], l0[2], l0[3], h0[0], h0[1], h0[2], h0[3]}, o[d0], 0, 0, 0); \
        o[d0] = __builtin_amdgcn_mfma_f32_32x32x16_bf16(pa1, (bf16x8){l1[0], l1[1], l1[2], l1[3], h1[0], h1[1], h1[2], h1[3]}, o[d0], 0, 0, 0); \
        o[d0] = __builtin_amdgcn_mfma_f32_32x32x16_bf16(pa2, (bf16x8){l2[0], l2[1], l2[2], l2[3], h2[0], h2[1], h2[2], h2[3]}, o[d0], 0, 0, 0); \
        o[d0] = __builtin_amdgcn_mfma_f32_32x32x16_bf16(pa3, (bf16x8){l3[0], l3[1], l3[2], l3[3], h3[0], h3[1], h3[2], h3[3]}, o[d0], 0, 0, 0); } while (0)
        PV_D0(0); PV_D0(1); PV_D0(2); PV_D0(3);
#undef PV_D0
#undef TRRD
        return;
    }
#pragma unroll
    for (int d0 = 0; d0 < 4; ++d0) {
        const s16x4 l0 = vtr(vp + d0 * 512), h0 = vtr(vp + d0 * 512 + 2048), l1 = vtr(vp + d0 * 512 + 4096), h1 = vtr(vp + d0 * 512 + 6144);
        const s16x4 l2 = vtr(vp + d0 * 512 + 8192), h2 = vtr(vp + d0 * 512 + 10240), l3 = vtr(vp + d0 * 512 + 12288), h3 = vtr(vp + d0 * 512 + 14336);
        o[d0] = __builtin_amdgcn_mfma_f32_32x32x16_bf16(pa0, (bf16x8){l0[0], l0[1], l0[2], l0[3], h0[0], h0[1], h0[2], h0[3]}, o[d0], 0, 0, 0);
        o[d0] = __builtin_amdgcn_mfma_f32_32x32x16_bf16(pa1, (bf16x8){l1[0], l1[1], l1[2], l1[3], h1[0], h1[1], h1[2], h1[3]}, o[d0], 0, 0, 0);
        o[d0] = __builtin_amdgcn_mfma_f32_32x32x16_bf16(pa2, (bf16x8){l2[0], l2[1], l2[2], l2[3], h2[0], h2[1], h2[2], h2[3]}, o[d0], 0, 0, 0);
        o[d0] = __builtin_amdgcn_mfma_f32_32x32x16_bf16(pa3, (bf16x8){l3[0], l3[1], l3[2], l3[3], h3[0], h3[1], h3[2], h3[3]}, o[d0], 0, 0, 0);
    }
}

struct Src { const bf16_t* Qn; const bf16_t* Qr; const bf16_t* Kn; const bf16_t* Kr; const bf16_t* V; };
template <bool MLA> struct Pitch { static constexpr int qn = 3072, qr = MLA ? 3072 : 16128, kn = 4096, kr = 16128, v = MLA ? 4096 : 16128; };

template <bool MLA, int NS>
__device__ __forceinline__ void attn_block(const Src& s, int qb, char* lds) {
    typedef Pitch<MLA> PT; typedef Lay<MLA, NS> L;
    constexpr int LA = NS - 1;
    constexpr int NPC = MLA ? 5 : 3;
    const int tid = threadIdx.x, wid = __builtin_amdgcn_readfirstlane(tid >> 6), lane = tid & 63, r32 = lane & 31, hi = lane >> 5;
    const int P0 = qb * QB, NT = (P0 + QB) / KVBLK;
    const int qlo = P0 + wid * QBLK, qm = qlo + r32 - 4 * hi;
    const unsigned lds0 = (unsigned)(uintptr_t)lds;
    float* ws = (float*)(lds + L::OFF_WS) + wid * 64; float* li_l = ws; float* al_l = ws + 32;
    float m_reg = -1e30f, l_reg = 0; f32x16 o[4];
#pragma unroll
    for (int d = 0; d < 4; ++d) o[d] = f32x16{};
    unsigned offV[2], offK[2], offR;
#pragma unroll
    for (int i = 0; i < 2; ++i) { const int q = (wid * 2 + i) * 64 + lane;
        { const int sidx = q >> 5, w5 = q & 31, kk = (sidx >> 2) * 8 + (w5 >> 2), c = (sidx & 3) * 32 + (w5 & 3) * 8, k = (kk & ~0xC) | ((kk & 4) << 1) | ((kk & 8) >> 1); offV[i] = (unsigned)(k * PT::v + c) * 2u; }
        offK[i] = MLA ? (unsigned)(lane * 2048 + wid * 16) : 0u; }
    if (MLA) offR = (unsigned)(lane * 64 + (wid & 3) * 16);
    else { const int q = wid * 64 + lane, row = q >> 3, c = (q & 7) ^ ((row >> 1) & 7); offR = (unsigned)(row * PT::kr + c * 8) * 2u; }
    const unsigned offV8 = (unsigned)(((wid >> 2) * 64 + lane) * 8192 + (wid & 3) * 16);
#define SLOT_INC(x) ((x) + 1 == NS ? 0 : (x) + 1)
#define DMA_K(t, sl) do { if (MLA) { glds16((const char*)s.Kn + (size_t)(t) * (KVBLK * 2048) + offK[0], (unsigned)__builtin_amdgcn_readfirstlane(lds0 + L::OFF_K + (sl) * SHM_K + wid * 1024)); \
            if (wid < 4) glds16((const char*)s.Kr + (size_t)(t) * (KVBLK * 64) + offR, (unsigned)__builtin_amdgcn_readfirstlane(lds0 + L::OFF_R + (sl) * SHM_R + wid * 1024)); } \
        else { const char* rb_ = (const char*)s.Kr + (size_t)(t) * (KVBLK * 2) * PT::kr; glds16(rb_ + offR, (unsigned)__builtin_amdgcn_readfirstlane(lds0 + L::OFF_R + (sl) * SHM_R + wid * 1024)); } } while (0)
#define DMA_V(t, sl) do { if (MLA) { glds16((const char*)s.V + (size_t)(t) * KVBLK + offV8, (unsigned)__builtin_amdgcn_readfirstlane(lds0 + L::OFF_V + (sl) * SHM_V + (wid & 3) * 2048 + (wid >> 2) * 1024)); } \
        else { const char* vb_ = (const char*)s.V + (size_t)(t) * (KVBLK * 2) * PT::v; \
        glds16(vb_ + offV[0], (unsigned)__builtin_amdgcn_readfirstlane(lds0 + L::OFF_V + (sl) * SHM_V + (wid * 2) * 1024)); glds16(vb_ + offV[1], (unsigned)__builtin_amdgcn_readfirstlane(lds0 + L::OFF_V + (sl) * SHM_V + (wid * 2 + 1) * 1024)); } } while (0)
    __syncthreads();
    DMA_K(0, 0);
    bf16x8 qr[4]; v8i32 q8[3];
    { const size_t qrow = (size_t)(qlo + r32);
        if (MLA) {
            const char* qn_ = (const char*)s.Qn + qrow * 3072 + 32 * hi; const char* qr_ = (const char*)s.Qr + qrow * 3072 + 32 * hi;
#pragma unroll
            for (int sl = 0; sl < 3; ++sl) { const char* p_ = sl < 2 ? qn_ + 64 * sl : qr_; const u32x4 x0 = *reinterpret_cast<const u32x4*>(p_), x1 = *reinterpret_cast<const u32x4*>(p_ + 16);
                q8[sl] = (v8i32){(int)x0[0], (int)x0[1], (int)x0[2], (int)x0[3], (int)x1[0], (int)x1[1], (int)x1[2], (int)x1[3]}; }
        } else {
#pragma unroll
            for (int d0 = 0; d0 < 4; ++d0) qr[d0] = *reinterpret_cast<const bf16x8*>(s.Qr + qrow * PT::qr + d0 * 16 + hi * 8);
        } }
    if (LA >= 2) { DMA_K(1, 1); DMA_V(0, 0); }
    const char* qimg = nullptr;
    const lds_cptr vb0 = (lds_cptr)lds + (L::OFF_V + v_rd_base(lane));
#define RESC(a) do { if (__any((a) < 1.f)) { if (hi == 0) al_l[r32] = (a); asm volatile("s_waitcnt lgkmcnt(0)" ::: "memory"); \
        _Pragma("unroll") for (int d_ = 0; d_ < 4; ++d_) _Pragma("unroll") for (int r = 0; r < 16; ++r) o[d_][r] *= al_l[crow(r, hi)]; } } while (0)
#define KBASE(t) ((t) * KVBLK)
#define MASKT(P0_, P1_, t) do { const int kb_ = KBASE(t); if (__builtin_expect(kb_ + KVBLK - 1 > qlo, 0)) { asm volatile("; causal-mask tile" ::: "memory"); mask_tile(P0_, P1_, qm - kb_); } } while (0)
#define WAIT_STEP(full) do { if (NS >= 3 && (full)) { if (MLA) asm volatile("s_waitcnt vmcnt(5) lgkmcnt(0)\n\ts_barrier" ::: "memory"); else asm volatile("s_waitcnt vmcnt(3) lgkmcnt(0)\n\ts_barrier" ::: "memory"); } \
        else WAIT_BAR(); } while (0)
    f32x16 pA0, pA1, pB0, pB1; float mnA, mnB, alA, alB; bf16x8 pa0, pa1, pa2, pa3; int P8[8];
    WAIT_BAR();
    int sc = 0;
    { const int sk = (LA % NS), sv = ((LA + NS - 1) % NS);
      DMA_K(LA, sk); DMA_V(LA - 1, sv);
      SBAR(); if (MLA) qkt8(pA0, pA1, lds + L::OFF_K + sc * SHM_K, lds + L::OFF_R + sc * SHM_R, r32, hi, q8); else qkt_batch(pA0, pA1, lds + L::OFF_R + sc * SHM_R, r32, hi, qr);
      MASKT(pA0, pA1, 0); partialSM<MLA>(pA0, pA1, m_reg, mnA, alA);
      WAIT_STEP(true); }
#define STEP(PX0, PX1, mnX, alX, PY0, PY1, alY, t, MASK) do { \
        const int sp_ = sc; sc = SLOT_INC(sc); \
        const int skw_ = sp_, svw_ = (NS == 2) ? sc : ((sp_ == 0) ? NS - 1 : sp_ - 1); \
        const bool gk_ = (t) + LA < NT, gv_ = (t) + LA - 1 < NT; \
        if (gk_) DMA_K((t) + LA, skw_); if (gv_) DMA_V((t) + LA - 1, svw_); \
        SBAR(); if (MLA) qkt8(PX0, PX1, lds + L::OFF_K + sc * SHM_K, lds + L::OFF_R + sc * SHM_R, r32, hi, q8); else qkt_batch(PX0, PX1, lds + L::OFF_R + sc * SHM_R, r32, hi, qr); \
        if (MLA) { finishSM8(PY0, PY1, alY, l_reg, P8); SBAR(); pv8(o, lds + L::OFF_V + sp_ * SHM_V, r32, hi, P8); } \
        else { finishSM(PY0, PY1, alY, l_reg, pa0, pa1, pa2, pa3); pv_tile_pipe(o, vb0 + sp_ * SHM_V, pa0, pa1, pa2, pa3); } if (MLA) { MASKT(PX0, PX1, (t)); } else if (MASK) mask_tile(PX0, PX1, qm - KBASE(t)); partialSM<MLA>(PX0, PX1, m_reg, mnX, alX); \
        RESC(alX); WAIT_STEP(gk_ && gv_); } while (0)
    int t = 1;
    if (!MLA) for (; t + 1 < NT - 4; t += 2) {
        STEP(pB0, pB1, mnB, alB, pA0, pA1, alA, t, false);
        STEP(pA0, pA1, mnA, alA, pB0, pB1, alB, t + 1, false);
    }
    for (; t + 1 < NT; t += 2) {
        STEP(pB0, pB1, mnB, alB, pA0, pA1, alA, t, true);
        STEP(pA0, pA1, mnA, alA, pB0, pB1, alB, t + 1, true);
    }
    STEP(pB0, pB1, mnB, alB, pA0, pA1, alA, NT - 1, true);
    if (MLA) { finishSM8(pB0, pB1, alB, l_reg, P8); SBAR(); pv8(o, lds + L::OFF_V + sc * SHM_V, r32, hi, P8); }
    else { finishSM(pB0, pB1, alB, l_reg, pa0, pa1, pa2, pa3); SBAR(); pv_tile_pipe(o, vb0 + sc * SHM_V, pa0, pa1, pa2, pa3); }
    if (hi == 0) li_l[r32] = l_reg;
    asm volatile("s_waitcnt lgkmcnt(0)" ::: "memory");
    float rl[16];
#pragma unroll
    for (int r = 0; r < 16; ++r) rl[r] = __builtin_amdgcn_rcpf(li_l[crow(r, hi)]);
    WAIT_BAR();
    float* st = (float*)(lds + wid * STG_WAVE) + hi * (4 * STG_ROW) + r32;
#pragma unroll
    for (int r = 0; r < 16; ++r)
#pragma unroll
        for (int d0 = 0; d0 < 4; ++d0) st[((r & 3) + 8 * (r >> 2)) * STG_ROW + d0 * 32] = o[d0][r] * rl[r];
    asm volatile("s_waitcnt lgkmcnt(0)" ::: "memory");
#undef SLOT_INC
#undef DMA_K
#undef DMA_V
#undef RESC
#undef KBASE
#undef MASKT
#undef WAIT_STEP
#undef STEP
}
constexpr int DK_SLOT = 8192, DV_SLOT = 16384, D_NSLOT = 3;
constexpr int D_LDS_K = 0, D_LDS_V = D_NSLOT * DK_SLOT, D_LDS_WS = D_LDS_V + D_NSLOT * DV_SLOT, D_LDS_END = D_LDS_WS + NW * 64 * 4;
constexpr int DPITCH = 16128;
typedef __attribute__((address_space(3))) const bf16x8* lds_b8;
__device__ __forceinline__ void kload2(bf16x8* kf, lds_cptr kp, int j) { kf[2 * j] = *(lds_b8)(kp + j * 2048); kf[2 * j + 1] = *(lds_b8)(kp + j * 2048 + 512); }
template <int THRL>
__device__ __forceinline__ void diff_block64(const bf16_t* Qh, const bf16_t* Kh, const bf16_t* Vh, int qb, char* lds) {
    int tid = threadIdx.x; asm volatile("" : "+v"(tid));
    const int lane = tid & 63, r32 = lane & 31, hi = lane >> 5; const int wid = __builtin_amdgcn_readfirstlane(tid >> 6);
    const int q0 = qb * QB, NT = (q0 + QB) / KVBLK;
    const unsigned lds0 = (unsigned)(uintptr_t)lds;
    float* wsf = (float*)(lds + D_LDS_WS) + wid * 64;
    const unsigned koff = (unsigned)(lane * DPITCH + wid * 8) * 2u;
    const unsigned voff = (unsigned)((16 * (wid & 3) + (lane >> 2)) * DPITCH + (wid >> 2) * 32 + (lane & 3) * 8) * 2u;
    const unsigned kdst = lds0 + D_LDS_K + wid * 1024, vdst = lds0 + D_LDS_V + wid * 1024;
#define DMA_K(t, sidx) glds16((const char*)Kh + (size_t)(t) * (KVBLK * DPITCH * 2) + koff, (unsigned)__builtin_amdgcn_readfirstlane(kdst + (sidx) * DK_SLOT))
#define DMA_V(t, sidx) do { const char* vb_ = (const char*)Vh + (size_t)(t) * (KVBLK * DPITCH * 2) + voff; \
        glds16(vb_, (unsigned)__builtin_amdgcn_readfirstlane(vdst + (sidx) * DV_SLOT)); glds16(vb_ + 128, (unsigned)__builtin_amdgcn_readfirstlane(vdst + (sidx) * DV_SLOT + 8192)); } while (0)
#define WAIT_BARN(N) asm volatile("s_waitcnt vmcnt(" #N ") lgkmcnt(0)\n\ts_barrier" ::: "memory")
#define SBAR() __builtin_amdgcn_sched_barrier(0)
    const lds_cptr shm3 = (lds_cptr)lds; const lds_cptr kp0 = shm3 + D_LDS_K + hi * 1024 + r32 * 16;
    const lds_cptr vp0 = shm3 + D_LDS_V + ((lane >> 4) & 1) * 32 + (lane & 3) * 8 + (4 * hi + ((lane & 15) >> 2)) * 64;
    __syncthreads();
    DMA_K(0, 0); DMA_V(0, 0); DMA_K(1, 1);
    bf16x8 qr[4], kf[8];
    { const bf16_t* Qw = Qh + (size_t)(q0 + wid * QBLK + r32) * DPITCH;
#pragma unroll
      for (int d0 = 0; d0 < 4; ++d0) qr[d0] = *reinterpret_cast<const bf16x8*>(Qw + d0 * 16 + hi * 8); }
    float mhat = 0.f, l_reg = 0.f; f32x16 o[4];
#pragma unroll
    for (int d = 0; d < 4; ++d) o[d] = f32x16{};
    const int qrel = wid * QBLK + r32;
#define CMASK(P0, P1, t) do { const int jb_ = (t) - (NT - 4); if (jb_ >= 0) { const float NEG_ = -__builtin_inff(); const int kb_ = 64 * jb_ + 4 * hi; \
        _Pragma("unroll") for (int r = 0; r < 16; ++r) { const int kv_ = kb_ + (r & 3) + 8 * (r >> 2); if (kv_ > qrel) P0[r] = NEG_; if (kv_ + 32 > qrel) P1[r] = NEG_; } } } while (0)
#define MX3(a, b, c) __builtin_fmaxf(__builtin_fmaxf((a), (b)), (c))
#define ROWMAX(rm, C0, C1) do { float a_ = MX3(C0[0], C0[1], C1[0]), b_ = MX3(C0[2], C0[3], C1[1]); a_ = MX3(a_, C1[2], C1[3]); \
        _Pragma("unroll") for (int r = 4; r < 16; r += 4) { a_ = MX3(a_, C0[r], C0[r + 1]); b_ = MX3(b_, C0[r + 2], C0[r + 3]); a_ = MX3(a_, C1[r], C1[r + 1]); b_ = MX3(b_, C1[r + 2], C1[r + 3]); } \
        rm = __builtin_fmaxf(a_, b_); { auto rr = __builtin_amdgcn_permlane32_swap(__float_as_uint(rm), __float_as_uint(rm), false, false); rm = __builtin_fmaxf(__uint_as_float(rr[0]), __uint_as_float(rr[1])); } } while (0)
    bool resc = false;
#define RESC() do { if (resc) { asm volatile("s_waitcnt lgkmcnt(0)" ::: "memory"); \
        _Pragma("unroll") for (int d_ = 0; d_ < 4; ++d_) _Pragma("unroll") for (int r = 0; r < 16; ++r) o[d_][r] *= wsf[crow(r, hi)]; } } while (0)
    f32x16 pA0, pA1, pB0, pB1;
    int s_prev = 0, s_cur = 0, s_next = 1;
#define ROT() do { s_prev = s_cur; s_cur = s_next; s_next = (s_next == D_NSLOT - 1) ? 0 : s_next + 1; } while (0)
    DMA_K(2, 2);
    WAIT_BARN(4);
    { const lds_cptr kp = kp0;
      pA0 = f32x16{}; pA1 = f32x16{};
#pragma unroll
      for (int d0 = 0; d0 < 4; ++d0) { const bf16x8 b0 = *(lds_b8)(kp + d0 * 2048), b1 = *(lds_b8)(kp + d0 * 2048 + 512);
          pA0 = __builtin_amdgcn_mfma_f32_32x32x16_bf16(b0, qr[d0], pA0, 0, 0, 0); pA1 = __builtin_amdgcn_mfma_f32_32x32x16_bf16(b1, qr[d0], pA1, 0, 0, 0); } }
    CMASK(pA0, pA1, 0);
    { float rm; ROWMAX(rm, pA0, pA1); mhat = rm;
#pragma unroll
      for (int r = 0; r < 16; ++r) { pA0[r] = __builtin_amdgcn_exp2f(pA0[r] - mhat); pA1[r] = __builtin_amdgcn_exp2f(pA1[r] - mhat); } }
    WAIT_BARN(0);
    DMA_K(3, 0); DMA_V(1, 1);
    ROT();
#pragma unroll
    for (int j = 0; j < 4; ++j) kload2(kf, kp0 + s_cur * DK_SLOT, j);
    WAIT_BARN(3);
    s16x4 vlo[8], vhi[8];
#define PKW(P, B) cvtpk(P[B], P[B + 1])
#define PKF(P, B) __uint_as_float(PKW(P, B))
#define PSEL(P0, P1, k) __builtin_bit_cast(bf16x8, __builtin_shufflevector(((k) < 2 ? P0 : P1), ((k) < 2 ? P0 : P1), ((k) & 1) * 4, ((k) & 1) * 4 + 1, ((k) & 1) * 4 + 2, ((k) & 1) * 4 + 3))
#define VFR(i) (bf16x8){vlo[i][0], vlo[i][1], vlo[i][2], vlo[i][3], vhi[i][0], vhi[i][1], vhi[i][2], vhi[i][3]}
#define PIN(x) asm volatile("" : "+v"(x))
#define GAPA(MF, A0, A1, A2, A3, W0, W1, PW) do { MF; sacc += A0; sacc += A1; sacc += A2; sacc += A3; PIN(sacc); W0; W1; PIN(PW); SBAR(); } while (0)
#define EXS(v) __builtin_amdgcn_exp2f((v) - mhat)
#define GAPB(MF, X, B) do { MF; X[B] = EXS(X[B]); X[B + 1] = EXS(X[B + 1]); PIN(X); SBAR(); } while (0)
#define VRD(i, blk) do { vlo[i] = vtr(vp_ + ((((i) >> 2) + (blk)) * 4096 + ((i) & 3) * 1024)); vhi[i] = vtr(vp_ + ((((i) >> 2) + (blk)) * 4096 + ((i) & 3) * 1024 + 512)); } while (0)
#define KRD(G, j) do { if (G) { kload2(kf, kp0 + s_next * DK_SLOT, j); SBAR(); } } while (0)
#define MFQ(C, i, first) C = __builtin_amdgcn_mfma_f32_32x32x16_bf16(kf[i], qr[(i) >> 1], first ? f32x16{} : C, 0, 0, 0)
#define MFP(P0, P1, f, blk) o[((f) >> 2) + (blk)] = __builtin_amdgcn_mfma_f32_32x32x16_bf16(PSEL(P0, P1, (f) & 3), VFR(f), o[((f) >> 2) + (blk)], 0, 0, 0)
#define STEP(C0, C1, P0, P1, t, GK, GV, GL) do { SBAR(); \
    const lds_cptr vp_ = vp0 + s_prev * DV_SLOT; \
    VRD(0, 0); SBAR(); float sacc = (P0[0] + P0[1]); \
    GAPA(MFQ(C0, 0, true),  P0[2], P0[3], P0[4], P0[5],     P0[0] = PKF(P0, 0),  P0[1] = PKF(P0, 2),  P0); \
    VRD(4, 0); SBAR(); GAPA(MFQ(C1, 1, true),  P0[6], P0[7], P0[8], P0[9],     P0[2] = PKF(P0, 4),  P0[3] = PKF(P0, 6),  P0); \
    VRD(1, 0); SBAR(); GAPA(MFQ(C0, 2, false), P0[10], P0[11], P0[12], P0[13], P0[4] = PKF(P0, 8),  P0[5] = PKF(P0, 10), P0); \
    VRD(5, 0); SBAR(); GAPA(MFQ(C1, 3, false), P0[14], P0[15], P1[0], P1[1],   P0[6] = PKF(P0, 12), P0[7] = PKF(P0, 14), P0); \
    VRD(2, 0); SBAR(); GAPA(MFQ(C0, 4, false), P1[2], P1[3], P1[4], P1[5],     P1[0] = PKF(P1, 0),  P1[1] = PKF(P1, 2),  P1); \
    VRD(6, 0); SBAR(); GAPA(MFQ(C1, 5, false), P1[6], P1[7], P1[8], P1[9],     P1[2] = PKF(P1, 4),  P1[3] = PKF(P1, 6),  P1); \
    VRD(3, 0); SBAR(); GAPA(MFQ(C0, 6, false), P1[10], P1[11], P1[12], P1[13], P1[4] = PKF(P1, 8),  P1[5] = PKF(P1, 10), P1); \
    VRD(7, 0); SBAR(); GAPA(MFQ(C1, 7, false), P1[14], P1[15], 0.f, 0.f,       P1[6] = PKF(P1, 12), P1[7] = PKF(P1, 14), P1); \
    l_reg += sacc; \
    if (GK) { DMA_K((t) + 3, s_cur); } if (GV) { DMA_V((t) + 1, s_next); } \
    CMASK(C0, C1, t); \
    { float rm; ROWMAX(rm, C0, C1); resc = false; \
      if (__builtin_expect(__any(rm - mhat > (float)THRL), 0)) { const float dl = __builtin_fmaxf(rm - mhat, 0.f); mhat += dl; \
          const float f = __builtin_amdgcn_exp2f(-dl); l_reg *= f; if (hi == 0) wsf[r32] = f; resc = true; } } \
    SBAR(); \
    GAPB(MFP(P0, P1, 0, 0), C0, 0);  VRD(0, 2); SBAR(); \
    GAPB(MFP(P0, P1, 4, 0), C0, 2);  VRD(4, 2); SBAR(); \
    GAPB(MFP(P0, P1, 1, 0), C0, 4);  VRD(1, 2); SBAR(); \
    GAPB(MFP(P0, P1, 5, 0), C0, 6);  VRD(5, 2); SBAR(); \
    GAPB(MFP(P0, P1, 2, 0), C0, 8);  VRD(2, 2); SBAR(); \
    GAPB(MFP(P0, P1, 6, 0), C0, 10); VRD(6, 2); SBAR(); \
    GAPB(MFP(P0, P1, 3, 0), C0, 12); VRD(3, 2); SBAR(); \
    GAPB(MFP(P0, P1, 7, 0), C0, 14); VRD(7, 2); SBAR(); \
    GAPB(MFP(P0, P1, 0, 2), C1, 0);  KRD(GL, 0); \
    GAPB(MFP(P0, P1, 4, 2), C1, 2);  KRD(GL, 1); \
    GAPB(MFP(P0, P1, 1, 2), C1, 4);  KRD(GL, 2); \
    GAPB(MFP(P0, P1, 5, 2), C1, 6);  KRD(GL, 3); \
    GAPB(MFP(P0, P1, 2, 2), C1, 8); \
    GAPB(MFP(P0, P1, 6, 2), C1, 10); \
    GAPB(MFP(P0, P1, 3, 2), C1, 12); \
    GAPB(MFP(P0, P1, 7, 2), C1, 14); \
    } while (0)
    int t = 1;
#undef CMASK
#define CMASK(P0, P1, t) do { } while (0)
    for (; t + 5 < NT; t += 2) {
        STEP(pB0, pB1, pA0, pA1, t, true, true, true);     WAIT_BARN(3); RESC(); ROT();
        STEP(pA0, pA1, pB0, pB1, t + 1, true, true, true); WAIT_BARN(3); RESC(); ROT();
    }
#undef CMASK
#define CMASK(P0, P1, t) do { const int jb_ = (t) - (NT - 4); if (jb_ >= 0) { const float NEG_ = -__builtin_inff(); const int kb_ = 64 * jb_ + 4 * hi; \
        _Pragma("unroll") for (int r = 0; r < 16; ++r) { const int kv_ = kb_ + (r & 3) + 8 * (r >> 2); if (kv_ > qrel) P0[r] = NEG_; if (kv_ + 32 > qrel) P1[r] = NEG_; } } } while (0)
#define ENDW(tt) do { if ((tt) + 3 < NT) { WAIT_BARN(3); } else if ((tt) + 2 < NT) { WAIT_BARN(2); } else { WAIT_BARN(0); } } while (0)
    for (; t + 1 < NT; t += 2) {
        STEP(pB0, pB1, pA0, pA1, t, (t + 3 < NT), (t + 1 < NT), (t + 1 < NT));         ENDW(t);     RESC(); ROT();
        STEP(pA0, pA1, pB0, pB1, t + 1, (t + 4 < NT), (t + 2 < NT), (t + 2 < NT));     ENDW(t + 1); RESC(); ROT();
    }
    STEP(pB0, pB1, pA0, pA1, NT - 1, false, false, false); RESC();
    { float sacc = pB0[0] + pB0[1];
#pragma unroll
      for (int r = 2; r < 16; ++r) sacc += pB0[r];
#pragma unroll
      for (int r = 0; r < 16; ++r) sacc += pB1[r];
      l_reg += sacc;
      const u32x4 pw0 = (u32x4){PKW(pB0, 0), PKW(pB0, 2), PKW(pB0, 4), PKW(pB0, 6)}, pw1 = (u32x4){PKW(pB0, 8), PKW(pB0, 10), PKW(pB0, 12), PKW(pB0, 14)};
      const u32x4 pw2 = (u32x4){PKW(pB1, 0), PKW(pB1, 2), PKW(pB1, 4), PKW(pB1, 6)}, pw3 = (u32x4){PKW(pB1, 8), PKW(pB1, 10), PKW(pB1, 12), PKW(pB1, 14)};
      SBAR(); const lds_cptr vp_ = vp0 + s_cur * DV_SLOT;
#define PAF(k) __builtin_bit_cast(bf16x8, pw##k)
#pragma unroll
      for (int blk = 0; blk < 4; blk += 2) {
#pragma unroll
          for (int i = 0; i < 8; ++i) { vlo[i] = vtr(vp_ + (((i >> 2) + blk) * 4096 + (i & 3) * 1024)); vhi[i] = vtr(vp_ + (((i >> 2) + blk) * 4096 + (i & 3) * 1024 + 512)); }
#pragma unroll
          for (int d = 0; d < 2; ++d) { o[d + blk] = __builtin_amdgcn_mfma_f32_32x32x16_bf16(PAF(0), VFR(d * 4 + 0), o[d + blk], 0, 0, 0); o[d + blk] = __builtin_amdgcn_mfma_f32_32x32x16_bf16(PAF(1), VFR(d * 4 + 1), o[d + blk], 0, 0, 0);
              o[d + blk] = __builtin_amdgcn_mfma_f32_32x32x16_bf16(PAF(2), VFR(d * 4 + 2), o[d + blk], 0, 0, 0); o[d + blk] = __builtin_amdgcn_mfma_f32_32x32x16_bf16(PAF(3), VFR(d * 4 + 3), o[d + blk], 0, 0, 0); } } }
    { auto rr = __builtin_amdgcn_permlane32_swap(__float_as_uint(l_reg), __float_as_uint(l_reg), false, false); l_reg = __uint_as_float(rr[0]) + __uint_as_float(rr[1]); }
    if (hi == 0) wsf[32 + r32] = l_reg;
    asm volatile("s_waitcnt lgkmcnt(0)" ::: "memory");
    float rl[16];
#pragma unroll
    for (int r = 0; r < 16; ++r) rl[r] = __builtin_amdgcn_rcpf(wsf[32 + crow(r, hi)]);
    WAIT_BARN(0);
    float* st = (float*)(lds + wid * STG_WAVE) + hi * (4 * STG_ROW) + r32;
#pragma unroll
    for (int r = 0; r < 16; ++r)
#pragma unroll
        for (int d0 = 0; d0 < 4; ++d0) st[((r & 3) + 8 * (r >> 2)) * STG_ROW + d0 * 32] = o[d0][r] * rl[r];
    asm volatile("s_waitcnt lgkmcnt(0)" ::: "memory");
#undef DMA_K
#undef DMA_V
#undef WAIT_BARN
#undef SBAR
#undef CMASK
#undef MX3
#undef ROWMAX
#undef RESC
#undef ROT
#undef PKW
#undef PAF
#undef PKF
#undef PSEL
#undef VFR
#undef PIN
#undef GAPA
#undef EXS
#undef GAPB
#undef VRD
#undef KRD
#undef MFQ
#undef MFP
#undef STEP
#undef ENDW
}
__device__ __forceinline__ f32x4 staged4(const char* lds, int wid, int lane, int j) {
    const int row = lane & 31, half = lane >> 5; const float* st = (const float*)(lds + wid * STG_WAVE);
    return *(const f32x4*)(st + row * STG_ROW + half * 64 + 4 * j);
}
#undef SBAR
}

constexpr size_t MiB = 1u << 20;
constexpr size_t WS_CTL = 0, CTL_ZERO_BYTES = 1 * MiB;
constexpr size_t WS_COS = 1 * MiB, WS_SIN = 2 * MiB;
constexpr size_t WS_SSQC = 3 * MiB;
constexpr size_t WS_SSQ1 = 4 * MiB, WS_SSQ2 = 6 * MiB;
constexpr size_t WS_RSTD1 = 8 * MiB;
constexpr size_t WS_WIN = 16 * MiB;
constexpr size_t WS_WUQ = 142 * MiB;
constexpr size_t WS_WUKV = 148 * MiB;
constexpr size_t WS_WO = 152 * MiB;
constexpr size_t WS_WOUT = 184 * MiB;
constexpr size_t WS_WUP = 216 * MiB;
constexpr size_t WS_WDOWN = 388 * MiB;
constexpr size_t WS_H = 474 * MiB;
constexpr size_t WS_O = 538 * MiB;
constexpr size_t WS_Z = 602 * MiB;
constexpr size_t WS_QM = 854 * MiB;
constexpr size_t WS_KV = 902 * MiB;
constexpr size_t WS_HALO = 602 * MiB;
constexpr size_t WS_U = 602 * MiB;
constexpr size_t WS_T1 = 966 * MiB;
constexpr size_t WS_O1 = 1094 * MiB;
constexpr size_t WS_ACT = 966 * MiB;
constexpr size_t WS_X1 = 1158 * MiB;
constexpr size_t WS_END = 1286 * MiB;
static_assert(WS_WIN + (size_t)ZW * DM * 2 <= WS_WUQ && WS_WUP + (size_t)UPW * DM * 2 <= WS_WDOWN && WS_WDOWN + (size_t)DM * DFF * 2 <= WS_H, "ws map (weights)");
static_assert(WS_Z + (size_t)S * ZW * 2 <= WS_QM && WS_U + (size_t)S * UPW * 2 <= WS_T1 && WS_ACT + (size_t)S * DFF * 2 <= WS_X1 && WS_X1 + (size_t)S * DM * 4 <= WS_END, "ws map (activations)");
constexpr int CW_TMO = 0, CW_BAR = 4096;

constexpr int NWAVES = 8;
constexpr int RING_OFF = 0, RING_BYTES = 131072;
constexpr int XCH_OFF = 131072;
constexpr int LDSCTL_OFF = 155648, MISC_OFF = LDSCTL_OFF + 320;
constexpr int LDS_BYTES = 163840;
static_assert(att::Pitch<true>::qn == QMW && att::Pitch<true>::kn == KVW && att::Pitch<false>::v == ZW && att::Pitch<true>::kr == ZW, "attention pitches");
static_assert(att::Lay<true, 2>::END <= LDSCTL_OFF && att::D_LDS_END <= LDSCTL_OFF && att::DPITCH == ZW && RING_BYTES <= LDSCTL_OFF, "LDS map");

__device__ __forceinline__ unsigned f2bf(float f) { unsigned u = __builtin_bit_cast(unsigned, f); return (u + 0x7fffu + ((u >> 16) & 1u)) >> 16; }
__device__ __forceinline__ unsigned pk2(float lo, float hi) { return pg8::cvt_pk_bf16(lo, hi); }

#define XB_TMO      128
#define XB_XCNT(j)  (256  + 64 * (j))
#define XB_XSUB(j)  (1280 + 64 * (j))
#define XB_XGEN(j)  (2304 + 64 * (j))
#define XB_TOP      3328
#define XB_TOPGEN   3392
#define XCD_BAR_WORDS 3456
#define XB_SPIN_CAP (1u << 18)
__device__ __forceinline__ unsigned xb_ld(unsigned* p)              { return __hip_atomic_load(p, __ATOMIC_RELAXED, __HIP_MEMORY_SCOPE_AGENT); }
__device__ __forceinline__ unsigned xb_add(unsigned* p, unsigned v) { return __hip_atomic_fetch_add(p, v, __ATOMIC_RELAXED, __HIP_MEMORY_SCOPE_AGENT); }
__device__ __forceinline__ unsigned xb_xcc_id() { return (unsigned)__builtin_amdgcn_s_getreg((3 << 11) | 20) & 0xFu; }
#define XB_SPIN(cond, bar) do { unsigned _sp = 0; while (cond) { __builtin_amdgcn_s_sleep(1); \
    if ((++_sp & 255u) == 0u) { if (xb_ld(&(bar)[XB_TMO])) break; if (_sp > XB_SPIN_CAP) { atomicAdd(&(bar)[XB_TMO], 1u); break; } } } } while (0)
struct XcdBarrier { unsigned* bar; unsigned x; volatile LAS unsigned* st; };
__device__ __forceinline__ XcdBarrier xcd_barrier_post(unsigned* bar, volatile LAS unsigned* st) {
    XcdBarrier b; b.bar = bar; b.x = xb_xcc_id(); b.st = st;
    if (threadIdx.x == 0) (void)xb_add(&bar[XB_XCNT(b.x)], 1u);
    return b;
}
__device__ __forceinline__ void xcd_barrier_complete(unsigned* bar, unsigned x, unsigned& nloc, unsigned& nx) {
    const unsigned G = gridDim.x * gridDim.y * gridDim.z;
    unsigned sum, cnt, mine, sp = 0u;
    for (;;) {
        sum = 0u; cnt = 0u; mine = 0u;
#pragma unroll
        for (unsigned j = 0; j < 16; ++j) { const unsigned c = xb_ld(&bar[XB_XCNT(j)]); sum += c; cnt += (c > 0u) ? 1u : 0u; mine = (j == x) ? c : mine; }
        if (sum == G) break;
        __builtin_amdgcn_s_sleep(1);
        if ((++sp & 255u) == 0u) { if (xb_ld(&bar[XB_TMO])) break; if (sp > XB_SPIN_CAP) { atomicAdd(&bar[XB_TMO], 1u); break; } }
    }
    nloc = mine > 0u ? mine : 1u; nx = cnt > 0u ? cnt : 1u;
}
__device__ __forceinline__ void xcd_barrier(const XcdBarrier& b) {
    asm volatile("s_waitcnt vmcnt(0)" ::: "memory");
    __syncthreads();
    if (threadIdx.x == 0) {
        unsigned* bar = b.bar;
        __builtin_amdgcn_s_waitcnt(0);
        unsigned nloc = b.st[0], nx = b.st[1];
        if (nloc == 0u) { xcd_barrier_complete(bar, b.x, nloc, nx); b.st[0] = nloc; b.st[1] = nx; }
        const unsigned old = xb_add(&bar[XB_XSUB(b.x)], 1u);
        const unsigned gen = old / nloc;
        if (old + 1u == (gen + 1u) * nloc) {
            __builtin_amdgcn_fence(__ATOMIC_RELEASE, "agent");
            asm volatile("s_waitcnt vmcnt(0)" ::: "memory");
            const unsigned og = xb_add(&bar[XB_TOP], 1u);
            const unsigned tg = og / nx;
            if (og + 1u == (tg + 1u) * nx) xb_add(&bar[XB_TOPGEN], 1u);
            else XB_SPIN(xb_ld(&bar[XB_TOPGEN]) == tg, bar);
            __builtin_amdgcn_fence(__ATOMIC_ACQUIRE, "agent");
            xb_add(&bar[XB_XGEN(b.x)], 1u);
            asm volatile("s_waitcnt vmcnt(0)" ::: "memory");
        } else {
            XB_SPIN(xb_ld(&bar[XB_XGEN(b.x)]) == gen, bar);
            __builtin_amdgcn_fence(__ATOMIC_ACQUIRE, "agent");
            asm volatile("s_waitcnt vmcnt(0)" ::: "memory");
        }
    }
    __syncthreads();
}

struct Args {
    const float* x; const int* pos; const float* norm_mix_w; const float* w_in; const float* lq1; const float* lk1; const float* lq2; const float* lk2;
    const float* subln_w; const float* q_norm_w; const float* w_uq; const float* kv_norm_w; const float* w_ukv; const float* w_o_diff; const float* w_o_mla;
    const float* w_out; const float* norm_ffn_w; const float* w_up; const float* conv_w; const float* conv_b; const float* w_down; const float* final_w;
    float* out; unsigned char* ws; int ph_lo, ph_hi;
};

__device__ __forceinline__ float wave_sum(float v) {
#pragma unroll
    for (int o = 1; o < 64; o <<= 1) v += __shfl_xor(v, o);
    return v;
}

struct MapId { __device__ __forceinline__ int operator()(int n) const { return n; } };
struct MapIn { __device__ __forceinline__ int operator()(int n) const {
    if (n < 4096) { const int d = n & 63; return (n & ~63) + 2 * (d & 31) + (d >> 5); }
    if (n < ZC_KR) return n;
    if (n < ZC_KR + 64) { const int d = n - ZC_KR; return ZC_KR + 2 * (d & 31) + (d >> 5); }
    return n + (ZC_GD - (ZC_KR + 64)); } };
struct MapUq { __device__ __forceinline__ int operator()(int n) const { const int h = n / 192, j = n - h * 192;
    if (j < 128) return h * 128 + j; const int d = j - 128; return 2048 + h * 64 + 2 * (d & 31) + (d >> 5); } };
struct MapUkv { __device__ __forceinline__ int operator()(int n) const { const int h = n >> 8, j = n & 255; return (j < 128) ? h * 128 + j : 2048 + h * 128 + (j - 128); } };
struct MapUp { __device__ __forceinline__ int operator()(int n) const { const int v = n >= DFF, c = v ? n - DFF : n; return (c >> 7) * 256 + v * 128 + (c & 127); } };

template <class Map>
__device__ __forceinline__ void tr_item(const float* W, int N, bf16* WT, int ldt, int koff, const float* kscale, Map map, LAS float* scr, int item, int lane) {
    const int nblk = N / 32, kb = item / nblk, nb = item - kb * nblk, k0 = 64 * kb, n0 = 32 * nb;
#pragma unroll 8
    for (int i = 0; i < 32; ++i) { const int kk = 2 * i + (lane >> 5); scr[kk * 33 + (lane & 31)] = W[(size_t)(k0 + kk) * N + n0 + (lane & 31)]; }
    LDS_WAIT(); asm volatile("" ::: "memory");
    const int c = lane & 7;
    float g[8];
#pragma unroll
    for (int e = 0; e < 8; ++e) g[e] = kscale ? kscale[k0 + 8 * c + e] : 1.0f;
#pragma unroll
    for (int j = 0; j < 4; ++j) { const int n = (lane >> 3) + 8 * j; const LAS float* s = scr + (8 * c) * 33 + n;
        v4u o; o.x = pk2(s[0 * 33] * g[0], s[1 * 33] * g[1]); o.y = pk2(s[2 * 33] * g[2], s[3 * 33] * g[3]); o.z = pk2(s[4 * 33] * g[4], s[5 * 33] * g[5]); o.w = pk2(s[6 * 33] * g[6], s[7 * 33] * g[7]);
        *(GAS v4u*)(WT + (size_t)map(n0 + n) * ldt + koff + k0 + 8 * c) = o; }
    LDS_WAIT(); asm volatile("" ::: "memory");
}

struct TrItem { const float* W; const float* ks; bf16* WT; int N, ldt, koff, mapk, k0, n0; unsigned char* W8; int w8row0; const unsigned* WM; };
__device__ __forceinline__ int tr_map(int mapk, int n) { switch (mapk) { case 1: return MapIn()(n); case 2: return MapUq()(n); case 3: return MapUkv()(n); case 4: return MapUp()(n); default: return n; } }
__device__ __forceinline__ void tr_load(const TrItem& d, float (&v)[32], float (&g)[8], int lane) {
    typedef float f4 __attribute__((ext_vector_type(4)));
    if (d.ks) { const f4 g0 = *(const GAS f4*)(d.ks + d.k0 + 8 * (lane & 7)), g1 = *(const GAS f4*)(d.ks + d.k0 + 8 * (lane & 7) + 4);
        g[0] = g0.x; g[1] = g0.y; g[2] = g0.z; g[3] = g0.w; g[4] = g1.x; g[5] = g1.y; g[6] = g1.z; g[7] = g1.w; }
    else {
#pragma unroll
        for (int e = 0; e < 8; ++e) g[e] = 1.0f; }
#pragma unroll
    for (int i = 0; i < 8; ++i) { const int kk = (lane >> 3) + 8 * i; const f4 t = __builtin_nontemporal_load((const GAS f4*)(d.W + (size_t)(d.k0 + kk) * d.N + d.n0 + 4 * (lane & 7)));
        v[4 * i] = t.x; v[4 * i + 1] = t.y; v[4 * i + 2] = t.z; v[4 * i + 3] = t.w; }
}
__device__ __forceinline__ void tr_store(const TrItem& d, const float (&v)[32], const float (&g)[8], LAS float* scr, int lane) {
#pragma unroll
    for (int i = 0; i < 8; ++i) { const int kk = (lane >> 3) + 8 * i;
#pragma unroll
        for (int j = 0; j < 4; ++j) scr[kk * 33 + 4 * (lane & 7) + j] = v[4 * i + j]; }
    LDS_WAIT(); asm volatile("" ::: "memory");
    const int c = lane & 7;
#pragma unroll
    for (int j = 0; j < 4; ++j) { const int n = (lane >> 3) + 8 * j; const LAS float* sp = scr + (8 * c) * 33 + n;
        v4u o; o.x = pk2(sp[0 * 33] * g[0], sp[1 * 33] * g[1]); o.y = pk2(sp[2 * 33] * g[2], sp[3 * 33] * g[3]); o.z = pk2(sp[4 * 33] * g[4], sp[5 * 33] * g[5]); o.w = pk2(sp[6 * 33] * g[6], sp[7 * 33] * g[7]);
        const int row = tr_map(d.mapk, d.n0 + n);
        if (d.W8 && row >= d.w8row0) { pg8::f32x4 f0 = {sp[0 * 33] * g[0], sp[1 * 33] * g[1], sp[2 * 33] * g[2], sp[3 * 33] * g[3]}, f1 = {sp[4 * 33] * g[4], sp[5 * 33] * g[5], sp[6 * 33] * g[6], sp[7 * 33] * g[7]};
            const float qs = 127.0f / fmaxf(__uint_as_float(d.WM[row - d.w8row0]), 1e-30f); v2u o8; o8.x = pg8::pk4_i8(f0 * qs); o8.y = pg8::pk4_i8(f1 * qs); *(GAS v2u*)(d.W8 + (size_t)(row - d.w8row0) * DM + d.k0 + 8 * c) = o8; }
        else *(GAS v4u*)(d.WT + (size_t)row * d.ldt + d.koff + d.k0 + 8 * c) = o; }
    LDS_WAIT(); asm volatile("" ::: "memory");
}

__constant__ float ROPE_INVF[32] = {
    1.000000000e+00f, 7.498942614e-01f, 5.623413324e-01f, 4.216965139e-01f, 3.162277639e-01f, 2.371373773e-01f, 1.778279394e-01f, 1.333521307e-01f,
    1.000000015e-01f, 7.498941571e-02f, 5.623413250e-02f, 4.216965288e-02f, 3.162277490e-02f, 2.371373773e-02f, 1.778279431e-02f, 1.333521493e-02f,
    9.999999776e-03f, 7.498941850e-03f, 5.623413250e-03f, 4.216964822e-03f, 3.162277630e-03f, 2.371373586e-03f, 1.778279431e-03f, 1.333521446e-03f,
    1.000000047e-03f, 7.498942432e-04f, 5.623413017e-04f, 4.216965172e-04f, 3.162277571e-04f, 2.371373703e-04f, 1.778279402e-04f, 1.333521504e-04f };

typedef float f32x4 __attribute__((ext_vector_type(4)));
typedef float f32x16 __attribute__((ext_vector_type(16)));

__global__ void __launch_bounds__(NWAVES * 64, 2) fwd_kernel(Args a) {
    extern __shared__ __attribute__((aligned(16))) unsigned char lds[];
    LAS unsigned char* ldsl = (LAS unsigned char*)lds;
    volatile LAS unsigned* MISC = (volatile LAS unsigned*)(ldsl + MISC_OFF);
    const int tid = threadIdx.x, lane = tid & 63, wave = __builtin_amdgcn_readfirstlane(tid >> 6);
    const int G = gridDim.x; const int bx = blockIdx.x; const int vcu = (G % 8 == 0) ? (bx % 8) * (G / 8) + bx / 8 : bx;
    unsigned char* ws = a.ws;
    gu32* ctl = (gu32*)(ws + WS_CTL);
    for (int u = tid; u < (LDS_BYTES - LDSCTL_OFF) / 4; u += NWAVES * 64) ((LAS unsigned*)(ldsl + LDSCTL_OFF))[u] = 0u;
    __syncthreads();
    XcdBarrier bar; bar.bar = (unsigned*)(ctl + CW_BAR); bar.x = 0; bar.st = nullptr;
    if (!MK_PER_PHASE) bar = xcd_barrier_post((unsigned*)(ctl + CW_BAR), MISC + 8);
    const int lo = a.ph_lo, hi = a.ph_hi;
#ifndef PH_MASK
#define PH_MASK 0x3ff
#endif
#ifndef DUP_MASK
#define DUP_MASK 0
#endif
#define IN(k) (((PH_MASK >> (k)) & 1) && lo <= (k) && (k) < hi)
#define SEAM(k) do { if (IN(k) && IN((k) + 1)) xcd_barrier(bar); } while (0)
#ifdef TP_I0
    unsigned long long* const tsw = (unsigned long long*)(ws + 768 * 1024);
#define STAMP(k) do { if (bx == 0 && tid == 0) __hip_atomic_store(tsw + (k), (unsigned long long)__builtin_amdgcn_s_memrealtime(), RLX_AGENT); } while (0)
#else
#define STAMP(k) do { } while (0)
#endif
    const int gw = vcu * NWAVES + wave, NGW = G * NWAVES;
    bf16* const WIN = (bf16*)(ws + WS_WIN); bf16* const WUQ = (bf16*)(ws + WS_WUQ); bf16* const WUKV = (bf16*)(ws + WS_WUKV); bf16* const WO = (bf16*)(ws + WS_WO);
    bf16* const WOUT = (bf16*)(ws + WS_WOUT); bf16* const WUP = (bf16*)(ws + WS_WUP); bf16* const WDOWN = (bf16*)(ws + WS_WDOWN);
    bf16* const HB = (bf16*)(ws + WS_H); bf16* const YB = HB; bf16* const OB = (bf16*)(ws + WS_O); bf16* const XB = OB;
    bf16* const ZB = (bf16*)(ws + WS_Z); bf16* const QM = (bf16*)(ws + WS_QM); bf16* const KV = (bf16*)(ws + WS_KV);
    unsigned* const WMU = (unsigned*)(ws + WS_CTL + 256 * 1024); unsigned* const WMG = (unsigned*)(ws + WS_CTL + 384 * 1024);
    unsigned char* const WUP8 = ws + WS_WUP; unsigned char* const XN8 = ws + WS_X1 + 72 * MiB; float* const XSC = (float*)(ws + WS_X1 + 105 * MiB);
    float* const HSC = (float*)(ws + WS_X1 + 104 * MiB);
    unsigned char* const H8 = ws + WS_X1; unsigned char* const WIN8 = ws + WS_X1 + 32 * MiB;
    unsigned char* const VT8 = ws + WS_KV;
    unsigned char* const QF8 = ws + WS_QM; unsigned char* const KF8N = ws + WS_QM + 24 * MiB; unsigned char* const KF8R = ws + WS_QM + 40 * MiB;
    float* const HALO = (float*)(ws + WS_HALO); float* const O1 = (float*)(ws + WS_O1); bf16* const ACT = (bf16*)(ws + WS_ACT); float* const X1 = (float*)(ws + WS_X1);
    float* const COS = (float*)(ws + WS_COS); float* const SIN = (float*)(ws + WS_SIN); float* const SSQC = (float*)(ws + WS_SSQC);
    float* const SSQ1 = (float*)(ws + WS_SSQ1); float* const SSQ2 = (float*)(ws + WS_SSQ2); float* const RSTD1 = (float*)(ws + WS_RSTD1);

    STAMP(0);
    if (((DUP_MASK >> 0) & 1) && IN(0)) {
        LAS float* scr = (LAS float*)(ldsl + RING_OFF + wave * 16384);
        constexpr int I_IN = (DM / 64) * (INW / 32), I_UQ = (QRANK / 64) * (QMW / 32), I_UKV = (KVRANK / 64) * (KVW / 32), I_OD = (2048 / 64) * (DM / 32), I_OUT = (DM / 64) * (DM / 32),
                      I_UP = (DM / 64) * (UPW / 32), I_DN = (DFF / 64) * (DM / 32);
        constexpr int NITEMS = I_IN + I_UQ + I_UKV + 2 * I_OD + I_OUT + I_UP + I_DN;
        auto decode = [&](int it) -> TrItem { TrItem d; int r = it; int KB_;
            d.W8 = nullptr; d.w8row0 = 0; d.WM = nullptr;
            if (r < I_IN) { d.W = a.w_in; d.W8 = WIN8; d.w8row0 = ZC_CQ; d.WM = WMG; d.ks = nullptr; d.WT = WIN; d.N = INW; d.ldt = DM; d.koff = 0; d.mapk = 1; KB_ = DM / 64; }
            else if ((r -= I_IN) < I_UQ) { d.W = a.w_uq; d.ks = a.q_norm_w; d.WT = WUQ; d.N = QMW; d.ldt = QRANK; d.koff = 0; d.mapk = 2; KB_ = QRANK / 64; }
            else if ((r -= I_UQ) < I_UKV) { d.W = a.w_ukv; d.ks = a.kv_norm_w; d.WT = WUKV; d.N = KVW; d.ldt = KVRANK; d.koff = 0; d.mapk = 3; KB_ = KVRANK / 64; }
            else if ((r -= I_UKV) < I_OD) { d.W = a.w_o_diff; d.ks = nullptr; d.WT = WO; d.N = DM; d.ldt = 4096; d.koff = 0; d.mapk = 0; KB_ = 2048 / 64; }
            else if ((r -= I_OD) < I_OD) { d.W = a.w_o_mla; d.ks = nullptr; d.WT = WO; d.N = DM; d.ldt = 4096; d.koff = 2048; d.mapk = 0; KB_ = 2048 / 64; }
            else if ((r -= I_OD) < I_OUT) { d.W = a.w_out; d.ks = nullptr; d.WT = WOUT; d.N = DM; d.ldt = DM; d.koff = 0; d.mapk = 0; KB_ = DM / 64; }
            else if ((r -= I_OUT) < I_UP) { d.W = a.w_up; d.ks = a.norm_ffn_w; d.WT = WUP; d.N = UPW; d.ldt = DM; d.koff = 0; d.mapk = 4; KB_ = DM / 64; d.W8 = WUP8; d.WM = WMU; }
            else { r -= I_UP; d.W = a.w_down; d.ks = nullptr; d.WT = WDOWN; d.N = DM; d.ldt = DFF; d.koff = 0; d.mapk = 0; KB_ = DFF / 64; }
            const int nblk = d.N / 32, kblk = KB_; const int grp = r / (kblk * 32), rem = r - grp * (kblk * 32); const int kb = rem % kblk, nb = grp * 32 + rem / kblk; (void)nblk;
            d.k0 = 64 * kb; d.n0 = 32 * nb; return d; };
        if (gw < NITEMS) {
            int it = gw; const int cs = NGW, it1 = NITEMS; TrItem d0, d1, d2, d3; float v0[32], v1[32], v2[32], v3[32], g0[8], g1[8], g2[8], g3[8];
            d0 = decode(it); tr_load(d0, v0, g0, lane); d1 = d0; d2 = d0; d3 = d0;
            if (it + cs < it1) { d1 = decode(it + cs); tr_load(d1, v1, g1, lane); }
            if (it + 2 * cs < it1) { d2 = decode(it + 2 * cs); tr_load(d2, v2, g2, lane); }
            for (;;) {
                if (it + 3 * cs < it1) { d3 = decode(it + 3 * cs); tr_load(d3, v3, g3, lane); }
                tr_store(d0, v0, g0, scr, lane); it += cs; if (it >= it1) break;
                if (it + 3 * cs < it1) { d0 = decode(it + 3 * cs); tr_load(d0, v0, g0, lane); }
                tr_store(d1, v1, g1, scr, lane); it += cs; if (it >= it1) break;
                if (it + 3 * cs < it1) { d1 = decode(it + 3 * cs); tr_load(d1, v1, g1, lane); }
                tr_store(d2, v2, g2, scr, lane); it += cs; if (it >= it1) break;
                if (it + 3 * cs < it1) { d2 = decode(it + 3 * cs); tr_load(d2, v2, g2, lane); }
                tr_store(d3, v3, g3, scr, lane); it += cs; if (it >= it1) break;
            }
        }
        { const int gt = vcu * (NWAVES * 64) + tid, NGT = G * NWAVES * 64; GAS v4u* pz = (GAS v4u*)(WIN8 + (size_t)(ZC_KR + 64 - ZC_CQ) * DM); const int nz = (ZC_GD - ZC_KR - 64) * DM / 16;
            for (int i = gt; i < nz; i += NGT) pz[i] = (v4u){0u, 0u, 0u, 0u};
            for (int i = gt; i < S * 32; i += NGT) { const int t = i >> 5, f = i & 31; const float ang = (float)a.pos[t] * ROPE_INVF[f];
                const double rev = (double)ang * 0.15915494309189535; const float fr = (float)(rev - __builtin_rint(rev));
                COS[i] = __builtin_amdgcn_cosf(fr); SIN[i] = __builtin_amdgcn_sinf(fr); } }
        if (gw < S) {
            f32x4 wn[16], va[16], vb[16];
            { const GAS f32x4* wv = (const GAS f32x4*)a.norm_mix_w + lane;
#pragma unroll
              for (int j = 0; j < 16; ++j) wn[j] = wv[64 * j]; }
#define H_LOAD(v, m_) do { const GAS f32x4* xr_ = (const GAS f32x4*)(a.x + (size_t)(m_) * DM) + lane; _Pragma("unroll") for (int j = 0; j < 16; ++j) v[j] = xr_[64 * j]; } while (0)
#define H_ROW(v, m_) do { float ss_ = 0.f; _Pragma("unroll") for (int j = 0; j < 16; ++j) ss_ += (v[j].x * v[j].x + v[j].y * v[j].y) + (v[j].z * v[j].z + v[j].w * v[j].w); \
            const float rs_ = 1.0f / sqrtf(wave_sum(ss_) * (1.0f / DM) + NORM_EPS); GAS unsigned long long* o8_ = (GAS unsigned long long*)(HB + (size_t)(m_) * DM) + lane; \
            GAS unsigned* h8_ = (GAS unsigned*)(H8 + (size_t)(m_) * DM) + lane; \
            float mx_ = 0.f; _Pragma("unroll") for (int j = 0; j < 16; ++j) { v[j] = v[j] * rs_ * wn[j]; mx_ = fmaxf(fmaxf(mx_, fmaxf(fabsf(v[j].x), fabsf(v[j].y))), fmaxf(fabsf(v[j].z), fabsf(v[j].w))); } \
            _Pragma("unroll") for (int o_ = 32; o_ >= 1; o_ >>= 1) mx_ = fmaxf(mx_, __shfl_xor(mx_, o_)); mx_ = fmaxf(mx_, 1e-20f); const float qs_ = 127.0f / mx_; if (lane == 0) HSC[m_] = mx_ * (1.0f / 127.0f); \
            _Pragma("unroll") for (int j = 0; j < 16; ++j) { const f32x4 hv_ = v[j]; o8_[64 * j] = (unsigned long long)pk2(hv_.x, hv_.y) | ((unsigned long long)pk2(hv_.z, hv_.w) << 32); h8_[64 * j] = pg8::pk4_i8(hv_ * qs_); } } while (0)
            int m = gw; H_LOAD(va, m);
            for (;;) {
                if (m + NGW < S) H_LOAD(vb, m + NGW);
                H_ROW(va, m); m += NGW; if (m >= S) break;
                if (m + NGW < S) H_LOAD(va, m + NGW);
                H_ROW(vb, m); m += NGW; if (m >= S) break;
            }
#undef H_LOAD
#undef H_ROW
        }
    }
    if (((DUP_MASK >> 0) & 1) && IN(0)) xcd_barrier(bar);
    if (IN(0)) {
        {
            constexpr int CB_UP = UPW / 256, CB_G = (INW - ZC_CQ + 255) / 256, NITM = (CB_UP + CB_G) * 64;
            for (int it = gw; it < NITM; it += NGW) { const int kb = it & 63, cb = it >> 6; const bool up = cb < CB_UP; const int c0 = up ? cb * 256 : (cb - CB_UP) * 256 + ZC_CQ; const int N_ = up ? UPW : INW;
                const float* W_ = up ? a.w_up : a.w_in;
                const GAS f32x4* p = (const GAS f32x4*)(W_ + (size_t)(kb * 64) * N_ + c0) + lane; f32x4 mx = {0.f, 0.f, 0.f, 0.f};
                const bool inr = c0 + 4 * lane < N_;
#pragma unroll 8
                for (int k = 0; k < 64; ++k) { const f32x4 v = inr ? p[(size_t)k * (N_ / 4)] : (f32x4){0.f, 0.f, 0.f, 0.f}; const float g = up ? a.norm_ffn_w[kb * 64 + k] : 1.0f;
#pragma unroll
                    for (int e = 0; e < 4; ++e) mx[e] = fmaxf(mx[e], fabsf(v[e] * g)); }
#pragma unroll
                for (int e = 0; e < 4; ++e) { const int n = c0 + 4 * lane + e; if (!inr) continue; const int row = up ? MapUp()(n) : MapIn()(n) - ZC_CQ;
                    __hip_atomic_fetch_max((up ? WMU : WMG) + row, __float_as_uint(mx[e]), __ATOMIC_RELAXED, __HIP_MEMORY_SCOPE_AGENT); } }
            xcd_barrier(bar);
        }
        LAS float* scr = (LAS float*)(ldsl + RING_OFF + wave * 16384);
        constexpr int I_IN = (DM / 64) * (INW / 32), I_UQ = (QRANK / 64) * (QMW / 32), I_UKV = (KVRANK / 64) * (KVW / 32), I_OD = (2048 / 64) * (DM / 32), I_OUT = (DM / 64) * (DM / 32),
                      I_UP = (DM / 64) * (UPW / 32), I_DN = (DFF / 64) * (DM / 32);
        constexpr int NITEMS = I_IN + I_UQ + I_UKV + 2 * I_OD + I_OUT + I_UP + I_DN;
        auto decode = [&](int it) -> TrItem { TrItem d; int r = it; int KB_;
            d.W8 = nullptr; d.w8row0 = 0; d.WM = nullptr;
            if (r < I_IN) { d.W = a.w_in; d.W8 = WIN8; d.w8row0 = ZC_CQ; d.WM = WMG; d.ks = nullptr; d.WT = WIN; d.N = INW; d.ldt = DM; d.koff = 0; d.mapk = 1; KB_ = DM / 64; }
            else if ((r -= I_IN) < I_UQ) { d.W = a.w_uq; d.ks = a.q_norm_w; d.WT = WUQ; d.N = QMW; d.ldt = QRANK; d.koff = 0; d.mapk = 2; KB_ = QRANK / 64; }
            else if ((r -= I_UQ) < I_UKV) { d.W = a.w_ukv; d.ks = a.kv_norm_w; d.WT = WUKV; d.N = KVW; d.ldt = KVRANK; d.koff = 0; d.mapk = 3; KB_ = KVRANK / 64; }
            else if ((r -= I_UKV) < I_OD) { d.W = a.w_o_diff; d.ks = nullptr; d.WT = WO; d.N = DM; d.ldt = 4096; d.koff = 0; d.mapk = 0; KB_ = 2048 / 64; }
            else if ((r -= I_OD) < I_OD) { d.W = a.w_o_mla; d.ks = nullptr; d.WT = WO; d.N = DM; d.ldt = 4096; d.koff = 2048; d.mapk = 0; KB_ = 2048 / 64; }
            else if ((r -= I_OD) < I_OUT) { d.W = a.w_out; d.ks = nullptr; d.WT = WOUT; d.N = DM; d.ldt = DM; d.koff = 0; d.mapk = 0; KB_ = DM / 64; }
            else if ((r -= I_OUT) < I_UP) { d.W = a.w_up; d.ks = a.norm_ffn_w; d.WT = WUP; d.N = UPW; d.ldt = DM; d.koff = 0; d.mapk = 4; KB_ = DM / 64; d.W8 = WUP8; d.WM = WMU; }
            else { r -= I_UP; d.W = a.w_down; d.ks = nullptr; d.WT = WDOWN; d.N = DM; d.ldt = DFF; d.koff = 0; d.mapk = 0; KB_ = DFF / 64; }
            const int nblk = d.N / 32, kblk = KB_; const int grp = r / (kblk * 32), rem = r - grp * (kblk * 32); const int kb = rem % kblk, nb = grp * 32 + rem / kblk; (void)nblk;
            d.k0 = 64 * kb; d.n0 = 32 * nb; return d; };
        if (gw < NITEMS) {
            int it = gw; const int cs = NGW, it1 = NITEMS; TrItem d0, d1, d2, d3; float v0[32], v1[32], v2[32], v3[32], g0[8], g1[8], g2[8], g3[8];
            d0 = decode(it); tr_load(d0, v0, g0, lane); d1 = d0; d2 = d0; d3 = d0;
            if (it + cs < it1) { d1 = decode(it + cs); tr_load(d1, v1, g1, lane); }
            if (it + 2 * cs < it1) { d2 = decode(it + 2 * cs); tr_load(d2, v2, g2, lane); }
            for (;;) {
                if (it + 3 * cs < it1) { d3 = decode(it + 3 * cs); tr_load(d3, v3, g3, lane); }
                tr_store(d0, v0, g0, scr, lane); it += cs; if (it >= it1) break;
                if (it + 3 * cs < it1) { d0 = decode(it + 3 * cs); tr_load(d0, v0, g0, lane); }
                tr_store(d1, v1, g1, scr, lane); it += cs; if (it >= it1) break;
                if (it + 3 * cs < it1) { d1 = decode(it + 3 * cs); tr_load(d1, v1, g1, lane); }
                tr_store(d2, v2, g2, scr, lane); it += cs; if (it >= it1) break;
                if (it + 3 * cs < it1) { d2 = decode(it + 3 * cs); tr_load(d2, v2, g2, lane); }
                tr_store(d3, v3, g3, scr, lane); it += cs; if (it >= it1) break;
            }
        }
        { const int gt = vcu * (NWAVES * 64) + tid, NGT = G * NWAVES * 64; GAS v4u* pz = (GAS v4u*)(WIN8 + (size_t)(ZC_KR + 64 - ZC_CQ) * DM); const int nz = (ZC_GD - ZC_KR - 64) * DM / 16;
            for (int i = gt; i < nz; i += NGT) pz[i] = (v4u){0u, 0u, 0u, 0u};
            for (int i = gt; i < S * 32; i += NGT) { const int t = i >> 5, f = i & 31; const float ang = (float)a.pos[t] * ROPE_INVF[f];
                const double rev = (double)ang * 0.15915494309189535; const float fr = (float)(rev - __builtin_rint(rev));
                COS[i] = __builtin_amdgcn_cosf(fr); SIN[i] = __builtin_amdgcn_sinf(fr); } }
        if (gw < S) {
            f32x4 wn[16], va[16], vb[16];
            { const GAS f32x4* wv = (const GAS f32x4*)a.norm_mix_w + lane;
#pragma unroll
              for (int j = 0; j < 16; ++j) wn[j] = wv[64 * j]; }
#define H_LOAD(v, m_) do { const GAS f32x4* xr_ = (const GAS f32x4*)(a.x + (size_t)(m_) * DM) + lane; _Pragma("unroll") for (int j = 0; j < 16; ++j) v[j] = xr_[64 * j]; } while (0)
#define H_ROW(v, m_) do { float ss_ = 0.f; _Pragma("unroll") for (int j = 0; j < 16; ++j) ss_ += (v[j].x * v[j].x + v[j].y * v[j].y) + (v[j].z * v[j].z + v[j].w * v[j].w); \
            const float rs_ = 1.0f / sqrtf(wave_sum(ss_) * (1.0f / DM) + NORM_EPS); GAS unsigned long long* o8_ = (GAS unsigned long long*)(HB + (size_t)(m_) * DM) + lane; \
            GAS unsigned* h8_ = (GAS unsigned*)(H8 + (size_t)(m_) * DM) + lane; \
            float mx_ = 0.f; _Pragma("unroll") for (int j = 0; j < 16; ++j) { v[j] = v[j] * rs_ * wn[j]; mx_ = fmaxf(fmaxf(mx_, fmaxf(fabsf(v[j].x), fabsf(v[j].y))), fmaxf(fabsf(v[j].z), fabsf(v[j].w))); } \
            _Pragma("unroll") for (int o_ = 32; o_ >= 1; o_ >>= 1) mx_ = fmaxf(mx_, __shfl_xor(mx_, o_)); mx_ = fmaxf(mx_, 1e-20f); const float qs_ = 127.0f / mx_; if (lane == 0) HSC[m_] = mx_ * (1.0f / 127.0f); \
            _Pragma("unroll") for (int j = 0; j < 16; ++j) { const f32x4 hv_ = v[j]; o8_[64 * j] = (unsigned long long)pk2(hv_.x, hv_.y) | ((unsigned long long)pk2(hv_.z, hv_.w) << 32); h8_[64 * j] = pg8::pk4_i8(hv_ * qs_); } } while (0)
            int m = gw; H_LOAD(va, m);
            for (;;) {
                if (m + NGW < S) H_LOAD(vb, m + NGW);
                H_ROW(va, m); m += NGW; if (m >= S) break;
                if (m + NGW < S) H_LOAD(va, m + NGW);
                H_ROW(vb, m); m += NGW; if (m >= S) break;
            }
#undef H_LOAD
#undef H_ROW
        }
    }
    SEAM(0);

    STAMP(1);
    if (((DUP_MASK >> 1) & 1) && IN(1)) {
        pg8::EpiIn E{ZB, COS, SIN, SSQC, KF8R};
        { pg8::Gemm g{HB, WIN, S, 24 * 256, DM, DM, DM}; pg8::StaticOrder So; So.init(S, 24 * 256, G, bx);
          pg8::gemm_phase<pg8::EpiIn, pg8::StaticOrder, true>(ldsl + RING_OFF, g, So, E); }
        {
          pg8::Gemm g{(const pg8::bf16_t*)H8, (const pg8::bf16_t*)WIN8 - (size_t)24 * 256 * (DM / 2), S, 39 * 256, DM / 2, DM / 2, DM / 2}; pg8::SkipOrder So; So.s.init(S, 39 * 256, G, bx); So.skip_from = 0; So.skip_n = 24;
          pg8::EpiIn8 E8{ZB, COS, SIN, SSQC, KF8R, HSC, (const float*)WMG};
          pg8::gemm_phase<pg8::EpiIn8, pg8::SkipOrder, true, pg8::NoHook, false, true>(ldsl + RING_OFF, g, So, E8); }
    }
    if (((DUP_MASK >> 1) & 1) && IN(1)) xcd_barrier(bar);
    if (IN(1)) {
        pg8::EpiIn E{ZB, COS, SIN, SSQC, KF8R};
        { pg8::Gemm g{HB, WIN, S, 24 * 256, DM, DM, DM}; pg8::StaticOrder So; So.init(S, 24 * 256, G, bx);
          pg8::gemm_phase<pg8::EpiIn, pg8::StaticOrder, true>(ldsl + RING_OFF, g, So, E); }
        {
          pg8::Gemm g{(const pg8::bf16_t*)H8, (const pg8::bf16_t*)WIN8 - (size_t)24 * 256 * (DM / 2), S, 39 * 256, DM / 2, DM / 2, DM / 2}; pg8::SkipOrder So; So.s.init(S, 39 * 256, G, bx); So.skip_from = 0; So.skip_n = 24;
          pg8::EpiIn8 E8{ZB, COS, SIN, SSQC, KF8R, HSC, (const float*)WMG};
          pg8::gemm_phase<pg8::EpiIn8, pg8::SkipOrder, true, pg8::NoHook, false, true>(ldsl + RING_OFF, g, So, E8); }
    }
    SEAM(1);

    STAMP(2);
    if (((DUP_MASK >> 2) & 1) && IN(2)) {
        { pg8::Gemm g{ZB + ZC_CQ, WUQ, S, QMW, QRANK, ZW, QRANK}; pg8::StaticOrder So; So.init(S, QMW, G, bx);
          pg8::EpiMla<0, 4, QRANK, 1 << 30> E{QM, QMW, SSQC, COS, SIN, 8, QF8, QMW};
          pg8::gemm_phase<pg8::EpiMla<0, 4, QRANK, 1 << 30>, pg8::StaticOrder, true>(ldsl + RING_OFF, g, So, E); }
        { pg8::Gemm g{ZB + ZC_CKV, WUKV, S, 2048, KVRANK, ZW, KVRANK}; pg8::StaticOrder So; So.init(S, 2048, G, bx);
          pg8::EpiMla<16, 2, KVRANK, 1 << 30> E{KV, KVW, SSQC, COS, SIN, 1 << 30, KF8N, 2048};
          pg8::gemm_phase<pg8::EpiMla<16, 2, KVRANK, 1 << 30>, pg8::StaticOrder, true>(ldsl + RING_OFF, g, So, E); }
        { pg8::Gemm g{WUKV + (size_t)2048 * KVRANK, ZB + ZC_CKV, 2048, S, KVRANK, KVRANK, ZW}; pg8::VtOrder Vo{bx, G};
          pg8::EpiVT E{VT8, SSQC, S};
          pg8::gemm_phase<pg8::EpiVT, pg8::VtOrder, true>(ldsl + RING_OFF, g, Vo, E); }
    }
    if (((DUP_MASK >> 2) & 1) && IN(2)) xcd_barrier(bar);
    if (IN(2)) {
        { pg8::Gemm g{ZB + ZC_CQ, WUQ, S, QMW, QRANK, ZW, QRANK}; pg8::StaticOrder So; So.init(S, QMW, G, bx);
          pg8::EpiMla<0, 4, QRANK, 1 << 30> E{QM, QMW, SSQC, COS, SIN, 8, QF8, QMW};
          pg8::gemm_phase<pg8::EpiMla<0, 4, QRANK, 1 << 30>, pg8::StaticOrder, true>(ldsl + RING_OFF, g, So, E); }
        { pg8::Gemm g{ZB + ZC_CKV, WUKV, S, 2048, KVRANK, ZW, KVRANK}; pg8::StaticOrder So; So.init(S, 2048, G, bx);
          pg8::EpiMla<16, 2, KVRANK, 1 << 30> E{KV, KVW, SSQC, COS, SIN, 1 << 30, KF8N, 2048};
          pg8::gemm_phase<pg8::EpiMla<16, 2, KVRANK, 1 << 30>, pg8::StaticOrder, true>(ldsl + RING_OFF, g, So, E); }
        { pg8::Gemm g{WUKV + (size_t)2048 * KVRANK, ZB + ZC_CKV, 2048, S, KVRANK, KVRANK, ZW}; pg8::VtOrder Vo{bx, G};
          pg8::EpiVT E{VT8, SSQC, S};
          pg8::gemm_phase<pg8::EpiVT, pg8::VtOrder, true>(ldsl + RING_OFF, g, Vo, E); }
    }
    SEAM(2);

    STAMP(3);
    if (((DUP_MASK >> 3) & 1) && IN(3)) {
        float lam;
        { const float a1 = wave_sum(a.lq1[lane] * a.lk1[lane]), a2 = wave_sum(a.lq2[lane] * a.lk2[lane]); lam = expf(a1) - expf(a2) + LAMBDA_INIT; }
        const int row_l = lane & 31, half_l = lane >> 5;
        char* const alds = (char*)lds + RING_OFF;
        if (wave >= 4) __builtin_amdgcn_s_setprio(1);
        for (int rep_ = 0; rep_ < 1 + ((DUP_MASK >> 10) & 1); ++rep_)
        for (int item = vcu; item < NHEAD * 16; item += G) {
            const int h = item >> 4, sp = item & 15;
#ifndef NO_DIFF
#pragma unroll 1
            for (int pc = 0; pc < 4; ++pc) {
                const int c = pc >> 1, pass = pc & 1, qb = pass ? sp : 31 - sp; const int trow = qb * 256 + wave * 32 + row_l;
                att::Src sd; sd.Qn = nullptr; sd.Kn = nullptr;
                sd.Qr = ZB + ZC_QD + (2 * h + c) * 64; sd.Kr = ZB + ZC_KD + (2 * h + c) * 64; sd.V = ZB + ZC_VD + h * 128;
                att::diff_block64<8>(sd.Qr, sd.Kr, sd.V, qb, alds);
                bf16* o1p = (bf16*)O1 + (size_t)trow * 2048 + h * 128 + half_l * 64;
                if (c == 0) {
#pragma unroll
                    for (int j = 0; j < 8; ++j) *(pg8::u32x4*)(o1p + 8 * j) = pg8::pack8(att::staged4(alds, wave, lane, 2 * j), att::staged4(alds, wave, lane, 2 * j + 1));
                } else {
                    f32x4 u[16]; float ss = 0.f;
#pragma unroll
                    for (int j = 0; j < 8; ++j) { pg8::f32x4 a0, a1; pg8::unpack8(*(const pg8::u32x4*)(o1p + 8 * j), a0, a1);
                        u[2 * j] = a0 - lam * att::staged4(alds, wave, lane, 2 * j); u[2 * j + 1] = a1 - lam * att::staged4(alds, wave, lane, 2 * j + 1);
#pragma unroll
                        for (int e = 0; e < 2; ++e) ss += (u[2 * j + e][0] * u[2 * j + e][0] + u[2 * j + e][1] * u[2 * j + e][1]) + (u[2 * j + e][2] * u[2 * j + e][2] + u[2 * j + e][3] * u[2 * j + e][3]); }
                    ss += __shfl_xor(ss, 32);
                    const float rs = (1.0f - LAMBDA_INIT) / sqrtf(ss * (1.0f / 128.0f) + SUBLN_EPS);
                    bf16* ob = OB + (size_t)trow * 4096 + h * 128 + half_l * 64; const float* swp = a.subln_w + half_l * 64;
#pragma unroll
                    for (int j = 0; j < 8; ++j) { const f32x4 w0 = *(const f32x4*)(swp + 8 * j), w1 = *(const f32x4*)(swp + 8 * j + 4);
                        *(pg8::u32x4*)(ob + 8 * j) = pg8::pack8(u[2 * j] * rs * w0, u[2 * j + 1] * rs * w1); }
                }
            }
#endif
        }
        for (int rep_ = 0; rep_ < 1 + ((DUP_MASK >> 11) & 1); ++rep_)
        for (int item = vcu; item < NHEAD * 16; item += G) {
            const int h = item >> 4, sp = item & 15;
#ifndef NO_MLA
#pragma unroll 1
            for (int pass = 0; pass < 2; ++pass) {
                const int qb = pass ? sp : 31 - sp; const int trow = qb * 256 + wave * 32 + row_l;
                att::Src sm; sm.Qn = (const att::bf16_t*)(QF8 + h * 128); sm.Qr = (const att::bf16_t*)(QF8 + 2048 + h * 64); sm.Kn = (const att::bf16_t*)(KF8N + h * 128); sm.Kr = (const att::bf16_t*)KF8R; sm.V = (const att::bf16_t*)(VT8 + (size_t)h * 128 * S);
                att::attn_block<true, 2>(sm, qb, alds);
                bf16* ob = OB + (size_t)trow * 4096 + 2048 + h * 128 + half_l * 64;
#pragma unroll
                for (int j = 0; j < 8; ++j) *(pg8::u32x4*)(ob + 8 * j) = pg8::pack8(att::staged4(alds, wave, lane, 2 * j), att::staged4(alds, wave, lane, 2 * j + 1));
            }
#endif
        }
    }
    if (((DUP_MASK >> 3) & 1) && IN(3)) xcd_barrier(bar);
    if (IN(3)) {
        float lam;
        { const float a1 = wave_sum(a.lq1[lane] * a.lk1[lane]), a2 = wave_sum(a.lq2[lane] * a.lk2[lane]); lam = expf(a1) - expf(a2) + LAMBDA_INIT; }
        const int row_l = lane & 31, half_l = lane >> 5;
        char* const alds = (char*)lds + RING_OFF;
        if (wave >= 4) __builtin_amdgcn_s_setprio(1);
        for (int rep_ = 0; rep_ < 1 + ((DUP_MASK >> 10) & 1); ++rep_)
        for (int item = vcu; item < NHEAD * 16; item += G) {
            const int h = item >> 4, sp = item & 15;
#ifndef NO_DIFF
#pragma unroll 1
            for (int pc = 0; pc < 4; ++pc) {
                const int c = pc >> 1, pass = pc & 1, qb = pass ? sp : 31 - sp; const int trow = qb * 256 + wave * 32 + row_l;
                att::Src sd; sd.Qn = nullptr; sd.Kn = nullptr;
                sd.Qr = ZB + ZC_QD + (2 * h + c) * 64; sd.Kr = ZB + ZC_KD + (2 * h + c) * 64; sd.V = ZB + ZC_VD + h * 128;
                att::diff_block64<8>(sd.Qr, sd.Kr, sd.V, qb, alds);
                bf16* o1p = (bf16*)O1 + (size_t)trow * 2048 + h * 128 + half_l * 64;
                if (c == 0) {
#pragma unroll
                    for (int j = 0; j < 8; ++j) *(pg8::u32x4*)(o1p + 8 * j) = pg8::pack8(att::staged4(alds, wave, lane, 2 * j), att::staged4(alds, wave, lane, 2 * j + 1));
                } else {
                    f32x4 u[16]; float ss = 0.f;
#pragma unroll
                    for (int j = 0; j < 8; ++j) { pg8::f32x4 a0, a1; pg8::unpack8(*(const pg8::u32x4*)(o1p + 8 * j), a0, a1);
                        u[2 * j] = a0 - lam * att::staged4(alds, wave, lane, 2 * j); u[2 * j + 1] = a1 - lam * att::staged4(alds, wave, lane, 2 * j + 1);
#pragma unroll
                        for (int e = 0; e < 2; ++e) ss += (u[2 * j + e][0] * u[2 * j + e][0] + u[2 * j + e][1] * u[2 * j + e][1]) + (u[2 * j + e][2] * u[2 * j + e][2] + u[2 * j + e][3] * u[2 * j + e][3]); }
                    ss += __shfl_xor(ss, 32);
                    const float rs = (1.0f - LAMBDA_INIT) / sqrtf(ss * (1.0f / 128.0f) + SUBLN_EPS);
                    bf16* ob = OB + (size_t)trow * 4096 + h * 128 + half_l * 64; const float* swp = a.subln_w + half_l * 64;
#pragma unroll
                    for (int j = 0; j < 8; ++j) { const f32x4 w0 = *(const f32x4*)(swp + 8 * j), w1 = *(const f32x4*)(swp + 8 * j + 4);
                        *(pg8::u32x4*)(ob + 8 * j) = pg8::pack8(u[2 * j] * rs * w0, u[2 * j + 1] * rs * w1); }
                }
            }
#endif
        }
        for (int rep_ = 0; rep_ < 1 + ((DUP_MASK >> 11) & 1); ++rep_)
        for (int item = vcu; item < NHEAD * 16; item += G) {
            const int h = item >> 4, sp = item & 15;
#ifndef NO_MLA
#pragma unroll 1
            for (int pass = 0; pass < 2; ++pass) {
                const int qb = pass ? sp : 31 - sp; const int trow = qb * 256 + wave * 32 + row_l;
                att::Src sm; sm.Qn = (const att::bf16_t*)(QF8 + h * 128); sm.Qr = (const att::bf16_t*)(QF8 + 2048 + h * 64); sm.Kn = (const att::bf16_t*)(KF8N + h * 128); sm.Kr = (const att::bf16_t*)KF8R; sm.V = (const att::bf16_t*)(VT8 + (size_t)h * 128 * S);
                att::attn_block<true, 2>(sm, qb, alds);
                bf16* ob = OB + (size_t)trow * 4096 + 2048 + h * 128 + half_l * 64;
#pragma unroll
                for (int j = 0; j < 8; ++j) *(pg8::u32x4*)(ob + 8 * j) = pg8::pack8(att::staged4(alds, wave, lane, 2 * j), att::staged4(alds, wave, lane, 2 * j + 1));
            }
#endif
        }
    }
    __builtin_amdgcn_s_setprio(0);
    SEAM(3);

    STAMP(4);
    if (((DUP_MASK >> 4) & 1) && IN(4)) {
        pg8::Gemm g{OB, WO, S, DM, 4096, 4096, 4096}; pg8::StaticOrder So; So.init(S, DM, G, bx);
        pg8::EpiGate E{ZB + ZC_GM, YB}; pg8::GateHook HK{ZB + ZC_GD, ZB + ZC_GM};
        pg8::gemm_phase<pg8::EpiGate, pg8::StaticOrder, true, pg8::GateHook>(ldsl + RING_OFF, g, So, E, HK);
    }
    if (((DUP_MASK >> 4) & 1) && IN(4)) xcd_barrier(bar);
    if (IN(4)) {
        pg8::Gemm g{OB, WO, S, DM, 4096, 4096, 4096}; pg8::StaticOrder So; So.init(S, DM, G, bx);
        pg8::EpiGate E{ZB + ZC_GM, YB}; pg8::GateHook HK{ZB + ZC_GD, ZB + ZC_GM};
        pg8::gemm_phase<pg8::EpiGate, pg8::StaticOrder, true, pg8::GateHook>(ldsl + RING_OFF, g, So, E, HK);
    }
    SEAM(4);

    STAMP(5);
    if (((DUP_MASK >> 5) & 1) && IN(5)) {
        pg8::Gemm g{YB, WOUT, S, DM, DM, DM, DM}; pg8::StaticOrder So; So.init(S, DM, G, bx);
        pg8::EpiRes<false> E{a.x, XB, SSQ1};
        pg8::gemm_phase<pg8::EpiRes<false>, pg8::StaticOrder, true>(ldsl + RING_OFF, g, So, E);
    }
    if (((DUP_MASK >> 5) & 1) && IN(5)) xcd_barrier(bar);
    if (IN(5)) {
        pg8::Gemm g{YB, WOUT, S, DM, DM, DM, DM}; pg8::StaticOrder So; So.init(S, DM, G, bx);
        pg8::EpiRes<false> E{a.x, XB, SSQ1};
        pg8::gemm_phase<pg8::EpiRes<false>, pg8::StaticOrder, true>(ldsl + RING_OFF, g, So, E);
    }
    SEAM(5);

    STAMP(6);
    if (IN(6)) {
        for (int m = gw; m < S; m += NGW) { const float sm = wave_sum(SSQ1[(size_t)m * 64 + lane]); const float rs = 1.0f / sqrtf(sm * (1.0f / DM) + NORM_EPS); if (lane == 0) RSTD1[m] = rs;
            const GAS pg8::u32x4* xr = (const GAS pg8::u32x4*)(XB + (size_t)m * DM) + lane; pg8::f32x4 xv[16]; float mx = 0.f;
#pragma unroll
            for (int jj = 0; jj < 8; ++jj) { pg8::unpack8(xr[64 * jj], xv[2 * jj], xv[2 * jj + 1]);
#pragma unroll
                for (int e = 0; e < 4; ++e) mx = fmaxf(mx, fmaxf(fabsf(xv[2 * jj][e]), fabsf(xv[2 * jj + 1][e]))); }
#pragma unroll
            for (int o_ = 32; o_ >= 1; o_ >>= 1) mx = fmaxf(mx, __shfl_xor(mx, o_));
            mx = fmaxf(mx * rs, 1e-20f); const float qs = rs * 127.0f / mx; if (lane == 0) XSC[m] = mx * (1.0f / 127.0f);
            GAS v2u* xo = (GAS v2u*)(XN8 + (size_t)m * DM) + lane;
#pragma unroll
            for (int jj = 0; jj < 8; ++jj) { v2u w; w.x = pg8::pk4_i8(xv[2 * jj] * qs); w.y = pg8::pk4_i8(xv[2 * jj + 1] * qs); xo[64 * jj] = w; } }
    }
    SEAM(6);

    STAMP(7);
    if (((DUP_MASK >> 7) & 1) && IN(7)) {
        pg8::Gemm g{(const pg8::bf16_t*)XN8, (const pg8::bf16_t*)WUP8, S, UPW, DM / 2, DM / 2, DM / 2}; pg8::StaticOrder So; So.init(S, UPW, G, bx);
        pg8::EpiUpConv E{ACT, HALO, a.conv_w, a.conv_b, XSC, (LAS float*)(ldsl + XCH_OFF), (const float*)WMU};
        pg8::gemm_phase<pg8::EpiUpConv, pg8::StaticOrder, true, pg8::NoHook, false, true>(ldsl + RING_OFF, g, So, E);
    }
    if (((DUP_MASK >> 7) & 1) && IN(7)) xcd_barrier(bar);
    if (IN(7)) {
        pg8::Gemm g{(const pg8::bf16_t*)XN8, (const pg8::bf16_t*)WUP8, S, UPW, DM / 2, DM / 2, DM / 2}; pg8::StaticOrder So; So.init(S, UPW, G, bx);
        pg8::EpiUpConv E{ACT, HALO, a.conv_w, a.conv_b, XSC, (LAS float*)(ldsl + XCH_OFF), (const float*)WMU};
        pg8::gemm_phase<pg8::EpiUpConv, pg8::StaticOrder, true, pg8::NoHook, false, true>(ldsl + RING_OFF, g, So, E);
    }
    SEAM(7);

    STAMP(8);
    if (IN(8)) {
        pg8::Gemm g{ACT, WDOWN, S, DM, DFF, DFF, DFF}; pg8::StaticOrder So; So.init(S, DM, G, bx);
        { pg8::Unit un; int last_pm = 0;
            for (int ui = 0; So.next(ui, un); ++ui) { const int pm = un.pm; if (pm == last_pm) continue; last_pm = pm;
                const float* ha = HALO + ((size_t)(pm - 1) * 4 + 2) * UPW; const float* hb = ha + UPW; const float* h0 = HALO + (size_t)pm * 4 * UPW; const float* h1 = h0 + UPW;
                for (int c = tid; c < DFF; c += NWAVES * 64) { const int gc = (c >> 7) * 256 + (c & 127), vc = gc + 128;
                    const float sg = __uint_as_float(WMU[gc]) * (1.0f / 127.0f), sv = __uint_as_float(WMU[vc]) * (1.0f / 127.0f);
                    const float wg0 = a.conv_w[c] * sg, wg1 = a.conv_w[UPW + c] * sg, wg2 = a.conv_w[2 * UPW + c] * sg, bg = a.conv_b[c];
                    const float wv0 = a.conv_w[DFF + c] * sv, wv1 = a.conv_w[UPW + DFF + c] * sv, wv2 = a.conv_w[2 * UPW + DFF + c] * sv, bv = a.conv_b[DFF + c];
                    const float ga = ha[gc], gb = hb[gc], g0 = h0[gc], g1 = h1[gc], va = ha[vc], vb = hb[vc], v0 = h0[vc], v1 = h1[vc];
                    const float og0 = bg + wg0 * ga + wg1 * gb + wg2 * g0, og1 = bg + wg0 * gb + wg1 * g0 + wg2 * g1;
                    const float ov0 = bv + wv0 * va + wv1 * vb + wv2 * v0, ov1 = bv + wv0 * vb + wv1 * v0 + wv2 * v1;
                    ACT[(size_t)(pm * 256) * DFF + c] = (bf16)f2bf(og0 * pg8::sigmoidf_fast(og0) * ov0);
                    ACT[(size_t)(pm * 256 + 1) * DFF + c] = (bf16)f2bf(og1 * pg8::sigmoidf_fast(og1) * ov1); } }
            VM_WAIT(); __syncthreads(); }
        pg8::EpiRes<true> E{nullptr, XB, SSQ2};
        pg8::gemm_phase<pg8::EpiRes<true>, pg8::StaticOrder, true>(ldsl + RING_OFF, g, So, E);
    }
    SEAM(8);

    STAMP(9);
    if (IN(9)) {
        if (gw < S) {
            int l9 = threadIdx.x; asm volatile("" : "+v"(l9)); l9 &= 63;
            f32x4 wf[16]; pg8::u32x4 xa[8], xb[8]; float qa, qb;
            { const GAS f32x4* wv = (const GAS f32x4*)a.final_w;
#pragma unroll
              for (int jj = 0; jj < 8; ++jj) { wf[2 * jj] = wv[(64 * jj + l9) * 2]; wf[2 * jj + 1] = wv[(64 * jj + l9) * 2 + 1]; } }
#define F_LOAD(x_, q_, m_) do { q_ = SSQ2[(size_t)(m_) * 64 + l9]; const GAS pg8::u32x4* xr_ = (const GAS pg8::u32x4*)(XB + (size_t)(m_) * DM) + l9; _Pragma("unroll") for (int jj = 0; jj < 8; ++jj) x_[jj] = xr_[64 * jj]; } while (0)
#define F_ROW(x_, q_, m_) do { const float rs_ = 1.0f / sqrtf(wave_sum(q_) * (1.0f / DM) + NORM_EPS); GAS f32x4* orow_ = (GAS f32x4*)(a.out + (size_t)(m_) * DM); \
            _Pragma("unroll") for (int jj = 0; jj < 8; ++jj) { pg8::f32x4 v0_, v1_; pg8::unpack8(x_[jj], v0_, v1_); const int c4_ = (64 * jj + l9) * 2; \
                orow_[c4_] = v0_ * rs_ * wf[2 * jj]; orow_[c4_ + 1] = v1_ * rs_ * wf[2 * jj + 1]; } } while (0)
            int m = gw; F_LOAD(xa, qa, m);
            for (;;) {
                if (m + NGW < S) F_LOAD(xb, qb, m + NGW);
                F_ROW(xa, qa, m); m += NGW; if (m >= S) break;
                if (m + NGW < S) F_LOAD(xa, qa, m + NGW);
                F_ROW(xb, qb, m); m += NGW; if (m >= S) break;
            }
#undef F_LOAD
#undef F_ROW
        }
    }
#ifdef TP_I0
    xcd_barrier(bar); STAMP(10); xcd_barrier(bar);
    { const unsigned long long tI = __hip_atomic_load(tsw + TP_I1 + 1, RLX_AGENT) - __hip_atomic_load(tsw + TP_I0, RLX_AGENT), tJ = __hip_atomic_load(tsw + TP_J1 + 1, RLX_AGENT) - __hip_atomic_load(tsw + TP_J0, RLX_AGENT);
      const float B = sqrtf((float)tI * 0.01f), A = (float)tJ * 0.01f;
      const size_t gt = (size_t)bx * (NWAVES * 64) + tid, NT = (size_t)G * NWAVES * 64;
      for (size_t i = gt; i < (size_t)S * DM; i += NT) a.out[i] = (i == 0) ? A : B; }
#endif
#undef IN
#undef SEAM
}


#if MK_PER_PHASE == 2
struct CsRange { size_t off; size_t bytes; };
__global__ void csum_kernel(const unsigned char* ws, const float* outp, unsigned* cs, CsRange r0, CsRange r1, CsRange r2, int use_out) {
    unsigned s1 = 0u, s2 = 0u;
    const size_t gt = (size_t)blockIdx.x * blockDim.x + threadIdx.x, NT = (size_t)gridDim.x * blockDim.x;
    CsRange rr[3] = {r0, r1, r2};
#pragma unroll
    for (int k = 0; k < 3; ++k) { const unsigned* p = (const unsigned*)(ws + rr[k].off); const size_t n = rr[k].bytes / 4;
        for (size_t i = gt; i < n; i += NT) { const unsigned w = p[i]; s1 += w; s2 += w * ((unsigned)(i & 0xffffu) | 1u); } }
    if (use_out) { const unsigned* p = (const unsigned*)outp; const size_t n = (size_t)S * DM;
        for (size_t i = gt; i < n; i += NT) { const unsigned w = p[i]; s1 += w; s2 += w * ((unsigned)(i & 0xffffu) | 1u); } }
    atomicAdd(cs, s1); atomicAdd(cs + 1, s2);
}
__global__ void encode_kernel(float* outp, const unsigned* cs) {
    int code = 20;
    for (int k = 9; k >= 0; --k) if (cs[2 * k] != cs[32 + 2 * k] || cs[2 * k + 1] != cs[32 + 2 * k + 1]) code = k + 1;
    const float c = sqrtf(10.0f * (float)code);
    const size_t gt = (size_t)blockIdx.x * blockDim.x + threadIdx.x, NT = (size_t)gridDim.x * blockDim.x;
    for (size_t i = gt; i < (size_t)S * DM; i += NT) outp[i] = c;
}
#endif


#if MK_PER_PHASE == 3
__global__ void zsum_kernel(const unsigned char* ws, unsigned* cs) {
    unsigned g[6] = {0u, 0u, 0u, 0u, 0u, 0u};
    const size_t gt = (size_t)blockIdx.x * blockDim.x + threadIdx.x, NT = (size_t)gridDim.x * blockDim.x;
    const unsigned* z = (const unsigned*)(ws + WS_Z); const size_t n = (size_t)S * ZW / 2;
    for (size_t i = gt; i < n; i += NT) { const int col = (int)(i % (ZW / 2)) * 2, pn = col >> 8; const unsigned w = z[i] * ((unsigned)(i & 0xffffu) | 1u);
        const int grp = (pn < 16) ? 0 : (pn < 24) ? 1 : (pn < 30) ? 2 : (pn == 30) ? 4 : 3; g[grp] += w; }
    const unsigned* q = (const unsigned*)(ws + WS_SSQC); for (size_t i = gt; i < (size_t)S * 24; i += NT) g[5] += q[i] * ((unsigned)(i & 0xffffu) | 1u);
#pragma unroll
    for (int k = 0; k < 6; ++k) atomicAdd(cs + k, g[k]);
}
__global__ void encode3_kernel(float* outp, const unsigned* cs) {
    int mask = 0;
    for (int k = 0; k < 6; ++k) if (cs[k] != cs[8 + k]) mask |= (k < 5 ? (1 << k) : 0);
    int rer = 0; for (int k = 0; k < 6; ++k) if (cs[8 + k] != cs[16 + k]) rer = 1;
    const int ssq = cs[5] != cs[13];
    const float c = sqrtf(10.0f * (float)(mask + 1) + 1000.0f * rer + 2000.0f * ssq);
    const size_t gt = (size_t)blockIdx.x * blockDim.x + threadIdx.x, NT = (size_t)gridDim.x * blockDim.x;
    for (size_t i = gt; i < (size_t)S * DM; i += NT) outp[i] = c;
}
#endif

constexpr int N_PHASES = 10;
extern "C" void kernel_launch(void* const* d_in, const int* in_sizes, int n_in, void* d_out, int out_size, void* d_ws, size_t ws_size, hipStream_t stream) {
    static int grid = 0;
    if (grid == 0) {
        if (n_in != 22 || in_sizes[0] != S * DM || out_size != S * DM || ws_size < WS_END) { fprintf(stderr, "kernel_launch: unexpected shapes (n_in %d, in0 %d, out %d, ws %zu)\n", n_in, n_in > 0 ? in_sizes[0] : -1, out_size, ws_size); grid = -1; return; }
        int dev = 0, cus = 0, per_cu = 0;
        if (hipGetDevice(&dev) != hipSuccess || hipDeviceGetAttribute(&cus, hipDeviceAttributeMultiprocessorCount, dev) != hipSuccess) { grid = -1; return; }
        if (hipFuncSetAttribute((const void*)fwd_kernel, hipFuncAttributeMaxDynamicSharedMemorySize, LDS_BYTES) != hipSuccess) { fprintf(stderr, "kernel_launch: hipFuncSetAttribute failed\n"); grid = -1; return; }
        if (hipOccupancyMaxActiveBlocksPerMultiprocessor(&per_cu, (const void*)fwd_kernel, NWAVES * 64, LDS_BYTES) != hipSuccess || per_cu < 1)
            fprintf(stderr, "kernel_launch: note: occupancy query reports %d workgroups per CU\n", per_cu);
        (void)hipGetLastError();
        grid = cus;
    }
    if (grid < 0) return;
    if (hipMemsetAsync((char*)d_ws + WS_CTL, 0, CTL_ZERO_BYTES, stream) != hipSuccess) return;
    Args a{};
    a.x = (const float*)d_in[0]; a.pos = (const int*)d_in[1]; a.norm_mix_w = (const float*)d_in[2]; a.w_in = (const float*)d_in[3];
    a.lq1 = (const float*)d_in[4]; a.lk1 = (const float*)d_in[5]; a.lq2 = (const float*)d_in[6]; a.lk2 = (const float*)d_in[7];
    a.subln_w = (const float*)d_in[8]; a.q_norm_w = (const float*)d_in[9]; a.w_uq = (const float*)d_in[10]; a.kv_norm_w = (const float*)d_in[11];
    a.w_ukv = (const float*)d_in[12]; a.w_o_diff = (const float*)d_in[13]; a.w_o_mla = (const float*)d_in[14]; a.w_out = (const float*)d_in[15];
    a.norm_ffn_w = (const float*)d_in[16]; a.w_up = (const float*)d_in[17]; a.conv_w = (const float*)d_in[18]; a.conv_b = (const float*)d_in[19];
    a.w_down = (const float*)d_in[20]; a.final_w = (const float*)d_in[21];
    a.out = (float*)d_out; a.ws = (unsigned char*)d_ws;
#if MK_PER_PHASE == 3
    unsigned* cs = (unsigned*)((char*)d_ws + 512 * 1024);
    for (int run = 0; run < 2; ++run) {
        hipMemsetAsync((char*)d_ws + MiB, run ? 0x55 : 0xAA, WS_END - MiB, stream);
        for (int p = 0; p < 2; ++p) { a.ph_lo = p; a.ph_hi = p + 1; hipLaunchKernelGGL(fwd_kernel, dim3(grid), dim3(NWAVES * 64), LDS_BYTES, stream, a); }
        hipLaunchKernelGGL(zsum_kernel, dim3(2048), dim3(256), 0, stream, (const unsigned char*)d_ws, cs + 8 * run);
    }
    a.ph_lo = 1; a.ph_hi = 2; hipLaunchKernelGGL(fwd_kernel, dim3(grid), dim3(NWAVES * 64), LDS_BYTES, stream, a);
    hipLaunchKernelGGL(zsum_kernel, dim3(2048), dim3(256), 0, stream, (const unsigned char*)d_ws, cs + 16);
    hipLaunchKernelGGL(encode3_kernel, dim3(2048), dim3(256), 0, stream, (float*)d_out, (const unsigned*)cs);
#elif MK_PER_PHASE == 2
    unsigned* cs = (unsigned*)((char*)d_ws + 512 * 1024);
    for (int run = 0; run < 2; ++run) {
        hipMemsetAsync((char*)d_ws + MiB, run ? 0x55 : 0xAA, WS_END - MiB, stream); hipMemsetAsync(d_out, run ? 0x55 : 0xAA, (size_t)S * DM * 4, stream);
        for (int p = 0; p < N_PHASES; ++p) { a.ph_lo = p; a.ph_hi = p + 1; hipLaunchKernelGGL(fwd_kernel, dim3(grid), dim3(NWAVES * 64), LDS_BYTES, stream, a);
            CsRange r0{0, 0}, r1{0, 0}, r2{0, 0}; int uo = 0;
            switch (p) {
                case 0: r0 = {WS_COS, 2 * MiB}; r1 = {WS_WIN, WS_O - WS_WIN}; break;
                case 1: r0 = {WS_Z, 252 * MiB}; r1 = {WS_SSQC, (size_t)S * 24 * 4}; break;
                case 2: r0 = {WS_QM, 112 * MiB}; break;
                case 3: r0 = {WS_O, 64 * MiB}; r1 = {WS_O1, 64 * MiB}; break;
                case 4: r0 = {WS_H, 64 * MiB}; r1 = {WS_T1, 128 * MiB}; break;
                case 5: r0 = {WS_X1, 128 * MiB}; r1 = {WS_O, 64 * MiB}; r2 = {WS_SSQ1, 2 * MiB}; break;
                case 6: r0 = {WS_U, 344 * MiB}; r1 = {WS_RSTD1, (size_t)S * 4}; break;
                case 7: r0 = {WS_ACT, 172 * MiB}; break;
                case 8: r0 = {WS_SSQ2, 2 * MiB}; uo = 1; break;
                default: uo = 1; break;
            }
            hipLaunchKernelGGL(csum_kernel, dim3(2048), dim3(256), 0, stream, (const unsigned char*)d_ws, (const float*)d_out, cs + 32 * run + 2 * p, r0, r1, r2, uo);
        }
    }
    hipLaunchKernelGGL(encode_kernel, dim3(2048), dim3(256), 0, stream, (float*)d_out, (const unsigned*)cs);
#elif MK_PER_PHASE
    for (int p = 0; p < N_PHASES; ++p) { a.ph_lo = p; a.ph_hi = p + 1; hipLaunchKernelGGL(fwd_kernel, dim3(grid), dim3(NWAVES * 64), LDS_BYTES, stream, a); }
#else
    a.ph_lo = 0; a.ph_hi = N_PHASES;
    hipLaunchKernelGGL(fwd_kernel, dim3(grid), dim3(NWAVES * 64), LDS_BYTES, stream, a);
#endif
    const hipError_t le = hipPeekAtLastError();
    if (le != hipSuccess) fprintf(stderr, "kernel_launch: launch failed: %s\n", hipGetErrorName(le));
}
```

```cpp
#include <hip/hip_runtime.h>
#include <hip/hip_bf16.h>
#include <cstdio>
#include <cstdint>

#ifndef MK_PER_PHASE
#define MK_PER_PHASE 0
#endif

constexpr int S = 8192, DM = 4096, NHEAD = 16;
constexpr int INW = 15936, ZW = 16128;
constexpr int ZC_QD = 0, ZC_KD = 2048, ZC_VD = 4096, ZC_CQ = 6144, ZC_CKV = 7168, ZC_KR = 7680, ZC_GD = 7936, ZC_GM = 12032;
constexpr int ZC_I8 = ZC_VD, PN_I8 = ZC_I8 / 256;
constexpr int QRANK = 1024, KVRANK = 512;
constexpr int QMW = 3072, KVW = 4096;
constexpr int DFF = 11008, UPW = 22016;
constexpr float NORM_EPS = 1e-6f, SUBLN_EPS = 1e-5f, LAMBDA_INIT = 0.2f;

#define GAS __attribute__((address_space(1)))
#define LAS __attribute__((address_space(3)))
typedef unsigned short bf16;
typedef unsigned v4u __attribute__((ext_vector_type(4)));
typedef unsigned v2u __attribute__((ext_vector_type(2)));
typedef GAS unsigned gu32;
#define RLX_AGENT __ATOMIC_RELAXED, __HIP_MEMORY_SCOPE_AGENT
#define LDS_WAIT() asm volatile("s_waitcnt lgkmcnt(0)" ::: "memory")
#define VM_WAIT() asm volatile("s_waitcnt vmcnt(0)" ::: "memory")

namespace pg8 {
#define PG8_LAS __attribute__((address_space(3)))
typedef unsigned short bf16_t;
typedef short bf16x8 __attribute__((ext_vector_type(8)));
typedef float f32x4 __attribute__((ext_vector_type(4)));
typedef unsigned u32x4 __attribute__((ext_vector_type(4)));
constexpr int BM = 256, BK = 64, HALF = 128, HTB = HALF * BK * 2, STAGE_BYTES = 8 * HTB, NXCD = 8, WGM = 8;

__host__ __device__ __forceinline__ int lds_byte(int r, int c) { const int st = (r >> 4) * 2 + (c >> 5), rr = r & 15, cc = c & 31, ob = rr * 64 + cc * 2; return st * 1024 + (ob ^ (((ob >> 9) & 1) << 5)); }
__host__ __device__ __forceinline__ void stage_rc(int b, int& R, int& C) { const int st = b / 1024, sb = b % 1024, swz = sb ^ (((sb >> 9) & 1) << 5); R = (st >> 1) * 16 + swz / 64; C = (st & 1) * 32 + (swz % 64) / 2; }
__host__ __device__ __forceinline__ int perm32(int rho) { const int n = rho >> 4, i = rho & 15; return 8 * (i >> 2) + 4 * n + (i & 3); }

struct Unit { int pm, pn; };
typedef int v8i32g __attribute__((ext_vector_type(8))); typedef int v4i32g __attribute__((ext_vector_type(4)));
struct Gemm { const bf16_t* A; const bf16_t* Bt; int M, N, K, lda, ldb; };

struct StaticOrder {
    int nM, nN, nwg, G, c;
    __host__ __device__ void init(int M, int N, int G_, int c_) { nM = M / BM; nN = N / BM; nwg = nM * nN; G = G_; c = c_; }
    __host__ __device__ __forceinline__ bool next(int i, Unit& u) const {
        const long L = (long)i * G + c; if (L >= nwg) return false;
        int wgid = (int)L; { const int q = nwg / NXCD, r = nwg % NXCD, xcd = wgid % NXCD, off = wgid / NXCD; wgid = (xcd < r ? xcd * (q + 1) : r * (q + 1) + (xcd - r) * q) + off; }
        const int nig = WGM * nN, gid = wgid / nig, fm = gid * WGM, gsz = (nM - fm) < WGM ? (nM - fm) : WGM;
        u.pm = fm + ((wgid % nig) % gsz); u.pn = (wgid % nig) / gsz; return true;
    }
    __device__ __forceinline__ void a_ready(const Unit&) const {}
    __device__ __forceinline__ void done(const Unit&) const {}
};

typedef float f32x2_t __attribute__((ext_vector_type(2))); typedef __bf16 bf16x2_t __attribute__((ext_vector_type(2)));
__device__ __forceinline__ unsigned cvt_pk_bf16(float lo, float hi) { f32x2_t v = {lo, hi}; bf16x2_t b = __builtin_convertvector(v, bf16x2_t); return __builtin_bit_cast(unsigned, b); }
__device__ __forceinline__ u32x4 pack8(f32x4 a, f32x4 b) { u32x4 w; w.x = cvt_pk_bf16(a[0], a[1]); w.y = cvt_pk_bf16(a[2], a[3]); w.z = cvt_pk_bf16(b[0], b[1]); w.w = cvt_pk_bf16(b[2], b[3]); return w; }
__device__ __forceinline__ void unpack8(u32x4 w, f32x4& a, f32x4& b) {
    a[0] = __uint_as_float(w.x << 16); a[1] = __uint_as_float(w.x & 0xffff0000u); a[2] = __uint_as_float(w.y << 16); a[3] = __uint_as_float(w.y & 0xffff0000u);
    b[0] = __uint_as_float(w.z << 16); b[1] = __uint_as_float(w.z & 0xffff0000u); b[2] = __uint_as_float(w.w << 16); b[3] = __uint_as_float(w.w & 0xffff0000u); }
__device__ __forceinline__ unsigned pk4_fp8(const f32x4 v) { int w = __builtin_amdgcn_cvt_pk_fp8_f32(v[0], v[1], 0, false); w = __builtin_amdgcn_cvt_pk_fp8_f32(v[2], v[3], w, true); return (unsigned)w; }
__device__ __forceinline__ unsigned pk4_i8(const f32x4 v) { unsigned w = 0;
#pragma unroll
    for (int e = 0; e < 4; ++e) { const int q = (int)__builtin_rintf(__builtin_fminf(__builtin_fmaxf(v[e], -127.f), 127.f)); w |= ((unsigned)q & 0xffu) << (8 * e); } return w; }
__device__ __forceinline__ float sigmoidf_fast(float v) { return __builtin_amdgcn_rcpf(1.0f + __builtin_amdgcn_exp2f(-1.4426950408889634f * v)); }
__device__ __forceinline__ void rope8(f32x4& v0, f32x4& v1, const f32x4 c4, const f32x4 s4) {
    const f32x4 a = v0, b = v1;
    v0[0] = a[0] * c4[0] - a[1] * s4[0]; v0[1] = a[1] * c4[0] + a[0] * s4[0]; v0[2] = a[2] * c4[1] - a[3] * s4[1]; v0[3] = a[3] * c4[1] + a[2] * s4[1];
    v1[0] = b[0] * c4[2] - b[1] * s4[2]; v1[1] = b[1] * c4[2] + b[0] * s4[2]; v1[2] = b[2] * c4[3] - b[3] * s4[3]; v1[3] = b[3] * c4[3] + b[2] * s4[3];
}
__device__ __forceinline__ float sumsq8(const f32x4 a, const f32x4 b) { return (a[0] * a[0] + a[1] * a[1]) + (a[2] * a[2] + a[3] * a[3]) + (b[0] * b[0] + b[1] * b[1]) + (b[2] * b[2] + b[3] * b[3]); }

#define EPI_ROWS(ai, m) _Pragma("unroll") for (int ai = 0; ai < 2; ++ai) _Pragma("unroll") for (int m = 0; m < 4; ++m)

typedef unsigned u32x2w __attribute__((ext_vector_type(2)));
struct EpiIn {
    static constexpr bool PERM = true, AFTER_DRAIN = false;
    bf16_t* Z; const float* cosT; const float* sinT; float* ssq; unsigned char* KR8;
    __device__ __forceinline__ void operator()(f32x4 (&acc)[2][2][4][2], const Unit& u, int wr, int wc, int fr, int fq) const {
        const int pn = u.pn, row0 = u.pm * BM + wr * 64 + fr, col0 = pn * BM + wc * 32 + 8 * fq;
        if (pn < 16 || pn == 30) {
            const int i0 = 16 * (wc & 1) + 4 * fq; const float qsc = (pn < 8) ? 0.18033688011112042f : 1.0f;
            EPI_ROWS(ai, m) { const int r = row0 + ai * HALF + m * 16; const f32x4 c4 = *(const f32x4*)(cosT + (size_t)r * 32 + i0), s4 = *(const f32x4*)(sinT + (size_t)r * 32 + i0);
                bf16_t* rowp = Z + (size_t)r * ZW + col0;
#pragma unroll
                for (int bj = 0; bj < 2; ++bj) { f32x4 v0 = acc[ai][bj][m][0], v1 = acc[ai][bj][m][1]; rope8(v0, v1, c4, s4); v0 *= qsc; v1 *= qsc; *(u32x4*)(rowp + bj * HALF) = pack8(v0, v1);
                    if (pn == 30 && bj == 0 && wc < 2) { u32x2w w8; w8.x = pk4_fp8(v0); w8.y = pk4_fp8(v1); *(u32x2w*)(KR8 + (size_t)r * 64 + wc * 32 + 8 * fq) = w8; } } }
        } else if (pn < 24) {
            EPI_ROWS(ai, m) { const int r = row0 + ai * HALF + m * 16; bf16_t* rowp = Z + (size_t)r * ZW + col0;
#pragma unroll
                for (int bj = 0; bj < 2; ++bj) *(u32x4*)(rowp + bj * HALF) = pack8(acc[ai][bj][m][0], acc[ai][bj][m][1]); }
        } else if (pn < 30) {
            EPI_ROWS(ai, m) { const int r = row0 + ai * HALF + m * 16; bf16_t* rowp = Z + (size_t)r * ZW + col0; float ss = 0.f;
#pragma unroll
                for (int bj = 0; bj < 2; ++bj) { ss += sumsq8(acc[ai][bj][m][0], acc[ai][bj][m][1]); *(u32x4*)(rowp + bj * HALF) = pack8(acc[ai][bj][m][0], acc[ai][bj][m][1]); }
                ss += __shfl_xor(ss, 16); ss += __shfl_xor(ss, 32);
                if (fq == 0) ssq[(size_t)r * 24 + (pn - 24) * 4 + wc] = ss; }
        } else {
            EPI_ROWS(ai, m) { const int r = row0 + ai * HALF + m * 16; bf16_t* rowp = Z + (size_t)r * ZW + col0;
#pragma unroll
                for (int bj = 0; bj < 2; ++bj) { f32x4 v0 = acc[ai][bj][m][0], v1 = acc[ai][bj][m][1];
#pragma unroll
                    for (int e = 0; e < 4; ++e) { v0[e] = sigmoidf_fast(v0[e]); v1[e] = sigmoidf_fast(v1[e]); }
                    *(u32x4*)(rowp + bj * HALF) = pack8(v0, v1); } }
        }
    }
};

struct EpiInMla {
    static constexpr bool PERM = true, AFTER_DRAIN = false;
    bf16_t* Z; const float* cosT; const float* sinT; float* ssq; unsigned char* KR8;
    __device__ __forceinline__ void operator()(f32x4 (&acc)[2][2][4][2], const Unit& u, int wr, int wc, int fr_, int fq_) const {
        int opq = 0; asm volatile("" : "+v"(opq));
        const int fr = fr_ + opq, fq = fq_ + opq;
        const int pn = u.pn, row0 = u.pm * BM + wr * 64 + fr, col0 = pn * BM + wc * 32 + 8 * fq;
        if (pn == 30) {
            const int i0 = 16 * (wc & 1) + 4 * fq;
            EPI_ROWS(ai, m) { const int r = row0 + ai * HALF + m * 16; const f32x4 c4 = *(const f32x4*)(cosT + (size_t)r * 32 + i0), s4 = *(const f32x4*)(sinT + (size_t)r * 32 + i0);
                bf16_t* rowp = Z + (size_t)r * ZW + col0;
#pragma unroll
                for (int bj = 0; bj < 2; ++bj) { f32x4 v0 = acc[ai][bj][m][0], v1 = acc[ai][bj][m][1]; rope8(v0, v1, c4, s4); *(u32x4*)(rowp + bj * HALF) = pack8(v0, v1);
                    if (bj == 0 && wc < 2) { u32x2w w8; w8.x = pk4_fp8(v0); w8.y = pk4_fp8(v1); *(u32x2w*)(KR8 + (size_t)r * 64 + wc * 32 + 8 * fq) = w8; } } }
        } else {
            EPI_ROWS(ai, m) { const int r = row0 + ai * HALF + m * 16; bf16_t* rowp = Z + (size_t)r * ZW + col0; float ss = 0.f;
#pragma unroll
                for (int bj = 0; bj < 2; ++bj) { ss += sumsq8(acc[ai][bj][m][0], acc[ai][bj][m][1]); *(u32x4*)(rowp + bj * HALF) = pack8(acc[ai][bj][m][0], acc[ai][bj][m][1]); }
                ss += __builtin_bit_cast(float, __builtin_amdgcn_ds_swizzle(__builtin_bit_cast(int, ss), 0x401F));
                { auto rr = __builtin_amdgcn_permlane32_swap(__builtin_bit_cast(unsigned, ss), __builtin_bit_cast(unsigned, ss), false, false); ss = __builtin_bit_cast(float, rr[0]) + __builtin_bit_cast(float, rr[1]); }
                if (fq == 0) ssq[(size_t)r * 24 + (pn - 24) * 4 + wc] = ss; }
        }
    }
};

struct EpiIn8 {
    static constexpr bool PERM = true, AFTER_DRAIN = false;
    bf16_t* Z; const float* cosT; const float* sinT; float* ssq; unsigned char* KR8; const float* hsc; const float* wmx;
    __device__ __forceinline__ void operator()(f32x4 (&acc)[2][2][4][2], const Unit& u, int wr, int wc, int fr_, int fq_) const {
        int opq = 0; asm volatile("" : "+v"(opq));
        const int fr = fr_ + opq, fq = fq_ + opq;
        const int pn = u.pn, row0 = u.pm * BM + wr * 64 + fr, col0 = pn * BM + wc * 32 + 8 * fq;
        f32x4 ws0[2], ws1[2];
#pragma unroll
        for (int bj = 0; bj < 2; ++bj) { const float* wp = wmx + (col0 - ZC_I8) + bj * HALF; ws0[bj] = *(const f32x4*)wp * (1.0f / 127.0f); ws1[bj] = *(const f32x4*)(wp + 4) * (1.0f / 127.0f); }
        if (pn < 24) {
            EPI_ROWS(ai, m) { const int r = row0 + ai * HALF + m * 16; bf16_t* rowp = Z + (size_t)r * ZW + col0; const float dq = hsc[r];
#pragma unroll
                for (int bj = 0; bj < 2; ++bj) *(u32x4*)(rowp + bj * HALF) = pack8(acc[ai][bj][m][0] * (ws0[bj] * dq), acc[ai][bj][m][1] * (ws1[bj] * dq)); }
        } else if (pn >= 31) {
            EPI_ROWS(ai, m) { const int r = row0 + ai * HALF + m * 16; bf16_t* rowp = Z + (size_t)r * ZW + col0; const float dq = hsc[r];
#pragma unroll
                for (int bj = 0; bj < 2; ++bj) { f32x4 v0 = acc[ai][bj][m][0] * (ws0[bj] * dq), v1 = acc[ai][bj][m][1] * (ws1[bj] * dq);
#pragma unroll
                    for (int e = 0; e < 4; ++e) { v0[e] = sigmoidf_fast(v0[e]); v1[e] = sigmoidf_fast(v1[e]); }
                    *(u32x4*)(rowp + bj * HALF) = pack8(v0, v1); } }
        } else if (pn == 30) {
            const int i0 = 16 * (wc & 1) + 4 * fq;
            EPI_ROWS(ai, m) { const int r = row0 + ai * HALF + m * 16; const float dq = hsc[r]; const f32x4 c4 = *(const f32x4*)(cosT + (size_t)r * 32 + i0), s4 = *(const f32x4*)(sinT + (size_t)r * 32 + i0);
                bf16_t* rowp = Z + (size_t)r * ZW + col0;
#pragma unroll
                for (int bj = 0; bj < 2; ++bj) { f32x4 v0 = acc[ai][bj][m][0] * (ws0[bj] * dq), v1 = acc[ai][bj][m][1] * (ws1[bj] * dq); rope8(v0, v1, c4, s4); *(u32x4*)(rowp + bj * HALF) = pack8(v0, v1);
                    if (bj == 0 && wc < 2) { u32x2w w8; w8.x = pk4_fp8(v0); w8.y = pk4_fp8(v1); *(u32x2w*)(KR8 + (size_t)r * 64 + wc * 32 + 8 * fq) = w8; } } }
        } else {
            EPI_ROWS(ai, m) { const int r = row0 + ai * HALF + m * 16; const float dq = hsc[r]; bf16_t* rowp = Z + (size_t)r * ZW + col0; float ss = 0.f;
#pragma unroll
                for (int bj = 0; bj < 2; ++bj) { const f32x4 v0 = acc[ai][bj][m][0] * (ws0[bj] * dq), v1 = acc[ai][bj][m][1] * (ws1[bj] * dq); ss += sumsq8(v0, v1); *(u32x4*)(rowp + bj * HALF) = pack8(v0, v1); }
                ss += __shfl_xor(ss, 16); ss += __shfl_xor(ss, 32);
                if (fq == 0) ssq[(size_t)r * 24 + (pn - 24) * 4 + wc] = ss; }
        }
    }
};

struct EpiInGate {
    static constexpr bool PERM = true, AFTER_DRAIN = false;
    bf16_t* Z; const float* hsc; const float* wmx;
    __device__ __forceinline__ void operator()(f32x4 (&acc)[2][2][4][2], const Unit& u, int wr, int wc, int fr_, int fq_) const {
        int opq = 0; asm volatile("" : "+v"(opq));
        const int fr = fr_ + opq, fq = fq_ + opq;
        const int row0 = u.pm * BM + wr * 64 + fr, col0 = u.pn * BM + wc * 32 + 8 * fq;
        f32x4 ws0[2], ws1[2];
#pragma unroll
        for (int bj = 0; bj < 2; ++bj) { const float* wp = wmx + (col0 - ZC_GD) + bj * HALF; ws0[bj] = *(const f32x4*)wp * (1.0f / 127.0f); ws1[bj] = *(const f32x4*)(wp + 4) * (1.0f / 127.0f); }
        EPI_ROWS(ai, m) { const int r = row0 + ai * HALF + m * 16; bf16_t* rowp = Z + (size_t)r * ZW + col0; const float dq = hsc[r];
#pragma unroll
            for (int bj = 0; bj < 2; ++bj) { f32x4 v0 = acc[ai][bj][m][0] * (ws0[bj] * dq), v1 = acc[ai][bj][m][1] * (ws1[bj] * dq);
#pragma unroll
                for (int e = 0; e < 4; ++e) { v0[e] = sigmoidf_fast(v0[e]); v1[e] = sigmoidf_fast(v1[e]); }
                *(u32x4*)(rowp + bj * HALF) = pack8(v0, v1); } }
    }
};

template <int SLOT0, int NP4, int KDIM, int F8_BELOW> struct EpiMla {
    static constexpr bool PERM = true, AFTER_DRAIN = false;
    bf16_t* O; int ldc; const float* ssq; const float* cosT; const float* sinT; int rope_from; unsigned char* O8; int ld8;
    __device__ __forceinline__ void operator()(f32x4 (&acc)[2][2][4][2], const Unit& u, int wr, int wc, int fr, int fq) const {
        const int pn = u.pn, row0 = u.pm * BM + wr * 64 + fr, col0 = pn * BM + wc * 32 + 8 * fq, i0 = 16 * (wc & 1) + 4 * fq;
        const bool rope = pn >= rope_from;
        EPI_ROWS(ai, m) { const int r = row0 + ai * HALF + m * 16; float ss = 0.f;
#pragma unroll
            for (int q = 0; q < NP4; ++q) { const f32x4 p = *(const f32x4*)(ssq + (size_t)r * 24 + SLOT0 + 4 * q); ss += (p[0] + p[1]) + (p[2] + p[3]); }
            const float rs = __builtin_amdgcn_rsqf(ss * (1.0f / KDIM) + NORM_EPS);
            f32x4 c4 = {1.f, 1.f, 1.f, 1.f}, s4 = {0.f, 0.f, 0.f, 0.f};
            if (rope) { c4 = *(const f32x4*)(cosT + (size_t)r * 32 + i0); s4 = *(const f32x4*)(sinT + (size_t)r * 32 + i0); }
            bf16_t* rowp = O + (size_t)r * ldc + col0;
#pragma unroll
            for (int bj = 0; bj < 2; ++bj) { f32x4 v0 = acc[ai][bj][m][0] * rs, v1 = acc[ai][bj][m][1] * rs; if (rope) rope8(v0, v1, c4, s4);
                if (pn < F8_BELOW) { u32x2w w8; w8.x = pk4_fp8(v0); w8.y = pk4_fp8(v1); *(u32x2w*)(O8 + (size_t)r * ld8 + col0 + bj * HALF) = w8; }
                else *(u32x4*)(rowp + bj * HALF) = pack8(v0, v1); } }
    }
};

struct GateHook {
    static constexpr bool ENABLED = true;
    const bf16_t* GD; const bf16_t* GM;
    __device__ __forceinline__ void operator()(f32x4 (&acc)[2][2][4][2], const Unit& u, int wr, int wc, int fr, int fq) const {
        int opq = 0; asm volatile("" : "+v"(opq));
        const int row0 = u.pm * BM + wr * 64 + fr + opq, col0 = u.pn * BM + wc * 32 + 8 * fq;
        EPI_ROWS(ai, m) { const size_t ro = (size_t)(row0 + ai * HALF + m * 16) * ZW + col0;
#pragma unroll
            for (int bj = 0; bj < 2; ++bj) { f32x4 d0, d1, m0, m1; unpack8(*(const u32x4*)(GD + ro + bj * HALF), d0, d1); unpack8(*(const u32x4*)(GM + ro + bj * HALF), m0, m1);
#pragma unroll
                for (int e = 0; e < 4; ++e) { acc[ai][bj][m][0][e] *= d0[e] * __builtin_amdgcn_rcpf(fmaxf(m0[e], 1e-20f)); acc[ai][bj][m][1][e] *= d1[e] * __builtin_amdgcn_rcpf(fmaxf(m1[e], 1e-20f)); } }
            asm volatile("" : "+v"(acc[ai][0][m][0]), "+v"(acc[ai][0][m][1]), "+v"(acc[ai][1][m][0]), "+v"(acc[ai][1][m][1]) :: "memory"); }
    }
};
struct EpiGate {
    static constexpr bool PERM = true, AFTER_DRAIN = false;
    const bf16_t* GM; bf16_t* Y;
    __device__ __forceinline__ void operator()(f32x4 (&acc)[2][2][4][2], const Unit& u, int wr, int wc, int fr, int fq) const {
        const int row0 = u.pm * BM + wr * 64 + fr, col0 = u.pn * BM + wc * 32 + 8 * fq;
        EPI_ROWS(ai, m) { const int r = row0 + ai * HALF + m * 16;
#pragma unroll
            for (int bj = 0; bj < 2; ++bj) { const int c = col0 + bj * HALF; f32x4 g0, g1; unpack8(*(const u32x4*)(GM + (size_t)r * ZW + c), g0, g1);
                *(u32x4*)(Y + (size_t)r * DM + c) = pack8(acc[ai][bj][m][0] * g0, acc[ai][bj][m][1] * g1); } }
    }
};

template <bool RES_BF16> struct EpiRes {
    static constexpr bool PERM = true, AFTER_DRAIN = false;
    const float* xi; bf16_t* xb; float* ssq;
    __device__ __forceinline__ void operator()(f32x4 (&acc)[2][2][4][2], const Unit& u, int wr, int wc, int fr, int fq) const {
        const int row0 = u.pm * BM + wr * 64 + fr, col0 = u.pn * BM + wc * 32 + 8 * fq;
        EPI_ROWS(ai, m) { const int r = row0 + ai * HALF + m * 16; float ss = 0.f;
#pragma unroll
            for (int bj = 0; bj < 2; ++bj) { const size_t off = (size_t)r * DM + col0 + bj * HALF; f32x4 r0, r1;
                if (RES_BF16) unpack8(*(const u32x4*)(xb + off), r0, r1); else { r0 = *(const f32x4*)(xi + off); r1 = *(const f32x4*)(xi + off + 4); }
                const f32x4 v0 = acc[ai][bj][m][0] + r0, v1 = acc[ai][bj][m][1] + r1;
                *(u32x4*)(xb + off) = pack8(v0, v1); ss += sumsq8(v0, v1); }
            ss += __shfl_xor(ss, 16); ss += __shfl_xor(ss, 32);
            if (fq == 0) ssq[(size_t)r * 64 + u.pn * 4 + wc] = ss; }
    }
};

struct EpiPlain {
    static constexpr bool PERM = true, AFTER_DRAIN = false;
    bf16_t* O; int ldc;
    __device__ __forceinline__ void operator()(f32x4 (&acc)[2][2][4][2], const Unit& u, int wr, int wc, int fr, int fq) const {
        const int row0 = u.pm * BM + wr * 64 + fr, col0 = u.pn * BM + wc * 32 + 8 * fq;
        EPI_ROWS(ai, m) { bf16_t* rowp = O + (size_t)(row0 + ai * HALF + m * 16) * ldc + col0;
#pragma unroll
            for (int bj = 0; bj < 2; ++bj) *(u32x4*)(rowp + bj * HALF) = pack8(acc[ai][bj][m][0], acc[ai][bj][m][1]); }
    }
};

__device__ __forceinline__ float dpp_shr1(float old, float src) { return __int_as_float(__builtin_amdgcn_update_dpp(__float_as_int(old), __float_as_int(src), 0x111, 0xf, 0xf, false)); }
__device__ __forceinline__ float dpp_shr2(float old, float src) { return __int_as_float(__builtin_amdgcn_update_dpp(__float_as_int(old), __float_as_int(src), 0x112, 0xf, 0xf, false)); }
__device__ __forceinline__ float dpp_ror1(float src) { return __int_as_float(__builtin_amdgcn_update_dpp(0, __float_as_int(src), 0x121, 0xf, 0xf, false)); }
__device__ __forceinline__ float dpp_ror2(float src) { return __int_as_float(__builtin_amdgcn_update_dpp(0, __float_as_int(src), 0x122, 0xf, 0xf, false)); }
typedef unsigned u32x2 __attribute__((ext_vector_type(2)));
struct EpiUpConv {
    static constexpr bool PERM = true, AFTER_DRAIN = false;
    bf16_t* ACT; float* HALO; const float* cw; const float* cb; const float* rstd; PG8_LAS float* xch; const float* wmx;
    static constexpr int UPW_ = 22016, DFF_ = 11008;
    __device__ __forceinline__ void operator()(f32x4 (&acc)[2][2][4][2], const Unit& u, int wr, int wc, int fr_, int fq_) const {
        int opq = 0; asm volatile("" : "+v"(opq));
        const int fr = fr_ + opq, fq = fq_ + opq;
        const int row0 = u.pm * BM + wr * 64 + fr;
        EPI_ROWS(ai, m) { const float rs = rstd[row0 + ai * HALF + m * 16];
#pragma unroll
            for (int bj = 0; bj < 2; ++bj) { acc[ai][bj][m][0] *= rs; acc[ai][bj][m][1] *= rs; } }
        const size_t hcol = (size_t)u.pn * BM + wc * 32 + 8 * fq;
        if (fr >= 14) {
#pragma unroll
            for (int ai = 0; ai < 2; ++ai) { const int ch = ai * 2 + wr; PG8_LAS float* xp = xch + ((((ch * 2 + (fr - 14)) * 4 + wc) * 4 + fq) * 16);
#pragma unroll
                for (int bj = 0; bj < 2; ++bj) { *(PG8_LAS f32x4*)(xp + bj * 8) = acc[ai][bj][3][0]; *(PG8_LAS f32x4*)(xp + bj * 8 + 4) = acc[ai][bj][3][1]; } }
            if (wr == 1) { float* hp = HALO + ((size_t)u.pm * 4 + 2 + (fr - 14)) * UPW_ + hcol;
#pragma unroll
                for (int bj = 0; bj < 2; ++bj) { *(f32x4*)(hp + bj * HALF) = acc[1][bj][3][0]; *(f32x4*)(hp + bj * HALF + 4) = acc[1][bj][3][1]; } }
        }
        if (fr < 2 && wr == 0) { float* hp = HALO + ((size_t)u.pm * 4 + fr) * UPW_ + hcol;
#pragma unroll
            for (int bj = 0; bj < 2; ++bj) { *(f32x4*)(hp + bj * HALF) = acc[0][bj][0][0]; *(f32x4*)(hp + bj * HALF + 4) = acc[0][bj][0][1]; } }
        PG8_LAS float* wl = xch + 2048;
        { const int tq = threadIdx.x + opq, k = tq >> 6, c2 = (tq & 63) * 2, tap = k & 3; const size_t gc = (size_t)u.pn * 128 + c2 + ((k >> 2) ? DFF_ : 0);
          const float* src = (tap < 3) ? cw + (size_t)tap * UPW_ + gc : cb + gc;
          f32x2_t t = *(const f32x2_t*)src; if (tap < 3) { const float* wsp = wmx + (size_t)u.pn * BM + (k >> 2) * HALF + c2; t[0] *= wsp[0] * (1.0f / 127.0f); t[1] *= wsp[1] * (1.0f / 127.0f); }
          *(PG8_LAS f32x2_t*)(wl + k * 128 + c2) = t; }
        asm volatile("s_waitcnt lgkmcnt(0)\n\ts_barrier" ::: "memory");
        const int c0 = u.pn * 128 + wc * 32 + 8 * fq; const PG8_LAS float* wlp = wl + wc * 32 + 8 * fq;
#pragma unroll
        for (int ai = 0; ai < 2; ++ai) {
            const int ch = ai * 2 + wr;
            f32x4 pgn[2], pvn[2];
#pragma unroll
            for (int m = 0; m < 4; ++m) {
                u32x2 keep;
#pragma unroll
                for (int n = 0; n < 2; ++n) {
                    const PG8_LAS float* wp = wlp + 4 * n;
                    const f32x4 wg0 = *(const PG8_LAS f32x4*)(wp), wg1 = *(const PG8_LAS f32x4*)(wp + 128), wg2 = *(const PG8_LAS f32x4*)(wp + 256), bg = *(const PG8_LAS f32x4*)(wp + 384);
                    const f32x4 wv0 = *(const PG8_LAS f32x4*)(wp + 512), wv1 = *(const PG8_LAS f32x4*)(wp + 640), wv2 = *(const PG8_LAS f32x4*)(wp + 768), bv = *(const PG8_LAS f32x4*)(wp + 896);
                    const f32x4 xg = acc[ai][0][m][n], xv = acc[ai][1][m][n]; f32x4 p1g, p2g, p1v, p2v;
                    if (m == 0) {
                        f32x4 h1g = {0.f, 0.f, 0.f, 0.f}, h2g = h1g, h1v = h1g, h2v = h1g;
                        if (ch > 0) { const PG8_LAS float* xp = xch + (((((ch - 1) * 2) * 4 + wc) * 4 + fq) * 16) + 4 * n;
                            h2g = *(const PG8_LAS f32x4*)xp; h2v = *(const PG8_LAS f32x4*)(xp + 8); h1g = *(const PG8_LAS f32x4*)(xp + 256); h1v = *(const PG8_LAS f32x4*)(xp + 256 + 8); }
#pragma unroll
                        for (int e = 0; e < 4; ++e) { p1g[e] = dpp_shr1(h1g[e], xg[e]); p2g[e] = dpp_shr2(fr == 1 ? h1g[e] : h2g[e], xg[e]); p1v[e] = dpp_shr1(h1v[e], xv[e]); p2v[e] = dpp_shr2(fr == 1 ? h1v[e] : h2v[e], xv[e]); }
                    } else {
#pragma unroll
                        for (int e = 0; e < 4; ++e) { p1g[e] = dpp_shr1(dpp_ror1(pgn[n][e]), xg[e]); p2g[e] = dpp_shr2(dpp_ror2(pgn[n][e]), xg[e]); p1v[e] = dpp_shr1(dpp_ror1(pvn[n][e]), xv[e]); p2v[e] = dpp_shr2(dpp_ror2(pvn[n][e]), xv[e]); }
                    }
                    f32x4 og = bg + wg0 * p2g + wg1 * p1g + wg2 * xg; const f32x4 ov = bv + wv0 * p2v + wv1 * p1v + wv2 * xv;
#pragma unroll
                    for (int e = 0; e < 4; ++e) og[e] = og[e] * sigmoidf_fast(og[e]) * ov[e];
                    u32x2 w; w.x = cvt_pk_bf16(og[0], og[1]); w.y = cvt_pk_bf16(og[2], og[3]);
                    if (n == 0) keep = w; else *(u32x4*)(ACT + (size_t)(row0 + ai * HALF + m * 16) * DFF_ + c0) = (u32x4){keep.x, keep.y, w.x, w.y};
                    pgn[n] = xg; pvn[n] = xv;
                }
                __builtin_amdgcn_sched_barrier(0);
            }
        }
    }
};

struct BalOrder {
    StaticOrder so; int c, G;
    __host__ __device__ void init(int M, int N, int G_, int c_) { so.init(M, N, 1, 0); c = c_; G = G_; }
    __host__ __device__ bool next(int i, Unit& u) const {
        int L;
        if (G != 256 || so.nwg != 512) { L = i * G + c; if (L >= so.nwg) return false; }
        else if (c < 128) { if (i >= 1) return false; L = c; }
        else { if (i >= 3) return false; L = 128 + 3 * (c - 128) + i; }
        return so.next(L, u);
    }
    __device__ __forceinline__ void a_ready(const Unit&) const {}
    __device__ __forceinline__ void done(const Unit&) const {}
};
struct VtOrder {
    int c, G;
    __device__ __forceinline__ bool next(int i, Unit& u) const {
        int L;
        if (G != 256) { L = i * G + c; if (L >= 256) return false; }
        else { if (c < 128 || i >= 2) return false; L = 2 * (c - 128) + i; }
        u.pm = L >> 5; u.pn = L & 31; return true;
    }
    __device__ __forceinline__ void a_ready(const Unit&) const {}
    __device__ __forceinline__ void done(const Unit&) const {}
};
struct EpiVT {
    static constexpr bool PERM = true, AFTER_DRAIN = false;
    unsigned char* VT; const float* ssq; int npos;
    __device__ __forceinline__ void operator()(f32x4 (&acc)[2][2][4][2], const Unit& u, int wr, int wc, int fr_, int fq_) const {
        int opq = 0; asm volatile("" : "+v"(opq));
        const int fr = fr_ + opq, fq = fq_ + opq;
        const int row0 = u.pm * BM + wr * 64 + fr, t0 = u.pn * BM + wc * 32 + 8 * fq;
#pragma unroll
        for (int bj = 0; bj < 2; ++bj) {
            const int tb = t0 + bj * HALF, k0 = tb & 63; const size_t pos = (size_t)(tb & ~63) + 16 * ((k0 >> 5) & 1) + 4 * ((k0 >> 3) & 3);
            f32x4 rs0, rs1;
#pragma unroll
            for (int e = 0; e < 8; ++e) { const float* sp = ssq + (size_t)(tb + e) * 24 + 16; const f32x4 p = *(const f32x4*)sp, q = *(const f32x4*)(sp + 4);
                const float r = __builtin_amdgcn_rsqf(((p[0] + p[1]) + (p[2] + p[3]) + (q[0] + q[1]) + (q[2] + q[3])) * (1.0f / KVRANK_) + NORM_EPS_);
                if (e < 4) rs0[e] = r; else rs1[e - 4] = r; }
            EPI_ROWS(ai, m) { unsigned char* rowp = VT + (size_t)(row0 + ai * HALF + m * 16) * npos + pos;
                *(unsigned*)rowp = pk4_fp8(acc[ai][bj][m][0] * rs0); *(unsigned*)(rowp + 32) = pk4_fp8(acc[ai][bj][m][1] * rs1); }
        }
    }
    static constexpr float KVRANK_ = 512.0f, NORM_EPS_ = 1e-6f;
};
struct SkipOrder {
    StaticOrder s; int skip_from, skip_n;
    __device__ __forceinline__ bool next(int i, Unit& u) const { if (!s.next(i, u)) return false; if (u.pn >= skip_from) u.pn += skip_n; return true; }
    __device__ __forceinline__ void a_ready(const Unit&) const {}
    __device__ __forceinline__ void done(const Unit&) const {}
};
struct NoHook { static constexpr bool ENABLED = false; __device__ __forceinline__ void operator()(f32x4 (&)[2][2][4][2], const Unit&, int, int, int, int) const {} };
template <class Epi, class Sched, bool ALIGN_EPI, class Hook = NoHook, bool F8 = false, bool I8 = false>
__device__ __forceinline__ void gemm_phase(PG8_LAS unsigned char* lds, const Gemm g, const Sched& S, const Epi& E, const Hook& HK = Hook()) {
    const int tid = threadIdx.x, wid = __builtin_amdgcn_readfirstlane(tid >> 6), lane = tid & 63, wr = wid >> 2, wc = wid & 3, fr = lane & 15, fq = lane >> 4;
    const int K = g.K, nt = K / BK;
    unsigned voffA[2], voffB[2];
#pragma unroll
    for (int i = 0; i < 2; ++i) { int R, C; stage_rc(tid * 16 + i * 8192, R, C); const int Rb = Epi::PERM ? ((R & ~31) + perm32(R & 31)) : R;
        voffA[i] = (unsigned)(R * g.lda + C) * 2u; voffB[i] = (unsigned)(Rb * g.ldb + C) * 2u; }
    const size_t kstep = (size_t)(BK * 2);
    const size_t hstepA = (size_t)HALF * g.lda * 2, hstepB = (size_t)HALF * g.ldb * 2;
    const size_t tstepA = 2 * hstepA, tstepB = 2 * hstepB;
    const unsigned ldsw = (unsigned)wid * 1024u;
    const int aoff = lds_byte(wr * 64 + fr, F8 ? fq * 16 : fq * 8), boff = lds_byte(wc * 32 + fr, F8 ? fq * 16 : fq * 8);
#define PG8_SA(b, h) (((b) * 2 + (h)) * HTB)
#define PG8_SB(b, h) ((4 + (b) * 2 + (h)) * HTB)
#define PG8_STAGE(bufoff, gbase, voff) do { _Pragma("unroll") for (int _i = 0; _i < 2; ++_i) { \
        if (F8) { unsigned keep_; const unsigned la_ = (unsigned)__builtin_amdgcn_readfirstlane((int)(unsigned)(uintptr_t)(lds + (bufoff) + ldsw + _i * 8192)); \
            asm volatile("s_mov_b32 %0, m0\n\ts_mov_b32 m0, %2\n\ts_nop 0\n\tglobal_load_lds_dwordx4 %1, %3\n\ts_mov_b32 m0, %0" : "=&s"(keep_) : "v"((voff)[_i]), "s"(la_), "s"((const char*)(gbase)) : "memory"); } \
        else __builtin_amdgcn_global_load_lds((const unsigned*)((const char*)(gbase) + (voff)[_i]), (PG8_LAS unsigned*)(lds + (bufoff) + ldsw + _i * 8192), 16, 0, 0); } } while (0)
#define PG8_LDA(dst, b, h) do { if (F8) { _Pragma("unroll") for (int m = 0; m < 2; ++m) dst##8[m] = *(const PG8_LAS v8i32g*)(lds + PG8_SA(b, h) + aoff + m * 2048); } \
        else { _Pragma("unroll") for (int m = 0; m < 4; ++m) _Pragma("unroll") for (int k = 0; k < 2; ++k) dst[m][k] = *(const PG8_LAS bf16x8*)(lds + PG8_SA(b, h) + aoff + m * 2048 + k * 1024); } } while (0)
#define PG8_LDB(dst, b, h) do { if (F8) { _Pragma("unroll") for (int n = 0; n < 2; ++n) dst##8[n] = *(const PG8_LAS v8i32g*)(lds + PG8_SB(b, h) + boff + n * 2048); } \
        else { _Pragma("unroll") for (int n = 0; n < 2; ++n) _Pragma("unroll") for (int k = 0; k < 2; ++k) dst[n][k] = *(const PG8_LAS bf16x8*)(lds + PG8_SB(b, h) + boff + n * 2048 + k * 1024); } } while (0)
#define PG8_MMA(ai, bj, At, Bt) do { __builtin_amdgcn_s_setprio(1); _Pragma("unroll") for (int m = 0; m < 4; ++m) _Pragma("unroll") for (int n = 0; n < 2; ++n) _Pragma("unroll") for (int k = 0; k < 2; ++k) { \
        if (I8) acc[ai][bj][m][n] = __builtin_bit_cast(f32x4, __builtin_amdgcn_mfma_i32_16x16x64_i8(__builtin_bit_cast(v4i32g, Bt[n][k]), __builtin_bit_cast(v4i32g, At[m][k]), __builtin_bit_cast(v4i32g, acc[ai][bj][m][n]), 0, 0, 0)); \
        else acc[ai][bj][m][n] = __builtin_amdgcn_mfma_f32_16x16x32_bf16(Bt[n][k], At[m][k], acc[ai][bj][m][n], 0, 0, 0); } __builtin_amdgcn_s_setprio(0); } while (0)
#define PG8_MMA2(ai, b) do { if (F8) { __builtin_amdgcn_s_setprio(1); \
        _Pragma("unroll") for (int m = 0; m < 2; ++m) _Pragma("unroll") for (int n = 0; n < 2; ++n) { \
            acc[ai][0][m][n] = __builtin_amdgcn_mfma_scale_f32_16x16x128_f8f6f4(B08[n], At8[m], acc[ai][0][m][n], 0, 0, 0, 0, 0, 0); acc[ai][1][m][n] = __builtin_amdgcn_mfma_scale_f32_16x16x128_f8f6f4(B18[n], At8[m], acc[ai][1][m][n], 0, 0, 0, 0, 0, 0); } \
        _Pragma("unroll") for (int m = 0; m < 2; ++m) At8[m] = *(const PG8_LAS v8i32g*)(lds + PG8_SA(b, ai) + aoff + (m + 2) * 2048); \
        _Pragma("unroll") for (int m = 0; m < 2; ++m) _Pragma("unroll") for (int n = 0; n < 2; ++n) { \
            acc[ai][0][m + 2][n] = __builtin_amdgcn_mfma_scale_f32_16x16x128_f8f6f4(B08[n], At8[m], acc[ai][0][m + 2][n], 0, 0, 0, 0, 0, 0); acc[ai][1][m + 2][n] = __builtin_amdgcn_mfma_scale_f32_16x16x128_f8f6f4(B18[n], At8[m], acc[ai][1][m + 2][n], 0, 0, 0, 0, 0, 0); } \
        __builtin_amdgcn_s_setprio(0); } else { PG8_MMA(ai, 0, At, B0); PG8_MMA(ai, 1, At, B1); } } while (0)
#define PG8_WAIT_V(n) asm volatile("s_waitcnt vmcnt(" #n ")" ::: "memory")
#define PG8_WAIT_L(n) asm volatile("s_waitcnt lgkmcnt(" #n ")" ::: "memory")
#define PG8_BAR __builtin_amdgcn_s_barrier()
#define PG8_SCHED __builtin_amdgcn_sched_barrier(0)
    Unit cur, nxt; int ui = 0;
    if (!S.next(0, cur)) return;
    f32x4 acc[2][2][4][2];
#pragma unroll
    for (int a = 0; a < 2; ++a)
#pragma unroll
        for (int b = 0; b < 2; ++b)
#pragma unroll
            for (int m = 0; m < 4; ++m)
#pragma unroll
                for (int n = 0; n < 2; ++n) acc[a][b][m][n] = (f32x4){0.f, 0.f, 0.f, 0.f};
    bf16x8 At[4][2], B0[2][2], B1[2][2];
    v8i32g At8[2], B08[2], B18[2];
    const char* cA = (const char*)g.A + (size_t)cur.pm * tstepA; const char* cB = (const char*)g.Bt + (size_t)cur.pn * tstepB;
    S.a_ready(cur);
    PG8_STAGE(PG8_SB(0, 0), cB, voffB); PG8_STAGE(PG8_SB(0, 1), cB + hstepB, voffB); PG8_STAGE(PG8_SA(0, 0), cA, voffA); PG8_STAGE(PG8_SA(0, 1), cA + hstepA, voffA);
    if (wr == 1) PG8_BAR;
    PG8_WAIT_V(2); PG8_BAR;
    PG8_STAGE(PG8_SB(1, 0), cB + kstep, voffB); PG8_STAGE(PG8_SA(1, 0), cA + kstep, voffA); PG8_STAGE(PG8_SB(1, 1), cB + hstepB + kstep, voffB);
    PG8_WAIT_V(6); PG8_BAR;
    for (;;) {
        const bool has_next = S.next(ui + 1, nxt);
        const char* nA = has_next ? (const char*)g.A + (size_t)nxt.pm * tstepA : cA; const char* nB = has_next ? (const char*)g.Bt + (size_t)nxt.pn * tstepB : cB;
        for (int t = 0; t < nt; t += 2) {
            const bool last = (t == nt - 2);
            const char* a1 = cA + (size_t)(t + 1) * kstep;
            const char* a2 = last ? nA : cA + (size_t)(t + 2) * kstep; const char* b2 = last ? nB : cB + (size_t)(t + 2) * kstep;
            const char* a3 = a2 + kstep; const char* b3 = b2 + kstep;
            if (last && has_next) S.a_ready(nxt);
            if (Hook::ENABLED && t == (nt >> 1)) HK(acc, cur, wr, wc, fr, fq);
            PG8_LDB(B0, 0, 0); PG8_LDB(B1, 0, 1); PG8_SCHED; PG8_LDA(At, 0, 0); PG8_STAGE(PG8_SA(1, 1), a1 + hstepA, voffA);
            PG8_WAIT_V(8); PG8_WAIT_L(0); PG8_BAR; PG8_MMA2(0, 0); PG8_BAR; PG8_SCHED;
            PG8_LDA(At, 0, 1); PG8_STAGE(PG8_SB(0, 0), b2, voffB); PG8_STAGE(PG8_SB(0, 1), b2 + hstepB, voffB); PG8_STAGE(PG8_SA(0, 0), a2, voffA);
            PG8_WAIT_V(8); PG8_WAIT_L(0); PG8_BAR; PG8_MMA2(1, 0); PG8_BAR; PG8_SCHED;
            PG8_LDB(B0, 1, 0); PG8_LDB(B1, 1, 1); PG8_SCHED; PG8_LDA(At, 1, 0); PG8_STAGE(PG8_SA(0, 1), a2 + hstepA, voffA);
            PG8_WAIT_V(8); PG8_WAIT_L(0); PG8_BAR; PG8_MMA2(0, 1); PG8_BAR; PG8_SCHED;
            PG8_LDA(At, 1, 1); PG8_STAGE(PG8_SB(1, 0), b3, voffB); PG8_STAGE(PG8_SB(1, 1), b3 + hstepB, voffB); PG8_STAGE(PG8_SA(1, 0), a3, voffA);
            PG8_WAIT_V(8); PG8_WAIT_L(0); PG8_BAR; PG8_MMA2(1, 1); PG8_BAR; PG8_SCHED;
        }
        if constexpr (ALIGN_EPI) { if (wr == 0) PG8_BAR; }
        if constexpr (I8) {
#pragma unroll
            for (int a = 0; a < 2; ++a)
#pragma unroll
                for (int b = 0; b < 2; ++b)
#pragma unroll
                    for (int m = 0; m < 4; ++m)
#pragma unroll
                        for (int n = 0; n < 2; ++n) acc[a][b][m][n] = __builtin_convertvector(__builtin_bit_cast(v4i32g, acc[a][b][m][n]), f32x4); }
        E(acc, cur, wr, wc, fr, fq); S.done(cur);
        if (!has_next) break;
#pragma unroll
        for (int a = 0; a < 2; ++a)
#pragma unroll
            for (int b = 0; b < 2; ++b)
#pragma unroll
                for (int m = 0; m < 4; ++m)
#pragma unroll
                    for (int n = 0; n < 2; ++n) acc[a][b][m][n] = (f32x4){0.f, 0.f, 0.f, 0.f};
        cur = nxt; cA = nA; cB = nB; ++ui;
        if constexpr (ALIGN_EPI) { if (wr == 1) PG8_BAR; }
    }
    PG8_WAIT_V(0);
    if constexpr (!ALIGN_EPI) { if (wr == 0) PG8_BAR; }
    PG8_BAR;
#undef PG8_SA
#undef PG8_SB
#undef PG8_STAGE
#undef PG8_LDA
#undef PG8_LDB
#undef PG8_MMA
#undef PG8_MMA2
#undef PG8_WAIT_V
#undef PG8_WAIT_L
#undef PG8_BAR
#undef PG8_SCHED
}
}

namespace att {
typedef unsigned short bf16_t;
typedef short bf16x8 __attribute__((ext_vector_type(8)));
typedef short s16x4 __attribute__((ext_vector_type(4)));
typedef float f32x16 __attribute__((ext_vector_type(16)));
typedef float f32x4 __attribute__((ext_vector_type(4)));
typedef unsigned u32x4 __attribute__((ext_vector_type(4)));
constexpr int NW = 8, QBLK = 32, KVBLK = 64, QB = NW * QBLK;
constexpr int SHM_V = KVBLK * 128 * 2, SHM_K = KVBLK * 128 * 2, SHM_R = KVBLK * 64 * 2;
constexpr int QROW = 272, QWAVE = 32 * QROW;
constexpr float THR = 8.f;
constexpr int STG_ROW = 132, STG_WAVE = 32 * STG_ROW * 4;
static_assert(NW * STG_WAVE <= 155648, "staging");

#define KSWZ(row, colB) ((row) * 256 + ((colB) ^ (((row) & 7) << 4)))
#define RSWZ(row, chunk) ((row) * 128 + ((((chunk) ^ (((row) >> 1) & 7))) << 4))
#define SBAR() __builtin_amdgcn_sched_barrier(0)
__device__ __forceinline__ int v_rd_base(int lane) { return ((lane & 3) << 3) | (((lane >> 2) & 3) << 6) | (((lane >> 4) & 1) << 5) | (((lane >> 5) & 1) << 8); }
constexpr int v_rd_off(int d0, int ks, int half) { return d0 * 512 + ks * 4096 + half * 2048; }
__device__ __forceinline__ int crow(int r, int hi) { return (r & 3) + 8 * (r >> 2) + 4 * hi; }
typedef float f32x2_t __attribute__((ext_vector_type(2))); typedef __bf16 bf16x2_t __attribute__((ext_vector_type(2)));
__device__ __forceinline__ unsigned cvtpk(float lo, float hi) { f32x2_t v = {lo, hi}; bf16x2_t b = __builtin_convertvector(v, bf16x2_t); return __builtin_bit_cast(unsigned, b); }
__device__ __forceinline__ void glds16(const void* gsrc, unsigned lds_dst) { unsigned keep;
    asm volatile("s_mov_b32 %0, m0\n\ts_mov_b32 m0, %2\n\ts_nop 0\n\tglobal_load_lds_dwordx4 %1, off\n\ts_mov_b32 m0, %0" : "=&s"(keep) : "v"(gsrc), "s"(lds_dst) : "memory"); }
#define WAIT_BAR() asm volatile("s_waitcnt vmcnt(0) lgkmcnt(0)\n\ts_barrier" ::: "memory")

__device__ __forceinline__ void mask_tile(f32x16& p0, f32x16& p1, int dq) {
    const float NEG = -__builtin_inff();
#pragma unroll
    for (int r = 0; r < 16; ++r) { const int c = (r & 3) + 8 * (r >> 2); if (dq - c < 0) p0[r] = NEG; if (dq - c - 32 < 0) p1[r] = NEG; }
}
template <bool MLA> __device__ __forceinline__ void partialSM(f32x16& p0, f32x16& p1, float& m_reg, float& mn, float& alpha) {
    constexpr float SCALE = MLA ? 0.07216878364870322f : 0.125f;
    float pmax = p0[0];
#pragma unroll
    for (int r = 1; r < 16; ++r) pmax = fmaxf(pmax, p0[r]);
#pragma unroll
    for (int r = 0; r < 16; ++r) pmax = fmaxf(pmax, p1[r]);
    { auto rr = __builtin_amdgcn_permlane32_swap(__float_as_uint(pmax), __float_as_uint(pmax), false, false); pmax = fmaxf(__uint_as_float(rr[0]), __uint_as_float(rr[1])); }
    constexpr float C2 = 1.4426950408889634f * SCALE;
    if (MLA) {
        if (__builtin_expect(__all((pmax - m_reg) * SCALE <= 5.0f), 1)) { mn = m_reg; alpha = 1.f; }
        else { mn = fmaxf(m_reg, pmax); alpha = __builtin_amdgcn_exp2f((m_reg - mn) * C2); m_reg = mn; }
    } else {
        const bool keep = __all((pmax - m_reg) * SCALE <= THR);
        mn = keep ? m_reg : fmaxf(m_reg, pmax); alpha = __builtin_amdgcn_exp2f((m_reg - mn) * C2); m_reg = mn;
    }
    const float mnL = -mn * C2;
#pragma unroll
    for (int r = 0; r < 16; ++r) p0[r] = fmaf(p0[r], C2, mnL);
#pragma unroll
    for (int r = 0; r < 16; ++r) p1[r] = fmaf(p1[r], C2, mnL);
#pragma unroll
    for (int r = 0; r < 16; ++r) p0[r] = __builtin_amdgcn_exp2f(p0[r]);
}
__device__ __forceinline__ void finishSM(f32x16& p0, f32x16& p1, float alpha, float& l_reg, bf16x8& pa0, bf16x8& pa1, bf16x8& pa2, bf16x8& pa3) {
#pragma unroll
    for (int r = 0; r < 16; ++r) p1[r] = __builtin_amdgcn_exp2f(p1[r]);
    float ps = 0;
#pragma unroll
    for (int r = 0; r < 16; ++r) ps += p0[r];
#pragma unroll
    for (int r = 0; r < 16; ++r) ps += p1[r];
    { auto rr = __builtin_amdgcn_permlane32_swap(__float_as_uint(ps), __float_as_uint(ps), false, false); ps = __uint_as_float(rr[0]) + __uint_as_float(rr[1]); }
    l_reg = l_reg * alpha + ps;
#define PK4(P, B_, OUT) do { unsigned a0 = cvtpk(P[B_+0], P[B_+1]), a1 = cvtpk(P[B_+2], P[B_+3]); unsigned b0 = cvtpk(P[B_+4], P[B_+5]), b1 = cvtpk(P[B_+6], P[B_+7]); \
        auto r0 = __builtin_amdgcn_permlane32_swap(a0, b0, false, false); auto r1 = __builtin_amdgcn_permlane32_swap(a1, b1, false, false); \
        u32x4 w = {r0[0], r1[0], r0[1], r1[1]}; OUT = *reinterpret_cast<bf16x8*>(&w); } while (0)
    PK4(p0, 0, pa0); PK4(p0, 8, pa1); PK4(p1, 0, pa2); PK4(p1, 8, pa3);
#undef PK4
}
__device__ __forceinline__ unsigned pk4f8(float a, float b, float c, float d) { int w = __builtin_amdgcn_cvt_pk_fp8_f32(a, b, 0, false); w = __builtin_amdgcn_cvt_pk_fp8_f32(c, d, w, true); return (unsigned)w; }
__device__ __forceinline__ void finishSM8(f32x16& p0, f32x16& p1, float alpha, float& l_reg, int (&P8)[8]) {
#pragma unroll
    for (int r = 0; r < 16; ++r) p1[r] = __builtin_amdgcn_exp2f(p1[r]);
    float ps = 0;
#pragma unroll
    for (int r = 0; r < 16; ++r) ps += p0[r];
#pragma unroll
    for (int r = 0; r < 16; ++r) ps += p1[r];
    { auto rr = __builtin_amdgcn_permlane32_swap(__float_as_uint(ps), __float_as_uint(ps), false, false); ps = __uint_as_float(rr[0]) + __uint_as_float(rr[1]); }
    l_reg = l_reg * alpha + ps;
#pragma unroll
    for (int i = 0; i < 4; ++i) { P8[i] = (int)pk4f8(p0[4 * i], p0[4 * i + 1], p0[4 * i + 2], p0[4 * i + 3]); P8[4 + i] = (int)pk4f8(p1[4 * i], p1[4 * i + 1], p1[4 * i + 2], p1[4 * i + 3]); }
}
typedef int v8i32b __attribute__((ext_vector_type(8)));
__device__ __forceinline__ void pv8(f32x16* o, const char* vt, int r32, int hi, const int (&P8)[8]) {
    const v8i32b pa = {P8[0], P8[1], P8[2], P8[3], P8[4], P8[5], P8[6], P8[7]};
    const char* va = vt + (2 * hi) * 2048 + r32 * 16;
#pragma unroll
    for (int blk = 0; blk < 4; ++blk) { const u32x4 x0 = *reinterpret_cast<const u32x4*>(va + blk * 512), x1 = *reinterpret_cast<const u32x4*>(va + 2048 + blk * 512);
        const v8i32b vb = {(int)x0[0], (int)x0[1], (int)x0[2], (int)x0[3], (int)x1[0], (int)x1[1], (int)x1[2], (int)x1[3]};
        o[blk] = __builtin_amdgcn_mfma_scale_f32_32x32x64_f8f6f4(pa, vb, o[blk], 0, 0, 0, 0, 0, 0); }
}
typedef int v8i32 __attribute__((ext_vector_type(8)));
__device__ __forceinline__ void qkt8(f32x16& p0, f32x16& p1, const char* kn, const char* kr, int r32, int hi, const v8i32* q8) {
    p0 = f32x16{}; p1 = f32x16{};
#pragma unroll
    for (int sl = 0; sl < 3; ++sl) { const char* a = (sl < 2 ? kn + (4 * sl + 2 * hi) * 1024 : kr + (2 * hi) * 1024) + r32 * 16;
        const u32x4 x0 = *reinterpret_cast<const u32x4*>(a), x1 = *reinterpret_cast<const u32x4*>(a + 1024), y0 = *reinterpret_cast<const u32x4*>(a + 512), y1 = *reinterpret_cast<const u32x4*>(a + 1024 + 512);
        const v8i32 k0 = {(int)x0[0], (int)x0[1], (int)x0[2], (int)x0[3], (int)x1[0], (int)x1[1], (int)x1[2], (int)x1[3]}, k1 = {(int)y0[0], (int)y0[1], (int)y0[2], (int)y0[3], (int)y1[0], (int)y1[1], (int)y1[2], (int)y1[3]};
        p0 = __builtin_amdgcn_mfma_scale_f32_32x32x64_f8f6f4(k0, q8[sl], p0, 0, 0, 0, 0, 0, 0); p1 = __builtin_amdgcn_mfma_scale_f32_32x32x64_f8f6f4(k1, q8[sl], p1, 0, 0, 0, 0, 0, 0); }
}
template <bool MLA, int NS> struct Lay {
    static constexpr int OFF_V = 0, OFF_K = NS * SHM_V, OFF_R = OFF_K + (MLA ? NS * SHM_K : 0), OFF_WS = OFF_R + NS * SHM_R, OFF_Q = OFF_WS + NW * 64 * 4, END = OFF_Q + (MLA ? NW * QWAVE : 0);
};
template <bool MLA>
__device__ __forceinline__ void qkt(f32x16& p0, f32x16& p1, const char* kn, const char* kr, int r32, int hi, const char* qimg, const bf16x8* qr) {
    p0 = f32x16{}; p1 = f32x16{};
    if (MLA) {
#pragma unroll
        for (int d0 = 0; d0 < 8; ++d0) { const char* a = kn + KSWZ(r32, ((d0 & 3) * 16 + hi * 8) * 2) + (d0 >> 2) * 128;
            bf16x8 b0 = *reinterpret_cast<const bf16x8*>(a); bf16x8 b1 = *reinterpret_cast<const bf16x8*>(a + 32 * 256);
            const bf16x8 q = *reinterpret_cast<const bf16x8*>(qimg + d0 * 32);
            p0 = __builtin_amdgcn_mfma_f32_32x32x16_bf16(b0, q, p0, 0, 0, 0); p1 = __builtin_amdgcn_mfma_f32_32x32x16_bf16(b1, q, p1, 0, 0, 0); }
    }
#pragma unroll
    for (int d0 = 0; d0 < 4; ++d0) { const char* a = kr + RSWZ(r32, 2 * d0 + hi);
        bf16x8 b0 = *reinterpret_cast<const bf16x8*>(a); bf16x8 b1 = *reinterpret_cast<const bf16x8*>(a + 32 * 128);
        p0 = __builtin_amdgcn_mfma_f32_32x32x16_bf16(b0, qr[d0], p0, 0, 0, 0); p1 = __builtin_amdgcn_mfma_f32_32x32x16_bf16(b1, qr[d0], p1, 0, 0, 0); }
}
typedef __attribute__((address_space(3))) const char* lds_cptr;
typedef short v4i16_t __attribute__((ext_vector_type(4)));
__device__ __forceinline__ s16x4 vtr(lds_cptr p) { return __builtin_bit_cast(s16x4, __builtin_amdgcn_ds_read_tr16_b64_v4i16((__attribute__((address_space(3))) v4i16_t*)p)); }
__device__ __forceinline__ void pv_tile_pipe(f32x16* o, lds_cptr vp, bf16x8 pa0, bf16x8 pa1, bf16x8 pa2, bf16x8 pa3) {
    const int vb = (int)(unsigned)(uintptr_t)vp;
#define TRRD(dst, off) asm volatile("ds_read_b64_tr_b16 %0, %1 offset:%2" : "=&v"(dst) : "v"(vb), "i"(off) : "memory")
#define RD8(S, d0) do { TRRD(S##l0, v_rd_off(d0, 0, 0)); TRRD(S##h0, v_rd_off(d0, 0, 0) + 2048); TRRD(S##l1, v_rd_off(d0, 0, 0) + 4096); TRRD(S##h1, v_rd_off(d0, 0, 0) + 6144); \
        TRRD(S##l2, v_rd_off(d0, 0, 0) + 8192); TRRD(S##h2, v_rd_off(d0, 0, 0) + 10240); TRRD(S##l3, v_rd_off(d0, 0, 0) + 12288); TRRD(S##h3, v_rd_off(d0, 0, 0) + 14336); } while (0)
#define LW8(S) asm volatile("s_waitcnt lgkmcnt(0)" : "+v"(S##l0), "+v"(S##h0), "+v"(S##l1), "+v"(S##h1), "+v"(S##l2), "+v"(S##h2), "+v"(S##l3), "+v"(S##h3) :: "memory")
#define MM4(S, d0) do { \
        o[d0] = __builtin_amdgcn_mfma_f32_32x32x16_bf16(pa0, (bf16x8){S##l0[0], S##l0[1], S##l0[2], S##l0[3], S##h0[0], S##h0[1], S##h0[2], S##h0[3]}, o[d0], 0, 0, 0); \
        o[d0] = __builtin_amdgcn_mfma_f32_32x32x16_bf16(pa1, (bf16x8){S##l1[0], S##l1[1], S##l1[2], S##l1[3], S##h1[0], S##h1[1], S##h1[2], S##h1[3]}, o[d0], 0, 0, 0); \
        o[d0] = __builtin_amdgcn_mfma_f32_32x32x16_bf16(pa2, (bf16x8){S##l2[0], S##l2[1], S##l2[2], S##l2[3], S##h2[0], S##h2[1], S##h2[2], S##h2[3]}, o[d0], 0, 0, 0); \
        o[d0] = __builtin_amdgcn_mfma_f32_32x32x16_bf16(pa3, (bf16x8){S##l3[0], S##l3[1], S##l3[2], S##l3[3], S##h3[0], S##h3[1], S##h3[2], S##h3[3]}, o[d0], 0, 0, 0); } while (0)
    s16x4 Al0, Ah0, Al1, Ah1, Al2, Ah2, Al3, Ah3, Bl0, Bh0, Bl1, Bh1, Bl2, Bh2, Bl3, Bh3;
    RD8(A, 0); LW8(A);
    RD8(B, 1); MM4(A, 0); LW8(B);
    RD8(A, 2); MM4(B, 1); LW8(A);
    RD8(B, 3); MM4(A, 2); LW8(B);
    MM4(B, 3);
#undef RD8
#undef LW8
#undef MM4
#undef TRRD
}
__device__ __forceinline__ void qkt_batch(f32x16& p0, f32x16& p1, const char* kr, int r32, int hi, const bf16x8* qr) {
    bf16x8 kf[8];
#pragma unroll
    for (int d0 = 0; d0 < 4; ++d0) { const int a = (int)(unsigned)(uintptr_t)(kr + RSWZ(r32, 2 * d0 + hi));
        asm volatile("ds_read_b128 %0, %1" : "=&v"(kf[2 * d0]) : "v"(a) : "memory"); asm volatile("ds_read_b128 %0, %1 offset:4096" : "=&v"(kf[2 * d0 + 1]) : "v"(a) : "memory"); }
    asm volatile("s_waitcnt lgkmcnt(0)" : "+v"(kf[0]), "+v"(kf[1]), "+v"(kf[2]), "+v"(kf[3]), "+v"(kf[4]), "+v"(kf[5]), "+v"(kf[6]), "+v"(kf[7]) :: "memory");
    p0 = f32x16{}; p1 = f32x16{};
#pragma unroll
    for (int d0 = 0; d0 < 4; ++d0) { p0 = __builtin_amdgcn_mfma_f32_32x32x16_bf16(kf[2 * d0], qr[d0], p0, 0, 0, 0); p1 = __builtin_amdgcn_mfma_f32_32x32x16_bf16(kf[2 * d0 + 1], qr[d0], p1, 0, 0, 0); }
}
template <bool VIS> __device__ __forceinline__ void pv_tile(f32x16* o, lds_cptr vp, bf16x8 pa0, bf16x8 pa1, bf16x8 pa2, bf16x8 pa3) {
    if (!VIS) {
        const int vb = (int)(unsigned)(uintptr_t)vp;
#define TRRD(dst, off) asm volatile("ds_read_b64_tr_b16 %0, %1 offset:%2" : "=&v"(dst) : "v"(vb), "i"(off) : "memory")
#define PV_D0(d0) do { s16x4 l0, l1, l2, l3, h0, h1, h2, h3; constexpr int b_ = v_rd_off(d0, 0, 0); \
        TRRD(l0, b_); TRRD(h0, b_ + 2048); TRRD(l1, b_ + 4096); TRRD(h1, b_ + 6144); TRRD(l2, b_ + 8192); TRRD(h2, b_ + 10240); TRRD(l3, b_ + 12288); TRRD(h3, b_ + 14336); \
        asm volatile("s_waitcnt lgkmcnt(0)" ::: "memory"); SBAR(); \
        o[d0] = __builtin_amdgcn_mfma_f32_32x32x16_bf16(pa0, (bf16x8){l0[0], l0[1], l0[2], l0[3], h0[0], h0[1], h0[2], h0[3]}, o[d0], 0, 0, 0); \
        o[d0] = __builtin_amdgcn_mfma_f32_32x32x16_bf16(pa1, (bf16x8){l1[0], l1[1], l1[2], l1[3], h1[0], h1[1], h1[2], h1[3]}, o[d0], 0, 0, 0); \
        o[d0] = __builtin_amdgcn_mfma_f32_32x32x16_bf16(pa2, (bf16x8){l2[0], l2[1], l2[2], l2[3], h2[0], h2[1], h2[2], h2[3]}, o[d0], 0, 0, 0); \
        o[d0] = __builtin_amdgcn_mfma_f32_32x32x16_bf16(pa3, (bf16x8){l3[0], l3[1], l3[2], l3[3], h3[0], h3[1], h3[2], h3[3]}, o[d0], 0, 0, 0); } while (0)
        PV_D0(0); PV_D0(1); PV_D0(2); PV_D0(3);
#undef PV_D0
#undef TRRD
        return;
    }
#pragma unroll
    for (int d0 = 0; d0 < 4; ++d0) {
        const s16x4 l0 = vtr(vp + d0 * 512), h0 = vtr(vp + d0 * 512 + 2048), l1 = vtr(vp + d0 * 512 + 4096), h1 = vtr(vp + d0 * 512 + 6144);
        const s16x4 l2 = vtr(vp + d0 * 512 + 8192), h2 = vtr(vp + d0 * 512 + 10240), l3 = vtr(vp + d0 * 512 + 12288), h3 = vtr(vp + d0 * 512 + 14336);
        o[d0] = __builtin_amdgcn_mfma_f32_32x32x16_bf16(pa0, (bf16x8){l0[0], l0[1], l0[2], l0[3], h0[0], h0[1], h0[2], h0[3]}, o[d0], 0, 0, 0);
        o[d0] = __builtin_amdgcn_mfma_f32_32x32x16_bf16(pa1, (bf16x8){l1[0], l1[1], l1[2], l1[3], h1[0], h1[1], h1[2], h1[3]}, o[d0], 0, 0, 0);
        o[d0] = __builtin_amdgcn_mfma_f32_32x32x16_bf16(pa2, (bf16x8){l2[0], l2[1], l2[2], l2[3], h2[0], h2[1], h2[2], h2[3]}, o[d0], 0, 0, 0);
        o[d0] = __builtin_amdgcn_mfma_f32_32x32x16_bf16(pa3, (bf16x8){l3[0], l3[1], l3[2], l3[3], h3[0], h3[1], h3[2], h3[3]}, o[d0], 0, 0, 0);
    }
}

struct Src { const bf16_t* Qn; const bf16_t* Qr; const bf16_t* Kn; const bf16_t* Kr; const bf16_t* V; };
template <bool MLA> struct Pitch { static constexpr int qn = 3072, qr = MLA ? 3072 : 16128, kn = 4096, kr = 16128, v = MLA ? 4096 : 16128; };

template <bool MLA, int NS>
__device__ __forceinline__ void attn_block(const Src& s, int qb, char* lds) {
    typedef Pitch<MLA> PT; typedef Lay<MLA, NS> L;
    constexpr int LA = NS - 1;
    constexpr int NPC = MLA ? 5 : 3;
    const int tid = threadIdx.x, wid = __builtin_amdgcn_readfirstlane(tid >> 6), lane = tid & 63, r32 = lane & 31, hi = lane >> 5;
    const int P0 = qb * QB, NT = (P0 + QB) / KVBLK;
    const int qlo = P0 + wid * QBLK, qm = qlo + r32 - 4 * hi;
    const unsigned lds0 = (unsigned)(uintptr_t)lds;
    float* ws = (float*)(lds + L::OFF_WS) + wid * 64; float* li_l = ws; float* al_l = ws + 32;
    float m_reg = -1e30f, l_reg = 0; f32x16 o[4];
#pragma unroll
    for (int d = 0; d < 4; ++d) o[d] = f32x16{};
    unsigned offV[2], offK[2], offR;
#pragma unroll
    for (int i = 0; i < 2; ++i) { const int q = (wid * 2 + i) * 64 + lane;
        { const int sidx = q >> 5, w5 = q & 31, kk = (sidx >> 2) * 8 + (w5 >> 2), c = (sidx & 3) * 32 + (w5 & 3) * 8, k = (kk & ~0xC) | ((kk & 4) << 1) | ((kk & 8) >> 1); offV[i] = (unsigned)(k * PT::v + c) * 2u; }
        offK[i] = MLA ? (unsigned)(lane * 2048 + wid * 16) : 0u; }
    if (MLA) offR = (unsigned)(lane * 64 + (wid & 3) * 16);
    else { const int q = wid * 64 + lane, row = q >> 3, c = (q & 7) ^ ((row >> 1) & 7); offR = (unsigned)(row * PT::kr + c * 8) * 2u; }
    const unsigned offV8 = (unsigned)(((wid >> 2) * 64 + lane) * 8192 + (wid & 3) * 16);
#define SLOT_INC(x) ((x) + 1 == NS ? 0 : (x) + 1)
#define DMA_K(t, sl) do { if (MLA) { glds16((const char*)s.Kn + (size_t)(t) * (KVBLK * 2048) + offK[0], (unsigned)__builtin_amdgcn_readfirstlane(lds0 + L::OFF_K + (sl) * SHM_K + wid * 1024)); \
            if (wid < 4) glds16((const char*)s.Kr + (size_t)(t) * (KVBLK * 64) + offR, (unsigned)__builtin_amdgcn_readfirstlane(lds0 + L::OFF_R + (sl) * SHM_R + wid * 1024)); } \
        else { const char* rb_ = (const char*)s.Kr + (size_t)(t) * (KVBLK * 2) * PT::kr; glds16(rb_ + offR, (unsigned)__builtin_amdgcn_readfirstlane(lds0 + L::OFF_R + (sl) * SHM_R + wid * 1024)); } } while (0)
#define DMA_V(t, sl) do { if (MLA) { glds16((const char*)s.V + (size_t)(t) * KVBLK + offV8, (unsigned)__builtin_amdgcn_readfirstlane(lds0 + L::OFF_V + (sl) * SHM_V + (wid & 3) * 2048 + (wid >> 2) * 1024)); } \
        else { const char* vb_ = (const char*)s.V + (size_t)(t) * (KVBLK * 2) * PT::v; \
        glds16(vb_ + offV[0], (unsigned)__builtin_amdgcn_readfirstlane(lds0 + L::OFF_V + (sl) * SHM_V + (wid * 2) * 1024)); glds16(vb_ + offV[1], (unsigned)__builtin_amdgcn_readfirstlane(lds0 + L::OFF_V + (sl) * SHM_V + (wid * 2 + 1) * 1024)); } } while (0)
    __syncthreads();
    DMA_K(0, 0);
    bf16x8 qr[4]; v8i32 q8[3];
    { const size_t qrow = (size_t)(qlo + r32);
        if (MLA) {
            const char* qn_ = (const char*)s.Qn + qrow * 3072 + 32 * hi; const char* qr_ = (const char*)s.Qr + qrow * 3072 + 32 * hi;
#pragma unroll
            for (int sl = 0; sl < 3; ++sl) { const char* p_ = sl < 2 ? qn_ + 64 * sl : qr_; const u32x4 x0 = *reinterpret_cast<const u32x4*>(p_), x1 = *reinterpret_cast<const u32x4*>(p_ + 16);
                q8[sl] = (v8i32){(int)x0[0], (int)x0[1], (int)x0[2], (int)x0[3], (int)x1[0], (int)x1[1], (int)x1[2], (int)x1[3]}; }
        } else {
#pragma unroll
            for (int d0 = 0; d0 < 4; ++d0) qr[d0] = *reinterpret_cast<const bf16x8*>(s.Qr + qrow * PT::qr + d0 * 16 + hi * 8);
        } }
    if (LA >= 2) { DMA_K(1, 1); DMA_V(0, 0); }
    const char* qimg = nullptr;
    const lds_cptr vb0 = (lds_cptr)lds + (L::OFF_V + v_rd_base(lane));
#define RESC(a) do { if (__any((a) < 1.f)) { if (hi == 0) al_l[r32] = (a); asm volatile("s_waitcnt lgkmcnt(0)" ::: "memory"); \
        _Pragma("unroll") for (int d_ = 0; d_ < 4; ++d_) _Pragma("unroll") for (int r = 0; r < 16; ++r) o[d_][r] *= al_l[crow(r, hi)]; } } while (0)
#define KBASE(t) ((t) * KVBLK)
#define MASKT(P0_, P1_, t) do { const int kb_ = KBASE(t); if (__builtin_expect(kb_ + KVBLK - 1 > qlo, 0)) { asm volatile("; causal-mask tile" ::: "memory"); mask_tile(P0_, P1_, qm - kb_); } } while (0)
#define WAIT_STEP(full) do { if (NS >= 3 && (full)) { if (MLA) asm volatile("s_waitcnt vmcnt(5) lgkmcnt(0)\n\ts_barrier" ::: "memory"); else asm volatile("s_waitcnt vmcnt(3) lgkmcnt(0)\n\ts_barrier" ::: "memory"); } \
        else WAIT_BAR(); } while (0)
    f32x16 pA0, pA1, pB0, pB1; float mnA, mnB, alA, alB; bf16x8 pa0, pa1, pa2, pa3; int P8[8];
    WAIT_BAR();
    int sc = 0;
    { const int sk = (LA % NS), sv = ((LA + NS - 1) % NS);
      DMA_K(LA, sk); DMA_V(LA - 1, sv);
      SBAR(); if (MLA) qkt8(pA0, pA1, lds + L::OFF_K + sc * SHM_K, lds + L::OFF_R + sc * SHM_R, r32, hi, q8); else qkt_batch(pA0, pA1, lds + L::OFF_R + sc * SHM_R, r32, hi, qr);
      MASKT(pA0, pA1, 0); partialSM<MLA>(pA0, pA1, m_reg, mnA, alA);
      WAIT_STEP(true); }
#define STEP(PX0, PX1, mnX, alX, PY0, PY1, alY, t, MASK) do { \
        const int sp_ = sc; sc = SLOT_INC(sc); \
        const int skw_ = sp_, svw_ = (NS == 2) ? sc : ((sp_ == 0) ? NS - 1 : sp_ - 1); \
        const bool gk_ = (t) + LA < NT, gv_ = (t) + LA - 1 < NT; \
        if (gk_) DMA_K((t) + LA, skw_); if (gv_) DMA_V((t) + LA - 1, svw_); \
        SBAR(); if (MLA) qkt8(PX0, PX1, lds + L::OFF_K + sc * SHM_K, lds + L::OFF_R + sc * SHM_R, r32, hi, q8); else qkt_batch(PX0, PX1, lds + L::OFF_R + sc * SHM_R, r32, hi, qr); \
        if (MLA) { finishSM8(PY0, PY1, alY, l_reg, P8); SBAR(); pv8(o, lds + L::OFF_V + sp_ * SHM_V, r32, hi, P8); } \
        else { finishSM(PY0, PY1, alY, l_reg, pa0, pa1, pa2, pa3); pv_tile_pipe(o, vb0 + sp_ * SHM_V, pa0, pa1, pa2, pa3); } if (MLA) { MASKT(PX0, PX1, (t)); } else if (MASK) mask_tile(PX0, PX1, qm - KBASE(t)); partialSM<MLA>(PX0, PX1, m_reg, mnX, alX); \
        RESC(alX); WAIT_STEP(gk_ && gv_); } while (0)
    int t = 1;
    if (!MLA) for (; t + 1 < NT - 4; t += 2) {
        STEP(pB0, pB1, mnB, alB, pA0, pA1, alA, t, false);
        STEP(pA0, pA1, mnA, alA, pB0, pB1, alB, t + 1, false);
    }
    for (; t + 1 < NT; t += 2) {
        STEP(pB0, pB1, mnB, alB, pA0, pA1, alA, t, true);
        STEP(pA0, pA1, mnA, alA, pB0, pB1, alB, t + 1, true);
    }
    STEP(pB0, pB1, mnB, alB, pA0, pA1, alA, NT - 1, true);
    if (MLA) { finishSM8(pB0, pB1, alB, l_reg, P8); SBAR(); pv8(o, lds + L::OFF_V + sc * SHM_V, r32, hi, P8); }
    else { finishSM(pB0, pB1, alB, l_reg, pa0, pa1, pa2, pa3); SBAR(); pv_tile_pipe(o, vb0 + sc * SHM_V, pa0, pa1, pa2, pa3); }
    if (hi == 0) li_l[r32] = l_reg;
    asm volatile("s_waitcnt lgkmcnt(0)" ::: "memory");
    float rl[16];
#pragma unroll
    for (int r = 0; r < 16; ++r) rl[r] = __builtin_amdgcn_rcpf(li_l[crow(r, hi)]);
    WAIT_BAR();
    float* st = (float*)(lds + wid * STG_WAVE) + hi * (4 * STG_ROW) + r32;
#pragma unroll
    for (int r = 0; r < 16; ++r)
#pragma unroll
        for (int d0 = 0; d0 < 4; ++d0) st[((r & 3) + 8 * (r >> 2)) * STG_ROW + d0 * 32] = o[d0][r] * rl[r];
    asm volatile("s_waitcnt lgkmcnt(0)" ::: "memory");
#undef SLOT_INC
#undef DMA_K
#undef DMA_V
#undef RESC
#undef KBASE
#undef MASKT
#undef WAIT_STEP
#undef STEP
}
constexpr int DK_SLOT = 8192, DV_SLOT = 16384, D_NSLOT = 3;
constexpr int D_LDS_K = 0, D_LDS_V = D_NSLOT * DK_SLOT, D_LDS_WS = D_LDS_V + D_NSLOT * DV_SLOT, D_LDS_END = D_LDS_WS + NW * 64 * 4;
constexpr int DPITCH = 16128;
typedef __attribute__((address_space(3))) const bf16x8* lds_b8;
__device__ __forceinline__ void kload2(bf16x8* kf, lds_cptr kp, int j) { kf[2 * j] = *(lds_b8)(kp + j * 2048); kf[2 * j + 1] = *(lds_b8)(kp + j * 2048 + 512); }
template <int THRL>
__device__ __forceinline__ void diff_block64(const bf16_t* Qh, const bf16_t* Kh, const bf16_t* Vh, int qb, char* lds) {
    int tid = threadIdx.x; asm volatile("" : "+v"(tid));
    const int lane = tid & 63, r32 = lane & 31, hi = lane >> 5; const int wid = __builtin_amdgcn_readfirstlane(tid >> 6);
    const int q0 = qb * QB, NT = (q0 + QB) / KVBLK;
    const unsigned lds0 = (unsigned)(uintptr_t)lds;
    float* wsf = (float*)(lds + D_LDS_WS) + wid * 64;
    const unsigned koff = (unsigned)(lane * DPITCH + wid * 8) * 2u;
    const unsigned voff = (unsigned)((16 * (wid & 3) + (lane >> 2)) * DPITCH + (wid >> 2) * 32 + (lane & 3) * 8) * 2u;
    const unsigned kdst = lds0 + D_LDS_K + wid * 1024, vdst = lds0 + D_LDS_V + wid * 1024;
#define DMA_K(t, sidx) glds16((const char*)Kh + (size_t)(t) * (KVBLK * DPITCH * 2) + koff, (unsigned)__builtin_amdgcn_readfirstlane(kdst + (sidx) * DK_SLOT))
#define DMA_V(t, sidx) do { const char* vb_ = (const char*)Vh + (size_t)(t) * (KVBLK * DPITCH * 2) + voff; \
        glds16(vb_, (unsigned)__builtin_amdgcn_readfirstlane(vdst + (sidx) * DV_SLOT)); glds16(vb_ + 128, (unsigned)__builtin_amdgcn_readfirstlane(vdst + (sidx) * DV_SLOT + 8192)); } while (0)
#define WAIT_BARN(N) asm volatile("s_waitcnt vmcnt(" #N ") lgkmcnt(0)\n\ts_barrier" ::: "memory")
#define SBAR() __builtin_amdgcn_sched_barrier(0)
    const lds_cptr shm3 = (lds_cptr)lds; const lds_cptr kp0 = shm3 + D_LDS_K + hi * 1024 + r32 * 16;
    const lds_cptr vp0 = shm3 + D_LDS_V + ((lane >> 4) & 1) * 32 + (lane & 3) * 8 + (4 * hi + ((lane & 15) >> 2)) * 64;
    __syncthreads();
    DMA_K(0, 0); DMA_V(0, 0); DMA_K(1, 1);
    bf16x8 qr[4], kf[8];
    { const bf16_t* Qw = Qh + (size_t)(q0 + wid * QBLK + r32) * DPITCH;
#pragma unroll
      for (int d0 = 0; d0 < 4; ++d0) qr[d0] = *reinterpret_cast<const bf16x8*>(Qw + d0 * 16 + hi * 8); }
    float mhat = 0.f, l_reg = 0.f; f32x16 o[4];
#pragma unroll
    for (int d = 0; d < 4; ++d) o[d] = f32x16{};
    const int qrel = wid * QBLK + r32;
#define CMASK(P0, P1, t) do { const int jb_ = (t) - (NT - 4); if (jb_ >= 0) { const float NEG_ = -__builtin_inff(); const int kb_ = 64 * jb_ + 4 * hi; \
        _Pragma("unroll") for (int r = 0; r < 16; ++r) { const int kv_ = kb_ + (r & 3) + 8 * (r >> 2); if (kv_ > qrel) P0[r] = NEG_; if (kv_ + 32 > qrel) P1[r] = NEG_; } } } while (0)
#define MX3(a, b, c) __builtin_fmaxf(__builtin_fmaxf((a), (b)), (c))
#define ROWMAX(rm, C0, C1) do { float a_ = MX3(C0[0], C0[1], C1[0]), b_ = MX3(C0[2], C0[3], C1[1]); a_ = MX3(a_, C1[2], C1[3]); \
        _Pragma("unroll") for (int r = 4; r < 16; r += 4) { a_ = MX3(a_, C0[r], C0[r + 1]); b_ = MX3(b_, C0[r + 2], C0[r + 3]); a_ = MX3(a_, C1[r], C1[r + 1]); b_ = MX3(b_, C1[r + 2], C1[r + 3]); } \
        rm = __builtin_fmaxf(a_, b_); { auto rr = __builtin_amdgcn_permlane32_swap(__float_as_uint(rm), __float_as_uint(rm), false, false); rm = __builtin_fmaxf(__uint_as_float(rr[0]), __uint_as_float(rr[1])); } } while (0)
    bool resc = false;
#define RESC() do { if (resc) { asm volatile("s_waitcnt lgkmcnt(0)" ::: "memory"); \
        _Pragma("unroll") for (int d_ = 0; d_ < 4; ++d_) _Pragma("unroll") for (int r = 0; r < 16; ++r) o[d_][r] *= wsf[crow(r, hi)]; } } while (0)
    f32x16 pA0, pA1, pB0, pB1;
    int s_prev = 0, s_cur = 0, s_next = 1;
#define ROT() do { s_prev = s_cur; s_cur = s_next; s_next = (s_next == D_NSLOT - 1) ? 0 : s_next + 1; } while (0)
    DMA_K(2, 2);
    WAIT_BARN(4);
    { const lds_cptr kp = kp0;
      pA0 = f32x16{}; pA1 = f32x16{};
#pragma unroll
      for (int d0 = 0; d0 < 4; ++d0) { const bf16x8 b0 = *(lds_b8)(kp + d0 * 2048), b1 = *(lds_b8)(kp + d0 * 2048 + 512);
          pA0 = __builtin_amdgcn_mfma_f32_32x32x16_bf16(b0, qr[d0], pA0, 0, 0, 0); pA1 = __builtin_amdgcn_mfma_f32_32x32x16_bf16(b1, qr[d0], pA1, 0, 0, 0); } }
    CMASK(pA0, pA1, 0);
    { float rm; ROWMAX(rm, pA0, pA1); mhat = rm;
#pragma unroll
      for (int r = 0; r < 16; ++r) { pA0[r] = __builtin_amdgcn_exp2f(pA0[r] - mhat); pA1[r] = __builtin_amdgcn_exp2f(pA1[r] - mhat); } }
    WAIT_BARN(0);
    DMA_K(3, 0); DMA_V(1, 1);
    ROT();
#pragma unroll
    for (int j = 0; j < 4; ++j) kload2(kf, kp0 + s_cur * DK_SLOT, j);
    WAIT_BARN(3);
    s16x4 vlo[8], vhi[8];
#define PKW(P, B) cvtpk(P[B], P[B + 1])
#define PKF(P, B) __uint_as_float(PKW(P, B))
#define PSEL(P0, P1, k) __builtin_bit_cast(bf16x8, __builtin_shufflevector(((k) < 2 ? P0 : P1), ((k) < 2 ? P0 : P1), ((k) & 1) * 4, ((k) & 1) * 4 + 1, ((k) & 1) * 4 + 2, ((k) & 1) * 4 + 3))
#define VFR(i) (bf16x8){vlo[i][0], vlo[i][1], vlo[i][2], vlo[i][3], vhi[i][0], vhi[i][1], vhi[i][2], vhi[i][3]}
#define PIN(x) asm volatile("" : "+v"(x))
#define GAPA(MF, A0, A1, A2, A3, W0, W1, PW) do { MF; sacc += A0; sacc += A1; sacc += A2; sacc += A3; PIN(sacc); W0; W1; PIN(PW); SBAR(); } while (0)
#define EXS(v) __builtin_amdgcn_exp2f((v) - mhat)
#define GAPB(MF, X, B) do { MF; X[B] = EXS(X[B]); X[B + 1] = EXS(X[B + 1]); PIN(X); SBAR(); } while (0)
#define VRD(i, blk) do { vlo[i] = vtr(vp_ + ((((i) >> 2) + (blk)) * 4096 + ((i) & 3) * 1024)); vhi[i] = vtr(vp_ + ((((i) >> 2) + (blk)) * 4096 + ((i) & 3) * 1024 + 512)); } while (0)
#define KRD(G, j) do { if (G) { kload2(kf, kp0 + s_next * DK_SLOT, j); SBAR(); } } while (0)
#define MFQ(C, i, first) C = __builtin_amdgcn_mfma_f32_32x32x16_bf16(kf[i], qr[(i) >> 1], first ? f32x16{} : C, 0, 0, 0)
#define MFP(P0, P1, f, blk) o[((f) >> 2) + (blk)] = __builtin_amdgcn_mfma_f32_32x32x16_bf16(PSEL(P0, P1, (f) & 3), VFR(f), o[((f) >> 2) + (blk)], 0, 0, 0)
#define STEP(C0, C1, P0, P1, t, GK, GV, GL) do { SBAR(); \
    const lds_cptr vp_ = vp0 + s_prev * DV_SLOT; \
    VRD(0, 0); SBAR(); float sacc = (P0[0] + P0[1]); \
    GAPA(MFQ(C0, 0, true),  P0[2], P0[3], P0[4], P0[5],     P0[0] = PKF(P0, 0),  P0[1] = PKF(P0, 2),  P0); \
    VRD(4, 0); SBAR(); GAPA(MFQ(C1, 1, true),  P0[6], P0[7], P0[8], P0[9],     P0[2] = PKF(P0, 4),  P0[3] = PKF(P0, 6),  P0); \
    VRD(1, 0); SBAR(); GAPA(MFQ(C0, 2, false), P0[10], P0[11], P0[12], P0[13], P0[4] = PKF(P0, 8),  P0[5] = PKF(P0, 10), P0); \
    VRD(5, 0); SBAR(); GAPA(MFQ(C1, 3, false), P0[14], P0[15], P1[0], P1[1],   P0[6] = PKF(P0, 12), P0[7] = PKF(P0, 14), P0); \
    VRD(2, 0); SBAR(); GAPA(MFQ(C0, 4, false), P1[2], P1[3], P1[4], P1[5],     P1[0] = PKF(P1, 0),  P1[1] = PKF(P1, 2),  P1); \
    VRD(6, 0); SBAR(); GAPA(MFQ(C1, 5, false), P1[6], P1[7], P1[8], P1[9],     P1[2] = PKF(P1, 4),  P1[3] = PKF(P1, 6),  P1); \
    VRD(3, 0); SBAR(); GAPA(MFQ(C0, 6, false), P1[10], P1[11], P1[12], P1[13], P1[4] = PKF(P1, 8),  P1[5] = PKF(P1, 10), P1); \
    VRD(7, 0); SBAR(); GAPA(MFQ(C1, 7, false), P1[14], P1[15], 0.f, 0.f,       P1[6] = PKF(P1, 12), P1[7] = PKF(P1, 14), P1); \
    l_reg += sacc; \
    if (GK) { DMA_K((t) + 3, s_cur); } if (GV) { DMA_V((t) + 1, s_next); } \
    CMASK(C0, C1, t); \
    { float rm; ROWMAX(rm, C0, C1); resc = false; \
      if (__builtin_expect(__any(rm - mhat > (float)THRL), 0)) { const float dl = __builtin_fmaxf(rm - mhat, 0.f); mhat += dl; \
          const float f = __builtin_amdgcn_exp2f(-dl); l_reg *= f; if (hi == 0) wsf[r32] = f; resc = true; } } \
    SBAR(); \
    GAPB(MFP(P0, P1, 0, 0), C0, 0);  VRD(0, 2); SBAR(); \
    GAPB(MFP(P0, P1, 4, 0), C0, 2);  VRD(4, 2); SBAR(); \
    GAPB(MFP(P0, P1, 1, 0), C0, 4);  VRD(1, 2); SBAR(); \
    GAPB(MFP(P0, P1, 5, 0), C0, 6);  VRD(5, 2); SBAR(); \
    GAPB(MFP(P0, P1, 2, 0), C0, 8);  VRD(2, 2); SBAR(); \
    GAPB(MFP(P0, P1, 6, 0), C0, 10); VRD(6, 2); SBAR(); \
    GAPB(MFP(P0, P1, 3, 0), C0, 12); VRD(3, 2); SBAR(); \
    GAPB(MFP(P0, P1, 7, 0), C0, 14); VRD(7, 2); SBAR(); \
    GAPB(MFP(P0, P1, 0, 2), C1, 0);  KRD(GL, 0); \
    GAPB(MFP(P0, P1, 4, 2), C1, 2);  KRD(GL, 1); \
    GAPB(MFP(P0, P1, 1, 2), C1, 4);  KRD(GL, 2); \
    GAPB(MFP(P0, P1, 5, 2), C1, 6);  KRD(GL, 3); \
    GAPB(MFP(P0, P1, 2, 2), C1, 8); \
    GAPB(MFP(P0, P1, 6, 2), C1, 10); \
    GAPB(MFP(P0, P1, 3, 2), C1, 12); \
    GAPB(MFP(P0, P1, 7, 2), C1, 14); \
    } while (0)
    int t = 1;
#undef CMASK
#define CMASK(P0, P1, t) do { } while (0)
    for (; t + 5 < NT; t += 2) {
        STEP(pB0, pB1, pA0, pA1, t, true, true, true);     WAIT_BARN(3); RESC(); ROT();
        STEP(pA0, pA1, pB0, pB1, t + 1, true, true, true); WAIT_BARN(3); RESC(); ROT();
    }
#undef CMASK
#define CMASK(P0, P1, t) do { const int jb_ = (t) - (NT - 4); if (jb_ >= 0) { const float NEG_ = -__builtin_inff(); const int kb_ = 64 * jb_ + 4 * hi; \
        _Pragma("unroll") for (int r = 0; r < 16; ++r) { const int kv_ = kb_ + (r & 3) + 8 * (r >> 2); if (kv_ > qrel) P0[r] = NEG_; if (kv_ + 32 > qrel) P1[r] = NEG_; } } } while (0)
#define ENDW(tt) do { if ((tt) + 3 < NT) { WAIT_BARN(3); } else if ((tt) + 2 < NT) { WAIT_BARN(2); } else { WAIT_BARN(0); } } while (0)
    for (; t + 1 < NT; t += 2) {
        STEP(pB0, pB1, pA0, pA1, t, (t + 3 < NT), (t + 1 < NT), (t + 1 < NT));         ENDW(t);     RESC(); ROT();
        STEP(pA0, pA1, pB0, pB1, t + 1, (t + 4 < NT), (t + 2 < NT), (t + 2 < NT));     ENDW(t + 1); RESC(); ROT();
    }
    STEP(pB0, pB1, pA0, pA1, NT - 1, false, false, false); RESC();
    { float sacc = pB0[0] + pB0[1];
#pragma unroll
      for (int r = 2; r < 16; ++r) sacc += pB0[r];
#pragma unroll
      for (int r = 0; r < 16; ++r) sacc += pB1[r];
      l_reg += sacc;
      const u32x4 pw0 = (u32x4){PKW(pB0, 0), PKW(pB0, 2), PKW(pB0, 4), PKW(pB0, 6)}, pw1 = (u32x4){PKW(pB0, 8), PKW(pB0, 10), PKW(pB0, 12), PKW(pB0, 14)};
      const u32x4 pw2 = (u32x4){PKW(pB1, 0), PKW(pB1, 2), PKW(pB1, 4), PKW(pB1, 6)}, pw3 = (u32x4){PKW(pB1, 8), PKW(pB1, 10), PKW(pB1, 12), PKW(pB1, 14)};
      SBAR(); const lds_cptr vp_ = vp0 + s_cur * DV_SLOT;
#define PAF(k) __builtin_bit_cast(bf16x8, pw##k)
#pragma unroll
      for (int blk = 0; blk < 4; blk += 2) {
#pragma unroll
          for (int i = 0; i < 8; ++i) { vlo[i] = vtr(vp_ + (((i >> 2) + blk) * 4096 + (i & 3) * 1024)); vhi[i] = vtr(vp_ + (((i >> 2) + blk) * 4096 + (i & 3) * 1024 + 512)); }
#pragma unroll
          for (int d = 0; d < 2; ++d) { o[d + blk] = __builtin_amdgcn_mfma_f32_32x32x16_bf16(PAF(0), VFR(d * 4 + 0), o[d + blk], 0, 0, 0); o[d + blk] = __builtin_amdgcn_mfma_f32_32x32x16_bf16(PAF(1), VFR(d * 4 + 1), o[d + blk], 0, 0, 0);
              o[d + blk] = __builtin_amdgcn_mfma_f32_32x32x16_bf16(PAF(2), VFR(d * 4 + 2), o[d + blk], 0, 0, 0); o[d + blk] = __builtin_amdgcn_mfma_f32_32x32x16_bf16(PAF(3), VFR(d * 4 + 3), o[d + blk], 0, 0, 0); } } }
    { auto rr = __builtin_amdgcn_permlane32_swap(__float_as_uint(l_reg), __float_as_uint(l_reg), false, false); l_reg = __uint_as_float(rr[0]) + __uint_as_float(rr[1]); }
    if (hi == 0) wsf[32 + r32] = l_reg;
    asm volatile("s_waitcnt lgkmcnt(0)" ::: "memory");
    float rl[16];
#pragma unroll
    for (int r = 0; r < 16; ++r) rl[r] = __builtin_amdgcn_rcpf(wsf[32 + crow(r, hi)]);
    WAIT_BARN(0);
    float* st = (float*)(lds + wid * STG_WAVE) + hi * (4 * STG_ROW) + r32;
#pragma unroll
    for (int r = 0; r < 16; ++r)
#pragma unroll
        for (int d0 = 0; d0 < 4; ++d0) st[((r & 3) + 8 * (r >> 2)) * STG_ROW + d0 * 32] = o[d0][r] * rl[r];
    asm volatile("s_waitcnt lgkmcnt(0)" ::: "memory");
#undef DMA_K
#undef DMA_V
#undef WAIT_BARN
#undef SBAR
#undef CMASK
#undef MX3
#undef ROWMAX
#undef RESC
#undef ROT
#undef PKW
#undef PAF
#undef PKF
#undef PSEL
#undef VFR
#undef PIN
#undef GAPA
#undef EXS
#undef GAPB
#undef VRD
#undef KRD
#undef MFQ
#undef MFP
#undef STEP
#undef ENDW
}
__device__ __forceinline__ f32x4 staged4(const char* lds, int wid, int lane, int j) {
    const int row = lane & 31, half = lane >> 5; const float* st = (const float*)(lds + wid * STG_WAVE);
    return *(const f32x4*)(st + row * STG_ROW + half * 64 + 4 * j);
}
#undef SBAR
}

constexpr size_t MiB = 1u << 20;
constexpr size_t WS_CTL = 0, CTL_ZERO_BYTES = 1 * MiB;
constexpr size_t WS_COS = 1 * MiB, WS_SIN = 2 * MiB;
constexpr size_t WS_SSQC = 3 * MiB;
constexpr size_t WS_SSQ1 = 4 * MiB, WS_SSQ2 = 6 * MiB;
constexpr size_t WS_RSTD1 = 8 * MiB;
constexpr size_t WS_WIN = 16 * MiB;
constexpr size_t WS_WUQ = 142 * MiB;
constexpr size_t WS_WUKV = 148 * MiB;
constexpr size_t WS_WO = 152 * MiB;
constexpr size_t WS_WOUT = 184 * MiB;
constexpr size_t WS_WUP = 216 * MiB;
constexpr size_t WS_WDOWN = 388 * MiB;
constexpr size_t WS_H = 474 * MiB;
constexpr size_t WS_O = 538 * MiB;
constexpr size_t WS_Z = 602 * MiB;
constexpr size_t WS_QM = 854 * MiB;
constexpr size_t WS_KV = 902 * MiB;
constexpr size_t WS_HALO = 602 * MiB;
constexpr size_t WS_U = 602 * MiB;
constexpr size_t WS_T1 = 966 * MiB;
constexpr size_t WS_O1 = 1094 * MiB;
constexpr size_t WS_ACT = 966 * MiB;
constexpr size_t WS_X1 = 1158 * MiB;
constexpr size_t WS_END = 1286 * MiB;
static_assert(WS_WIN + (size_t)ZW * DM * 2 <= WS_WUQ && WS_WUP + (size_t)UPW * DM * 2 <= WS_WDOWN && WS_WDOWN + (size_t)DM * DFF * 2 <= WS_H, "ws map (weights)");
static_assert(WS_Z + (size_t)S * ZW * 2 <= WS_QM && WS_U + (size_t)S * UPW * 2 <= WS_T1 && WS_ACT + (size_t)S * DFF * 2 <= WS_X1 && WS_X1 + (size_t)S * DM * 4 <= WS_END, "ws map (activations)");
constexpr int CW_TMO = 0, CW_BAR = 4096;

constexpr int NWAVES = 8;
constexpr int RING_OFF = 0, RING_BYTES = 131072;
constexpr int XCH_OFF = 131072;
constexpr int LDSCTL_OFF = 155648, MISC_OFF = LDSCTL_OFF + 320;
constexpr int LDS_BYTES = 163840;
static_assert(att::Pitch<true>::qn == QMW && att::Pitch<true>::kn == KVW && att::Pitch<false>::v == ZW && att::Pitch<true>::kr == ZW, "attention pitches");
static_assert(att::Lay<true, 2>::END <= LDSCTL_OFF && att::D_LDS_END <= LDSCTL_OFF && att::DPITCH == ZW && RING_BYTES <= LDSCTL_OFF, "LDS map");

__device__ __forceinline__ unsigned f2bf(float f) { unsigned u = __builtin_bit_cast(unsigned, f); return (u + 0x7fffu + ((u >> 16) & 1u)) >> 16; }
__device__ __forceinline__ unsigned pk2(float lo, float hi) { return pg8::cvt_pk_bf16(lo, hi); }

#define XB_TMO      128
#define XB_XCNT(j)  (256  + 64 * (j))
#define XB_XSUB(j)  (1280 + 64 * (j))
#define XB_XGEN(j)  (2304 + 64 * (j))
#define XB_TOP      3328
#define XB_TOPGEN   3392
#define XCD_BAR_WORDS 3456
#define XB_SPIN_CAP (1u << 18)
__device__ __forceinline__ unsigned xb_ld(unsigned* p)              { return __hip_atomic_load(p, __ATOMIC_RELAXED, __HIP_MEMORY_SCOPE_AGENT); }
__device__ __forceinline__ unsigned xb_add(unsigned* p, unsigned v) { return __hip_atomic_fetch_add(p, v, __ATOMIC_RELAXED, __HIP_MEMORY_SCOPE_AGENT); }
__device__ __forceinline__ unsigned xb_xcc_id() { return (unsigned)__builtin_amdgcn_s_getreg((3 << 11) | 20) & 0xFu; }
#define XB_SPIN(cond, bar) do { unsigned _sp = 0; while (cond) { __builtin_amdgcn_s_sleep(1); \
    if ((++_sp & 255u) == 0u) { if (xb_ld(&(bar)[XB_TMO])) break; if (_sp > XB_SPIN_CAP) { atomicAdd(&(bar)[XB_TMO], 1u); break; } } } } while (0)
struct XcdBarrier { unsigned* bar; unsigned x; volatile LAS unsigned* st; };
__device__ __forceinline__ XcdBarrier xcd_barrier_post(unsigned* bar, volatile LAS unsigned* st) {
    XcdBarrier b; b.bar = bar; b.x = xb_xcc_id(); b.st = st;
    if (threadIdx.x == 0) (void)xb_add(&bar[XB_XCNT(b.x)], 1u);
    return b;
}
__device__ __forceinline__ void xcd_barrier_complete(unsigned* bar, unsigned x, unsigned& nloc, unsigned& nx) {
    const unsigned G = gridDim.x * gridDim.y * gridDim.z;
    unsigned sum, cnt, mine, sp = 0u;
    for (;;) {
        sum = 0u; cnt = 0u; mine = 0u;
#pragma unroll
        for (unsigned j = 0; j < 16; ++j) { const unsigned c = xb_ld(&bar[XB_XCNT(j)]); sum += c; cnt += (c > 0u) ? 1u : 0u; mine = (j == x) ? c : mine; }
        if (sum == G) break;
        __builtin_amdgcn_s_sleep(1);
        if ((++sp & 255u) == 0u) { if (xb_ld(&bar[XB_TMO])) break; if (sp > XB_SPIN_CAP) { atomicAdd(&bar[XB_TMO], 1u); break; } }
    }
    nloc = mine > 0u ? mine : 1u; nx = cnt > 0u ? cnt : 1u;
}
__device__ __forceinline__ void xcd_barrier(const XcdBarrier& b) {
    asm volatile("s_waitcnt vmcnt(0)" ::: "memory");
    __syncthreads();
    if (threadIdx.x == 0) {
        unsigned* bar = b.bar;
        __builtin_amdgcn_s_waitcnt(0);
        unsigned nloc = b.st[0], nx = b.st[1];
        if (nloc == 0u) { xcd_barrier_complete(bar, b.x, nloc, nx); b.st[0] = nloc; b.st[1] = nx; }
        const unsigned old = xb_add(&bar[XB_XSUB(b.x)], 1u);
        const unsigned gen = old / nloc;
        if (old + 1u == (gen + 1u) * nloc) {
            __builtin_amdgcn_fence(__ATOMIC_RELEASE, "agent");
            asm volatile("s_waitcnt vmcnt(0)" ::: "memory");
            const unsigned og = xb_add(&bar[XB_TOP], 1u);
            const unsigned tg = og / nx;
            if (og + 1u == (tg + 1u) * nx) xb_add(&bar[XB_TOPGEN], 1u);
            else XB_SPIN(xb_ld(&bar[XB_TOPGEN]) == tg, bar);
            __builtin_amdgcn_fence(__ATOMIC_ACQUIRE, "agent");
            xb_add(&bar[XB_XGEN(b.x)], 1u);
            asm volatile("s_waitcnt vmcnt(0)" ::: "memory");
        } else {
            XB_SPIN(xb_ld(&bar[XB_XGEN(b.x)]) == gen, bar);
            __builtin_amdgcn_fence(__ATOMIC_ACQUIRE, "agent");
            asm volatile("s_waitcnt vmcnt(0)" ::: "memory");
        }
    }
    __syncthreads();
}

struct Args {
    const float* x; const int* pos; const float* norm_mix_w; const float* w_in; const float* lq1; const float* lk1; const float* lq2; const float* lk2;
    const float* subln_w; const float* q_norm_w; const float* w_uq; const float* kv_norm_w; const float* w_ukv; const float* w_o_diff; const float* w_o_mla;
    const float* w_out; const float* norm_ffn_w; const float* w_up; const float* conv_w; const float* conv_b; const float* w_down; const float* final_w;
    float* out; unsigned char* ws; int ph_lo, ph_hi;
};

__device__ __forceinline__ float wave_sum(float v) {
#pragma unroll
    for (int o = 1; o < 64; o <<= 1) v += __shfl_xor(v, o);
    return v;
}

struct MapId { __device__ __forceinline__ int operator()(int n) const { return n; } };
struct MapIn { __device__ __forceinline__ int operator()(int n) const {
    if (n < 4096) { const int d = n & 63; return (n & ~63) + 2 * (d & 31) + (d >> 5); }
    if (n < ZC_KR) return n;
    if (n < ZC_KR + 64) { const int d = n - ZC_KR; return ZC_KR + 2 * (d & 31) + (d >> 5); }
    return n + (ZC_GD - (ZC_KR + 64)); } };
struct MapUq { __device__ __forceinline__ int operator()(int n) const { const int h = n / 192, j = n - h * 192;
    if (j < 128) return h * 128 + j; const int d = j - 128; return 2048 + h * 64 + 2 * (d & 31) + (d >> 5); } };
struct MapUkv { __device__ __forceinline__ int operator()(int n) const { const int h = n >> 8, j = n & 255; return (j < 128) ? h * 128 + j : 2048 + h * 128 + (j - 128); } };
struct MapUp { __device__ __forceinline__ int operator()(int n) const { const int v = n >= DFF, c = v ? n - DFF : n; return (c >> 7) * 256 + v * 128 + (c & 127); } };

template <class Map>
__device__ __forceinline__ void tr_item(const float* W, int N, bf16* WT, int ldt, int koff, const float* kscale, Map map, LAS float* scr, int item, int lane) {
    const int nblk = N / 32, kb = item / nblk, nb = item - kb * nblk, k0 = 64 * kb, n0 = 32 * nb;
#pragma unroll 8
    for (int i = 0; i < 32; ++i) { const int kk = 2 * i + (lane >> 5); scr[kk * 33 + (lane & 31)] = W[(size_t)(k0 + kk) * N + n0 + (lane & 31)]; }
    LDS_WAIT(); asm volatile("" ::: "memory");
    const int c = lane & 7;
    float g[8];
#pragma unroll
    for (int e = 0; e < 8; ++e) g[e] = kscale ? kscale[k0 + 8 * c + e] : 1.0f;
#pragma unroll
    for (int j = 0; j < 4; ++j) { const int n = (lane >> 3) + 8 * j; const LAS float* s = scr + (8 * c) * 33 + n;
        v4u o; o.x = pk2(s[0 * 33] * g[0], s[1 * 33] * g[1]); o.y = pk2(s[2 * 33] * g[2], s[3 * 33] * g[3]); o.z = pk2(s[4 * 33] * g[4], s[5 * 33] * g[5]); o.w = pk2(s[6 * 33] * g[6], s[7 * 33] * g[7]);
        *(GAS v4u*)(WT + (size_t)map(n0 + n) * ldt + koff + k0 + 8 * c) = o; }
    LDS_WAIT(); asm volatile("" ::: "memory");
}

struct TrItem { const float* W; const float* ks; bf16* WT; int N, ldt, koff, mapk, k0, n0; unsigned char* W8; int w8row0; const unsigned* WM; };
__device__ __forceinline__ int tr_map(int mapk, int n) { switch (mapk) { case 1: return MapIn()(n); case 2: return MapUq()(n); case 3: return MapUkv()(n); case 4: return MapUp()(n); default: return n; } }
__device__ __forceinline__ void tr_load(const TrItem& d, float (&v)[32], float (&g)[8], int lane) {
    typedef float f4 __attribute__((ext_vector_type(4)));
    if (d.ks) { const f4 g0 = *(const GAS f4*)(d.ks + d.k0 + 8 * (lane & 7)), g1 = *(const GAS f4*)(d.ks + d.k0 + 8 * (lane & 7) + 4);
        g[0] = g0.x; g[1] = g0.y; g[2] = g0.z; g[3] = g0.w; g[4] = g1.x; g[5] = g1.y; g[6] = g1.z; g[7] = g1.w; }
    else {
#pragma unroll
        for (int e = 0; e < 8; ++e) g[e] = 1.0f; }
#pragma unroll
    for (int i = 0; i < 8; ++i) { const int kk = (lane >> 3) + 8 * i; const f4 t = __builtin_nontemporal_load((const GAS f4*)(d.W + (size_t)(d.k0 + kk) * d.N + d.n0 + 4 * (lane & 7)));
        v[4 * i] = t.x; v[4 * i + 1] = t.y; v[4 * i + 2] = t.z; v[4 * i + 3] = t.w; }
}
__device__ __forceinline__ void tr_store(const TrItem& d, const float (&v)[32], const float (&g)[8], LAS float* scr, int lane) {
#pragma unroll
    for (int i = 0; i < 8; ++i) { const int kk = (lane >> 3) + 8 * i;
#pragma unroll
        for (int j = 0; j < 4; ++j) scr[kk * 33 + 4 * (lane & 7) + j] = v[4 * i + j]; }
    LDS_WAIT(); asm volatile("" ::: "memory");
    const int c = lane & 7;
#pragma unroll
    for (int j = 0; j < 4; ++j) { const int n = (lane >> 3) + 8 * j; const LAS float* sp = scr + (8 * c) * 33 + n;
        v4u o; o.x = pk2(sp[0 * 33] * g[0], sp[1 * 33] * g[1]); o.y = pk2(sp[2 * 33] * g[2], sp[3 * 33] * g[3]); o.z = pk2(sp[4 * 33] * g[4], sp[5 * 33] * g[5]); o.w = pk2(sp[6 * 33] * g[6], sp[7 * 33] * g[7]);
        const int row = tr_map(d.mapk, d.n0 + n);
        if (d.W8 && row >= d.w8row0) { pg8::f32x4 f0 = {sp[0 * 33] * g[0], sp[1 * 33] * g[1], sp[2 * 33] * g[2], sp[3 * 33] * g[3]}, f1 = {sp[4 * 33] * g[4], sp[5 * 33] * g[5], sp[6 * 33] * g[6], sp[7 * 33] * g[7]};
            const float qs = 127.0f / fmaxf(__uint_as_float(d.WM[row - d.w8row0]), 1e-30f); v2u o8; o8.x = pg8::pk4_i8(f0 * qs); o8.y = pg8::pk4_i8(f1 * qs); *(GAS v2u*)(d.W8 + (size_t)(row - d.w8row0) * DM + d.k0 + 8 * c) = o8; }
        else *(GAS v4u*)(d.WT + (size_t)row * d.ldt + d.koff + d.k0 + 8 * c) = o; }
    LDS_WAIT(); asm volatile("" ::: "memory");
}

__constant__ float ROPE_INVF[32] = {
    1.000000000e+00f, 7.498942614e-01f, 5.623413324e-01f, 4.216965139e-01f, 3.162277639e-01f, 2.371373773e-01f, 1.778279394e-01f, 1.333521307e-01f,
    1.000000015e-01f, 7.498941571e-02f, 5.623413250e-02f, 4.216965288e-02f, 3.162277490e-02f, 2.371373773e-02f, 1.778279431e-02f, 1.333521493e-02f,
    9.999999776e-03f, 7.498941850e-03f, 5.623413250e-03f, 4.216964822e-03f, 3.162277630e-03f, 2.371373586e-03f, 1.778279431e-03f, 1.333521446e-03f,
    1.000000047e-03f, 7.498942432e-04f, 5.623413017e-04f, 4.216965172e-04f, 3.162277571e-04f, 2.371373703e-04f, 1.778279402e-04f, 1.333521504e-04f };

typedef float f32x4 __attribute__((ext_vector_type(4)));
typedef float f32x16 __attribute__((ext_vector_type(16)));

__global__ void __launch_bounds__(NWAVES * 64, 2) fwd_kernel(Args a) {
    extern __shared__ __attribute__((aligned(16))) unsigned char lds[];
    LAS unsigned char* ldsl = (LAS unsigned char*)lds;
    volatile LAS unsigned* MISC = (volatile LAS unsigned*)(ldsl + MISC_OFF);
    const int tid = threadIdx.x, lane = tid & 63, wave = __builtin_amdgcn_readfirstlane(tid >> 6);
    const int G = gridDim.x; const int bx = blockIdx.x; const int vcu = (G % 8 == 0) ? (bx % 8) * (G / 8) + bx / 8 : bx;
    unsigned char* ws = a.ws;
    gu32* ctl = (gu32*)(ws + WS_CTL);
    for (int u = tid; u < (LDS_BYTES - LDSCTL_OFF) / 4; u += NWAVES * 64) ((LAS unsigned*)(ldsl + LDSCTL_OFF))[u] = 0u;
    __syncthreads();
    XcdBarrier bar; bar.bar = (unsigned*)(ctl + CW_BAR); bar.x = 0; bar.st = nullptr;
    if (!MK_PER_PHASE) bar = xcd_barrier_post((unsigned*)(ctl + CW_BAR), MISC + 8);
    const int lo = a.ph_lo, hi = a.ph_hi;
#ifndef PH_MASK
#define PH_MASK 0x3ff
#endif
#ifndef DUP_MASK
#define DUP_MASK 0
#endif
#define IN(k) (((PH_MASK >> (k)) & 1) && lo <= (k) && (k) < hi)
#define SEAM(k) do { if (IN(k) && IN((k) + 1)) xcd_barrier(bar); } while (0)
#ifdef TP_I0
    unsigned long long* const tsw = (unsigned long long*)(ws + 768 * 1024);
#define STAMP(k) do { if (bx == 0 && tid == 0) __hip_atomic_store(tsw + (k), (unsigned long long)__builtin_amdgcn_s_memrealtime(), RLX_AGENT); } while (0)
#else
#define STAMP(k) do { } while (0)
#endif
    const int gw = vcu * NWAVES + wave, NGW = G * NWAVES;
    bf16* const WIN = (bf16*)(ws + WS_WIN); bf16* const WUQ = (bf16*)(ws + WS_WUQ); bf16* const WUKV = (bf16*)(ws + WS_WUKV); bf16* const WO = (bf16*)(ws + WS_WO);
    bf16* const WOUT = (bf16*)(ws + WS_WOUT); bf16* const WUP = (bf16*)(ws + WS_WUP); bf16* const WDOWN = (bf16*)(ws + WS_WDOWN);
    bf16* const HB = (bf16*)(ws + WS_H); bf16* const YB = HB; bf16* const OB = (bf16*)(ws + WS_O); bf16* const XB = OB;
    bf16* const ZB = (bf16*)(ws + WS_Z); bf16* const QM = (bf16*)(ws + WS_QM); bf16* const KV = (bf16*)(ws + WS_KV);
    unsigned* const WMU = (unsigned*)(ws + WS_CTL + 256 * 1024); unsigned* const WMG = (unsigned*)(ws + WS_CTL + 384 * 1024);
    unsigned char* const WUP8 = ws + WS_WUP; unsigned char* const XN8 = ws + WS_X1 + 80 * MiB; float* const XSC = (float*)(ws + WS_X1 + 113 * MiB);
    float* const HSC = (float*)(ws + WS_X1 + 112 * MiB);
    unsigned char* const H8 = ws + WS_X1; unsigned char* const WIN8 = ws + WS_X1 + 32 * MiB;
    unsigned char* const VT8 = ws + WS_KV;
    unsigned char* const QF8 = ws + WS_QM; unsigned char* const KF8N = ws + WS_QM + 24 * MiB; unsigned char* const KF8R = ws + WS_QM + 40 * MiB;
    float* const HALO = (float*)(ws + WS_HALO); float* const O1 = (float*)(ws + WS_O1); bf16* const ACT = (bf16*)(ws + WS_ACT); float* const X1 = (float*)(ws + WS_X1);
    float* const COS = (float*)(ws + WS_COS); float* const SIN = (float*)(ws + WS_SIN); float* const SSQC = (float*)(ws + WS_SSQC);
    float* const SSQ1 = (float*)(ws + WS_SSQ1); float* const SSQ2 = (float*)(ws + WS_SSQ2); float* const RSTD1 = (float*)(ws + WS_RSTD1);

    STAMP(0);
    if (((DUP_MASK >> 0) & 1) && IN(0)) {
        LAS float* scr = (LAS float*)(ldsl + RING_OFF + wave * 16384);
        constexpr int I_IN = (DM / 64) * (INW / 32), I_UQ = (QRANK / 64) * (QMW / 32), I_UKV = (KVRANK / 64) * (KVW / 32), I_OD = (2048 / 64) * (DM / 32), I_OUT = (DM / 64) * (DM / 32),
                      I_UP = (DM / 64) * (UPW / 32), I_DN = (DFF / 64) * (DM / 32);
        constexpr int NITEMS = I_IN + I_UQ + I_UKV + 2 * I_OD + I_OUT + I_UP + I_DN;
        auto decode = [&](int it) -> TrItem { TrItem d; int r = it; int KB_;
            d.W8 = nullptr; d.w8row0 = 0; d.WM = nullptr;
            if (r < I_IN) { d.W = a.w_in; d.W8 = WIN8; d.w8row0 = ZC_I8; d.WM = WMG; d.ks = nullptr; d.WT = WIN; d.N = INW; d.ldt = DM; d.koff = 0; d.mapk = 1; KB_ = DM / 64; }
            else if ((r -= I_IN) < I_UQ) { d.W = a.w_uq; d.ks = a.q_norm_w; d.WT = WUQ; d.N = QMW; d.ldt = QRANK; d.koff = 0; d.mapk = 2; KB_ = QRANK / 64; }
            else if ((r -= I_UQ) < I_UKV) { d.W = a.w_ukv; d.ks = a.kv_norm_w; d.WT = WUKV; d.N = KVW; d.ldt = KVRANK; d.koff = 0; d.mapk = 3; KB_ = KVRANK / 64; }
            else if ((r -= I_UKV) < I_OD) { d.W = a.w_o_diff; d.ks = nullptr; d.WT = WO; d.N = DM; d.ldt = 4096; d.koff = 0; d.mapk = 0; KB_ = 2048 / 64; }
            else if ((r -= I_OD) < I_OD) { d.W = a.w_o_mla; d.ks = nullptr; d.WT = WO; d.N = DM; d.ldt = 4096; d.koff = 2048; d.mapk = 0; KB_ = 2048 / 64; }
            else if ((r -= I_OD) < I_OUT) { d.W = a.w_out; d.ks = nullptr; d.WT = WOUT; d.N = DM; d.ldt = DM; d.koff = 0; d.mapk = 0; KB_ = DM / 64; }
            else if ((r -= I_OUT) < I_UP) { d.W = a.w_up; d.ks = a.norm_ffn_w; d.WT = WUP; d.N = UPW; d.ldt = DM; d.koff = 0; d.mapk = 4; KB_ = DM / 64; d.W8 = WUP8; d.WM = WMU; }
            else { r -= I_UP; d.W = a.w_down; d.ks = nullptr; d.WT = WDOWN; d.N = DM; d.ldt = DFF; d.koff = 0; d.mapk = 0; KB_ = DFF / 64; }
            const int nblk = d.N / 32, kblk = KB_; const int grp = r / (kblk * 32), rem = r - grp * (kblk * 32); const int kb = rem % kblk, nb = grp * 32 + rem / kblk; (void)nblk;
            d.k0 = 64 * kb; d.n0 = 32 * nb; return d; };
        if (gw < NITEMS) {
            int it = gw; const int cs = NGW, it1 = NITEMS; TrItem d0, d1, d2, d3; float v0[32], v1[32], v2[32], v3[32], g0[8], g1[8], g2[8], g3[8];
            d0 = decode(it); tr_load(d0, v0, g0, lane); d1 = d0; d2 = d0; d3 = d0;
            if (it + cs < it1) { d1 = decode(it + cs); tr_load(d1, v1, g1, lane); }
            if (it + 2 * cs < it1) { d2 = decode(it + 2 * cs); tr_load(d2, v2, g2, lane); }
            for (;;) {
                if (it + 3 * cs < it1) { d3 = decode(it + 3 * cs); tr_load(d3, v3, g3, lane); }
                tr_store(d0, v0, g0, scr, lane); it += cs; if (it >= it1) break;
                if (it + 3 * cs < it1) { d0 = decode(it + 3 * cs); tr_load(d0, v0, g0, lane); }
                tr_store(d1, v1, g1, scr, lane); it += cs; if (it >= it1) break;
                if (it + 3 * cs < it1) { d1 = decode(it + 3 * cs); tr_load(d1, v1, g1, lane); }
                tr_store(d2, v2, g2, scr, lane); it += cs; if (it >= it1) break;
                if (it + 3 * cs < it1) { d2 = decode(it + 3 * cs); tr_load(d2, v2, g2, lane); }
                tr_store(d3, v3, g3, scr, lane); it += cs; if (it >= it1) break;
            }
        }
        { const int gt = vcu * (NWAVES * 64) + tid, NGT = G * NWAVES * 64; GAS v4u* pz = (GAS v4u*)(WIN8 + (size_t)(ZC_KR + 64 - ZC_I8) * DM); const int nz = (ZC_GD - ZC_KR - 64) * DM / 16;
            for (int i = gt; i < nz; i += NGT) pz[i] = (v4u){0u, 0u, 0u, 0u};
            for (int i = gt; i < S * 32; i += NGT) { const int t = i >> 5, f = i & 31; const float ang = (float)a.pos[t] * ROPE_INVF[f];
                const double rev = (double)ang * 0.15915494309189535; const float fr = (float)(rev - __builtin_rint(rev));
                COS[i] = __builtin_amdgcn_cosf(fr); SIN[i] = __builtin_amdgcn_sinf(fr); } }
        if (gw < S) {
            f32x4 wn[16], va[16], vb[16];
            { const GAS f32x4* wv = (const GAS f32x4*)a.norm_mix_w + lane;
#pragma unroll
              for (int j = 0; j < 16; ++j) wn[j] = wv[64 * j]; }
#define H_LOAD(v, m_) do { const GAS f32x4* xr_ = (const GAS f32x4*)(a.x + (size_t)(m_) * DM) + lane; _Pragma("unroll") for (int j = 0; j < 16; ++j) v[j] = xr_[64 * j]; } while (0)
#define H_ROW(v, m_) do { float ss_ = 0.f; _Pragma("unroll") for (int j = 0; j < 16; ++j) ss_ += (v[j].x * v[j].x + v[j].y * v[j].y) + (v[j].z * v[j].z + v[j].w * v[j].w); \
            const float rs_ = 1.0f / sqrtf(wave_sum(ss_) * (1.0f / DM) + NORM_EPS); GAS unsigned long long* o8_ = (GAS unsigned long long*)(HB + (size_t)(m_) * DM) + lane; \
            GAS unsigned* h8_ = (GAS unsigned*)(H8 + (size_t)(m_) * DM) + lane; \
            float mx_ = 0.f; _Pragma("unroll") for (int j = 0; j < 16; ++j) { v[j] = v[j] * rs_ * wn[j]; mx_ = fmaxf(fmaxf(mx_, fmaxf(fabsf(v[j].x), fabsf(v[j].y))), fmaxf(fabsf(v[j].z), fabsf(v[j].w))); } \
            _Pragma("unroll") for (int o_ = 32; o_ >= 1; o_ >>= 1) mx_ = fmaxf(mx_, __shfl_xor(mx_, o_)); mx_ = fmaxf(mx_, 1e-20f); const float qs_ = 127.0f / mx_; if (lane == 0) HSC[m_] = mx_ * (1.0f / 127.0f); \
            _Pragma("unroll") for (int j = 0; j < 16; ++j) { const f32x4 hv_ = v[j]; o8_[64 * j] = (unsigned long long)pk2(hv_.x, hv_.y) | ((unsigned long long)pk2(hv_.z, hv_.w) << 32); h8_[64 * j] = pg8::pk4_i8(hv_ * qs_); } } while (0)
            int m = gw; H_LOAD(va, m);
            for (;;) {
                if (m + NGW < S) H_LOAD(vb, m + NGW);
                H_ROW(va, m); m += NGW; if (m >= S) break;
                if (m + NGW < S) H_LOAD(va, m + NGW);
                H_ROW(vb, m); m += NGW; if (m >= S) break;
            }
#undef H_LOAD
#undef H_ROW
        }
    }
    if (((DUP_MASK >> 0) & 1) && IN(0)) xcd_barrier(bar);
    if (IN(0)) {
        {
            constexpr int CB_UP = UPW / 256, CB_G = (INW - ZC_I8 + 255) / 256, NITM = (CB_UP + CB_G) * 64;
            for (int it = gw; it < NITM; it += NGW) { const int kb = it & 63, cb = it >> 6; const bool up = cb < CB_UP; const int c0 = up ? cb * 256 : (cb - CB_UP) * 256 + ZC_I8; const int N_ = up ? UPW : INW;
                const float* W_ = up ? a.w_up : a.w_in;
                const GAS f32x4* p = (const GAS f32x4*)(W_ + (size_t)(kb * 64) * N_ + c0) + lane; f32x4 mx = {0.f, 0.f, 0.f, 0.f};
                const bool inr = c0 + 4 * lane < N_;
#pragma unroll 8
                for (int k = 0; k < 64; ++k) { const f32x4 v = inr ? p[(size_t)k * (N_ / 4)] : (f32x4){0.f, 0.f, 0.f, 0.f}; const float g = up ? a.norm_ffn_w[kb * 64 + k] : 1.0f;
#pragma unroll
                    for (int e = 0; e < 4; ++e) mx[e] = fmaxf(mx[e], fabsf(v[e] * g)); }
#pragma unroll
                for (int e = 0; e < 4; ++e) { const int n = c0 + 4 * lane + e; if (!inr) continue; const int row = up ? MapUp()(n) : MapIn()(n) - ZC_I8;
                    __hip_atomic_fetch_max((up ? WMU : WMG) + row, __float_as_uint(mx[e]), __ATOMIC_RELAXED, __HIP_MEMORY_SCOPE_AGENT); } }
            xcd_barrier(bar);
        }
        LAS float* scr = (LAS float*)(ldsl + RING_OFF + wave * 16384);
        constexpr int I_IN = (DM / 64) * (INW / 32), I_UQ = (QRANK / 64) * (QMW / 32), I_UKV = (KVRANK / 64) * (KVW / 32), I_OD = (2048 / 64) * (DM / 32), I_OUT = (DM / 64) * (DM / 32),
                      I_UP = (DM / 64) * (UPW / 32), I_DN = (DFF / 64) * (DM / 32);
        constexpr int NITEMS = I_IN + I_UQ + I_UKV + 2 * I_OD + I_OUT + I_UP + I_DN;
        auto decode = [&](int it) -> TrItem { TrItem d; int r = it; int KB_;
            d.W8 = nullptr; d.w8row0 = 0; d.WM = nullptr;
            if (r < I_IN) { d.W = a.w_in; d.W8 = WIN8; d.w8row0 = ZC_I8; d.WM = WMG; d.ks = nullptr; d.WT = WIN; d.N = INW; d.ldt = DM; d.koff = 0; d.mapk = 1; KB_ = DM / 64; }
            else if ((r -= I_IN) < I_UQ) { d.W = a.w_uq; d.ks = a.q_norm_w; d.WT = WUQ; d.N = QMW; d.ldt = QRANK; d.koff = 0; d.mapk = 2; KB_ = QRANK / 64; }
            else if ((r -= I_UQ) < I_UKV) { d.W = a.w_ukv; d.ks = a.kv_norm_w; d.WT = WUKV; d.N = KVW; d.ldt = KVRANK; d.koff = 0; d.mapk = 3; KB_ = KVRANK / 64; }
            else if ((r -= I_UKV) < I_OD) { d.W = a.w_o_diff; d.ks = nullptr; d.WT = WO; d.N = DM; d.ldt = 4096; d.koff = 0; d.mapk = 0; KB_ = 2048 / 64; }
            else if ((r -= I_OD) < I_OD) { d.W = a.w_o_mla; d.ks = nullptr; d.WT = WO; d.N = DM; d.ldt = 4096; d.koff = 2048; d.mapk = 0; KB_ = 2048 / 64; }
            else if ((r -= I_OD) < I_OUT) { d.W = a.w_out; d.ks = nullptr; d.WT = WOUT; d.N = DM; d.ldt = DM; d.koff = 0; d.mapk = 0; KB_ = DM / 64; }
            else if ((r -= I_OUT) < I_UP) { d.W = a.w_up; d.ks = a.norm_ffn_w; d.WT = WUP; d.N = UPW; d.ldt = DM; d.koff = 0; d.mapk = 4; KB_ = DM / 64; d.W8 = WUP8; d.WM = WMU; }
            else { r -= I_UP; d.W = a.w_down; d.ks = nullptr; d.WT = WDOWN; d.N = DM; d.ldt = DFF; d.koff = 0; d.mapk = 0; KB_ = DFF / 64; }
            const int nblk = d.N / 32, kblk = KB_; const int grp = r / (kblk * 32), rem = r - grp * (kblk * 32); const int kb = rem % kblk, nb = grp * 32 + rem / kblk; (void)nblk;
            d.k0 = 64 * kb; d.n0 = 32 * nb; return d; };
        if (gw < NITEMS) {
            int it = gw; const int cs = NGW, it1 = NITEMS; TrItem d0, d1, d2, d3; float v0[32], v1[32], v2[32], v3[32], g0[8], g1[8], g2[8], g3[8];
            d0 = decode(it); tr_load(d0, v0, g0, lane); d1 = d0; d2 = d0; d3 = d0;
            if (it + cs < it1) { d1 = decode(it + cs); tr_load(d1, v1, g1, lane); }
            if (it + 2 * cs < it1) { d2 = decode(it + 2 * cs); tr_load(d2, v2, g2, lane); }
            for (;;) {
                if (it + 3 * cs < it1) { d3 = decode(it + 3 * cs); tr_load(d3, v3, g3, lane); }
                tr_store(d0, v0, g0, scr, lane); it += cs; if (it >= it1) break;
                if (it + 3 * cs < it1) { d0 = decode(it + 3 * cs); tr_load(d0, v0, g0, lane); }
                tr_store(d1, v1, g1, scr, lane); it += cs; if (it >= it1) break;
                if (it + 3 * cs < it1) { d1 = decode(it + 3 * cs); tr_load(d1, v1, g1, lane); }
                tr_store(d2, v2, g2, scr, lane); it += cs; if (it >= it1) break;
                if (it + 3 * cs < it1) { d2 = decode(it + 3 * cs); tr_load(d2, v2, g2, lane); }
                tr_store(d3, v3, g3, scr, lane); it += cs; if (it >= it1) break;
            }
        }
        { const int gt = vcu * (NWAVES * 64) + tid, NGT = G * NWAVES * 64; GAS v4u* pz = (GAS v4u*)(WIN8 + (size_t)(ZC_KR + 64 - ZC_I8) * DM); const int nz = (ZC_GD - ZC_KR - 64) * DM / 16;
            for (int i = gt; i < nz; i += NGT) pz[i] = (v4u){0u, 0u, 0u, 0u};
            for (int i = gt; i < S * 32; i += NGT) { const int t = i >> 5, f = i & 31; const float ang = (float)a.pos[t] * ROPE_INVF[f];
                const double rev = (double)ang * 0.15915494309189535; const float fr = (float)(rev - __builtin_rint(rev));
                COS[i] = __builtin_amdgcn_cosf(fr); SIN[i] = __builtin_amdgcn_sinf(fr); } }
        if (gw < S) {
            f32x4 wn[16], va[16], vb[16];
            { const GAS f32x4* wv = (const GAS f32x4*)a.norm_mix_w + lane;
#pragma unroll
              for (int j = 0; j < 16; ++j) wn[j] = wv[64 * j]; }
#define H_LOAD(v, m_) do { const GAS f32x4* xr_ = (const GAS f32x4*)(a.x + (size_t)(m_) * DM) + lane; _Pragma("unroll") for (int j = 0; j < 16; ++j) v[j] = xr_[64 * j]; } while (0)
#define H_ROW(v, m_) do { float ss_ = 0.f; _Pragma("unroll") for (int j = 0; j < 16; ++j) ss_ += (v[j].x * v[j].x + v[j].y * v[j].y) + (v[j].z * v[j].z + v[j].w * v[j].w); \
            const float rs_ = 1.0f / sqrtf(wave_sum(ss_) * (1.0f / DM) + NORM_EPS); GAS unsigned long long* o8_ = (GAS unsigned long long*)(HB + (size_t)(m_) * DM) + lane; \
            GAS unsigned* h8_ = (GAS unsigned*)(H8 + (size_t)(m_) * DM) + lane; \
            float mx_ = 0.f; _Pragma("unroll") for (int j = 0; j < 16; ++j) { v[j] = v[j] * rs_ * wn[j]; mx_ = fmaxf(fmaxf(mx_, fmaxf(fabsf(v[j].x), fabsf(v[j].y))), fmaxf(fabsf(v[j].z), fabsf(v[j].w))); } \
            _Pragma("unroll") for (int o_ = 32; o_ >= 1; o_ >>= 1) mx_ = fmaxf(mx_, __shfl_xor(mx_, o_)); mx_ = fmaxf(mx_, 1e-20f); const float qs_ = 127.0f / mx_; if (lane == 0) HSC[m_] = mx_ * (1.0f / 127.0f); \
            _Pragma("unroll") for (int j = 0; j < 16; ++j) { const f32x4 hv_ = v[j]; o8_[64 * j] = (unsigned long long)pk2(hv_.x, hv_.y) | ((unsigned long long)pk2(hv_.z, hv_.w) << 32); h8_[64 * j] = pg8::pk4_i8(hv_ * qs_); } } while (0)
            int m = gw; H_LOAD(va, m);
            for (;;) {
                if (m + NGW < S) H_LOAD(vb, m + NGW);
                H_ROW(va, m); m += NGW; if (m >= S) break;
                if (m + NGW < S) H_LOAD(va, m + NGW);
                H_ROW(vb, m); m += NGW; if (m >= S) break;
            }
#undef H_LOAD
#undef H_ROW
        }
    }
    SEAM(0);

    STAMP(1);
    if (((DUP_MASK >> 1) & 1) && IN(1)) {
        pg8::EpiIn E{ZB, COS, SIN, SSQC, KF8R};
        { pg8::Gemm g{HB, WIN, S, PN_I8 * 256, DM, DM, DM}; pg8::StaticOrder So; So.init(S, PN_I8 * 256, G, bx);
          pg8::gemm_phase<pg8::EpiIn, pg8::StaticOrder, true>(ldsl + RING_OFF, g, So, E); }
        {
          pg8::Gemm g{(const pg8::bf16_t*)H8, (const pg8::bf16_t*)WIN8 - (size_t)PN_I8 * 256 * (DM / 2), S, (63 - PN_I8) * 256, DM / 2, DM / 2, DM / 2}; pg8::SkipOrder So; So.s.init(S, (63 - PN_I8) * 256, G, bx); So.skip_from = 0; So.skip_n = PN_I8;
          pg8::EpiIn8 E8{ZB, COS, SIN, SSQC, KF8R, HSC, (const float*)WMG};
          pg8::gemm_phase<pg8::EpiIn8, pg8::SkipOrder, true, pg8::NoHook, false, true>(ldsl + RING_OFF, g, So, E8); }
    }
    if (((DUP_MASK >> 1) & 1) && IN(1)) xcd_barrier(bar);
    if (IN(1)) {
        pg8::EpiIn E{ZB, COS, SIN, SSQC, KF8R};
        { pg8::Gemm g{HB, WIN, S, PN_I8 * 256, DM, DM, DM}; pg8::StaticOrder So; So.init(S, PN_I8 * 256, G, bx);
          pg8::gemm_phase<pg8::EpiIn, pg8::StaticOrder, true>(ldsl + RING_OFF, g, So, E); }
        {
          pg8::Gemm g{(const pg8::bf16_t*)H8, (const pg8::bf16_t*)WIN8 - (size_t)PN_I8 * 256 * (DM / 2), S, (63 - PN_I8) * 256, DM / 2, DM / 2, DM / 2}; pg8::SkipOrder So; So.s.init(S, (63 - PN_I8) * 256, G, bx); So.skip_from = 0; So.skip_n = PN_I8;
          pg8::EpiIn8 E8{ZB, COS, SIN, SSQC, KF8R, HSC, (const float*)WMG};
          pg8::gemm_phase<pg8::EpiIn8, pg8::SkipOrder, true, pg8::NoHook, false, true>(ldsl + RING_OFF, g, So, E8); }
    }
    SEAM(1);

    STAMP(2);
    if (((DUP_MASK >> 2) & 1) && IN(2)) {
        { pg8::Gemm g{ZB + ZC_CQ, WUQ, S, QMW, QRANK, ZW, QRANK}; pg8::StaticOrder So; So.init(S, QMW, G, bx);
          pg8::EpiMla<0, 4, QRANK, 1 << 30> E{QM, QMW, SSQC, COS, SIN, 8, QF8, QMW};
          pg8::gemm_phase<pg8::EpiMla<0, 4, QRANK, 1 << 30>, pg8::StaticOrder, true>(ldsl + RING_OFF, g, So, E); }
        { pg8::Gemm g{ZB + ZC_CKV, WUKV, S, 2048, KVRANK, ZW, KVRANK}; pg8::StaticOrder So; So.init(S, 2048, G, bx);
          pg8::EpiMla<16, 2, KVRANK, 1 << 30> E{KV, KVW, SSQC, COS, SIN, 1 << 30, KF8N, 2048};
          pg8::gemm_phase<pg8::EpiMla<16, 2, KVRANK, 1 << 30>, pg8::StaticOrder, true>(ldsl + RING_OFF, g, So, E); }
        { pg8::Gemm g{WUKV + (size_t)2048 * KVRANK, ZB + ZC_CKV, 2048, S, KVRANK, KVRANK, ZW}; pg8::VtOrder Vo{bx, G};
          pg8::EpiVT E{VT8, SSQC, S};
          pg8::gemm_phase<pg8::EpiVT, pg8::VtOrder, true>(ldsl + RING_OFF, g, Vo, E); }
    }
    if (((DUP_MASK >> 2) & 1) && IN(2)) xcd_barrier(bar);
    if (IN(2)) {
        { pg8::Gemm g{ZB + ZC_CQ, WUQ, S, QMW, QRANK, ZW, QRANK}; pg8::StaticOrder So; So.init(S, QMW, G, bx);
          pg8::EpiMla<0, 4, QRANK, 1 << 30> E{QM, QMW, SSQC, COS, SIN, 8, QF8, QMW};
          pg8::gemm_phase<pg8::EpiMla<0, 4, QRANK, 1 << 30>, pg8::StaticOrder, true>(ldsl + RING_OFF, g, So, E); }
        { pg8::Gemm g{ZB + ZC_CKV, WUKV, S, 2048, KVRANK, ZW, KVRANK}; pg8::StaticOrder So; So.init(S, 2048, G, bx);
          pg8::EpiMla<16, 2, KVRANK, 1 << 30> E{KV, KVW, SSQC, COS, SIN, 1 << 30, KF8N, 2048};
          pg8::gemm_phase<pg8::EpiMla<16, 2, KVRANK, 1 << 30>, pg8::StaticOrder, true>(ldsl + RING_OFF, g, So, E); }
        { pg8::Gemm g{WUKV + (size_t)2048 * KVRANK, ZB + ZC_CKV, 2048, S, KVRANK, KVRANK, ZW}; pg8::VtOrder Vo{bx, G};
          pg8::EpiVT E{VT8, SSQC, S};
          pg8::gemm_phase<pg8::EpiVT, pg8::VtOrder, true>(ldsl + RING_OFF, g, Vo, E); }
    }
    SEAM(2);

    STAMP(3);
    if (((DUP_MASK >> 3) & 1) && IN(3)) {
        float lam;
        { const float a1 = wave_sum(a.lq1[lane] * a.lk1[lane]), a2 = wave_sum(a.lq2[lane] * a.lk2[lane]); lam = expf(a1) - expf(a2) + LAMBDA_INIT; }
        const int row_l = lane & 31, half_l = lane >> 5;
        char* const alds = (char*)lds + RING_OFF;
        if (wave >= 4) __builtin_amdgcn_s_setprio(1);
        for (int rep_ = 0; rep_ < 1 + ((DUP_MASK >> 10) & 1); ++rep_)
        for (int item = vcu; item < NHEAD * 16; item += G) {
            const int h = item >> 4, sp = item & 15;
#ifndef NO_DIFF
#pragma unroll 1
            for (int pc = 0; pc < 4; ++pc) {
                const int c = pc >> 1, pass = pc & 1, qb = pass ? sp : 31 - sp; const int trow = qb * 256 + wave * 32 + row_l;
                att::Src sd; sd.Qn = nullptr; sd.Kn = nullptr;
                sd.Qr = ZB + ZC_QD + (2 * h + c) * 64; sd.Kr = ZB + ZC_KD + (2 * h + c) * 64; sd.V = ZB + ZC_VD + h * 128;
                att::diff_block64<8>(sd.Qr, sd.Kr, sd.V, qb, alds);
                bf16* o1p = (bf16*)O1 + (size_t)trow * 2048 + h * 128 + half_l * 64;
                if (c == 0) {
#pragma unroll
                    for (int j = 0; j < 8; ++j) *(pg8::u32x4*)(o1p + 8 * j) = pg8::pack8(att::staged4(alds, wave, lane, 2 * j), att::staged4(alds, wave, lane, 2 * j + 1));
                } else {
                    f32x4 u[16]; float ss = 0.f;
#pragma unroll
                    for (int j = 0; j < 8; ++j) { pg8::f32x4 a0, a1; pg8::unpack8(*(const pg8::u32x4*)(o1p + 8 * j), a0, a1);
                        u[2 * j] = a0 - lam * att::staged4(alds, wave, lane, 2 * j); u[2 * j + 1] = a1 - lam * att::staged4(alds, wave, lane, 2 * j + 1);
#pragma unroll
                        for (int e = 0; e < 2; ++e) ss += (u[2 * j + e][0] * u[2 * j + e][0] + u[2 * j + e][1] * u[2 * j + e][1]) + (u[2 * j + e][2] * u[2 * j + e][2] + u[2 * j + e][3] * u[2 * j + e][3]); }
                    ss += __shfl_xor(ss, 32);
                    const float rs = (1.0f - LAMBDA_INIT) / sqrtf(ss * (1.0f / 128.0f) + SUBLN_EPS);
                    bf16* ob = OB + (size_t)trow * 4096 + h * 128 + half_l * 64; const float* swp = a.subln_w + half_l * 64;
#pragma unroll
                    for (int j = 0; j < 8; ++j) { const f32x4 w0 = *(const f32x4*)(swp + 8 * j), w1 = *(const f32x4*)(swp + 8 * j + 4);
                        *(pg8::u32x4*)(ob + 8 * j) = pg8::pack8(u[2 * j] * rs * w0, u[2 * j + 1] * rs * w1); }
                }
            }
#endif
        }
        for (int rep_ = 0; rep_ < 1 + ((DUP_MASK >> 11) & 1); ++rep_)
        for (int item = vcu; item < NHEAD * 16; item += G) {
            const int h = item >> 4, sp = item & 15;
#ifndef NO_MLA
#pragma unroll 1
            for (int pass = 0; pass < 2; ++pass) {
                const int qb = pass ? sp : 31 - sp; const int trow = qb * 256 + wave * 32 + row_l;
                att::Src sm; sm.Qn = (const att::bf16_t*)(QF8 + h * 128); sm.Qr = (const att::bf16_t*)(QF8 + 2048 + h * 64); sm.Kn = (const att::bf16_t*)(KF8N + h * 128); sm.Kr = (const att::bf16_t*)KF8R; sm.V = (const att::bf16_t*)(VT8 + (size_t)h * 128 * S);
                att::attn_block<true, 2>(sm, qb, alds);
                bf16* ob = OB + (size_t)trow * 4096 + 2048 + h * 128 + half_l * 64;
#pragma unroll
                for (int j = 0; j < 8; ++j) *(pg8::u32x4*)(ob + 8 * j) = pg8::pack8(att::staged4(alds, wave, lane, 2 * j), att::staged4(alds, wave, lane, 2 * j + 1));
            }
#endif
        }
    }
    if (((DUP_MASK >> 3) & 1) && IN(3)) xcd_barrier(bar);
    if (IN(3)) {
        float lam;
        { const float a1 = wave_sum(a.lq1[lane] * a.lk1[lane]), a2 = wave_sum(a.lq2[lane] * a.lk2[lane]); lam = expf(a1) - expf(a2) + LAMBDA_INIT; }
        const int row_l = lane & 31, half_l = lane >> 5;
        char* const alds = (char*)lds + RING_OFF;
        if (wave >= 4) __builtin_amdgcn_s_setprio(1);
        for (int rep_ = 0; rep_ < 1 + ((DUP_MASK >> 10) & 1); ++rep_)
        for (int item = vcu; item < NHEAD * 16; item += G) {
            const int h = item >> 4, sp = item & 15;
#ifndef NO_DIFF
#pragma unroll 1
            for (int pc = 0; pc < 4; ++pc) {
                const int c = pc >> 1, pass = pc & 1, qb = pass ? sp : 31 - sp; const int trow = qb * 256 + wave * 32 + row_l;
                att::Src sd; sd.Qn = nullptr; sd.Kn = nullptr;
                sd.Qr = ZB + ZC_QD + (2 * h + c) * 64; sd.Kr = ZB + ZC_KD + (2 * h + c) * 64; sd.V = ZB + ZC_VD + h * 128;
                att::diff_block64<8>(sd.Qr, sd.Kr, sd.V, qb, alds);
                bf16* o1p = (bf16*)O1 + (size_t)trow * 2048 + h * 128 + half_l * 64;
                if (c == 0) {
#pragma unroll
                    for (int j = 0; j < 8; ++j) *(pg8::u32x4*)(o1p + 8 * j) = pg8::pack8(att::staged4(alds, wave, lane, 2 * j), att::staged4(alds, wave, lane, 2 * j + 1));
                } else {
                    f32x4 u[16]; float ss = 0.f;
#pragma unroll
                    for (int j = 0; j < 8; ++j) { pg8::f32x4 a0, a1; pg8::unpack8(*(const pg8::u32x4*)(o1p + 8 * j), a0, a1);
                        u[2 * j] = a0 - lam * att::staged4(alds, wave, lane, 2 * j); u[2 * j + 1] = a1 - lam * att::staged4(alds, wave, lane, 2 * j + 1);
#pragma unroll
                        for (int e = 0; e < 2; ++e) ss += (u[2 * j + e][0] * u[2 * j + e][0] + u[2 * j + e][1] * u[2 * j + e][1]) + (u[2 * j + e][2] * u[2 * j + e][2] + u[2 * j + e][3] * u[2 * j + e][3]); }
                    ss += __shfl_xor(ss, 32);
                    const float rs = (1.0f - LAMBDA_INIT) / sqrtf(ss * (1.0f / 128.0f) + SUBLN_EPS);
                    bf16* ob = OB + (size_t)trow * 4096 + h * 128 + half_l * 64; const float* swp = a.subln_w + half_l * 64;
#pragma unroll
                    for (int j = 0; j < 8; ++j) { const f32x4 w0 = *(const f32x4*)(swp + 8 * j), w1 = *(const f32x4*)(swp + 8 * j + 4);
                        *(pg8::u32x4*)(ob + 8 * j) = pg8::pack8(u[2 * j] * rs * w0, u[2 * j + 1] * rs * w1); }
                }
            }
#endif
        }
        for (int rep_ = 0; rep_ < 1 + ((DUP_MASK >> 11) & 1); ++rep_)
        for (int item = vcu; item < NHEAD * 16; item += G) {
            const int h = item >> 4, sp = item & 15;
#ifndef NO_MLA
#pragma unroll 1
            for (int pass = 0; pass < 2; ++pass) {
                const int qb = pass ? sp : 31 - sp; const int trow = qb * 256 + wave * 32 + row_l;
                att::Src sm; sm.Qn = (const att::bf16_t*)(QF8 + h * 128); sm.Qr = (const att::bf16_t*)(QF8 + 2048 + h * 64); sm.Kn = (const att::bf16_t*)(KF8N + h * 128); sm.Kr = (const att::bf16_t*)KF8R; sm.V = (const att::bf16_t*)(VT8 + (size_t)h * 128 * S);
                att::attn_block<true, 2>(sm, qb, alds);
                bf16* ob = OB + (size_t)trow * 4096 + 2048 + h * 128 + half_l * 64;
#pragma unroll
                for (int j = 0; j < 8; ++j) *(pg8::u32x4*)(ob + 8 * j) = pg8::pack8(att::staged4(alds, wave, lane, 2 * j), att::staged4(alds, wave, lane, 2 * j + 1));
            }
#endif
        }
    }
    __builtin_amdgcn_s_setprio(0);
    SEAM(3);

    STAMP(4);
    if (((DUP_MASK >> 4) & 1) && IN(4)) {
        pg8::Gemm g{OB, WO, S, DM, 4096, 4096, 4096}; pg8::StaticOrder So; So.init(S, DM, G, bx);
        pg8::EpiGate E{ZB + ZC_GM, YB}; pg8::GateHook HK{ZB + ZC_GD, ZB + ZC_GM};
        pg8::gemm_phase<pg8::EpiGate, pg8::StaticOrder, true, pg8::GateHook>(ldsl + RING_OFF, g, So, E, HK);
    }
    if (((DUP_MASK >> 4) & 1) && IN(4)) xcd_barrier(bar);
    if (IN(4)) {
        pg8::Gemm g{OB, WO, S, DM, 4096, 4096, 4096}; pg8::StaticOrder So; So.init(S, DM, G, bx);
        pg8::EpiGate E{ZB + ZC_GM, YB}; pg8::GateHook HK{ZB + ZC_GD, ZB + ZC_GM};
        pg8::gemm_phase<pg8::EpiGate, pg8::StaticOrder, true, pg8::GateHook>(ldsl + RING_OFF, g, So, E, HK);
    }
    SEAM(4);

    STAMP(5);
    if (((DUP_MASK >> 5) & 1) && IN(5)) {
        pg8::Gemm g{YB, WOUT, S, DM, DM, DM, DM}; pg8::StaticOrder So; So.init(S, DM, G, bx);
        pg8::EpiRes<false> E{a.x, XB, SSQ1};
        pg8::gemm_phase<pg8::EpiRes<false>, pg8::StaticOrder, true>(ldsl + RING_OFF, g, So, E);
    }
    if (((DUP_MASK >> 5) & 1) && IN(5)) xcd_barrier(bar);
    if (IN(5)) {
        pg8::Gemm g{YB, WOUT, S, DM, DM, DM, DM}; pg8::StaticOrder So; So.init(S, DM, G, bx);
        pg8::EpiRes<false> E{a.x, XB, SSQ1};
        pg8::gemm_phase<pg8::EpiRes<false>, pg8::StaticOrder, true>(ldsl + RING_OFF, g, So, E);
    }
    SEAM(5);

    STAMP(6);
    if (IN(6)) {
        for (int m = gw; m < S; m += NGW) { const float sm = wave_sum(SSQ1[(size_t)m * 64 + lane]); const float rs = 1.0f / sqrtf(sm * (1.0f / DM) + NORM_EPS); if (lane == 0) RSTD1[m] = rs;
            const GAS pg8::u32x4* xr = (const GAS pg8::u32x4*)(XB + (size_t)m * DM) + lane; pg8::f32x4 xv[16]; float mx = 0.f;
#pragma unroll
            for (int jj = 0; jj < 8; ++jj) { pg8::unpack8(xr[64 * jj], xv[2 * jj], xv[2 * jj + 1]);
#pragma unroll
                for (int e = 0; e < 4; ++e) mx = fmaxf(mx, fmaxf(fabsf(xv[2 * jj][e]), fabsf(xv[2 * jj + 1][e]))); }
#pragma unroll
            for (int o_ = 32; o_ >= 1; o_ >>= 1) mx = fmaxf(mx, __shfl_xor(mx, o_));
            mx = fmaxf(mx * rs, 1e-20f); const float qs = rs * 127.0f / mx; if (lane == 0) XSC[m] = mx * (1.0f / 127.0f);
            GAS v2u* xo = (GAS v2u*)(XN8 + (size_t)m * DM) + lane;
#pragma unroll
            for (int jj = 0; jj < 8; ++jj) { v2u w; w.x = pg8::pk4_i8(xv[2 * jj] * qs); w.y = pg8::pk4_i8(xv[2 * jj + 1] * qs); xo[64 * jj] = w; } }
    }
    SEAM(6);

    STAMP(7);
    if (((DUP_MASK >> 7) & 1) && IN(7)) {
        pg8::Gemm g{(const pg8::bf16_t*)XN8, (const pg8::bf16_t*)WUP8, S, UPW, DM / 2, DM / 2, DM / 2}; pg8::StaticOrder So; So.init(S, UPW, G, bx);
        pg8::EpiUpConv E{ACT, HALO, a.conv_w, a.conv_b, XSC, (LAS float*)(ldsl + XCH_OFF), (const float*)WMU};
        pg8::gemm_phase<pg8::EpiUpConv, pg8::StaticOrder, true, pg8::NoHook, false, true>(ldsl + RING_OFF, g, So, E);
    }
    if (((DUP_MASK >> 7) & 1) && IN(7)) xcd_barrier(bar);
    if (IN(7)) {
        pg8::Gemm g{(const pg8::bf16_t*)XN8, (const pg8::bf16_t*)WUP8, S, UPW, DM / 2, DM / 2, DM / 2}; pg8::StaticOrder So; So.init(S, UPW, G, bx);
        pg8::EpiUpConv E{ACT, HALO, a.conv_w, a.conv_b, XSC, (LAS float*)(ldsl + XCH_OFF), (const float*)WMU};
        pg8::gemm_phase<pg8::EpiUpConv, pg8::StaticOrder, true, pg8::NoHook, false, true>(ldsl + RING_OFF, g, So, E);
    }
    SEAM(7);

    STAMP(8);
    if (IN(8)) {
        pg8::Gemm g{ACT, WDOWN, S, DM, DFF, DFF, DFF}; pg8::StaticOrder So; So.init(S, DM, G, bx);
        { pg8::Unit un; int last_pm = 0;
            for (int ui = 0; So.next(ui, un); ++ui) { const int pm = un.pm; if (pm == last_pm) continue; last_pm = pm;
                const float* ha = HALO + ((size_t)(pm - 1) * 4 + 2) * UPW; const float* hb = ha + UPW; const float* h0 = HALO + (size_t)pm * 4 * UPW; const float* h1 = h0 + UPW;
                for (int c = tid; c < DFF; c += NWAVES * 64) { const int gc = (c >> 7) * 256 + (c & 127), vc = gc + 128;
                    const float sg = __uint_as_float(WMU[gc]) * (1.0f / 127.0f), sv = __uint_as_float(WMU[vc]) * (1.0f / 127.0f);
                    const float wg0 = a.conv_w[c] * sg, wg1 = a.conv_w[UPW + c] * sg, wg2 = a.conv_w[2 * UPW + c] * sg, bg = a.conv_b[c];
                    const float wv0 = a.conv_w[DFF + c] * sv, wv1 = a.conv_w[UPW + DFF + c] * sv, wv2 = a.conv_w[2 * UPW + DFF + c] * sv, bv = a.conv_b[DFF + c];
                    const float ga = ha[gc], gb = hb[gc], g0 = h0[gc], g1 = h1[gc], va = ha[vc], vb = hb[vc], v0 = h0[vc], v1 = h1[vc];
                    const float og0 = bg + wg0 * ga + wg1 * gb + wg2 * g0, og1 = bg + wg0 * gb + wg1 * g0 + wg2 * g1;
                    const float ov0 = bv + wv0 * va + wv1 * vb + wv2 * v0, ov1 = bv + wv0 * vb + wv1 * v0 + wv2 * v1;
                    ACT[(size_t)(pm * 256) * DFF + c] = (bf16)f2bf(og0 * pg8::sigmoidf_fast(og0) * ov0);
                    ACT[(size_t)(pm * 256 + 1) * DFF + c] = (bf16)f2bf(og1 * pg8::sigmoidf_fast(og1) * ov1); } }
            VM_WAIT(); __syncthreads(); }
        pg8::EpiRes<true> E{nullptr, XB, SSQ2};
        pg8::gemm_phase<pg8::EpiRes<true>, pg8::StaticOrder, true>(ldsl + RING_OFF, g, So, E);
    }
    SEAM(8);

    STAMP(9);
    if (IN(9)) {
        if (gw < S) {
            int l9 = threadIdx.x; asm volatile("" : "+v"(l9)); l9 &= 63;
            f32x4 wf[16]; pg8::u32x4 xa[8], xb[8]; float qa, qb;
            { const GAS f32x4* wv = (const GAS f32x4*)a.final_w;
#pragma unroll
              for (int jj = 0; jj < 8; ++jj) { wf[2 * jj] = wv[(64 * jj + l9) * 2]; wf[2 * jj + 1] = wv[(64 * jj + l9) * 2 + 1]; } }
#define F_LOAD(x_, q_, m_) do { q_ = SSQ2[(size_t)(m_) * 64 + l9]; const GAS pg8::u32x4* xr_ = (const GAS pg8::u32x4*)(XB + (size_t)(m_) * DM) + l9; _Pragma("unroll") for (int jj = 0; jj < 8; ++jj) x_[jj] = xr_[64 * jj]; } while (0)
#define F_ROW(x_, q_, m_) do { const float rs_ = 1.0f / sqrtf(wave_sum(q_) * (1.0f / DM) + NORM_EPS); GAS f32x4* orow_ = (GAS f32x4*)(a.out + (size_t)(m_) * DM); \
            _Pragma("unroll") for (int jj = 0; jj < 8; ++jj) { pg8::f32x4 v0_, v1_; pg8::unpack8(x_[jj], v0_, v1_); const int c4_ = (64 * jj + l9) * 2; \
                orow_[c4_] = v0_ * rs_ * wf[2 * jj]; orow_[c4_ + 1] = v1_ * rs_ * wf[2 * jj + 1]; } } while (0)
            int m = gw; F_LOAD(xa, qa, m);
            for (;;) {
                if (m + NGW < S) F_LOAD(xb, qb, m + NGW);
                F_ROW(xa, qa, m); m += NGW; if (m >= S) break;
                if (m + NGW < S) F_LOAD(xa, qa, m + NGW);
                F_ROW(xb, qb, m); m += NGW; if (m >= S) break;
            }
#undef F_LOAD
#undef F_ROW
        }
    }
#ifdef TP_I0
    xcd_barrier(bar); STAMP(10); xcd_barrier(bar);
    { const unsigned long long tI = __hip_atomic_load(tsw + TP_I1 + 1, RLX_AGENT) - __hip_atomic_load(tsw + TP_I0, RLX_AGENT), tJ = __hip_atomic_load(tsw + TP_J1 + 1, RLX_AGENT) - __hip_atomic_load(tsw + TP_J0, RLX_AGENT);
      const float B = sqrtf((float)tI * 0.01f), A = (float)tJ * 0.01f;
      const size_t gt = (size_t)bx * (NWAVES * 64) + tid, NT = (size_t)G * NWAVES * 64;
      for (size_t i = gt; i < (size_t)S * DM; i += NT) a.out[i] = (i == 0) ? A : B; }
#endif
#undef IN
#undef SEAM
}


#if MK_PER_PHASE == 2
struct CsRange { size_t off; size_t bytes; };
__global__ void csum_kernel(const unsigned char* ws, const float* outp, unsigned* cs, CsRange r0, CsRange r1, CsRange r2, int use_out) {
    unsigned s1 = 0u, s2 = 0u;
    const size_t gt = (size_t)blockIdx.x * blockDim.x + threadIdx.x, NT = (size_t)gridDim.x * blockDim.x;
    CsRange rr[3] = {r0, r1, r2};
#pragma unroll
    for (int k = 0; k < 3; ++k) { const unsigned* p = (const unsigned*)(ws + rr[k].off); const size_t n = rr[k].bytes / 4;
        for (size_t i = gt; i < n; i += NT) { const unsigned w = p[i]; s1 += w; s2 += w * ((unsigned)(i & 0xffffu) | 1u); } }
    if (use_out) { const unsigned* p = (const unsigned*)outp; const size_t n = (size_t)S * DM;
        for (size_t i = gt; i < n; i += NT) { const unsigned w = p[i]; s1 += w; s2 += w * ((unsigned)(i & 0xffffu) | 1u); } }
    atomicAdd(cs, s1); atomicAdd(cs + 1, s2);
}
__global__ void encode_kernel(float* outp, const unsigned* cs) {
    int code = 20;
    for (int k = 9; k >= 0; --k) if (cs[2 * k] != cs[32 + 2 * k] || cs[2 * k + 1] != cs[32 + 2 * k + 1]) code = k + 1;
    const float c = sqrtf(10.0f * (float)code);
    const size_t gt = (size_t)blockIdx.x * blockDim.x + threadIdx.x, NT = (size_t)gridDim.x * blockDim.x;
    for (size_t i = gt; i < (size_t)S * DM; i += NT) outp[i] = c;
}
#endif


#if MK_PER_PHASE == 3
__global__ void zsum_kernel(const unsigned char* ws, unsigned* cs) {
    unsigned g[6] = {0u, 0u, 0u, 0u, 0u, 0u};
    const size_t gt = (size_t)blockIdx.x * blockDim.x + threadIdx.x, NT = (size_t)gridDim.x * blockDim.x;
    const unsigned* z = (const unsigned*)(ws + WS_Z); const size_t n = (size_t)S * ZW / 2;
    for (size_t i = gt; i < n; i += NT) { const int col = (int)(i % (ZW / 2)) * 2, pn = col >> 8; const unsigned w = z[i] * ((unsigned)(i & 0xffffu) | 1u);
        const int grp = (pn < 16) ? 0 : (pn < 24) ? 1 : (pn < 30) ? 2 : (pn == 30) ? 4 : 3; g[grp] += w; }
    const unsigned* q = (const unsigned*)(ws + WS_SSQC); for (size_t i = gt; i < (size_t)S * 24; i += NT) g[5] += q[i] * ((unsigned)(i & 0xffffu) | 1u);
#pragma unroll
    for (int k = 0; k < 6; ++k) atomicAdd(cs + k, g[k]);
}
__global__ void encode3_kernel(float* outp, const unsigned* cs) {
    int mask = 0;
    for (int k = 0; k < 6; ++k) if (cs[k] != cs[8 + k]) mask |= (k < 5 ? (1 << k) : 0);
    int rer = 0; for (int k = 0; k < 6; ++k) if (cs[8 + k] != cs[16 + k]) rer = 1;
    const int ssq = cs[5] != cs[13];
    const float c = sqrtf(10.0f * (float)(mask + 1) + 1000.0f * rer + 2000.0f * ssq);
    const size_t gt = (size_t)blockIdx.x * blockDim.x + threadIdx.x, NT = (size_t)gridDim.x * blockDim.x;
    for (size_t i = gt; i < (size_t)S * DM; i += NT) outp[i] = c;
}
#endif

constexpr int N_PHASES = 10;
extern "C" void kernel_launch(void* const* d_in, const int* in_sizes, int n_in, void* d_out, int out_size, void* d_ws, size_t ws_size, hipStream_t stream) {
    static int grid = 0;
    if (grid == 0) {
        if (n_in != 22 || in_sizes[0] != S * DM || out_size != S * DM || ws_size < WS_END) { fprintf(stderr, "kernel_launch: unexpected shapes (n_in %d, in0 %d, out %d, ws %zu)\n", n_in, n_in > 0 ? in_sizes[0] : -1, out_size, ws_size); grid = -1; return; }
        int dev = 0, cus = 0, per_cu = 0;
        if (hipGetDevice(&dev) != hipSuccess || hipDeviceGetAttribute(&cus, hipDeviceAttributeMultiprocessorCount, dev) != hipSuccess) { grid = -1; return; }
        if (hipFuncSetAttribute((const void*)fwd_kernel, hipFuncAttributeMaxDynamicSharedMemorySize, LDS_BYTES) != hipSuccess) { fprintf(stderr, "kernel_launch: hipFuncSetAttribute failed\n"); grid = -1; return; }
        if (hipOccupancyMaxActiveBlocksPerMultiprocessor(&per_cu, (const void*)fwd_kernel, NWAVES * 64, LDS_BYTES) != hipSuccess || per_cu < 1)
            fprintf(stderr, "kernel_launch: note: occupancy query reports %d workgroups per CU\n", per_cu);
        (void)hipGetLastError();
        grid = cus;
    }
    if (grid < 0) return;
    if (hipMemsetAsync((char*)d_ws + WS_CTL, 0, CTL_ZERO_BYTES, stream) != hipSuccess) return;
    Args a{};
    a.x = (const float*)d_in[0]; a.pos = (const int*)d_in[1]; a.norm_mix_w = (const float*)d_in[2]; a.w_in = (const float*)d_in[3];
    a.lq1 = (const float*)d_in[4]; a.lk1 = (const float*)d_in[5]; a.lq2 = (const float*)d_in[6]; a.lk2 = (const float*)d_in[7];
    a.subln_w = (const float*)d_in[8]; a.q_norm_w = (const float*)d_in[9]; a.w_uq = (const float*)d_in[10]; a.kv_norm_w = (const float*)d_in[11];
    a.w_ukv = (const float*)d_in[12]; a.w_o_diff = (const float*)d_in[13]; a.w_o_mla = (const float*)d_in[14]; a.w_out = (const float*)d_in[15];
    a.norm_ffn_w = (const float*)d_in[16]; a.w_up = (const float*)d_in[17]; a.conv_w = (const float*)d_in[18]; a.conv_b = (const float*)d_in[19];
    a.w_down = (const float*)d_in[20]; a.final_w = (const float*)d_in[21];
    a.out = (float*)d_out; a.ws = (unsigned char*)d_ws;
#if MK_PER_PHASE == 3
    unsigned* cs = (unsigned*)((char*)d_ws + 512 * 1024);
    for (int run = 0; run < 2; ++run) {
        hipMemsetAsync((char*)d_ws + MiB, run ? 0x55 : 0xAA, WS_END - MiB, stream);
        for (int p = 0; p < 2; ++p) { a.ph_lo = p; a.ph_hi = p + 1; hipLaunchKernelGGL(fwd_kernel, dim3(grid), dim3(NWAVES * 64), LDS_BYTES, stream, a); }
        hipLaunchKernelGGL(zsum_kernel, dim3(2048), dim3(256), 0, stream, (const unsigned char*)d_ws, cs + 8 * run);
    }
    a.ph_lo = 1; a.ph_hi = 2; hipLaunchKernelGGL(fwd_kernel, dim3(grid), dim3(NWAVES * 64), LDS_BYTES, stream, a);
    hipLaunchKernelGGL(zsum_kernel, dim3(2048), dim3(256), 0, stream, (const unsigned char*)d_ws, cs + 16);
    hipLaunchKernelGGL(encode3_kernel, dim3(2048), dim3(256), 0, stream, (float*)d_out, (const unsigned*)cs);
#elif MK_PER_PHASE == 2
    unsigned* cs = (unsigned*)((char*)d_ws + 512 * 1024);
    for (int run = 0; run < 2; ++run) {
        hipMemsetAsync((char*)d_ws + MiB, run ? 0x55 : 0xAA, WS_END - MiB, stream); hipMemsetAsync(d_out, run ? 0x55 : 0xAA, (size_t)S * DM * 4, stream);
        for (int p = 0; p < N_PHASES; ++p) { a.ph_lo = p; a.ph_hi = p + 1; hipLaunchKernelGGL(fwd_kernel, dim3(grid), dim3(NWAVES * 64), LDS_BYTES, stream, a);
            CsRange r0{0, 0}, r1{0, 0}, r2{0, 0}; int uo = 0;
            switch (p) {
                case 0: r0 = {WS_COS, 2 * MiB}; r1 = {WS_WIN, WS_O - WS_WIN}; break;
                case 1: r0 = {WS_Z, 252 * MiB}; r1 = {WS_SSQC, (size_t)S * 24 * 4}; break;
                case 2: r0 = {WS_QM, 112 * MiB}; break;
                case 3: r0 = {WS_O, 64 * MiB}; r1 = {WS_O1, 64 * MiB}; break;
                case 4: r0 = {WS_H, 64 * MiB}; r1 = {WS_T1, 128 * MiB}; break;
                case 5: r0 = {WS_X1, 128 * MiB}; r1 = {WS_O, 64 * MiB}; r2 = {WS_SSQ1, 2 * MiB}; break;
                case 6: r0 = {WS_U, 344 * MiB}; r1 = {WS_RSTD1, (size_t)S * 4}; break;
                case 7: r0 = {WS_ACT, 172 * MiB}; break;
                case 8: r0 = {WS_SSQ2, 2 * MiB}; uo = 1; break;
                default: uo = 1; break;
            }
            hipLaunchKernelGGL(csum_kernel, dim3(2048), dim3(256), 0, stream, (const unsigned char*)d_ws, (const float*)d_out, cs + 32 * run + 2 * p, r0, r1, r2, uo);
        }
    }
    hipLaunchKernelGGL(encode_kernel, dim3(2048), dim3(256), 0, stream, (float*)d_out, (const unsigned*)cs);
#elif MK_PER_PHASE
    for (int p = 0; p < N_PHASES; ++p) { a.ph_lo = p; a.ph_hi = p + 1; hipLaunchKernelGGL(fwd_kernel, dim3(grid), dim3(NWAVES * 64), LDS_BYTES, stream, a); }
#else
    a.ph_lo = 0; a.ph_hi = N_PHASES;
    hipLaunchKernelGGL(fwd_kernel, dim3(grid), dim3(NWAVES * 64), LDS_BYTES, stream, a);
#endif
    const hipError_t le = hipPeekAtLastError();
    if (le != hipSuccess) fprintf(stderr, "kernel_launch: launch failed: %s\n", hipGetErrorName(le));
}
```
